# Optimizing an MI355X kernel written in HIP

```python
import jax
import jax.numpy as jnp
from jax import lax
import numpy as np

D_MODEL = 1024
BATCH = 16
SEQ = 256
DEPTH = 4
DEC_BATCH = 8
DEC_SEQ = 4096
PAST_LEN = 256

GRID_W = 64
N_EVEN = (DEPTH + 1) // 2
N_ODD = DEPTH // 2
EPS = 1e-6

GDN_HEADS = 4
GDN_DK = 128
GDN_DV = 128
GDN_CONV = 3
GDN_CHUNK = 64
A_QK = GDN_HEADS * GDN_DK
A_V = GDN_HEADS * GDN_DV
A_CONV = 2 * A_QK + A_V
FNET_GROUPS = 4
FNET_GROUP_DIM = 128
B_W = FNET_GROUPS * FNET_GROUP_DIM
EVEN_IN = A_CONV + A_V + 4 * GDN_HEADS + B_W
EVEN_MIX = A_V + B_W
MLA_HEADS = 8
MLA_Q_LORA = 512
MLA_KV_LORA = 256
MLA_NOPE = 128
MLA_ROPE = 64
MLA_V = 128
MLA_QK = MLA_NOPE + MLA_ROPE
ODD_IN = MLA_Q_LORA + MLA_KV_LORA + MLA_ROPE
ROPE_BASE = 10000.0
Q_BLOCK = 128
PEER_HEADS = 8
PEER_NKEYS = 128
PEER_EXPERTS = PEER_NKEYS * PEER_NKEYS
PEER_DQ = 256
PEER_HALF = PEER_DQ // 2
PEER_TOPK = 16
PEER_BLOCK = 128

kernel_name = 'gdn_fnet_mla_peer_flow_step'


def rmsnorm(x, w):
    xf = x.astype(jnp.float32)
    y = xf * lax.rsqrt(jnp.mean(xf * xf, -1, keepdims=True) + EPS)
    return (y * w.astype(jnp.float32)).astype(x.dtype)


def l2norm(x):
    xf = x.astype(jnp.float32)
    return (xf * lax.rsqrt(jnp.sum(xf * xf, -1, keepdims=True) + EPS)).astype(x.dtype)


def ada_mods(cvec, w_mod, b_mod):
    m = (jax.nn.silu(cvec) @ w_mod + b_mod)[:, None, :]
    return jnp.split(m, 6, axis=-1)


def short_conv(x, w):
    pad = (GDN_CONV - 1) // 2
    L = x.shape[1]
    xp = jnp.pad(x, ((0, 0), (pad, pad), (0, 0)))
    y = xp[:, 0:L] * w[0]
    for i in range(1, GDN_CONV):
        y = y + xp[:, i:i + L] * w[i]
    return jax.nn.silu(y)


def gdn_chunked(q, k, v, g, beta, s0):
    f32 = jnp.float32
    B, L, H, DK = q.shape
    DV = v.shape[-1]
    C = GDN_CHUNK
    N = L // C
    qc = q.astype(f32).reshape(B, N, C, H, DK).transpose(1, 0, 3, 2, 4) * (DK ** -0.5)
    kc = k.astype(f32).reshape(B, N, C, H, DK).transpose(1, 0, 3, 2, 4)
    vc = v.astype(f32).reshape(B, N, C, H, DV).transpose(1, 0, 3, 2, 4)
    gc = jnp.cumsum(g.astype(f32).reshape(B, N, C, H).transpose(1, 0, 3, 2), axis=-1)
    bc = beta.astype(f32).reshape(B, N, C, H).transpose(1, 0, 3, 2)
    tri = jnp.tril(jnp.ones((C, C), bool))
    strict = jnp.tril(jnp.ones((C, C), bool), -1)
    decay = jnp.exp(jnp.where(tri, gc[..., :, None] - gc[..., None, :], -jnp.inf))
    kb = kc * bc[..., None]
    a = jnp.where(strict, jnp.einsum('nbhid,nbhjd->nbhij', kb, kc) * decay, 0.0)
    rhs = jnp.concatenate([vc * bc[..., None], kb * jnp.exp(gc)[..., None]], -1)
    sol = lax.linalg.triangular_solve(a, rhs, left_side=True, lower=True, unit_diagonal=True)
    u = sol[..., :DV]
    w = sol[..., DV:]
    qk = jnp.einsum('nbhid,nbhjd->nbhij', qc, kc) * decay

    def step(S, xs):
        q_i, k_i, u_i, w_i, g_i, qk_i = xs
        v_new = u_i - jnp.einsum('bhcd,bhde->bhce', w_i, S)
        o_i = (jnp.einsum('bhcd,bhde->bhce', q_i * jnp.exp(g_i)[..., None], S)
               + jnp.einsum('bhij,bhje->bhie', qk_i, v_new))
        g_last = g_i[..., -1:]
        S = (S * jnp.exp(g_last)[..., None]
             + jnp.einsum('bhcd,bhce->bhde', k_i * jnp.exp(g_last - g_i)[..., None], v_new))
        return S, o_i

    S, o = lax.scan(step, s0.astype(f32), (qc, kc, u, w, gc, qk))
    o = o.transpose(1, 0, 3, 2, 4).reshape(B, L, H, DV)
    return o.astype(q.dtype), S


def even_mixer(h, s_fwd, s_bwd, w_in, conv_w, a_log, dt_bias, o_norm_w, w_out):
    f32 = jnp.float32
    B, L, _ = h.shape
    p = h @ w_in
    qkv = short_conv(p[..., :A_CONV], conv_w)
    q = l2norm(qkv[..., :A_QK].reshape(B, L, GDN_HEADS, GDN_DK))
    k = l2norm(qkv[..., A_QK:2 * A_QK].reshape(B, L, GDN_HEADS, GDN_DK))
    v = qkv[..., 2 * A_QK:].reshape(B, L, GDN_HEADS, GDN_DV)
    gate = p[..., A_CONV:A_CONV + A_V].reshape(B, L, GDN_HEADS, GDN_DV)
    off = A_CONV + A_V
    ba = p[..., off:off + 4 * GDN_HEADS].astype(f32).reshape(B, L, 4, GDN_HEADS)
    beta = jax.nn.sigmoid(ba[:, :, :2])
    g = -jnp.exp(a_log.astype(f32)) * jax.nn.softplus(ba[:, :, 2:] + dt_bias.astype(f32))
    flip = lambda t: jnp.flip(t, 1)
    o_f, s_fwd = gdn_chunked(q, k, v, g[:, :, 0], beta[:, :, 0], s_fwd)
    o_b, s_bwd = gdn_chunked(flip(q), flip(k), flip(v), flip(g[:, :, 1]), flip(beta[:, :, 1]), s_bwd)
    o = o_f + flip(o_b)
    o = rmsnorm(o, o_norm_w) * jax.nn.silu(gate)
    xb = p[..., off + 4 * GDN_HEADS:].reshape(B, L, FNET_GROUPS, FNET_GROUP_DIM)
    fb = jnp.fft.fft2(xb.astype(f32), axes=(1, 3), norm='ortho').real.astype(h.dtype)
    mix = jnp.concatenate([o.reshape(B, L, A_V), fb.reshape(B, L, B_W)], -1)
    return mix @ w_out, s_fwd, s_bwd


def axial_angles(L):
    f32 = jnp.float32
    rows = L // GRID_W
    row = jnp.repeat(jnp.arange(rows, dtype=f32), GRID_W)
    col = jnp.tile(jnp.arange(GRID_W, dtype=f32), rows)
    n = MLA_ROPE // 4
    inv = jnp.power(ROPE_BASE, -jnp.arange(n, dtype=f32) / n)
    return row[:, None] * inv, col[:, None] * inv


def rotate(x, ang):
    n = x.shape[-1] // 2
    cos = jnp.cos(ang)[None, :, None, :]
    sin = jnp.sin(ang)[None, :, None, :]
    x1 = x[..., :n].astype(jnp.float32)
    x2 = x[..., n:].astype(jnp.float32)
    return jnp.concatenate([x1 * cos - x2 * sin, x1 * sin + x2 * cos], -1)


def rope_latent(x, ang_r, ang_c):
    half = MLA_ROPE // 2
    xr = x[..., MLA_NOPE:]
    rot = jnp.concatenate([rotate(xr[..., :half], ang_r), rotate(xr[..., half:], ang_c)], -1)
    return jnp.concatenate([x[..., :MLA_NOPE], rot.astype(x.dtype)], -1)


def mla_compress(h, w_in, q_norm_w, kv_norm_w):
    p = h @ w_in
    cq = rmsnorm(p[..., :MLA_Q_LORA], q_norm_w)
    ckv = rmsnorm(p[..., MLA_Q_LORA:MLA_Q_LORA + MLA_KV_LORA], kv_norm_w)
    kr = p[..., MLA_Q_LORA + MLA_KV_LORA:]
    return cq, ckv, kr


def mla_queries(cq, w_uq, qn_w):
    B, L, _ = cq.shape
    return rmsnorm((cq @ w_uq).reshape(B, L, MLA_HEADS, MLA_QK), qn_w)


def mla_keys_values(ckv, kr, w_ukv, kn_w):
    B, L, _ = ckv.shape
    kv = (ckv @ w_ukv).reshape(B, L, MLA_HEADS, MLA_NOPE + MLA_V)
    k_rope = jnp.broadcast_to(kr[:, :, None, :], (B, L, MLA_HEADS, MLA_ROPE))
    k = rmsnorm(jnp.concatenate([kv[..., :MLA_NOPE], k_rope], -1), kn_w)
    return k, kv[..., MLA_NOPE:]


def attend(q, k, v):
    B, Lq, H, dq = q.shape
    dv = v.shape[-1]
    nb = Lq // Q_BLOCK
    qb = q.reshape(B, nb, Q_BLOCK, H, dq).transpose(1, 0, 2, 3, 4)
    scale = dq ** -0.5

    def one(qi):
        s = jnp.einsum('bqhd,bkhd->bhqk', qi, k).astype(jnp.float32) * scale
        p = jax.nn.softmax(s, -1).astype(v.dtype)
        return jnp.einsum('bhqk,bkhd->bqhd', p, v)

    o = lax.map(one, qb)
    return o.transpose(1, 0, 2, 3, 4).reshape(B, Lq, H * dv)


def peer(h, w_q, sub_keys, u_tab, v_tab):
    B, L, D = h.shape
    x = h.reshape(-1, D)
    nb = x.shape[0] // PEER_BLOCK
    K = PEER_TOPK

    def block(xb):
        T = xb.shape[0]
        q = (xb @ w_q).reshape(T, PEER_HEADS, 2, PEER_HALF)
        s = jnp.einsum('thpd,hpkd->thpk', q, sub_keys).astype(jnp.float32)
        sv, si = lax.top_k(s, K)
        cand = (sv[:, :, 0, :, None] + sv[:, :, 1, None, :]).reshape(T, PEER_HEADS, K * K)
        cidx = (si[:, :, 0, :, None] * PEER_NKEYS + si[:, :, 1, None, :]).reshape(T, PEER_HEADS, K * K)
        cs, ci = lax.top_k(cand, K)
        eidx = jnp.take_along_axis(cidx, ci, -1)
        gate = jax.nn.softmax(cs, -1)
        act = jax.nn.gelu(jnp.einsum('thkd,td->thk', u_tab[eidx], xb).astype(jnp.float32))
        return jnp.einsum('thk,thkd->td', (gate * act).astype(xb.dtype), v_tab[eidx])

    y = lax.map(block, x.reshape(nb, PEER_BLOCK, D))
    return y.reshape(B, L, D)


def setup_inputs(seed: int = 0) -> dict:
    key = jax.random.key(seed)
    ks = jax.random.split(key, 30)
    f32 = jnp.float32
    D = D_MODEL

    def nrm(k, shape, scale):
        return jax.random.normal(k, shape, f32) * scale

    def gain(k, shape):
        return 1.0 + 0.05 * jax.random.normal(k, shape, f32)

    col_scale = jnp.concatenate([
        jnp.ones((A_CONV + A_V + 2 * GDN_HEADS,), f32),
        jnp.full((2 * GDN_HEADS,), 0.1, f32),
        jnp.ones((B_W,), f32)])
    dt = jnp.exp(jax.random.uniform(ks[14], (N_EVEN, 2, GDN_HEADS), f32,
                                    float(np.log(0.001)), float(np.log(0.1))))
    return {
        'x_prompt': nrm(ks[0], (BATCH, SEQ, D), 1.0),
        'x_sample': nrm(ks[1], (DEC_BATCH, DEC_SEQ, D), 1.0),
        'state_gdn': nrm(ks[2], (DEC_BATCH, N_EVEN, 2, GDN_HEADS, GDN_DK, GDN_DV), GDN_DK ** -0.5),
        'cache_mla_ckv': nrm(ks[3], (DEC_BATCH, N_ODD, PAST_LEN, MLA_KV_LORA), 1.0),
        'cache_mla_krope': nrm(ks[4], (DEC_BATCH, N_ODD, PAST_LEN, MLA_ROPE), 1.0),
        'c': nrm(ks[5], (DEC_BATCH, D), 1.0),
        'c_ctx': nrm(ks[6], (D,), 1.0),
        'w_mod': nrm(ks[7], (DEPTH, D, 6 * D), 0.5 * D ** -0.5),
        'b_mod': nrm(ks[8], (DEPTH, 6 * D), 0.02),
        'norm_mix': gain(ks[9], (DEPTH, D)),
        'norm_ffn': gain(ks[10], (DEPTH, D)),
        'even_w_in': nrm(ks[11], (N_EVEN, D, EVEN_IN), D ** -0.5) * col_scale,
        'even_conv_w': nrm(ks[12], (N_EVEN, GDN_CONV, A_CONV), GDN_CONV ** -0.5),
        'gdn_a_log': jnp.log(jax.random.uniform(ks[13], (N_EVEN, 2, GDN_HEADS), f32, 1.0, 16.0)),
        'gdn_dt_bias': dt + jnp.log(-jnp.expm1(-dt)),
        'gdn_o_norm': gain(ks[15], (N_EVEN, GDN_DV)),
        'even_w_out': nrm(ks[16], (N_EVEN, EVEN_MIX, D), EVEN_MIX ** -0.5),
        'odd_w_in': nrm(ks[17], (N_ODD, D, ODD_IN), D ** -0.5),
        'mla_q_norm': gain(ks[18], (N_ODD, MLA_Q_LORA)),
        'mla_kv_norm': gain(ks[19], (N_ODD, MLA_KV_LORA)),
        'mla_w_uq': nrm(ks[20], (N_ODD, MLA_Q_LORA, MLA_HEADS * MLA_QK), MLA_Q_LORA ** -0.5),
        'mla_w_ukv': nrm(ks[21], (N_ODD, MLA_KV_LORA, MLA_HEADS * (MLA_NOPE + MLA_V)), MLA_KV_LORA ** -0.5),
        'mla_q_headnorm': gain(ks[22], (N_ODD, MLA_QK)),
        'mla_k_headnorm': gain(ks[23], (N_ODD, MLA_QK)),
        'odd_w_out': nrm(ks[24], (N_ODD, MLA_HEADS * MLA_V, D), (MLA_HEADS * MLA_V) ** -0.5),
        'peer_w_q': nrm(ks[25], (DEPTH, D, PEER_HEADS * PEER_DQ), D ** -0.5),
        'peer_sub_keys': nrm(ks[26], (DEPTH, PEER_HEADS, 2, PEER_NKEYS, PEER_HALF), PEER_HALF ** -0.5),
        'peer_u': nrm(ks[27], (DEPTH, PEER_EXPERTS, D), D ** -0.5),
        'peer_v': nrm(ks[28], (DEPTH, PEER_EXPERTS, D), PEER_HEADS ** -0.5),
    }


def reference(x_prompt, x_sample, state_gdn, cache_mla_ckv, cache_mla_krope, c, c_ctx,
              w_mod, b_mod, norm_mix, norm_ffn,
              even_w_in, even_conv_w, gdn_a_log, gdn_dt_bias, gdn_o_norm, even_w_out,
              odd_w_in, mla_q_norm, mla_kv_norm, mla_w_uq, mla_w_ukv, mla_q_headnorm, mla_k_headnorm, odd_w_out,
              peer_w_q, peer_sub_keys, peer_u, peer_v):
    xp, xs = x_prompt, x_sample
    ang_r, ang_c = axial_angles(xs.shape[1])
    c_ctx_b = c_ctx[None, :]
    new_gdn, new_ckv, new_kr = [], [], []
    for l in range(DEPTH):
        j = l // 2
        sh1p, sc1p, g1p, sh2p, sc2p, g2p = ada_mods(c_ctx_b, w_mod[l], b_mod[l])
        sh1s, sc1s, g1s, sh2s, sc2s, g2s = ada_mods(c, w_mod[l], b_mod[l])
        hp = rmsnorm(xp, norm_mix[l]) * (1 + sc1p) + sh1p
        hs = rmsnorm(xs, norm_mix[l]) * (1 + sc1s) + sh1s
        if l % 2 == 0:
            zero = jnp.zeros((xp.shape[0], GDN_HEADS, GDN_DK, GDN_DV), jnp.float32)
            yp, sf, sb = even_mixer(hp, zero, zero, even_w_in[j], even_conv_w[j], gdn_a_log[j],
                                    gdn_dt_bias[j], gdn_o_norm[j], even_w_out[j])
            ys, _, _ = even_mixer(hs, state_gdn[:, j, 0], state_gdn[:, j, 1], even_w_in[j], even_conv_w[j],
                                  gdn_a_log[j], gdn_dt_bias[j], gdn_o_norm[j], even_w_out[j])
            new_gdn.append(jnp.stack([sf, sb], 1).astype(xp.dtype))
        else:
            cq_p, ckv_p, kr_p = mla_compress(hp, odd_w_in[j], mla_q_norm[j], mla_kv_norm[j])
            q_p = mla_queries(cq_p, mla_w_uq[j], mla_q_headnorm[j])
            k_p, v_p = mla_keys_values(ckv_p, kr_p, mla_w_ukv[j], mla_k_headnorm[j])
            yp = attend(q_p, k_p, v_p) @ odd_w_out[j]
            new_ckv.append(ckv_p)
            new_kr.append(kr_p)
            cq_s, ckv_s, kr_s = mla_compress(hs, odd_w_in[j], mla_q_norm[j], mla_kv_norm[j])
            q_s = rope_latent(mla_queries(cq_s, mla_w_uq[j], mla_q_headnorm[j]), ang_r, ang_c)
            k_s, v_s = mla_keys_values(ckv_s, kr_s, mla_w_ukv[j], mla_k_headnorm[j])
            k_s = rope_latent(k_s, ang_r, ang_c)
            k_c, v_c = mla_keys_values(cache_mla_ckv[:, j], cache_mla_krope[:, j], mla_w_ukv[j], mla_k_headnorm[j])
            ys = attend(q_s, jnp.concatenate([k_s, k_c], 1), jnp.concatenate([v_s, v_c], 1)) @ odd_w_out[j]
        xp = xp + g1p * yp
        xs = xs + g1s * ys
        hp = rmsnorm(xp, norm_ffn[l]) * (1 + sc2p) + sh2p
        hs = rmsnorm(xs, norm_ffn[l]) * (1 + sc2s) + sh2s
        xp = xp + g2p * peer(hp, peer_w_q[l], peer_sub_keys[l], peer_u[l], peer_v[l])
        xs = xs + g2s * peer(hs, peer_w_q[l], peer_sub_keys[l], peer_u[l], peer_v[l])
    new_state_gdn = jnp.stack(new_gdn, 1)
    new_mla_ckv = jnp.stack(new_ckv, 1)
    new_mla_krope = jnp.stack(new_kr, 1)
    return (xp, xs, new_state_gdn, new_mla_ckv, new_mla_krope)
```

```cpp
#include <hip/hip_runtime.h>
#include <stdint.h>

typedef unsigned short bf16_t;
typedef short bf16x8 __attribute__((ext_vector_type(8)));
typedef float f32x4 __attribute__((ext_vector_type(4)));
typedef unsigned u32x4 __attribute__((ext_vector_type(4)));

#define T_TOK   36864
#define TP_TOK  4096
#define DM      1024
#define NTHREADS 512
#define N_EIN   3200
#define N_OIN   896
#define OUT_STATE 37748736L
#define OUT_CKV   41943040L
#define OUT_KR    44040192L

struct Params {
    const float *x_prompt, *x_sample, *state_gdn, *cache_ckv, *cache_kr, *c, *c_ctx, *w_mod, *b_mod, *norm_mix, *norm_ffn;
    const float *even_w_in, *even_conv_w, *gdn_a_log, *gdn_dt_bias, *gdn_o_norm, *even_w_out;
    const float *odd_w_in, *mla_q_norm, *mla_kv_norm, *mla_w_uq, *mla_w_ukv, *mla_q_headnorm, *mla_k_headnorm, *odd_w_out;
    const float *peer_w_q, *peer_sub_keys, *peer_u, *peer_v;
    float* out;
    unsigned* bar;
    float* mods;
    bf16_t *wtE_in, *wtE_out, *wtO_in, *wtUq, *wtUkv, *wtO_out, *wtPq, *subk, *dftS, *dftP, *tabU, *tabV;
    bf16_t* H;
    bf16_t *qkvraw, *gate, *ZtA, *qn, *kn, *Wb, *Ub, *QKb, *of, *ob, *mix;
    float *ba, *gcb;
    float *Podd, *kr_all;
    bf16_t *cq, *ckv_all, *Qb, *Kb, *Vtb, *Ob;
    bf16_t* qp;
    float *topv, *pgate;
    unsigned char* topi;
    int* eidx;
};

__device__ __forceinline__ bf16_t f2bf(float f) {
    unsigned u = __float_as_uint(f);
    u += 0x7FFFu + ((u >> 16) & 1u);
    return (bf16_t)(u >> 16);
}
__device__ __forceinline__ float bf2f(bf16_t h) { return __uint_as_float(((unsigned)h) << 16); }
__device__ __forceinline__ unsigned pack2(float lo, float hi) { return (unsigned)f2bf(lo) | ((unsigned)f2bf(hi) << 16); }
__device__ __forceinline__ float bflo(unsigned u) { return __uint_as_float(u << 16); }
__device__ __forceinline__ float bfhi(unsigned u) { return __uint_as_float(u & 0xFFFF0000u); }
__device__ __forceinline__ float silu_f(float x) { return x / (1.f + __expf(-x)); }
__device__ __forceinline__ float sigmoid_f(float x) { return 1.f / (1.f + __expf(-x)); }
__device__ __forceinline__ float softplus_f(float x) { return x > 20.f ? x : log1pf(__expf(x)); }
__device__ __forceinline__ float gelu_tanh(float x) {
    const float u = 0.7978845608028654f * (x + 0.044715f * x * x * x);
    return 0.5f * x * (1.f + tanhf(u));
}
__device__ __forceinline__ float wave_sum(float v) {
#pragma unroll
    for (int o = 32; o > 0; o >>= 1) v += __shfl_xor(v, o, 64);
    return v;
}
__device__ __forceinline__ int tok_modrow(int t) { return t < TP_TOK ? 0 : 1 + ((t - TP_TOK) >> 12); }
__device__ __forceinline__ int tok_seq0(int t) { return t < TP_TOK ? (t & ~255) : (TP_TOK + ((t - TP_TOK) & ~4095)); }
__device__ __forceinline__ int tok_len(int t) { return t < TP_TOK ? 256 : 4096; }

template <int MT, int NT>
__device__ __forceinline__ void wave_mma(f32x4 (&acc)[MT][NT], const bf16_t* A, int lda, const bf16_t* B, int ldb, int K) {
    const int lane = threadIdx.x & 63, r = lane & 15, kg = (lane >> 4) * 8;
#pragma unroll 1
    for (int k0 = 0; k0 < K; k0 += 32) {
        bf16x8 a[MT], b[NT];
#pragma unroll
        for (int m = 0; m < MT; ++m) a[m] = *(const bf16x8*)(A + (m * 16 + r) * lda + k0 + kg);
#pragma unroll
        for (int n = 0; n < NT; ++n) b[n] = *(const bf16x8*)(B + (n * 16 + r) * ldb + k0 + kg);
#pragma unroll
        for (int m = 0; m < MT; ++m)
#pragma unroll
            for (int n = 0; n < NT; ++n) acc[m][n] = __builtin_amdgcn_mfma_f32_16x16x32_bf16(a[m], b[n], acc[m][n], 0, 0, 0);
    }
}

#define GLD 72
#define GEMM_SMEM_BYTES (2 * (256 + 128) * GLD * 2)
template <class Epi>
__device__ __forceinline__ void gemm_tile(const bf16_t* __restrict__ A, long lda, const bf16_t* __restrict__ B, long ldb, int K, bf16_t* smem, Epi epi) {
    const int tid = threadIdx.x, lane = tid & 63, wave = tid >> 6;
    const int wm = wave >> 1, wn = wave & 1;
    bf16_t* As = smem;
    bf16_t* Bs = smem + 2 * 256 * GLD;
    f32x4 acc[4][4];
#pragma unroll
    for (int m = 0; m < 4; ++m)
#pragma unroll
        for (int n = 0; n < 4; ++n) acc[m][n] = (f32x4){0.f, 0.f, 0.f, 0.f};
    uint4 ra[4], rb[2];
    const int lrow = tid >> 3, lkc = (tid & 7) * 8;
    const bf16_t* ap = A + (long)lrow * lda + lkc;
    const bf16_t* bp = B + (long)lrow * ldb + lkc;
#pragma unroll
    for (int i = 0; i < 4; ++i) ra[i] = *(const uint4*)(ap + (long)i * 64 * lda);
#pragma unroll
    for (int i = 0; i < 2; ++i) rb[i] = *(const uint4*)(bp + (long)i * 64 * ldb);
#pragma unroll
    for (int i = 0; i < 4; ++i) *(uint4*)(As + (i * 64 + lrow) * GLD + lkc) = ra[i];
#pragma unroll
    for (int i = 0; i < 2; ++i) *(uint4*)(Bs + (i * 64 + lrow) * GLD + lkc) = rb[i];
    __syncthreads();
    const int nk = K >> 6;
    for (int kt = 0; kt < nk; ++kt) {
        const int cur = kt & 1;
        if (kt + 1 < nk) {
            const long k0 = (long)(kt + 1) * 64;
#pragma unroll
            for (int i = 0; i < 4; ++i) ra[i] = *(const uint4*)(ap + (long)i * 64 * lda + k0);
#pragma unroll
            for (int i = 0; i < 2; ++i) rb[i] = *(const uint4*)(bp + (long)i * 64 * ldb + k0);
        }
        const bf16_t* Ac = As + cur * 256 * GLD + (wm * 64) * GLD;
        const bf16_t* Bc = Bs + cur * 128 * GLD + (wn * 64) * GLD;
        wave_mma<4, 4>(acc, Ac, GLD, Bc, GLD, 32);
        wave_mma<4, 4>(acc, Ac + 32, GLD, Bc + 32, GLD, 32);
        if (kt + 1 < nk) {
            bf16_t* An = As + (cur ^ 1) * 256 * GLD;
            bf16_t* Bn = Bs + (cur ^ 1) * 128 * GLD;
#pragma unroll
            for (int i = 0; i < 4; ++i) *(uint4*)(An + (i * 64 + lrow) * GLD + lkc) = ra[i];
#pragma unroll
            for (int i = 0; i < 2; ++i) *(uint4*)(Bn + (i * 64 + lrow) * GLD + lkc) = rb[i];
        }
        __syncthreads();
    }
#pragma unroll
    for (int m = 0; m < 4; ++m)
#pragma unroll
        for (int n = 0; n < 4; ++n) epi(wm * 64 + m * 16 + (lane >> 4) * 4, wn * 64 + n * 16 + (lane & 15), acc[m][n]);
}
__device__ void conv_t(const float* __restrict__ src, int ldsrc, int Nvalid, int Nstore, int K, bf16_t* __restrict__ dst, float* ts) {
    const int tid = threadIdx.x;
    const int ntn = (Nstore + 63) / 64, ntk = K / 64;
    for (int tile = blockIdx.x; tile < ntn * ntk; tile += gridDim.x) {
        const int tn = tile % ntn, tk = tile / ntn;
        {
            const int kk = tid >> 3, n8 = (tid & 7) * 8;
#pragma unroll
            for (int i = 0; i < 8; ++i) {
                const int n = tn * 64 + n8 + i;
                ts[kk * 65 + n8 + i] = n < Nvalid ? src[(long)(tk * 64 + kk) * ldsrc + n] : 0.f;
            }
        }
        __syncthreads();
        {
            const int nn = tid >> 3, k8 = (tid & 7) * 8;
            const int n = tn * 64 + nn;
            if (n < Nstore) {
                uint4 v;
                v.x = pack2(ts[(k8 + 0) * 65 + nn], ts[(k8 + 1) * 65 + nn]);
                v.y = pack2(ts[(k8 + 2) * 65 + nn], ts[(k8 + 3) * 65 + nn]);
                v.z = pack2(ts[(k8 + 4) * 65 + nn], ts[(k8 + 5) * 65 + nn]);
                v.w = pack2(ts[(k8 + 6) * 65 + nn], ts[(k8 + 7) * 65 + nn]);
                *(uint4*)(dst + (long)n * K + tk * 64 + k8) = v;
            }
        }
        __syncthreads();
    }
}

__device__ void ph_init(const Params& p, char* smem) {
    const int tid = threadIdx.x, bid = blockIdx.x, nb = gridDim.x;
    {
        const float4* a = (const float4*)p.x_prompt;
        const float4* b = (const float4*)p.x_sample;
        float4* o = (float4*)p.out;
        const long na = (long)TP_TOK * DM / 4, ntot = (long)T_TOK * DM / 4;
        for (long i = (long)bid * NTHREADS + tid; i < ntot; i += (long)nb * NTHREADS) o[i] = i < na ? a[i] : b[i - na];
    }
    {
        float* sl = (float*)smem;
        float* part = sl + 9 * 1024;
        for (int i = tid; i < 9 * 1024; i += NTHREADS) {
            const int r = i >> 10, k = i & 1023;
            const float v = r == 0 ? p.c_ctx[k] : p.c[(r - 1) * 1024 + k];
            sl[i] = silu_f(v);
        }
        __syncthreads();
        for (int unit = bid; unit < 192; unit += nb) {
            const int l = unit / 48, cb = unit % 48;
            const int col = cb * 128 + (tid & 127), kq = tid >> 7;
            float acc[9];
#pragma unroll
            for (int r = 0; r < 9; ++r) acc[r] = 0.f;
            const float* wp = p.w_mod + ((long)l * 1024 + kq * 256) * 6144 + col;
            for (int k = 0; k < 256; ++k) {
                const float w = wp[(long)k * 6144];
#pragma unroll
                for (int r = 0; r < 9; ++r) acc[r] += sl[r * 1024 + kq * 256 + k] * w;
            }
#pragma unroll
            for (int r = 0; r < 9; ++r) part[(kq * 9 + r) * 128 + (tid & 127)] = acc[r];
            __syncthreads();
            if (tid < 128) {
#pragma unroll
                for (int r = 0; r < 9; ++r) {
                    const float s = part[(0 * 9 + r) * 128 + tid] + part[(1 * 9 + r) * 128 + tid] + part[(2 * 9 + r) * 128 + tid] + part[(3 * 9 + r) * 128 + tid];
                    p.mods[((long)l * 9 + r) * 6144 + col] = s + p.b_mod[l * 6144 + col];
                }
            }
            __syncthreads();
        }
    }
    {
        float* ts = (float*)smem;
        for (int j = 0; j < 2; ++j) {
            conv_t(p.even_w_in + (long)j * 1024 * 2576, 2576, 2064, 2064, 1024, p.wtE_in + (long)j * N_EIN * 1024, ts);
            conv_t(p.even_w_out + (long)j * 1024 * 1024, 1024, 1024, 1024, 1024, p.wtE_out + (long)j * 1024 * 1024, ts);
            conv_t(p.odd_w_in + (long)j * 1024 * 832, 832, 832, N_OIN, 1024, p.wtO_in + (long)j * N_OIN * 1024, ts);
            conv_t(p.mla_w_uq + (long)j * 512 * 1536, 1536, 1536, 1536, 512, p.wtUq + (long)j * 1536 * 512, ts);
            conv_t(p.mla_w_ukv + (long)j * 256 * 2048, 2048, 2048, 2048, 256, p.wtUkv + (long)j * 2048 * 256, ts);
            conv_t(p.odd_w_out + (long)j * 1024 * 1024, 1024, 1024, 1024, 1024, p.wtO_out + (long)j * 1024 * 1024, ts);
        }
        for (int l = 0; l < 4; ++l) conv_t(p.peer_w_q + (long)l * 1024 * 2048, 2048, 2048, 2048, 1024, p.wtPq + (long)l * 2048 * 1024, ts);
    }
    {
        float* wt = (float*)smem;
        float* ct = wt + 64 * 129;
        float* st = ct + 128;
        if (tid < 128) {
            float s, c;
            sincospif((float)tid / 64.f, &s, &c);
            ct[tid] = c; st[tid] = s;
        }
        for (int unit = bid; unit < 128; unit += nb) {
            const int j = unit >> 6, g = (unit >> 4) & 3, kb = unit & 15;
            __syncthreads();
            for (int i = tid; i < 64 * 128; i += NTHREADS) {
                const int kk = i >> 7, d = i & 127;
                wt[kk * 129 + d] = p.even_w_in[((long)j * 1024 + kb * 64 + kk) * 2576 + 2064 + g * 128 + d];
            }
            __syncthreads();
            const int dq = tid & 127, kq = tid >> 7;
            for (int kk = kq * 16; kk < kq * 16 + 16; ++kk) {
                float ar = 0.f, ai = 0.f;
                for (int d = 0; d < 128; ++d) {
                    const float w = wt[kk * 129 + d];
                    const int idx = (d * dq) & 127;
                    ar += w * ct[idx];
                    ai -= w * st[idx];
                }
                const float sc = 0.08838834764831845f;
                bf16_t* dst = p.wtE_in + (long)j * N_EIN * 1024;
                dst[(long)(2064 + g * 128 + dq) * 1024 + kb * 64 + kk] = f2bf(ar * sc);
                dst[(long)(2576 + g * 128 + dq) * 1024 + kb * 64 + kk] = f2bf(ai * sc);
            }
        }
        __syncthreads();
        for (long i = (long)bid * NTHREADS + tid; i < 2L * 112 * 1024; i += (long)nb * NTHREADS) {
            const int j = (int)(i / (112 * 1024));
            const long r = i % (112 * 1024);
            p.wtE_in[(long)j * N_EIN * 1024 + 3088L * 1024 + r] = 0;
        }
    }
    for (long i = (long)bid * NTHREADS + tid; i < 4L * 8 * 2 * 128 * 128; i += (long)nb * NTHREADS) p.subk[i] = f2bf(p.peer_sub_keys[i]);
    for (long i = (long)bid * NTHREADS + tid; i < 4096L * 8192 / 8; i += (long)nb * NTHREADS) {
        const int k = (int)(i >> 10), n0 = (int)(i & 1023) * 8;
        unsigned w[4];
#pragma unroll
        for (int e = 0; e < 4; ++e) {
            float v[2];
#pragma unroll
            for (int q = 0; q < 2; ++q) {
                const int np = n0 + e * 2 + q, n = np & 4095;
                const int prod = (k * n) & 4095;
                float s, c;
                sincospif((float)prod / 2048.f, &s, &c);
                v[q] = ((np >> 12) ? s : c) * (1.f / 64.f);
            }
            w[e] = pack2(v[0], v[1]);
        }
        *(uint4*)(p.dftS + i * 8) = make_uint4(w[0], w[1], w[2], w[3]);
    }
    for (long i = (long)bid * NTHREADS + tid; i < 256L * 512; i += (long)nb * NTHREADS) {
        const int k = (int)(i >> 9), np = (int)(i & 511), n = np & 255;
        const int prod = (k * n) & 255;
        float s, c;
        sincospif((float)prod / 128.f, &s, &c);
        p.dftP[i] = f2bf(((np >> 8) ? s : c) * (1.f / 16.f));
    }
}

__device__ void ph_tab(const Params& p, int l) {
    const long n8 = 16384L * 1024 / 8;
    const float4* su = (const float4*)(p.peer_u + (long)l * 16384 * 1024);
    const float4* sv = (const float4*)(p.peer_v + (long)l * 16384 * 1024);
    for (long i = (long)blockIdx.x * NTHREADS + threadIdx.x; i < 2 * n8; i += (long)gridDim.x * NTHREADS) {
        const bool isv = i >= n8;
        const long k = isv ? i - n8 : i;
        const float4* s = isv ? sv : su;
        const float4 a = s[2 * k], b = s[2 * k + 1];
        uint4 o = make_uint4(pack2(a.x, a.y), pack2(a.z, a.w), pack2(b.x, b.y), pack2(b.z, b.w));
        *(uint4*)((isv ? p.tabV : p.tabU) + k * 8) = o;
    }
}

__device__ void ph_norm(const Params& p, const float* __restrict__ w, const float* __restrict__ mods_l, int sh_off, int sc_off) {
    const int lane = threadIdx.x & 63, wave = threadIdx.x >> 6;
    const int nw = gridDim.x * 8;
    for (int row = blockIdx.x * 8 + wave; row < T_TOK; row += nw) {
        const float* xr = p.out + (long)row * DM;
        float4 v[4];
        float ss = 0.f;
#pragma unroll
        for (int i = 0; i < 4; ++i) {
            v[i] = *(const float4*)(xr + i * 256 + lane * 4);
            ss += v[i].x * v[i].x + v[i].y * v[i].y + v[i].z * v[i].z + v[i].w * v[i].w;
        }
        ss = wave_sum(ss);
        const float r = rsqrtf(ss * (1.f / 1024.f) + 1e-6f);
        const float* mr = mods_l + (long)tok_modrow(row) * 6144;
#pragma unroll
        for (int i = 0; i < 4; ++i) {
            const int c = i * 256 + lane * 4;
            const float4 ww = *(const float4*)(w + c);
            const float4 sc = *(const float4*)(mr + sc_off + c);
            const float4 sh = *(const float4*)(mr + sh_off + c);
            const float h0 = v[i].x * r * ww.x * (1.f + sc.x) + sh.x;
            const float h1 = v[i].y * r * ww.y * (1.f + sc.y) + sh.y;
            const float h2 = v[i].z * r * ww.z * (1.f + sc.z) + sh.z;
            const float h3 = v[i].w * r * ww.w * (1.f + sc.w) + sh.w;
            *(uint2*)(p.H + (long)row * DM + c) = make_uint2(pack2(h0, h1), pack2(h2, h3));
        }
    }
}
__device__ void ph_e_gemm(const Params& p, int j, char* smem) {
    const int ntn = N_EIN / 128, ntm = T_TOK / 256;
    const bf16_t* Bt = p.wtE_in + (long)j * N_EIN * 1024;
    for (int u = blockIdx.x; u < ntn * ntm; u += gridDim.x) {
        const int tn = u % ntn, tm = u / ntn;
        const int row0 = tm * 256, col0 = tn * 128;
        const int s0 = tok_seq0(row0), L = tok_len(row0);
        gemm_tile(p.H + (long)row0 * DM, DM, Bt + (long)col0 * 1024, 1024, 1024, (bf16_t*)smem,
                  [&](int r, int c, f32x4 v) {
                      const int row = row0 + r, col = col0 + c;
                      if (col < 1536) {
#pragma unroll
                          for (int i = 0; i < 4; ++i) p.qkvraw[(long)(row + i) * 1536 + col] = f2bf(v[i]);
                      } else if (col < 2048) {
#pragma unroll
                          for (int i = 0; i < 4; ++i) p.gate[(long)(row + i) * 512 + (col - 1536)] = f2bf(v[i]);
                      } else if (col < 2064) {
#pragma unroll
                          for (int i = 0; i < 4; ++i) p.ba[(long)(row + i) * 16 + (col - 2048)] = v[i];
                      } else if (col < 3088) {
                          const int cc = col - 2064, part = cc >> 9, cf = cc & 511;
                          bf16_t* dst = p.ZtA + (long)s0 * 1024 + ((long)cf * 2 + part) * L + (row - s0);
                          *(uint2*)dst = make_uint2(pack2(v[0], v[1]), pack2(v[2], v[3]));
                      }
                  });
    }
}

#define PREP_SMEM_BYTES (66048 + 34816 + 16384 + 2048 + 15360)
__device__ void ph_e_prep(const Params& p, int j, char* smem) {
    const float* cw = p.even_conv_w + (long)j * 3 * 1536;
    for (int u = blockIdx.x; u < 576 * 4; u += gridDim.x) {
        const int cg = u >> 2, h = u & 3;
        const int t0 = cg * 64;
        const int s0 = tok_seq0(t0), L = tok_len(t0);
        int lz = 0, tid = threadIdx.x;
        asm volatile("" : "+s"(lz), "+v"(tid));
        const int lane = tid & 63, wave = tid >> 6;
        char* sm = smem + lz;
        bf16_t* raw = (bf16_t*)sm;
        float* KK = (float*)sm;
        float* QKr = KK + 64 * 65;
        float* Am = QKr + 64 * 65;
        bf16_t* qn = (bf16_t*)(sm + 66048);
        bf16_t* kn = qn + 64 * 136;
        bf16_t* vv = (bf16_t*)(sm + 66048 + 34816);
        float* sb = (float*)(sm + 66048 + 34816 + 16384);
        float* sg = sb + 128;
        float* sgr = sg + 128;
        bf16_t* Dinv = (bf16_t*)(sm + 66048 + 34816 + 16384 + 2048);
        bf16_t* A10 = Dinv + 4 * 32 * 40;
        __syncthreads();
        for (int i = tid; i < 3 * 66 * 16; i += NTHREADS) {
            const int part = i / (66 * 16), rem = i % (66 * 16), rr = rem >> 4, ch = rem & 15;
            const int t = t0 - 1 + rr;
            uint4 v = make_uint4(0, 0, 0, 0);
            if (t >= s0 && t < s0 + L) v = *(const uint4*)(p.qkvraw + (long)t * 1536 + part * 512 + h * 128 + ch * 8);
            *(uint4*)(raw + (part * 66 + rr) * 128 + ch * 8) = v;
        }
        if (tid < 128) {
            const int dir = tid >> 6, i = tid & 63;
            const int t = t0 + (dir ? 63 - i : i);
            const float* bar_ = p.ba + (long)t * 16;
            sb[dir * 64 + i] = sigmoid_f(bar_[dir * 4 + h]);
            const float a = __expf(p.gdn_a_log[(j * 2 + dir) * 4 + h]);
            sgr[dir * 64 + i] = -a * softplus_f(bar_[(2 + dir) * 4 + h] + p.gdn_dt_bias[(j * 2 + dir) * 4 + h]);
        }
        __syncthreads();
        if (tid == 0 || tid == 64) {
            const int dir = tid >> 6;
            float acc = 0.f;
            for (int i = 0; i < 64; ++i) { acc += sgr[dir * 64 + i]; sg[dir * 64 + i] = acc; }
        }
        for (int q = 0; q < 24; ++q) {
            const int pr = wave * 24 + q, part = pr >> 6, rr = pr & 63;
            const int d = lane * 2;
            const int ch = part * 512 + h * 128 + d;
            const unsigned x0 = *(const unsigned*)(raw + (part * 66 + rr) * 128 + d);
            const unsigned x1 = *(const unsigned*)(raw + (part * 66 + rr + 1) * 128 + d);
            const unsigned x2 = *(const unsigned*)(raw + (part * 66 + rr + 2) * 128 + d);
            float y0 = cw[ch] * bflo(x0) + cw[1536 + ch] * bflo(x1) + cw[3072 + ch] * bflo(x2);
            float y1 = cw[ch + 1] * bfhi(x0) + cw[1536 + ch + 1] * bfhi(x1) + cw[3072 + ch + 1] * bfhi(x2);
            y0 = silu_f(y0); y1 = silu_f(y1);
            if (part < 2) {
                const float ss = wave_sum(y0 * y0 + y1 * y1);
                const float r = rsqrtf(ss + 1e-6f);
                y0 *= r; y1 *= r;
            }
            const unsigned pk = pack2(y0, y1);
            if (part == 0) { *(unsigned*)(qn + rr * 136 + d) = pk; *(unsigned*)(p.qn + ((long)(t0 + rr) * 4 + h) * 128 + d) = pk; }
            else if (part == 1) { *(unsigned*)(kn + rr * 136 + d) = pk; *(unsigned*)(p.kn + ((long)(t0 + rr) * 4 + h) * 128 + d) = pk; }
            else { *(unsigned*)(vv + rr * 128 + d) = pk; }
        }
        __syncthreads();
        {
            const int mat = wave >> 2, rt = wave & 3;
            f32x4 acc[1][4];
#pragma unroll
            for (int n = 0; n < 4; ++n) acc[0][n] = (f32x4){0.f, 0.f, 0.f, 0.f};
            wave_mma<1, 4>(acc, (mat ? qn : kn) + rt * 16 * 136, 136, kn, 136, 128);
            float* dst = mat ? QKr : KK;
#pragma unroll
            for (int n = 0; n < 4; ++n)
#pragma unroll
                for (int r = 0; r < 4; ++r) dst[(rt * 16 + (lane >> 4) * 4 + r) * 65 + n * 16 + (lane & 15)] = acc[0][n][r];
        }
        __syncthreads();
        {
            const int dir = tid >> 8, q = tid & 255;
            const long ud = ((long)(dir ? (s0 + L - 64 - (t0 - s0)) / 64 : cg) * 4 + h) * 2 + dir;
            bf16_t* qkout = p.QKb + ud * 4096;
            for (int e = q; e < 4096; e += 256) {
                const int i = e >> 6, jj = e & 63;
                const int ti = dir ? 63 - i : i, tj = dir ? 63 - jj : jj;
                const float dec = jj <= i ? __expf(sg[dir * 64 + i] - sg[dir * 64 + jj]) : 0.f;
                Am[(dir * 64 + i) * 64 + jj] = jj < i ? sb[dir * 64 + i] * KK[ti * 65 + tj] * dec : 0.f;
                qkout[e] = f2bf(QKr[ti * 65 + tj] * 0.08838834764831845f * dec);
            }
            if (q < 64) p.gcb[ud * 64 + q] = sg[dir * 64 + q];
        }
        __syncthreads();
        if (tid < 128) {
            const int dir = tid >> 6, blk = (tid >> 5) & 1, c = tid & 31;
            const float* Dm = Am + (dir * 64 + blk * 32) * 64 + blk * 32;
            float x[32];
#pragma unroll
            for (int i = 0; i < 32; ++i) x[i] = (i == c) ? 1.f : 0.f;
#pragma unroll
            for (int i = 1; i < 32; ++i) {
                float a = x[i];
#pragma unroll
                for (int jj = 0; jj < i; ++jj) a -= Dm[i * 64 + jj] * x[jj];
                x[i] = a;
            }
            bf16_t* dv = Dinv + (dir * 2 + blk) * 32 * 40 + c;
#pragma unroll
            for (int i = 0; i < 32; ++i) dv[i * 40] = f2bf(x[i]);
        }
        for (int e = tid; e < 2048; e += NTHREADS) {
            const int dir = e >> 10, i = (e >> 5) & 31, jj = e & 31;
            A10[(dir * 32 + i) * 40 + jj] = f2bf(Am[(dir * 64 + 32 + i) * 64 + jj]);
        }
        __syncthreads();
        {
            const int dir = wave >> 2, slab = wave & 3;
            const long ud = ((long)(dir ? (s0 + L - 64 - (t0 - s0)) / 64 : cg) * 4 + h) * 2 + dir;
            bf16_t* RT = (bf16_t*)sm + wave * 4096;
            const int c = slab * 64 + lane;
            const int g4 = (lane >> 4) * 4, cn = lane & 15, kg = (lane >> 4) * 8;
            {
                const bf16_t* src = c < 128 ? vv + c : kn + (c - 128);
                const int sst = c < 128 ? 128 : 136;
#pragma unroll
                for (int i8 = 0; i8 < 8; ++i8) {
                    unsigned w[4];
#pragma unroll
                    for (int e = 0; e < 4; ++e) {
                        float v[2];
#pragma unroll
                        for (int q = 0; q < 2; ++q) {
                            const int i = i8 * 8 + e * 2 + q;
                            const int ti = dir ? 63 - i : i;
                            float f = bf2f(src[ti * sst]) * sb[dir * 64 + i];
                            if (c >= 128) f *= __expf(sg[dir * 64 + i]);
                            v[q] = f;
                        }
                        w[e] = pack2(v[0], v[1]);
                    }
                    *(uint4*)(RT + lane * 64 + i8 * 8) = make_uint4(w[0], w[1], w[2], w[3]);
                }
            }
            asm volatile("s_waitcnt lgkmcnt(0)" ::: "memory");
            const bf16_t* D0 = Dinv + (dir * 2 + 0) * 32 * 40;
            const bf16_t* D1 = Dinv + (dir * 2 + 1) * 32 * 40;
            const bf16_t* A1 = A10 + dir * 32 * 40;
            bf16_t* dstb = (c < 128 ? p.Ub : p.Wb) + ud * 8192;
            const int cbase = (slab & 1) * 64;
            bf16x8 bfr[4];
            f32x4 X0[2][4];
#pragma unroll
            for (int nt = 0; nt < 4; ++nt) bfr[nt] = *(const bf16x8*)(RT + (nt * 16 + cn) * 64 + kg);
#pragma unroll
            for (int mt = 0; mt < 2; ++mt) {
                const bf16x8 af = *(const bf16x8*)(D0 + (mt * 16 + cn) * 40 + kg);
#pragma unroll
                for (int nt = 0; nt < 4; ++nt) X0[mt][nt] = __builtin_amdgcn_mfma_f32_16x16x32_bf16(af, bfr[nt], (f32x4){0.f, 0.f, 0.f, 0.f}, 0, 0, 0);
            }
#pragma unroll
            for (int mt = 0; mt < 2; ++mt)
#pragma unroll
                for (int nt = 0; nt < 4; ++nt) {
#pragma unroll
                    for (int r = 0; r < 4; ++r) dstb[(mt * 16 + g4 + r) * 128 + cbase + nt * 16 + cn] = f2bf(X0[mt][nt][r]);
                    *(uint2*)(RT + (nt * 16 + cn) * 64 + mt * 16 + g4) = make_uint2(pack2(X0[mt][nt][0], X0[mt][nt][1]), pack2(X0[mt][nt][2], X0[mt][nt][3]));
                }
            asm volatile("s_waitcnt lgkmcnt(0)" ::: "memory");
            f32x4 R1[2][4];
#pragma unroll
            for (int nt = 0; nt < 4; ++nt) bfr[nt] = *(const bf16x8*)(RT + (nt * 16 + cn) * 64 + kg);
#pragma unroll
            for (int mt = 0; mt < 2; ++mt) {
                const bf16x8 af = *(const bf16x8*)(A1 + (mt * 16 + cn) * 40 + kg);
#pragma unroll
                for (int nt = 0; nt < 4; ++nt) {
                    const f32x4 pr = __builtin_amdgcn_mfma_f32_16x16x32_bf16(af, bfr[nt], (f32x4){0.f, 0.f, 0.f, 0.f}, 0, 0, 0);
                    const uint2 rr = *(const uint2*)(RT + (nt * 16 + cn) * 64 + 32 + mt * 16 + g4);
                    R1[mt][nt][0] = bflo(rr.x) - pr[0]; R1[mt][nt][1] = bfhi(rr.x) - pr[1];
                    R1[mt][nt][2] = bflo(rr.y) - pr[2]; R1[mt][nt][3] = bfhi(rr.y) - pr[3];
                }
            }
            asm volatile("s_waitcnt lgkmcnt(0)" ::: "memory");
#pragma unroll
            for (int mt = 0; mt < 2; ++mt)
#pragma unroll
                for (int nt = 0; nt < 4; ++nt)
                    *(uint2*)(RT + (nt * 16 + cn) * 64 + 32 + mt * 16 + g4) = make_uint2(pack2(R1[mt][nt][0], R1[mt][nt][1]), pack2(R1[mt][nt][2], R1[mt][nt][3]));
            asm volatile("s_waitcnt lgkmcnt(0)" ::: "memory");
#pragma unroll
            for (int nt = 0; nt < 4; ++nt) bfr[nt] = *(const bf16x8*)(RT + (nt * 16 + cn) * 64 + 32 + kg);
#pragma unroll
            for (int mt = 0; mt < 2; ++mt) {
                const bf16x8 af = *(const bf16x8*)(D1 + (mt * 16 + cn) * 40 + kg);
#pragma unroll
                for (int nt = 0; nt < 4; ++nt) {
                    const f32x4 x1 = __builtin_amdgcn_mfma_f32_16x16x32_bf16(af, bfr[nt], (f32x4){0.f, 0.f, 0.f, 0.f}, 0, 0, 0);
#pragma unroll
                    for (int r = 0; r < 4; ++r) dstb[(32 + mt * 16 + g4 + r) * 128 + cbase + nt * 16 + cn] = f2bf(x1[r]);
                }
            }
        }
    }
}
#define SCAN_SMEM_BYTES (17408 + 17408 + 9216 + 18432 + 8 * 4352 + 8 * 2 * 2304 + 512)
__device__ void ph_e_scan(const Params& p, int j, char* smem) {
    const int tid = threadIdx.x, lane = tid & 63, wave = tid >> 6;
    bf16_t* Ws = (bf16_t*)smem;
    bf16_t* Qs = Ws + 64 * 136;
    bf16_t* QKs = Qs + 64 * 136;
    bf16_t* KnT = QKs + 64 * 72;
    bf16_t* St = KnT + 128 * 72 + wave * (16 * 136);
    bf16_t* VNt = KnT + 128 * 72 + 8 * (16 * 136) + wave * (2 * 16 * 72);
    bf16_t* VNs = VNt + 16 * 72;
    float* gcs = (float*)(smem + 17408 + 17408 + 9216 + 18432 + 8 * 4352 + 8 * 2 * 2304);
    const int g4 = (lane >> 4) * 4, cn = lane & 15;
    for (int st = blockIdx.x; st < 192; st += gridDim.x) {
        int seq, h, dir;
        if (st < 64) { seq = 16 + (st >> 3); h = (st >> 1) & 3; dir = st & 1; }
        else { const int q = st - 64; seq = q >> 3; h = (q >> 1) & 3; dir = q & 1; }
        const int L = seq < 16 ? 256 : 4096;
        const int s0 = seq < 16 ? seq * 256 : TP_TOK + (seq - 16) * 4096;
        const int nch = L / 64;
        f32x4 S[8][1];
        if (seq >= 16) {
            const float* sp = p.state_gdn + ((((long)(seq - 16) * 2 + j) * 2 + dir) * 4 + h) * 16384;
#pragma unroll
            for (int mt = 0; mt < 8; ++mt)
#pragma unroll
                for (int r = 0; r < 4; ++r) S[mt][0][r] = sp[(mt * 16 + g4 + r) * 128 + wave * 16 + cn];
        } else {
#pragma unroll
            for (int mt = 0; mt < 8; ++mt) S[mt][0] = (f32x4){0.f, 0.f, 0.f, 0.f};
        }
        for (int m = 0; m < nch; ++m) {
            const long ud = ((long)(s0 / 64 + m) * 4 + h) * 2 + dir;
            __syncthreads();
            for (int i = tid; i < 64 * 16; i += NTHREADS) {
                const int c = i >> 4, ch = i & 15;
                *(uint4*)(Ws + c * 136 + ch * 8) = *(const uint4*)(p.Wb + ud * 8192 + c * 128 + ch * 8);
                const int t = dir ? s0 + L - 1 - (m * 64 + c) : s0 + m * 64 + c;
                *(uint4*)(Qs + c * 136 + ch * 8) = *(const uint4*)(p.qn + ((long)t * 4 + h) * 128 + ch * 8);
                const uint4 kv = *(const uint4*)(p.kn + ((long)t * 4 + h) * 128 + ch * 8);
                const unsigned kw[4] = {kv.x, kv.y, kv.z, kv.w};
#pragma unroll
                for (int e = 0; e < 4; ++e) {
                    KnT[(ch * 8 + e * 2) * 72 + c] = (bf16_t)(kw[e] & 0xFFFFu);
                    KnT[(ch * 8 + e * 2 + 1) * 72 + c] = (bf16_t)(kw[e] >> 16);
                }
            }
            {
                const int c = tid >> 3, ch = tid & 7;
                *(uint4*)(QKs + c * 72 + ch * 8) = *(const uint4*)(p.QKb + ud * 4096 + c * 64 + ch * 8);
            }
            if (tid < 64) gcs[tid] = p.gcb[ud * 64 + tid];
#pragma unroll
            for (int mt = 0; mt < 8; ++mt)
                *(uint2*)(St + cn * 136 + mt * 16 + g4) = make_uint2(pack2(S[mt][0][0], S[mt][0][1]), pack2(S[mt][0][2], S[mt][0][3]));
            __syncthreads();
            f32x4 ws[4][1], qs[4][1];
#pragma unroll
            for (int mt = 0; mt < 4; ++mt) { ws[mt][0] = (f32x4){0.f, 0.f, 0.f, 0.f}; qs[mt][0] = (f32x4){0.f, 0.f, 0.f, 0.f}; }
            wave_mma<4, 1>(ws, Ws, 136, St, 136, 128);
            wave_mma<4, 1>(qs, Qs, 136, St, 136, 128);
            const float glast = gcs[63];
            f32x4 vn[4];
#pragma unroll
            for (int mt = 0; mt < 4; ++mt) {
                float sc[4];
#pragma unroll
                for (int r = 0; r < 4; ++r) {
                    const int c = mt * 16 + g4 + r;
                    const float u = bf2f(p.Ub[ud * 8192 + c * 128 + wave * 16 + cn]);
                    vn[mt][r] = u - ws[mt][0][r];
                    sc[r] = vn[mt][r] * __expf(glast - gcs[c]);
                }
                *(uint2*)(VNt + cn * 72 + mt * 16 + g4) = make_uint2(pack2(vn[mt][0], vn[mt][1]), pack2(vn[mt][2], vn[mt][3]));
                *(uint2*)(VNs + cn * 72 + mt * 16 + g4) = make_uint2(pack2(sc[0], sc[1]), pack2(sc[2], sc[3]));
            }
            __syncthreads();
            f32x4 oo[4][1];
#pragma unroll
            for (int mt = 0; mt < 4; ++mt)
#pragma unroll
                for (int r = 0; r < 4; ++r) oo[mt][0][r] = 0.08838834764831845f * __expf(gcs[mt * 16 + g4 + r]) * qs[mt][0][r];
            wave_mma<4, 1>(oo, QKs, 72, VNt, 72, 64);
            bf16_t* od = dir ? p.ob : p.of;
#pragma unroll
            for (int mt = 0; mt < 4; ++mt)
#pragma unroll
                for (int r = 0; r < 4; ++r) {
                    const int c = mt * 16 + g4 + r;
                    const int t = dir ? s0 + L - 1 - (m * 64 + c) : s0 + m * 64 + c;
                    od[((long)t * 4 + h) * 128 + wave * 16 + cn] = f2bf(oo[mt][0][r]);
                }
            const float eg = __expf(glast);
#pragma unroll
            for (int mt = 0; mt < 8; ++mt) S[mt][0] = S[mt][0] * eg;
            wave_mma<8, 1>(S, KnT, 72, VNs, 72, 64);
        }
        if (seq < 16) {
            float* dp = p.out + OUT_STATE + ((((long)seq * 2 + j) * 2 + dir) * 4 + h) * 16384;
#pragma unroll
            for (int mt = 0; mt < 8; ++mt)
#pragma unroll
                for (int r = 0; r < 4; ++r) dp[(mt * 16 + g4 + r) * 128 + wave * 16 + cn] = S[mt][0][r];
        }
    }
}

__device__ void ph_e_fft(const Params& p, char* smem) {
    for (int u = blockIdx.x; u < 576; u += gridDim.x) {
        int seq, tm, tn, L;
        if (u < 512) { seq = 16 + (u >> 6); tm = (u >> 5) & 1; tn = u & 31; L = 4096; }
        else { const int q = u - 512; seq = q >> 2; tm = (q >> 1) & 1; tn = q & 1; L = 256; }
        const int s0 = seq < 16 ? seq * 256 : TP_TOK + (seq - 16) * 4096;
        const bf16_t* A = p.ZtA + (long)s0 * 1024 + (long)tm * 256 * 2 * L;
        const bf16_t* Bt = (seq < 16 ? p.dftP : p.dftS) + (long)tn * 128 * 2 * L;
        gemm_tile(A, 2 * L, Bt, 2 * L, 2 * L, (bf16_t*)smem, [&](int r, int c, f32x4 v) {
            const int cf = tm * 256 + r, k = tn * 128 + c;
            *(uint2*)(p.mix + (long)(s0 + k) * DM + 512 + cf) = make_uint2(pack2(v[0], v[1]), pack2(v[2], v[3]));
        });
    }
}

__device__ void ph_e_mix(const Params& p, int j) {
    const int lane = threadIdx.x & 63, wave = threadIdx.x >> 6;
    const float* onw = p.gdn_o_norm + j * 128;
    const float w0 = onw[lane * 2], w1 = onw[lane * 2 + 1];
    for (int row = blockIdx.x * 8 + wave; row < T_TOK; row += gridDim.x * 8) {
#pragma unroll
        for (int h = 0; h < 4; ++h) {
            const unsigned a = *(const unsigned*)(p.of + ((long)row * 4 + h) * 128 + lane * 2);
            const unsigned b = *(const unsigned*)(p.ob + ((long)row * 4 + h) * 128 + lane * 2);
            const unsigned g = *(const unsigned*)(p.gate + (long)row * 512 + h * 128 + lane * 2);
            const float o0 = bflo(a) + bflo(b), o1 = bfhi(a) + bfhi(b);
            const float ss = wave_sum(o0 * o0 + o1 * o1);
            const float r = rsqrtf(ss * (1.f / 128.f) + 1e-6f);
            *(unsigned*)(p.mix + (long)row * DM + h * 128 + lane * 2) = pack2(o0 * r * w0 * silu_f(bflo(g)), o1 * r * w1 * silu_f(bfhi(g)));
        }
    }
}

__device__ void ph_out_gemm(const Params& p, const bf16_t* A, const bf16_t* Wt, const float* mods_l, int g_off, char* smem) {
    const int ntn = 8, ntm = T_TOK / 256;
    for (int u = blockIdx.x; u < ntn * ntm; u += gridDim.x) {
        const int tn = u % ntn, tm = u / ntn;
        const int row0 = tm * 256, col0 = tn * 128;
        const float* gv = mods_l + (long)tok_modrow(row0) * 6144 + g_off;
        gemm_tile(A + (long)row0 * DM, DM, Wt + (long)col0 * 1024, 1024, 1024, (bf16_t*)smem, [&](int r, int c, f32x4 v) {
            const int col = col0 + c;
            const float g = gv[col];
#pragma unroll
            for (int i = 0; i < 4; ++i) {
                float* xp = p.out + (long)(row0 + r + i) * DM + col;
                *xp = *xp + g * v[i];
            }
        });
    }
}
__device__ void ph_o_gemm1(const Params& p, int j, char* smem) {
    const int ntn = N_OIN / 128, ntm = T_TOK / 256;
    const bf16_t* Bt = p.wtO_in + (long)j * N_OIN * 1024;
    for (int u = blockIdx.x; u < ntn * ntm; u += gridDim.x) {
        const int tn = u % ntn, tm = u / ntn;
        const int row0 = tm * 256, col0 = tn * 128;
        gemm_tile(p.H + (long)row0 * DM, DM, Bt + (long)col0 * 1024, 1024, 1024, (bf16_t*)smem, [&](int r, int c, f32x4 v) {
            const int col = col0 + c;
            if (col < 832) {
#pragma unroll
                for (int i = 0; i < 4; ++i) p.Podd[(long)(row0 + r + i) * 832 + col] = v[i];
            }
        });
    }
}

__device__ void ph_o_norm(const Params& p, int j) {
    const int lane = threadIdx.x & 63, wave = threadIdx.x >> 6;
    const float* qw = p.mla_q_norm + j * 512;
    const float* kw = p.mla_kv_norm + j * 256;
    for (int row = blockIdx.x * 8 + wave; row < T_TOK + 2048; row += gridDim.x * 8) {
        if (row < T_TOK) {
            const float* pr = p.Podd + (long)row * 832;
            float q[8], k[4];
            float ssq = 0.f, ssk = 0.f;
#pragma unroll
            for (int i = 0; i < 8; ++i) { q[i] = pr[i * 64 + lane]; ssq += q[i] * q[i]; }
#pragma unroll
            for (int i = 0; i < 4; ++i) { k[i] = pr[512 + i * 64 + lane]; ssk += k[i] * k[i]; }
            const float kr = pr[768 + lane];
            ssq = wave_sum(ssq); ssk = wave_sum(ssk);
            const float rq = rsqrtf(ssq * (1.f / 512.f) + 1e-6f), rk = rsqrtf(ssk * (1.f / 256.f) + 1e-6f);
#pragma unroll
            for (int i = 0; i < 8; ++i) p.cq[(long)row * 512 + i * 64 + lane] = f2bf(q[i] * rq * qw[i * 64 + lane]);
#pragma unroll
            for (int i = 0; i < 4; ++i) {
                const float v = k[i] * rk * kw[i * 64 + lane];
                p.ckv_all[(long)row * 256 + i * 64 + lane] = f2bf(v);
                if (row < TP_TOK) p.out[OUT_CKV + (((long)(row >> 8) * 2 + j) * 256 + (row & 255)) * 256 + i * 64 + lane] = v;
            }
            p.kr_all[(long)row * 64 + lane] = kr;
            if (row < TP_TOK) p.out[OUT_KR + (((long)(row >> 8) * 2 + j) * 256 + (row & 255)) * 64 + lane] = kr;
        } else {
            const int rc = row - T_TOK, b = rc >> 8, t = rc & 255;
            const float* src = p.cache_ckv + (((long)b * 2 + j) * 256 + t) * 256;
#pragma unroll
            for (int i = 0; i < 4; ++i) p.ckv_all[(long)row * 256 + i * 64 + lane] = f2bf(src[i * 64 + lane]);
            p.kr_all[(long)row * 64 + lane] = p.cache_kr[(((long)b * 2 + j) * 256 + t) * 64 + lane];
        }
    }
}

#define KB_S (16L * 8 * 256 * 192)
#define VT_S (16L * 8 * 128 * 256)
__device__ void ph_o_gemm2(const Params& p, int j, char* smem) {
    const int nA = 12 * (T_TOK / 256);
    const int nB = 16 * ((T_TOK + 2048) / 256);
    for (int u = blockIdx.x; u < nA + nB; u += gridDim.x) {
        if (u < nA) {
            const int tn = u % 12, tm = u / 12;
            const int row0 = tm * 256, col0 = tn * 128;
            const int s0 = tok_seq0(row0), L = tok_len(row0);
            gemm_tile(p.cq + (long)row0 * 512, 512, p.wtUq + (long)j * 1536 * 512 + (long)col0 * 512, 512, 512, (bf16_t*)smem, [&](int r, int c, f32x4 v) {
                const int col = col0 + c, h = col / 192, d = col % 192;
#pragma unroll
                for (int i = 0; i < 4; ++i) p.Qb[(long)s0 * 1536 + ((long)h * L + (row0 + r + i - s0)) * 192 + d] = f2bf(v[i]);
            });
        } else {
            const int q = u - nA;
            const int tn = q % 16, tm = q / 16;
            const int row0 = tm * 256, col0 = tn * 128;
            long kbase, vbase; int Lk, pos0;
            if (row0 < TP_TOK) { const int s = row0 >> 8; kbase = (long)s * 8 * 256 * 192; vbase = (long)s * 8 * 128 * 256; Lk = 256; pos0 = 0; }
            else if (row0 < T_TOK) { const int b = (row0 - TP_TOK) >> 12; kbase = KB_S + (long)b * 8 * 4352 * 192; vbase = VT_S + (long)b * 8 * 128 * 4352; Lk = 4352; pos0 = (row0 - TP_TOK) & 4095; }
            else { const int b = (row0 - T_TOK) >> 8; kbase = KB_S + (long)b * 8 * 4352 * 192; vbase = VT_S + (long)b * 8 * 128 * 4352; Lk = 4352; pos0 = 4096; }
            gemm_tile(p.ckv_all + (long)row0 * 256, 256, p.wtUkv + (long)j * 2048 * 256 + (long)col0 * 256, 256, 256, (bf16_t*)smem, [&](int r, int c, f32x4 v) {
                const int col = col0 + c, h = col >> 8, w = col & 255;
                if (w < 128) {
#pragma unroll
                    for (int i = 0; i < 4; ++i) p.Kb[kbase + ((long)h * Lk + pos0 + r + i) * 192 + w] = f2bf(v[i]);
                } else {
                    *(uint2*)(p.Vtb + vbase + ((long)h * 128 + (w - 128)) * Lk + pos0 + r) = make_uint2(pack2(v[0], v[1]), pack2(v[2], v[3]));
                }
            });
        }
    }
}

__device__ void ph_o_qknorm(const Params& p, int j) {
    const int lane = threadIdx.x & 63, wave = threadIdx.x >> 6;
    const float* qnw = p.mla_q_headnorm + j * 192;
    const float* knw = p.mla_k_headnorm + j * 192;
    const float qw0 = qnw[lane], qw1 = qnw[64 + lane], qw2 = qnw[128 + lane];
    const float kw0 = knw[lane], kw1 = knw[64 + lane], kw2 = knw[128 + lane];
    const float inv = powf(10000.f, -(float)(lane & 15) / 16.f);
    for (int row = blockIdx.x * 8 + wave; row < T_TOK + 2048; row += gridDim.x * 8) {
        bool rope = false; float cs = 1.f, sn = 0.f;
        long kbase; int Lk, pos;
        if (row < TP_TOK) { const int s = row >> 8; kbase = (long)s * 8 * 256 * 192; Lk = 256; pos = row & 255; }
        else if (row < T_TOK) {
            const int b = (row - TP_TOK) >> 12; pos = (row - TP_TOK) & 4095; kbase = KB_S + (long)b * 8 * 4352 * 192; Lk = 4352; rope = true;
            const float ang = (float)((lane & 32) ? (pos & 63) : (pos >> 6)) * inv;
            sincosf(ang, &sn, &cs);
        } else { const int rc = row - T_TOK; const int b = rc >> 8; pos = 4096 + (rc & 255); kbase = KB_S + (long)b * 8 * 4352 * 192; Lk = 4352; }
        const float kr = p.kr_all[(long)row * 64 + lane];
        const bool hi = (lane & 16) != 0;
#pragma unroll
        for (int h = 0; h < 8; ++h) {
            bf16_t* kp = p.Kb + kbase + ((long)h * Lk + pos) * 192;
            const float k0 = bf2f(kp[lane]), k1 = bf2f(kp[64 + lane]);
            const float ss = wave_sum(k0 * k0 + k1 * k1 + kr * kr);
            const float r = rsqrtf(ss * (1.f / 192.f) + 1e-6f);
            float y2 = kr * r * kw2;
            if (rope) {
                const float o = __shfl_xor(y2, 16, 64);
                y2 = hi ? (o * sn + y2 * cs) : (y2 * cs - o * sn);
            }
            kp[lane] = f2bf(k0 * r * kw0); kp[64 + lane] = f2bf(k1 * r * kw1); kp[128 + lane] = f2bf(y2);
        }
        if (row < T_TOK) {
            const int s0 = tok_seq0(row), L = tok_len(row);
#pragma unroll
            for (int h = 0; h < 8; ++h) {
                bf16_t* qp = p.Qb + (long)s0 * 1536 + ((long)h * L + (row - s0)) * 192;
                const float q0 = bf2f(qp[lane]), q1 = bf2f(qp[64 + lane]), q2 = bf2f(qp[128 + lane]);
                const float ss = wave_sum(q0 * q0 + q1 * q1 + q2 * q2);
                const float r = rsqrtf(ss * (1.f / 192.f) + 1e-6f) * 0.07216878364870322f;
                float y2 = q2 * r * qw2;
                if (rope) {
                    const float o = __shfl_xor(y2, 16, 64);
                    y2 = hi ? (o * sn + y2 * cs) : (y2 * cs - o * sn);
                }
                qp[lane] = f2bf(q0 * r * qw0); qp[64 + lane] = f2bf(q1 * r * qw1); qp[128 + lane] = f2bf(y2);
            }
        }
    }
}

#define ATT_KLD 200
#define ATT_VLD 72
#define ATTN_SMEM_BYTES (2 * 64 * ATT_KLD * 2 + 2 * 128 * ATT_VLD * 2 + 8 * 32 * ATT_VLD * 2)
__device__ void ph_o_attn(const Params& p, char* smem) {
    for (int u = blockIdx.x; u < 1152; u += gridDim.x) {
        int lz = 0, tid = threadIdx.x;
        asm volatile("" : "+s"(lz), "+v"(tid));
        const int lane = tid & 63, wave = tid >> 6;
        const int g4 = (lane >> 4) * 4, cn = lane & 15, kg = (lane >> 4) * 8;
        bf16_t* Ks = (bf16_t*)(smem + lz);
        bf16_t* Vs = Ks + 2 * 64 * ATT_KLD;
        bf16_t* Ps = Vs + 2 * 128 * ATT_VLD + wave * 32 * ATT_VLD;
        int s0, L, Lk, h, q0; long kbase, vbase;
        if (u < 1024) { const int b = u >> 7; h = (u >> 4) & 7; q0 = (u & 15) * 256; s0 = TP_TOK + b * 4096; L = 4096; Lk = 4352; kbase = KB_S + (long)b * 8 * 4352 * 192; vbase = VT_S + (long)b * 8 * 128 * 4352; }
        else { const int q = u - 1024; const int s = q >> 3; h = q & 7; q0 = 0; s0 = s * 256; L = 256; Lk = 256; kbase = (long)s * 8 * 256 * 192; vbase = (long)s * 8 * 128 * 256; }
        const bf16_t* Qp = p.Qb + (long)s0 * 1536 + ((long)h * L + q0 + wave * 32) * 192;
        const bf16_t* Kp = p.Kb + kbase + (long)h * Lk * 192;
        const bf16_t* Vp = p.Vtb + vbase + (long)h * 128 * Lk;
        bf16x8 qa[2][6];
#pragma unroll
        for (int mt = 0; mt < 2; ++mt)
#pragma unroll
            for (int ks = 0; ks < 6; ++ks) qa[mt][ks] = *(const bf16x8*)(Qp + (mt * 16 + cn) * 192 + ks * 32 + kg);
        f32x4 o[2][8];
        float mrow[2][4], lrow[2][4];
#pragma unroll
        for (int mt = 0; mt < 2; ++mt) {
#pragma unroll
            for (int dt = 0; dt < 8; ++dt) o[mt][dt] = (f32x4){0.f, 0.f, 0.f, 0.f};
#pragma unroll
            for (int r = 0; r < 4; ++r) { mrow[mt][r] = -1e30f; lrow[mt][r] = 0.f; }
        }
        const int nkt = Lk / 64;
        u32x4 rk[3], rv[2];
        __syncthreads();
#pragma unroll
        for (int i = 0; i < 3; ++i) { const int ch = tid + i * 512, row = ch / 24, kc = ch % 24; rk[i] = *(const u32x4*)(Kp + (long)row * 192 + kc * 8); }
#pragma unroll
        for (int i = 0; i < 2; ++i) { const int ch = tid + i * 512, row = ch >> 3, kc = ch & 7; rv[i] = *(const u32x4*)(Vp + (long)row * Lk + kc * 8); }
#pragma unroll
        for (int i = 0; i < 3; ++i) { const int ch = tid + i * 512, row = ch / 24, kc = ch % 24; *(u32x4*)(Ks + row * ATT_KLD + kc * 8) = rk[i]; }
#pragma unroll
        for (int i = 0; i < 2; ++i) { const int ch = tid + i * 512, row = ch >> 3, kc = ch & 7; *(u32x4*)(Vs + row * ATT_VLD + kc * 8) = rv[i]; }
        __syncthreads();
        for (int kt = 0; kt < nkt; ++kt) {
            const int cur = kt & 1;
            const bf16_t* Kc = Ks + cur * 64 * ATT_KLD;
            const bf16_t* Vc = Vs + cur * 128 * ATT_VLD;
            f32x4 s[2][4];
#pragma unroll
            for (int mt = 0; mt < 2; ++mt)
#pragma unroll
                for (int nt = 0; nt < 4; ++nt) s[mt][nt] = (f32x4){0.f, 0.f, 0.f, 0.f};
#pragma unroll
            for (int ks = 0; ks < 6; ++ks) {
                bf16x8 kb[4];
#pragma unroll
                for (int nt = 0; nt < 4; ++nt) kb[nt] = *(const bf16x8*)(Kc + (nt * 16 + cn) * ATT_KLD + ks * 32 + kg);
#pragma unroll
                for (int mt = 0; mt < 2; ++mt)
#pragma unroll
                    for (int nt = 0; nt < 4; ++nt) s[mt][nt] = __builtin_amdgcn_mfma_f32_16x16x32_bf16(qa[mt][ks], kb[nt], s[mt][nt], 0, 0, 0);
            }
            if (kt + 1 < nkt) {
                const long key0 = (long)(kt + 1) * 64;
#pragma unroll
                for (int i = 0; i < 3; ++i) { const int ch = tid + i * 512, row = ch / 24, kc = ch % 24; rk[i] = *(const u32x4*)(Kp + (key0 + row) * 192 + kc * 8); }
#pragma unroll
                for (int i = 0; i < 2; ++i) { const int ch = tid + i * 512, row = ch >> 3, kc = ch & 7; rv[i] = *(const u32x4*)(Vp + (long)row * Lk + key0 + kc * 8); }
            }
#pragma unroll
            for (int mt = 0; mt < 2; ++mt) {
#pragma unroll
                for (int r = 0; r < 4; ++r) {
                    float mx = fmaxf(fmaxf(s[mt][0][r], s[mt][1][r]), fmaxf(s[mt][2][r], s[mt][3][r]));
                    mx = fmaxf(mx, __shfl_xor(mx, 1, 64));
                    mx = fmaxf(mx, __shfl_xor(mx, 2, 64));
                    mx = fmaxf(mx, __shfl_xor(mx, 4, 64));
                    mx = fmaxf(mx, __shfl_xor(mx, 8, 64));
                    const float mn = fmaxf(mrow[mt][r], mx);
                    const float al = __expf(mrow[mt][r] - mn);
                    mrow[mt][r] = mn;
                    float ps = 0.f;
#pragma unroll
                    for (int nt = 0; nt < 4; ++nt) {
                        const float pv = __expf(s[mt][nt][r] - mn);
                        ps += pv;
                        Ps[(mt * 16 + g4 + r) * ATT_VLD + nt * 16 + cn] = f2bf(pv);
                    }
                    lrow[mt][r] = lrow[mt][r] * al + ps;
#pragma unroll
                    for (int dt = 0; dt < 8; ++dt) o[mt][dt][r] *= al;
                }
            }
            asm volatile("s_waitcnt lgkmcnt(0)" ::: "memory");
#pragma unroll
            for (int ks = 0; ks < 2; ++ks) {
                bf16x8 pa[2];
#pragma unroll
                for (int mt = 0; mt < 2; ++mt) pa[mt] = *(const bf16x8*)(Ps + (mt * 16 + cn) * ATT_VLD + ks * 32 + kg);
#pragma unroll
                for (int dt = 0; dt < 8; ++dt) {
                    const bf16x8 vb = *(const bf16x8*)(Vc + (dt * 16 + cn) * ATT_VLD + ks * 32 + kg);
#pragma unroll
                    for (int mt = 0; mt < 2; ++mt) o[mt][dt] = __builtin_amdgcn_mfma_f32_16x16x32_bf16(pa[mt], vb, o[mt][dt], 0, 0, 0);
                }
            }
            if (kt + 1 < nkt) {
                bf16_t* Kn = Ks + (cur ^ 1) * 64 * ATT_KLD;
                bf16_t* Vn = Vs + (cur ^ 1) * 128 * ATT_VLD;
#pragma unroll
                for (int i = 0; i < 3; ++i) { const int ch = tid + i * 512, row = ch / 24, kc = ch % 24; *(u32x4*)(Kn + row * ATT_KLD + kc * 8) = rk[i]; }
#pragma unroll
                for (int i = 0; i < 2; ++i) { const int ch = tid + i * 512, row = ch >> 3, kc = ch & 7; *(u32x4*)(Vn + row * ATT_VLD + kc * 8) = rv[i]; }
            }
            __syncthreads();
        }
#pragma unroll
        for (int mt = 0; mt < 2; ++mt)
#pragma unroll
            for (int r = 0; r < 4; ++r) {
                float l = lrow[mt][r];
                l += __shfl_xor(l, 1, 64); l += __shfl_xor(l, 2, 64); l += __shfl_xor(l, 4, 64); l += __shfl_xor(l, 8, 64);
                const float il = 1.f / l;
                const long t = s0 + q0 + wave * 32 + mt * 16 + g4 + r;
#pragma unroll
                for (int dt = 0; dt < 8; ++dt) p.Ob[t * DM + h * 128 + dt * 16 + cn] = f2bf(o[mt][dt][r] * il);
            }
    }
}
__device__ void ph_p_gemm(const Params& p, int l, char* smem) {
    const int ntn = 16, ntm = T_TOK / 256;
    const bf16_t* Bt = p.wtPq + (long)l * 2048 * 1024;
    for (int u = blockIdx.x; u < ntn * ntm; u += gridDim.x) {
        const int tn = u % ntn, tm = u / ntn;
        const int row0 = tm * 256, col0 = tn * 128;
        gemm_tile(p.H + (long)row0 * DM, DM, Bt + (long)col0 * 1024, 1024, 1024, (bf16_t*)smem, [&](int r, int c, f32x4 v) {
#pragma unroll
            for (int i = 0; i < 4; ++i) p.qp[(long)(row0 + r + i) * 2048 + col0 + c] = f2bf(v[i]);
        });
    }
}

__device__ __forceinline__ unsigned f2ord(float f) { const unsigned u = __float_as_uint(f); return u ^ ((u >> 31) ? 0xFFFFFFFFu : 0x80000000u); }
__device__ __forceinline__ float ord2f(unsigned o) { const unsigned u = (o >> 31) ? (o ^ 0x80000000u) : ~o; return __uint_as_float(u); }

#define SCORE_SMEM_BYTES (256 * 129 * 4)
__device__ void ph_p_score(const Params& p, int l, char* smem) {
    const int tid = threadIdx.x;
    float* sc = (float*)smem;
    for (int u = blockIdx.x; u < 16 * (T_TOK / 256); u += gridDim.x) {
        const int li = u & 15, tm = u >> 4;
        const int row0 = tm * 256;
        __syncthreads();
        gemm_tile(p.qp + (long)row0 * 2048 + li * 128, 2048, p.subk + ((long)l * 16 + li) * 128 * 128, 128, 128, (bf16_t*)smem, [&](int r, int c, f32x4 v) {
#pragma unroll
            for (int i = 0; i < 4; ++i) sc[(r + i) * 129 + c] = v[i];
        });
        __syncthreads();
        if (tid < 256) {
            unsigned top[16];
#pragma unroll
            for (int i = 0; i < 16; ++i) top[i] = 0u;
            for (int k = 0; k < 128; ++k) {
                unsigned x = (f2ord(sc[tid * 129 + k]) & 0xFFFFFF00u) | (unsigned)k;
#pragma unroll
                for (int i = 0; i < 16; ++i) { const unsigned hi = max(top[i], x); x = min(top[i], x); top[i] = hi; }
            }
            const long base = ((long)(row0 + tid) * 16 + li) * 16;
            unsigned iw[4] = {0u, 0u, 0u, 0u};
#pragma unroll
            for (int i = 0; i < 16; ++i) {
                const int k = top[i] & 0xFF;
                p.topv[base + i] = sc[tid * 129 + k];
                iw[i >> 2] |= (unsigned)k << ((i & 3) * 8);
            }
            *(uint4*)(p.topi + base) = make_uint4(iw[0], iw[1], iw[2], iw[3]);
        }
    }
}

__device__ void ph_p_cand(const Params& p) {
    for (long th = (long)blockIdx.x * NTHREADS + threadIdx.x; th < (long)T_TOK * 8; th += (long)gridDim.x * NTHREADS) {
        const long b0 = th * 32;
        float s0[16], s1[16];
#pragma unroll
        for (int i = 0; i < 4; ++i) {
            const float4 a = *(const float4*)(p.topv + b0 + i * 4);
            const float4 b = *(const float4*)(p.topv + b0 + 16 + i * 4);
            s0[i * 4] = a.x; s0[i * 4 + 1] = a.y; s0[i * 4 + 2] = a.z; s0[i * 4 + 3] = a.w;
            s1[i * 4] = b.x; s1[i * 4 + 1] = b.y; s1[i * 4 + 2] = b.z; s1[i * 4 + 3] = b.w;
        }
        unsigned top[16];
#pragma unroll
        for (int i = 0; i < 16; ++i) top[i] = 0u;
#pragma unroll
        for (int a = 0; a < 16; ++a)
#pragma unroll
            for (int b = 0; b < 16; ++b)
                if ((a + 1) * (b + 1) <= 16) {
                    unsigned x = (f2ord(s0[a] + s1[b]) & 0xFFFFFF00u) | (unsigned)(a * 16 + b);
#pragma unroll
                    for (int i = 0; i < 16; ++i) { const unsigned hi = max(top[i], x); x = min(top[i], x); top[i] = hi; }
                }
        float cv[16];
        float mx = -1e30f;
#pragma unroll
        for (int i = 0; i < 16; ++i) { cv[i] = ord2f((top[i] & 0xFFFFFF00u) | 0x80u); mx = fmaxf(mx, cv[i]); }
        float sum = 0.f;
#pragma unroll
        for (int i = 0; i < 16; ++i) { cv[i] = __expf(cv[i] - mx); sum += cv[i]; }
        const float inv = 1.f / sum;
#pragma unroll
        for (int i = 0; i < 16; ++i) {
            const int a = (top[i] >> 4) & 15, b = top[i] & 15;
            const int i0 = p.topi[b0 + a], i1 = p.topi[b0 + 16 + b];
            p.eidx[th * 16 + i] = i0 * 128 + i1;
            p.pgate[th * 16 + i] = cv[i] * inv;
        }
    }
}

__device__ void ph_p_eval(const Params& p, const float* mods_l) {
    const int lane = threadIdx.x & 63, wave = threadIdx.x >> 6;
    for (int row = blockIdx.x * 8 + wave; row < T_TOK; row += gridDim.x * 8) {
        float x[16];
        {
            const uint4 a = *(const uint4*)(p.H + (long)row * DM + lane * 8);
            const uint4 b = *(const uint4*)(p.H + (long)row * DM + 512 + lane * 8);
            x[0] = bflo(a.x); x[1] = bfhi(a.x); x[2] = bflo(a.y); x[3] = bfhi(a.y); x[4] = bflo(a.z); x[5] = bfhi(a.z); x[6] = bflo(a.w); x[7] = bfhi(a.w);
            x[8] = bflo(b.x); x[9] = bfhi(b.x); x[10] = bflo(b.y); x[11] = bfhi(b.y); x[12] = bflo(b.z); x[13] = bfhi(b.z); x[14] = bflo(b.w); x[15] = bfhi(b.w);
        }
        const int e0 = p.eidx[(long)row * 128 + lane], e1 = p.eidx[(long)row * 128 + 64 + lane];
        const float g0 = p.pgate[(long)row * 128 + lane], g1 = p.pgate[(long)row * 128 + 64 + lane];
        float y[16];
#pragma unroll
        for (int i = 0; i < 16; ++i) y[i] = 0.f;
        for (int k = 0; k < 128; ++k) {
            const int e = __shfl(k < 64 ? e0 : e1, k & 63, 64);
            const float g = __shfl(k < 64 ? g0 : g1, k & 63, 64);
            const bf16_t* ur = p.tabU + (long)e * 1024 + lane * 8;
            const bf16_t* vr = p.tabV + (long)e * 1024 + lane * 8;
            const uint4 ua = *(const uint4*)ur, ub = *(const uint4*)(ur + 512);
            const uint4 va = *(const uint4*)vr, vb = *(const uint4*)(vr + 512);
            float d = bflo(ua.x) * x[0] + bfhi(ua.x) * x[1] + bflo(ua.y) * x[2] + bfhi(ua.y) * x[3] + bflo(ua.z) * x[4] + bfhi(ua.z) * x[5] + bflo(ua.w) * x[6] + bfhi(ua.w) * x[7]
                    + bflo(ub.x) * x[8] + bfhi(ub.x) * x[9] + bflo(ub.y) * x[10] + bfhi(ub.y) * x[11] + bflo(ub.z) * x[12] + bfhi(ub.z) * x[13] + bflo(ub.w) * x[14] + bfhi(ub.w) * x[15];
            d = wave_sum(d);
            const float w = g * gelu_tanh(d);
            y[0] += w * bflo(va.x); y[1] += w * bfhi(va.x); y[2] += w * bflo(va.y); y[3] += w * bfhi(va.y);
            y[4] += w * bflo(va.z); y[5] += w * bfhi(va.z); y[6] += w * bflo(va.w); y[7] += w * bfhi(va.w);
            y[8] += w * bflo(vb.x); y[9] += w * bfhi(vb.x); y[10] += w * bflo(vb.y); y[11] += w * bfhi(vb.y);
            y[12] += w * bflo(vb.z); y[13] += w * bfhi(vb.z); y[14] += w * bflo(vb.w); y[15] += w * bfhi(vb.w);
        }
        const float* gv = mods_l + (long)tok_modrow(row) * 6144 + 5 * 1024;
        float* xr = p.out + (long)row * DM;
#pragma unroll
        for (int hlf = 0; hlf < 2; ++hlf) {
#pragma unroll
            for (int q = 0; q < 2; ++q) {
                const int c = hlf * 512 + lane * 8 + q * 4;
                float4 xv = *(float4*)(xr + c);
                const float4 gg = *(const float4*)(gv + c);
                xv.x += gg.x * y[hlf * 8 + q * 4 + 0]; xv.y += gg.y * y[hlf * 8 + q * 4 + 1];
                xv.z += gg.z * y[hlf * 8 + q * 4 + 2]; xv.w += gg.w * y[hlf * 8 + q * 4 + 3];
                *(float4*)(xr + c) = xv;
            }
        }
    }
}
#define SMEM_MAX 135168
enum { PH_INIT, PH_TAB, PH_NORM1, PH_NORM2, PH_E_GEMM, PH_E_PREP, PH_E_SCAN, PH_E_FFT, PH_E_MIX, PH_E_OUT, PH_O_GEMM1, PH_O_NORM, PH_O_GEMM2, PH_O_QKNORM, PH_O_ATTN, PH_O_OUT,
       PH_P_GEMM, PH_P_SCORE, PH_P_CAND, PH_P_EVAL };

template <int PH>
__global__ void __launch_bounds__(NTHREADS, 2) k_phase(Params p, int l) {
    extern __shared__ __attribute__((aligned(16))) char smem[];
    const int j = l >> 1;
    const float* mods_l = p.mods + (long)l * 9 * 6144;
    if (PH == PH_INIT) ph_init(p, smem);
    if (PH == PH_TAB) ph_tab(p, l);
    if (PH == PH_NORM1) ph_norm(p, p.norm_mix + l * 1024, mods_l, 0, 1024);
    if (PH == PH_NORM2) ph_norm(p, p.norm_ffn + l * 1024, mods_l, 3 * 1024, 4 * 1024);
    if (PH == PH_E_GEMM) ph_e_gemm(p, j, smem);
    if (PH == PH_E_PREP) ph_e_prep(p, j, smem);
    if (PH == PH_E_SCAN) ph_e_scan(p, j, smem);
    if (PH == PH_E_FFT) ph_e_fft(p, smem);
    if (PH == PH_E_MIX) ph_e_mix(p, j);
    if (PH == PH_E_OUT) ph_out_gemm(p, p.mix, p.wtE_out + (long)j * 1024 * 1024, mods_l, 2 * 1024, smem);
    if (PH == PH_O_GEMM1) ph_o_gemm1(p, j, smem);
    if (PH == PH_O_NORM) ph_o_norm(p, j);
    if (PH == PH_O_GEMM2) ph_o_gemm2(p, j, smem);
    if (PH == PH_O_QKNORM) ph_o_qknorm(p, j);
    if (PH == PH_O_ATTN) ph_o_attn(p, smem);
    if (PH == PH_O_OUT) ph_out_gemm(p, p.Ob, p.wtO_out + (long)j * 1024 * 1024, mods_l, 2 * 1024, smem);
    if (PH == PH_P_GEMM) ph_p_gemm(p, l, smem);
    if (PH == PH_P_SCORE) ph_p_score(p, l, smem);
    if (PH == PH_P_CAND) ph_p_cand(p);
    if (PH == PH_P_EVAL) ph_p_eval(p, mods_l);
}

template <int PH>
static void launch(const Params& p, int l, hipStream_t stream) {
    static bool attr = false;
    if (!attr) { hipFuncSetAttribute((const void*)k_phase<PH>, hipFuncAttributeMaxDynamicSharedMemorySize, SMEM_MAX); attr = true; }
    hipLaunchKernelGGL(k_phase<PH>, dim3(256), dim3(NTHREADS), SMEM_MAX, stream, p, l);
}

static inline size_t al256(size_t x) { return (x + 255) & ~(size_t)255; }

extern "C" void kernel_launch(void* const* d_in, const int* in_sizes, int n_in, void* d_out, int out_size, void* d_ws, size_t ws_size, hipStream_t stream) {
    Params p{};
    const float* const* in = (const float* const*)d_in;
    p.x_prompt = in[0]; p.x_sample = in[1]; p.state_gdn = in[2]; p.cache_ckv = in[3]; p.cache_kr = in[4]; p.c = in[5]; p.c_ctx = in[6];
    p.w_mod = in[7]; p.b_mod = in[8]; p.norm_mix = in[9]; p.norm_ffn = in[10];
    p.even_w_in = in[11]; p.even_conv_w = in[12]; p.gdn_a_log = in[13]; p.gdn_dt_bias = in[14]; p.gdn_o_norm = in[15]; p.even_w_out = in[16];
    p.odd_w_in = in[17]; p.mla_q_norm = in[18]; p.mla_kv_norm = in[19]; p.mla_w_uq = in[20]; p.mla_w_ukv = in[21]; p.mla_q_headnorm = in[22]; p.mla_k_headnorm = in[23]; p.odd_w_out = in[24];
    p.peer_w_q = in[25]; p.peer_sub_keys = in[26]; p.peer_u = in[27]; p.peer_v = in[28];
    p.out = (float*)d_out;
    char* ws = (char*)d_ws;
    size_t off = 0;
    auto take = [&](size_t bytes) { char* r = ws + off; off = al256(off + bytes); return r; };
    p.bar = (unsigned*)take(16384);
    p.mods = (float*)take(4L * 9 * 6144 * 4);
    p.wtE_in = (bf16_t*)take(2L * N_EIN * 1024 * 2);
    p.wtE_out = (bf16_t*)take(2L * 1024 * 1024 * 2);
    p.wtO_in = (bf16_t*)take(2L * N_OIN * 1024 * 2);
    p.wtUq = (bf16_t*)take(2L * 1536 * 512 * 2);
    p.wtUkv = (bf16_t*)take(2L * 2048 * 256 * 2);
    p.wtO_out = (bf16_t*)take(2L * 1024 * 1024 * 2);
    p.wtPq = (bf16_t*)take(4L * 2048 * 1024 * 2);
    p.subk = (bf16_t*)take(4L * 16 * 128 * 128 * 2);
    p.dftS = (bf16_t*)take(4096L * 8192 * 2);
    p.dftP = (bf16_t*)take(256L * 512 * 2);
    p.tabU = (bf16_t*)take(16384L * 1024 * 2);
    p.tabV = (bf16_t*)take(16384L * 1024 * 2);
    p.H = (bf16_t*)take((long)T_TOK * 1024 * 2);
    const size_t ubase = off;
    p.qkvraw = (bf16_t*)take((long)T_TOK * 1536 * 2);
    p.mix = p.qkvraw;
    p.gate = (bf16_t*)take((long)T_TOK * 512 * 2);
    p.ba = (float*)take((long)T_TOK * 16 * 4);
    p.ZtA = (bf16_t*)take((long)T_TOK * 1024 * 2);
    p.qn = (bf16_t*)take((long)T_TOK * 512 * 2);
    p.kn = (bf16_t*)take((long)T_TOK * 512 * 2);
    p.Wb = (bf16_t*)take(4608L * 8192 * 2);
    p.Ub = (bf16_t*)take(4608L * 8192 * 2);
    p.QKb = (bf16_t*)take(4608L * 4096 * 2);
    p.gcb = (float*)take(4608L * 64 * 4);
    p.of = (bf16_t*)take((long)T_TOK * 512 * 2);
    p.ob = (bf16_t*)take((long)T_TOK * 512 * 2);
    const size_t even_end = off;
    off = ubase;
    p.Podd = (float*)take((long)T_TOK * 832 * 4);
    p.Ob = (bf16_t*)p.Podd;
    p.cq = (bf16_t*)take((long)T_TOK * 512 * 2);
    p.ckv_all = (bf16_t*)take((long)(T_TOK + 2048) * 256 * 2);
    p.kr_all = (float*)take((long)(T_TOK + 2048) * 64 * 4);
    p.Qb = (bf16_t*)take((long)T_TOK * 1536 * 2);
    p.Kb = (bf16_t*)take((KB_S + 8L * 8 * 4352 * 192) * 2);
    p.Vtb = (bf16_t*)take((VT_S + 8L * 8 * 128 * 4352) * 2);
    const size_t odd_end = off;
    off = ubase;
    p.qp = (bf16_t*)take((long)T_TOK * 2048 * 2);
    p.topv = (float*)take((long)T_TOK * 256 * 4);
    p.topi = (unsigned char*)take((long)T_TOK * 256);
    p.eidx = (int*)take((long)T_TOK * 128 * 4);
    p.pgate = (float*)take((long)T_TOK * 128 * 4);
    const size_t peer_end = off;
    size_t need = even_end > odd_end ? even_end : odd_end;
    if (peer_end > need) need = peer_end;
    if (need > ws_size) return;

    launch<PH_INIT>(p, 0, stream);
    for (int l = 0; l < 4; ++l) {
        launch<PH_TAB>(p, l, stream);
        launch<PH_NORM1>(p, l, stream);
        if ((l & 1) == 0) {
            launch<PH_E_GEMM>(p, l, stream);
            launch<PH_E_PREP>(p, l, stream);
            launch<PH_E_SCAN>(p, l, stream);
            launch<PH_E_FFT>(p, l, stream);
            launch<PH_E_MIX>(p, l, stream);
            launch<PH_E_OUT>(p, l, stream);
        } else {
            launch<PH_O_GEMM1>(p, l, stream);
            launch<PH_O_NORM>(p, l, stream);
            launch<PH_O_GEMM2>(p, l, stream);
            launch<PH_O_QKNORM>(p, l, stream);
            launch<PH_O_ATTN>(p, l, stream);
            launch<PH_O_OUT>(p, l, stream);
        }
        launch<PH_NORM2>(p, l, stream);
        launch<PH_P_GEMM>(p, l, stream);
        launch<PH_P_SCORE>(p, l, stream);
        launch<PH_P_CAND>(p, l, stream);
        launch<PH_P_EVAL>(p, l, stream);
    }
}
```

```cpp
#include <hip/hip_runtime.h>
#include <stdint.h>

typedef unsigned short bf16_t;
typedef short bf16x8 __attribute__((ext_vector_type(8)));
typedef float f32x4 __attribute__((ext_vector_type(4)));
typedef unsigned u32x4 __attribute__((ext_vector_type(4)));
typedef int i32x4 __attribute__((ext_vector_type(4)));

#define T_TOK   36864
#define TP_TOK  4096
#define DM      1024
#define NTHREADS 512
#define N_EIN   3328
#define N_OIN   1024
#define OUT_STATE 37748736L
#define OUT_CKV   41943040L
#define OUT_KR    44040192L

struct Params {
    const float *x_prompt, *x_sample, *state_gdn, *cache_ckv, *cache_kr, *c, *c_ctx, *w_mod, *b_mod, *norm_mix, *norm_ffn;
    const float *even_w_in, *even_conv_w, *gdn_a_log, *gdn_dt_bias, *gdn_o_norm, *even_w_out;
    const float *odd_w_in, *mla_q_norm, *mla_kv_norm, *mla_w_uq, *mla_w_ukv, *mla_q_headnorm, *mla_k_headnorm, *odd_w_out;
    const float *peer_w_q, *peer_sub_keys, *peer_u, *peer_v;
    float* out;
    unsigned* bar;
    float* mods;
    bf16_t *wtE_in, *wtE_out, *wtO_in, *wtUq, *wtUkv, *wtO_out, *wtPq, *subk, *dftP, *fftMA, *fftMB, *HB;
    float* fftTW;
    unsigned char *tabU, *tabV;
    float *su, *sv;
    bf16_t* H;
    bf16_t *qkvraw, *gate, *ZtA, *qn, *kn, *Wb, *Ub, *QKb, *of, *ob, *mix;
    float *ba, *gcb;
    float *Podd, *kr_all;
    bf16_t *cq, *ckv_all, *Qb, *Kb, *Vtb, *Ob;
    float* pgate;
    int* eidx;
};

typedef const Params __attribute__((address_space(4))) CP;

__device__ __forceinline__ int ltid() { int t = threadIdx.x; asm volatile("" : "+v"(t)); return t; }
__device__ __forceinline__ int lbid() { int b = blockIdx.x; asm volatile("" : "+s"(b)); return b; }
typedef __bf16 bf16v2 __attribute__((ext_vector_type(2)));
typedef float f32x2 __attribute__((ext_vector_type(2)));
__device__ __forceinline__ bf16_t f2bf(float f) { return __builtin_bit_cast(unsigned short, (__bf16)f); }
__device__ __forceinline__ float bf2f(bf16_t h) { return __uint_as_float(((unsigned)h) << 16); }
__device__ __forceinline__ unsigned pack2(float lo, float hi) { const f32x2 v = {lo, hi}; return __builtin_bit_cast(unsigned, __builtin_convertvector(v, bf16v2)); }
__device__ __forceinline__ float bflo(unsigned u) { return __uint_as_float(u << 16); }
__device__ __forceinline__ float bfhi(unsigned u) { return __uint_as_float(u & 0xFFFF0000u); }
__device__ __forceinline__ float silu_f(float x) { return x / (1.f + __expf(-x)); }
__device__ __forceinline__ float sigmoid_f(float x) { return 1.f / (1.f + __expf(-x)); }
__device__ __forceinline__ float softplus_f(float x) { return fmaxf(x, 0.f) + __logf(1.f + __expf(-fabsf(x))); }
__device__ __forceinline__ float gelu_tanh(float x) {
    const float u = 0.7978845608028654f * (x + 0.044715f * x * x * x);
    return 0.5f * x * (1.f + tanhf(u));
}
template <int M>
__device__ __forceinline__ int xshfl_i(int v) {
    if constexpr (M == 1) return __builtin_amdgcn_mov_dpp(v, 0xB1, 0xF, 0xF, true);
    else if constexpr (M == 2) return __builtin_amdgcn_mov_dpp(v, 0x4E, 0xF, 0xF, true);
    else if constexpr (M == 4) return __builtin_amdgcn_update_dpp(__builtin_amdgcn_update_dpp(0, v, 0x104, 0xF, 0x5, false), v, 0x114, 0xF, 0xA, false);
    else if constexpr (M == 8) return __builtin_amdgcn_mov_dpp(v, 0x128, 0xF, 0xF, true);
    else if constexpr (M == 16) { const auto r = __builtin_amdgcn_permlane16_swap((unsigned)v, (unsigned)v, false, false); return (int)(r[0] ^ r[1] ^ (unsigned)v); }
    else { const auto r = __builtin_amdgcn_permlane32_swap((unsigned)v, (unsigned)v, false, false); return (int)(r[0] ^ r[1] ^ (unsigned)v); }
}
template <int M>
__device__ __forceinline__ float xshfl(float v) { return __int_as_float(xshfl_i<M>(__float_as_int(v))); }
template <int CTRL> __device__ __forceinline__ float dppf(float v) { return __int_as_float(__builtin_amdgcn_mov_dpp(__float_as_int(v), CTRL, 0xF, 0xF, true)); }
__device__ __forceinline__ float wave_sum(float v) {
    v += dppf<0xB1>(v); v += dppf<0x4E>(v); v += dppf<0x141>(v); v += dppf<0x140>(v);
    { const auto r = __builtin_amdgcn_permlane16_swap(__float_as_uint(v), __float_as_uint(v), false, false); v = __uint_as_float(r[0]) + __uint_as_float(r[1]); }
    { const auto r = __builtin_amdgcn_permlane32_swap(__float_as_uint(v), __float_as_uint(v), false, false); v = __uint_as_float(r[0]) + __uint_as_float(r[1]); }
    return v;
}
__device__ __forceinline__ float wave_max(float v) {
    v = fmaxf(v, dppf<0xB1>(v)); v = fmaxf(v, dppf<0x4E>(v)); v = fmaxf(v, dppf<0x141>(v)); v = fmaxf(v, dppf<0x140>(v));
    { const auto r = __builtin_amdgcn_permlane16_swap(__float_as_uint(v), __float_as_uint(v), false, false); v = fmaxf(__uint_as_float(r[0]), __uint_as_float(r[1])); }
    { const auto r = __builtin_amdgcn_permlane32_swap(__float_as_uint(v), __float_as_uint(v), false, false); v = fmaxf(__uint_as_float(r[0]), __uint_as_float(r[1])); }
    return v;
}
__device__ __forceinline__ int tok_modrow(int t) { return t < TP_TOK ? 0 : 1 + ((t - TP_TOK) >> 12); }
__device__ __forceinline__ int tok_seq0(int t) { return t < TP_TOK ? (t & ~255) : (TP_TOK + ((t - TP_TOK) & ~4095)); }
__device__ __forceinline__ int tok_len(int t) { return t < TP_TOK ? 256 : 4096; }

template <int MT, int NT>
__device__ __forceinline__ void wave_mma(f32x4 (&acc)[MT][NT], const bf16_t* A, int lda, const bf16_t* B, int ldb, int K) {
    const int lane = ltid() & 63, r = lane & 15, kg = (lane >> 4) * 8;
#pragma unroll 1
    for (int k0 = 0; k0 < K; k0 += 32) {
        bf16x8 a[MT], b[NT];
#pragma unroll
        for (int m = 0; m < MT; ++m) a[m] = *(const bf16x8*)(A + (m * 16 + r) * lda + k0 + kg);
#pragma unroll
        for (int n = 0; n < NT; ++n) b[n] = *(const bf16x8*)(B + (n * 16 + r) * ldb + k0 + kg);
#pragma unroll
        for (int m = 0; m < MT; ++m)
#pragma unroll
            for (int n = 0; n < NT; ++n) acc[m][n] = __builtin_amdgcn_mfma_f32_16x16x32_bf16(a[m], b[n], acc[m][n], 0, 0, 0);
    }
}
template <int MT, int NT, int KSTEPS>
__device__ __forceinline__ void wave_mma_u(f32x4 (&acc)[MT][NT], const bf16_t* A, int lda, const bf16_t* B, int ldb) {
    const int lane = ltid() & 63, r = lane & 15, kg = (lane >> 4) * 8;
    bf16x8 a[KSTEPS][MT], b[KSTEPS][NT];
#pragma unroll
    for (int ks = 0; ks < KSTEPS; ++ks) {
#pragma unroll
        for (int m = 0; m < MT; ++m) a[ks][m] = *(const bf16x8*)(A + (m * 16 + r) * lda + ks * 32 + kg);
#pragma unroll
        for (int n = 0; n < NT; ++n) b[ks][n] = *(const bf16x8*)(B + (n * 16 + r) * ldb + ks * 32 + kg);
    }
#pragma unroll
    for (int ks = 0; ks < KSTEPS; ++ks)
#pragma unroll
        for (int m = 0; m < MT; ++m)
#pragma unroll
            for (int n = 0; n < NT; ++n) acc[m][n] = __builtin_amdgcn_mfma_f32_16x16x32_bf16(a[ks][m], b[ks][n], acc[m][n], 0, 0, 0);
}

#define GLD 72
#define GEMM_SMEM_BYTES (2 * (256 + 128) * GLD * 2)
template <int PERM = 0, class Epi>
__device__ __forceinline__ void gemm_tile(const bf16_t* __restrict__ A, long lda, const bf16_t* __restrict__ B, long ldb, int K, bf16_t* smem, Epi epi) {
    const int tid = ltid(), lane = tid & 63, wave = tid >> 6;
    const int wm = wave >> 1, wn = wave & 1;
    bf16_t* As = smem;
    bf16_t* Bs = smem + 2 * 256 * GLD;
    f32x4 acc[4][4];
#pragma unroll
    for (int m = 0; m < 4; ++m)
#pragma unroll
        for (int n = 0; n < 4; ++n) acc[m][n] = (f32x4){0.f, 0.f, 0.f, 0.f};
    uint4 ra[4], rb[2];
    const int lrow = tid >> 3, lkc = (tid & 7) * 8;
    const bf16_t* ap = A + (long)lrow * (PERM ? 64 : 1) * lda + lkc;
    const bf16_t* bp = B + (long)lrow * ldb + lkc;
    const long astep = (PERM ? 1 : 64) * lda;
#pragma unroll
    for (int i = 0; i < 4; ++i) ra[i] = *(const uint4*)(ap + (long)i * astep);
#pragma unroll
    for (int i = 0; i < 2; ++i) rb[i] = *(const uint4*)(bp + (long)i * 64 * ldb);
    __builtin_amdgcn_sched_barrier(0);
#pragma unroll
    for (int i = 0; i < 4; ++i) *(uint4*)(As + (i * 64 + lrow) * GLD + lkc) = ra[i];
#pragma unroll
    for (int i = 0; i < 2; ++i) *(uint4*)(Bs + (i * 64 + lrow) * GLD + lkc) = rb[i];
    __syncthreads();
    const int nk = K >> 6;
    for (int kt = 0; kt < nk; ++kt) {
        const int cur = kt & 1;
        if (kt + 1 < nk) {
            const long k0 = (long)(kt + 1) * 64;
#pragma unroll
            for (int i = 0; i < 4; ++i) ra[i] = *(const uint4*)(ap + (long)i * astep + k0);
#pragma unroll
            for (int i = 0; i < 2; ++i) rb[i] = *(const uint4*)(bp + (long)i * 64 * ldb + k0);
            __builtin_amdgcn_sched_barrier(0);
        }
        const bf16_t* Ac = As + cur * 256 * GLD + (wm * 64) * GLD;
        const bf16_t* Bc = Bs + cur * 128 * GLD + (wn * 64) * GLD;
        wave_mma<4, 4>(acc, Ac, GLD, Bc, GLD, 32);
        wave_mma<4, 4>(acc, Ac + 32, GLD, Bc + 32, GLD, 32);
        if (kt + 1 < nk) {
            bf16_t* An = As + (cur ^ 1) * 256 * GLD;
            bf16_t* Bn = Bs + (cur ^ 1) * 128 * GLD;
#pragma unroll
            for (int i = 0; i < 4; ++i) *(uint4*)(An + (i * 64 + lrow) * GLD + lkc) = ra[i];
#pragma unroll
            for (int i = 0; i < 2; ++i) *(uint4*)(Bn + (i * 64 + lrow) * GLD + lkc) = rb[i];
        }
        __syncthreads();
    }
#pragma unroll
    for (int m = 0; m < 4; ++m)
#pragma unroll
        for (int n = 0; n < 4; ++n) epi(wm * 64 + m * 16 + (lane >> 4) * 4, wn * 64 + n * 16 + (lane & 15), acc[m][n]);
}
namespace g8 {
constexpr int BK = 64, HALF = 128, HT = HALF * BK;
__device__ __forceinline__ int lds_byte(int r, int c) {
    const int st = (r >> 4) * 2 + (c >> 5), rr = r & 15, cc = c & 31, ob = rr * 64 + cc * 2;
    return st * 1024 + (ob ^ (((ob >> 9) & 1) << 5));
}
__device__ __forceinline__ void stage_rc(int b, int& R, int& C) {
    const int st = b / 1024, sb = b % 1024, swz = sb ^ (((sb >> 9) & 1) << 5);
    R = (st >> 1) * 16 + swz / 64; C = (st & 1) * 32 + (swz % 64) / 2;
}
}

template <int PERM = 0, int PRE = 0, int SWAP = 0>
__device__ __forceinline__ void gemm_tile256_acc(const bf16_t* __restrict__ A, long lda, const bf16_t* __restrict__ Bt, long ldb, int K, bf16_t* shm, f32x4 (&acc)[2][2][4][2]) {
    using namespace g8;
#define G8_SA(b, h) (shm + ((b) * 2 + (h)) * HT)
#define G8_SB(b, h) (shm + (4 + (b) * 2 + (h)) * HT)
#define G8_STAGE_A(T, P, h, kt) do { for (int _i = 0; _i < 2; ++_i) { const int _b = (T) * 16 + _i * 8192; int _r, _c; stage_rc(_b, _r, _c); \
        const int _R = (h) * HALF + _r; const long _ar = PERM ? (long)((_R & 63) * 64 + (_R >> 6)) : (long)_R; \
        __builtin_amdgcn_global_load_lds((const unsigned*)(A + _ar * lda + (long)(kt) * BK + _c), (__attribute__((address_space(3))) unsigned*)((char*)(P) + _b), 16, 0, 0); } } while (0)
#define G8_STAGE_B(T, P, h, kt) do { for (int _i = 0; _i < 2; ++_i) { const int _b = (T) * 16 + _i * 8192; int _r, _c; stage_rc(_b, _r, _c); \
        __builtin_amdgcn_global_load_lds((const unsigned*)(Bt + (long)((h) * HALF + _r) * ldb + (long)(kt) * BK + _c), (__attribute__((address_space(3))) unsigned*)((char*)(P) + _b), 16, 0, 0); } } while (0)
#define G8_LDA(dst, b, h) _Pragma("unroll") for (int m = 0; m < 4; ++m) _Pragma("unroll") for (int k = 0; k < 2; ++k) \
        dst[m][k] = *reinterpret_cast<const bf16x8*>((char*)G8_SA(b, h) + lds_byte(wr * 64 + m * 16 + fr, k * 32 + fq * 8))
#define G8_LDB(dst, b, h) _Pragma("unroll") for (int n = 0; n < 2; ++n) _Pragma("unroll") for (int k = 0; k < 2; ++k) \
        dst[n][k] = *reinterpret_cast<const bf16x8*>((char*)G8_SB(b, h) + lds_byte(wc * 32 + n * 16 + fr, k * 32 + fq * 8))
#define G8_MMA(ai, bj, At_, Bt_) do { __builtin_amdgcn_s_setprio(1); \
        _Pragma("unroll") for (int m = 0; m < 4; ++m) _Pragma("unroll") for (int n = 0; n < 2; ++n) _Pragma("unroll") for (int k = 0; k < 2; ++k) \
            acc[ai][bj][m][n] = ((SWAP >> (bj)) & 1) ? __builtin_amdgcn_mfma_f32_16x16x32_bf16(Bt_[n][k], At_[m][k], acc[ai][bj][m][n], 0, 0, 0) \
                                                       : __builtin_amdgcn_mfma_f32_16x16x32_bf16(At_[m][k], Bt_[n][k], acc[ai][bj][m][n], 0, 0, 0); \
        __builtin_amdgcn_s_setprio(0); } while (0)
#define G8_WAIT_V(n) asm volatile("s_waitcnt vmcnt(" #n ")" ::: "memory")
#define G8_WAIT_L(n) asm volatile("s_waitcnt lgkmcnt(" #n ")" ::: "memory")
#define G8_BAR __builtin_amdgcn_s_barrier()
#define G8_SCHED __builtin_amdgcn_sched_barrier(0)
    int tz = ltid();
    int wid = tz >> 6, lane = tz & 63, wr = wid >> 2, wc = wid & 3, fr = lane & 15, fq = lane >> 4;
#pragma unroll
    for (int a = 0; a < 2; ++a)
#pragma unroll
        for (int b = 0; b < 2; ++b)
#pragma unroll
            for (int m = 0; m < 4; ++m)
#pragma unroll
                for (int n = 0; n < 2; ++n) acc[a][b][m][n] = (f32x4){0.f, 0.f, 0.f, 0.f};
    bf16x8 At[4][2], B0[2][2], B1[2][2];
    const int nt = K / BK;
    if (PRE) {
        if (wr == 1) G8_BAR;
        G8_WAIT_V(0); G8_BAR;
        G8_BAR;
    } else {
        G8_STAGE_B(tz, G8_SB(0, 0), 0, 0); G8_STAGE_A(tz, G8_SA(0, 0), 0, 0);
        G8_STAGE_B(tz, G8_SB(0, 1), 1, 0); G8_STAGE_A(tz, G8_SA(0, 1), 1, 0);
        if (wr == 1) G8_BAR;
        G8_WAIT_V(4); G8_BAR;
        G8_STAGE_B(tz, G8_SB(1, 0), 0, 1); G8_STAGE_A(tz, G8_SA(1, 0), 0, 1); G8_STAGE_B(tz, G8_SB(1, 1), 1, 1);
        G8_WAIT_V(6); G8_BAR;
    }
    for (int t = 0; t < nt - 2; t += 2) {
        G8_LDB(B0, 0, 0); G8_SCHED; G8_LDA(At, 0, 0); G8_STAGE_A(tz, G8_SA(1, 1), 1, t + 1);
        G8_WAIT_L(8); G8_BAR; G8_WAIT_L(0); G8_MMA(0, 0, At, B0); G8_BAR; G8_SCHED;
        G8_LDB(B1, 0, 1); G8_STAGE_B(tz, G8_SB(0, 0), 0, t + 2);
        G8_BAR; G8_WAIT_L(0); G8_MMA(0, 1, At, B1); G8_BAR;
        G8_LDA(At, 0, 1); G8_STAGE_A(tz, G8_SA(0, 0), 0, t + 2);
        G8_BAR; G8_WAIT_L(0); G8_MMA(1, 0, At, B0); G8_BAR; G8_SCHED;
        G8_STAGE_B(tz, G8_SB(0, 1), 1, t + 2);
        G8_WAIT_V(6); G8_BAR; G8_MMA(1, 1, At, B1); G8_BAR;
        G8_LDB(B0, 1, 0); G8_SCHED; G8_LDA(At, 1, 0); G8_STAGE_A(tz, G8_SA(0, 1), 1, t + 2);
        G8_WAIT_L(8); G8_BAR; G8_WAIT_L(0); G8_MMA(0, 0, At, B0); G8_BAR; G8_SCHED;
        G8_LDB(B1, 1, 1); G8_STAGE_B(tz, G8_SB(1, 0), 0, t + 3);
        G8_BAR; G8_WAIT_L(0); G8_MMA(0, 1, At, B1); G8_BAR;
        G8_LDA(At, 1, 1); G8_STAGE_A(tz, G8_SA(1, 0), 0, t + 3);
        G8_BAR; G8_WAIT_L(0); G8_MMA(1, 0, At, B0); G8_BAR; G8_SCHED;
        G8_STAGE_B(tz, G8_SB(1, 1), 1, t + 3);
        G8_WAIT_V(6); G8_BAR; G8_MMA(1, 1, At, B1); G8_BAR;
    }
    tz = ltid(); wid = tz >> 6; lane = tz & 63; wr = wid >> 2; wc = wid & 3; fr = lane & 15; fq = lane >> 4;
    { G8_LDB(B0, 0, 0); G8_WAIT_V(0); G8_LDA(At, 0, 0); G8_STAGE_A(tz, G8_SA(1, 1), 1, nt - 1);
      G8_BAR; G8_WAIT_L(0); G8_MMA(0, 0, At, B0); G8_BAR;
      G8_LDB(B1, 0, 1); G8_BAR; G8_WAIT_L(0); G8_MMA(0, 1, At, B1); G8_BAR;
      G8_LDA(At, 0, 1); G8_WAIT_V(4); G8_BAR; G8_WAIT_L(0); G8_MMA(1, 0, At, B0); G8_MMA(1, 1, At, B1); G8_BAR; }
    { G8_LDB(B0, 1, 0); G8_LDA(At, 1, 0); G8_WAIT_V(2); G8_BAR; G8_WAIT_L(0); G8_MMA(0, 0, At, B0); G8_BAR;
      G8_LDB(B1, 1, 1); G8_WAIT_V(0); G8_BAR; G8_WAIT_L(0); G8_MMA(0, 1, At, B1); G8_BAR;
      G8_LDA(At, 1, 1); G8_BAR; G8_WAIT_L(0); G8_MMA(1, 0, At, B0); G8_MMA(1, 1, At, B1); G8_BAR; }
    if (wr == 0) G8_BAR;
#undef G8_SA
#undef G8_SB
#undef G8_STAGE_A
#undef G8_STAGE_B
#undef G8_LDA
#undef G8_LDB
#undef G8_MMA
#undef G8_WAIT_V
#undef G8_WAIT_L
#undef G8_BAR
#undef G8_SCHED
}

template <int PERM = 0>
__device__ __forceinline__ void g8_prologue(const bf16_t* __restrict__ A, long lda, const bf16_t* __restrict__ Bt, long ldb, bf16_t* shm) {
    using namespace g8;
    const int tz = ltid();
#define G8P_STAGE_A(P, h, kt) do { for (int _i = 0; _i < 2; ++_i) { const int _b = tz * 16 + _i * 8192; int _r, _c; stage_rc(_b, _r, _c); \
        const int _R = (h) * HALF + _r; const long _ar = PERM ? (long)((_R & 63) * 64 + (_R >> 6)) : (long)_R; \
        __builtin_amdgcn_global_load_lds((const unsigned*)(A + _ar * lda + (long)(kt) * BK + _c), (__attribute__((address_space(3))) unsigned*)((char*)(P) + _b), 16, 0, 0); } } while (0)
#define G8P_STAGE_B(P, h, kt) do { for (int _i = 0; _i < 2; ++_i) { const int _b = tz * 16 + _i * 8192; int _r, _c; stage_rc(_b, _r, _c); \
        __builtin_amdgcn_global_load_lds((const unsigned*)(Bt + (long)((h) * HALF + _r) * ldb + (long)(kt) * BK + _c), (__attribute__((address_space(3))) unsigned*)((char*)(P) + _b), 16, 0, 0); } } while (0)
#define G8P_SA(b, h) (shm + ((b) * 2 + (h)) * HT)
#define G8P_SB(b, h) (shm + (4 + (b) * 2 + (h)) * HT)
    G8P_STAGE_B(G8P_SB(0, 0), 0, 0); G8P_STAGE_A(G8P_SA(0, 0), 0, 0);
    G8P_STAGE_B(G8P_SB(0, 1), 1, 0); G8P_STAGE_A(G8P_SA(0, 1), 1, 0);
    G8P_STAGE_B(G8P_SB(1, 0), 0, 1); G8P_STAGE_A(G8P_SA(1, 0), 0, 1); G8P_STAGE_B(G8P_SB(1, 1), 1, 1);
#undef G8P_STAGE_A
#undef G8P_STAGE_B
#undef G8P_SA
#undef G8P_SB
}

template <int PERM = 0, class Epi>
__device__ __forceinline__ void gemm_tile256(const bf16_t* __restrict__ A, long lda, const bf16_t* __restrict__ Bt, long ldb, int K, bf16_t* shm, Epi epi) {
    f32x4 acc[2][2][4][2];
    gemm_tile256_acc<PERM>(A, lda, Bt, ldb, K, shm, acc);
    const int tz = ltid(), wid = tz >> 6, lane = tz & 63, wr = wid >> 2, wc = wid & 3, fr = lane & 15, fq = lane >> 4;
#pragma unroll
    for (int ai = 0; ai < 2; ++ai)
#pragma unroll
        for (int bj = 0; bj < 2; ++bj)
#pragma unroll
            for (int m = 0; m < 4; ++m)
#pragma unroll
                for (int n = 0; n < 2; ++n) epi(ai * 128 + wr * 64 + m * 16 + fq * 4, bj * 128 + wc * 32 + n * 16 + fr, acc[ai][bj][m][n]);
}

__device__ __forceinline__ void tile_map(int u, int nM, int nN, int& pm, int& pn) {
    const int nwg = nM * nN;
    int wgid = u;
    { const int q = nwg / 8, r = nwg % 8, xcd = wgid % 8, off = wgid / 8; wgid = (xcd < r ? xcd * (q + 1) : r * (q + 1) + (xcd - r) * q) + off; }
    const int nig = 8 * nN, gid = wgid / nig, fm = gid * 8, gsz = (nM - fm) < 8 ? (nM - fm) : 8;
    pm = fm + ((wgid % nig) % gsz); pn = (wgid % nig) / gsz;
}
#define XB_TMO      128
#define XB_XCNT(j)  (256  + 64 * (j))
#define XB_XSUB(j)  (1280 + 64 * (j))
#define XB_XGEN(j)  (2304 + 64 * (j))
#define XB_TOP      3328
#define XB_TOPGEN   3392
#define XCD_BAR_WORDS 3456
#define XB_SPIN_CAP (1u << 18)
#define LAS __attribute__((address_space(3)))

__device__ __forceinline__ unsigned xb_ld(unsigned* p)              { return __hip_atomic_load(p, __ATOMIC_RELAXED, __HIP_MEMORY_SCOPE_AGENT); }
__device__ __forceinline__ unsigned xb_add(unsigned* p, unsigned v) { return __hip_atomic_fetch_add(p, v, __ATOMIC_RELAXED, __HIP_MEMORY_SCOPE_AGENT); }
__device__ __forceinline__ unsigned xb_xcc_id() { return (unsigned)__builtin_amdgcn_s_getreg((3 << 11) | 20) & 0xFu; }
#define XB_SPIN(cond, bar) do { unsigned _sp = 0; while (cond) { __builtin_amdgcn_s_sleep(1); \
    if ((++_sp & 255u) == 0u) { if (xb_ld(&(bar)[XB_TMO])) break; if (_sp > XB_SPIN_CAP) { atomicAdd(&(bar)[XB_TMO], 1u); break; } } } } while (0)

struct XcdBarrier {
    unsigned* bar; unsigned x;
    volatile LAS unsigned* st;
};

__device__ __forceinline__ XcdBarrier xcd_barrier_post(unsigned* bar, volatile LAS unsigned* st) {
    XcdBarrier b; b.bar = bar; b.x = xb_xcc_id(); b.st = st;
    if (threadIdx.x == 0) (void)xb_add(&bar[XB_XCNT(b.x)], 1u);
    return b;
}
__device__ __forceinline__ void xcd_barrier_complete(unsigned* bar, unsigned x, unsigned& nloc, unsigned& nx) {
    const unsigned G = gridDim.x * gridDim.y * gridDim.z;
    unsigned sum, cnt, mine, sp = 0u;
    for (;;) {
        sum = 0u; cnt = 0u; mine = 0u;
#pragma unroll
        for (unsigned j = 0; j < 16; ++j) { const unsigned c = xb_ld(&bar[XB_XCNT(j)]); sum += c; cnt += (c > 0u) ? 1u : 0u; mine = (j == x) ? c : mine; }
        if (sum == G) break;
        __builtin_amdgcn_s_sleep(1);
        if ((++sp & 255u) == 0u) { if (xb_ld(&bar[XB_TMO])) break; if (sp > XB_SPIN_CAP) { atomicAdd(&bar[XB_TMO], 1u); break; } }
    }
    nloc = mine > 0u ? mine : 1u; nx = cnt > 0u ? cnt : 1u;
}

__device__ __forceinline__ void xcd_barrier(const XcdBarrier& b) {
    asm volatile("s_waitcnt vmcnt(0)" ::: "memory");
    __syncthreads();
    if (threadIdx.x == 0) {
        unsigned* bar = b.bar;
        __builtin_amdgcn_s_waitcnt(0);
        unsigned nloc = b.st[0], nx = b.st[1];
        if (nloc == 0u) { xcd_barrier_complete(bar, b.x, nloc, nx); b.st[0] = nloc; b.st[1] = nx; }
        const unsigned old = xb_add(&bar[XB_XSUB(b.x)], 1u);
        const unsigned gen = old / nloc;
        if (old + 1u == (gen + 1u) * nloc) {
            __builtin_amdgcn_fence(__ATOMIC_RELEASE, "agent");
            asm volatile("s_waitcnt vmcnt(0)" ::: "memory");
            const unsigned og = xb_add(&bar[XB_TOP], 1u);
            const unsigned tg = og / nx;
            if (og + 1u == (tg + 1u) * nx) xb_add(&bar[XB_TOPGEN], 1u);
            else XB_SPIN(xb_ld(&bar[XB_TOPGEN]) == tg, bar);
            __builtin_amdgcn_fence(__ATOMIC_ACQUIRE, "agent");
            xb_add(&bar[XB_XGEN(b.x)], 1u);
            asm volatile("s_waitcnt vmcnt(0)" ::: "memory");
        } else {
            XB_SPIN(xb_ld(&bar[XB_XGEN(b.x)]) == gen, bar);
            __builtin_amdgcn_fence(__ATOMIC_ACQUIRE, "agent");
            asm volatile("s_waitcnt vmcnt(0)" ::: "memory");
        }
    }
    __syncthreads();
}

__device__ __forceinline__ void conv_t(const float* __restrict__ src, int ldsrc, int Nvalid, int Nstore, int K, bf16_t* __restrict__ dst, float* ts, int b0 = 0) {
    const int tid = ltid();
    const int ntn = (Nstore + 63) / 64, ntk = K / 64;
    for (int tile = lbid() - b0; tile < ntn * ntk; tile += gridDim.x - b0) {
        const int tn = tile % ntn, tk = tile / ntn;
        {
            const int kk = tid >> 3, n8 = (tid & 7) * 8;
#pragma unroll
            for (int i = 0; i < 8; ++i) {
                const int n = tn * 64 + n8 + i;
                ts[kk * 65 + n8 + i] = n < Nvalid ? src[(long)(tk * 64 + kk) * ldsrc + n] : 0.f;
            }
        }
        __syncthreads();
        {
            const int nn = tid >> 3, k8 = (tid & 7) * 8;
            const int n = tn * 64 + nn;
            if (n < Nstore) {
                uint4 v;
                v.x = pack2(ts[(k8 + 0) * 65 + nn], ts[(k8 + 1) * 65 + nn]);
                v.y = pack2(ts[(k8 + 2) * 65 + nn], ts[(k8 + 3) * 65 + nn]);
                v.z = pack2(ts[(k8 + 4) * 65 + nn], ts[(k8 + 5) * 65 + nn]);
                v.w = pack2(ts[(k8 + 6) * 65 + nn], ts[(k8 + 7) * 65 + nn]);
                *(uint4*)(dst + (long)n * K + tk * 64 + k8) = v;
            }
        }
        __syncthreads();
    }
}

__device__ __forceinline__ void fold_fourier(CP& p, int j, char* smem, int b0) {
    const int tid = ltid(), bid = lbid() - b0, nb = gridDim.x - b0;
    float* wt = (float*)smem;
    for (int unit = bid; unit < 256; unit += nb) {
        const int g = unit >> 6, kb = unit & 63;
        const int dq = ltid() & 127, kq = ltid() >> 7;
        const float rs = __builtin_amdgcn_sinf((float)dq * (1.f / 128.f)), rc = __builtin_amdgcn_cosf((float)dq * (1.f / 128.f));
        __syncthreads();
        for (int i = tid; i < 16 * 128; i += NTHREADS) {
            const int kk = i >> 7, d = i & 127;
            wt[kk * 129 + d] = p.even_w_in[((long)j * 1024 + kb * 16 + kk) * 2576 + 2064 + g * 128 + d];
        }
        __syncthreads();
        float ar[4], ai[4];
#pragma unroll
        for (int q = 0; q < 4; ++q) { ar[q] = 0.f; ai[q] = 0.f; }
        for (int d0 = 0; d0 < 128; d0 += 16) {
            float s = __builtin_amdgcn_sinf((float)((d0 * dq) & 127) * (1.f / 128.f)), c = __builtin_amdgcn_cosf((float)((d0 * dq) & 127) * (1.f / 128.f));
#pragma unroll
            for (int dd = 0; dd < 16; ++dd) {
#pragma unroll
                for (int q = 0; q < 4; ++q) {
                    const float w = wt[(kq * 4 + q) * 129 + d0 + dd];
                    ar[q] += w * c;
                    ai[q] -= w * s;
                }
                const float cn = c * rc - s * rs, sn = s * rc + c * rs;
                c = cn; s = sn;
            }
        }
        const float sc = 0.08838834764831845f;
        bf16_t* dst = p.wtE_in + (long)j * N_EIN * 1024;
#pragma unroll
        for (int q = 0; q < 4; ++q) {
            dst[(long)(2064 + g * 128 + dq) * 1024 + kb * 16 + kq * 4 + q] = f2bf(ar[q] * sc);
            dst[(long)(2576 + g * 128 + dq) * 1024 + kb * 16 + kq * 4 + q] = f2bf(ai[q] * sc);
        }
    }
    __syncthreads();
    for (long i = (long)bid * NTHREADS + tid; i < 240L * 1024; i += (long)nb * NTHREADS) p.wtE_in[(long)j * N_EIN * 1024 + 3088L * 1024 + i] = 0;
}
__device__ __forceinline__ void ph_init2(CP& p, char* smem, int b0) {
    if ((int)lbid() < b0) return;
    __syncthreads();
    float* ts = (float*)smem;
    conv_t(p.even_w_in + 1024L * 2576, 2576, 2064, 2064, 1024, p.wtE_in + (long)N_EIN * 1024, ts, b0);
    for (int j = 0; j < 2; ++j) {
        conv_t(p.even_w_out + (long)j * 1024 * 1024, 1024, 1024, 1024, 1024, p.wtE_out + (long)j * 1024 * 1024, ts, b0);
        conv_t(p.odd_w_in + (long)j * 1024 * 832, 832, 832, N_OIN, 1024, p.wtO_in + (long)j * N_OIN * 1024, ts, b0);
        conv_t(p.mla_w_uq + (long)j * 512 * 1536, 1536, 1536, 1536, 512, p.wtUq + (long)j * 1536 * 512, ts, b0);
        conv_t(p.mla_w_ukv + (long)j * 256 * 2048, 2048, 2048, 2048, 256, p.wtUkv + (long)j * 2048 * 256, ts, b0);
        conv_t(p.odd_w_out + (long)j * 1024 * 1024, 1024, 1024, 1024, 1024, p.wtO_out + (long)j * 1024 * 1024, ts, b0);
    }
    for (int l = 0; l < 4; ++l) conv_t(p.peer_w_q + (long)l * 1024 * 2048, 2048, 2048, 2048, 1024, p.wtPq + (long)l * 2048 * 1024, ts, b0);
    fold_fourier(p, 1, smem, b0);
}

__device__ __forceinline__ void ph_init(CP& p, char* smem) {
    const int tid = ltid(), bid = lbid(), nb = gridDim.x;
    {
        float* sl = (float*)smem;
        for (int i = tid; i < 9 * 1024; i += NTHREADS) {
            const int r = i >> 10, k = i & 1023;
            const float v = r == 0 ? p.c_ctx[k] : p.c[(r - 1) * 1024 + k];
            sl[i] = silu_f(v);
        }
        __syncthreads();
        float* part16 = sl + 9 * 1024;
        for (int unit = bid; unit < 192; unit += nb) {
            const int l = unit / 48, cb = unit % 48;
            const int c4 = (tid & 31) * 4, kq = tid >> 5;
            f32x4 acc[9];
#pragma unroll
            for (int r = 0; r < 9; ++r) acc[r] = (f32x4){0.f, 0.f, 0.f, 0.f};
            const float* wp = p.w_mod + ((long)l * 1024 + kq * 64) * 6144 + cb * 128 + c4;
            for (int k = 0; k < 64; k += 8) {
                f32x4 w[8];
#pragma unroll
                for (int q = 0; q < 8; ++q) w[q] = *(const f32x4*)(wp + (long)(k + q) * 6144);
#pragma unroll
                for (int q = 0; q < 8; ++q)
#pragma unroll
                    for (int r = 0; r < 9; ++r) acc[r] = acc[r] + w[q] * sl[r * 1024 + kq * 64 + k + q];
            }
#pragma unroll
            for (int r = 0; r < 9; ++r) *(f32x4*)(part16 + (kq * 9 + r) * 128 + c4) = acc[r];
            __syncthreads();
            if (tid < 128) {
                const int col = cb * 128 + tid;
                const float bias = p.b_mod[l * 6144 + col];
#pragma unroll
                for (int r = 0; r < 9; ++r) {
                    float s = bias;
#pragma unroll
                    for (int g = 0; g < 16; ++g) s += part16[(g * 9 + r) * 128 + tid];
                    p.mods[((long)l * 9 + r) * 6144 + col] = s;
                }
            }
            __syncthreads();
        }
    }
    {
        float* ts = (float*)smem;
        conv_t(p.even_w_in, 2576, 2064, 2064, 1024, p.wtE_in, ts);
    }
    fold_fourier(p, 0, smem, 0);
    for (long i = (long)bid * NTHREADS + tid; i < 4L * 8 * 2 * 128 * 128; i += (long)nb * NTHREADS) p.subk[i] = f2bf(p.peer_sub_keys[i]);
    for (int i = bid * NTHREADS + tid; i < 128 * 128; i += nb * NTHREADS) {
        const int jrow = i >> 7, kk = i & 127;
        {
            const int k1 = jrow >> 1, po = jrow & 1, pi = kk >> 6, n1 = kk & 63;
            float s, c;
            sincospif((float)((k1 * n1) & 63) / 32.f, &s, &c);
            const float v = po == 0 ? (pi == 0 ? c : s) : (pi == 0 ? -s : c);
            p.fftMA[i] = f2bf(v * 0.125f);
        }
        {
            const int k2 = jrow, pi = kk >> 6, n2 = kk & 63;
            float s, c;
            sincospif((float)((k2 * n2) & 63) / 32.f, &s, &c);
            p.fftMB[i] = jrow < 64 ? f2bf((pi == 0 ? c : s) * 0.125f) : (bf16_t)0;
        }
    }
    for (int i = bid * NTHREADS + tid; i < 4096; i += nb * NTHREADS) {
        const int n2 = i >> 6, k1 = i & 63;
        float s, c;
        sincospif((float)(n2 * k1) / 2048.f, &s, &c);
        p.fftTW[i * 2] = c; p.fftTW[i * 2 + 1] = s;
    }
    for (long i = (long)bid * NTHREADS + tid; i < 256L * 512; i += (long)nb * NTHREADS) {
        const int k = (int)(i >> 9), np = (int)(i & 511), n = np & 255;
        const int prod = (k * n) & 255;
        float s, c;
        sincospif((float)prod / 128.f, &s, &c);
        p.dftP[i] = f2bf(((np >> 8) ? s : c) * (1.f / 16.f));
    }
}

__device__ __forceinline__ void ph_tab(CP& p, int l, int b0) {
    const int lane = ltid() & 63, wave = ltid() >> 6;
    if ((int)lbid() < b0) return;
    unsigned char* tab = p.tabU + (long)(l & 1) * 16384 * 2048;
    float* su = p.su + (l & 1) * 32768; float* sv = su + 16384;
    for (int row = (lbid() - b0) * 8 + wave; row < 32768; row += (gridDim.x - b0) * 8) {
        const bool isv = row >= 16384;
        const int e = isv ? row - 16384 : row;
        const float* src = (isv ? p.peer_v : p.peer_u) + ((long)l * 16384 + e) * 1024 + lane * 16;
        float v[16];
#pragma unroll
        for (int i = 0; i < 4; ++i) {
            const float4 f = *(const float4*)(src + i * 4);
            v[i * 4] = f.x; v[i * 4 + 1] = f.y; v[i * 4 + 2] = f.z; v[i * 4 + 3] = f.w;
        }
        float m = 0.f;
#pragma unroll
        for (int i = 0; i < 16; ++i) m = fmaxf(m, fabsf(v[i]));
        m = wave_max(m);
        const float scale = m > 0.f ? m * (1.f / 127.f) : 1.f;
        const float inv = 1.f / scale;
        unsigned w[4];
#pragma unroll
        for (int i = 0; i < 4; ++i) {
            unsigned pk = 0;
#pragma unroll
            for (int q = 0; q < 4; ++q) {
                int qi = (int)rintf(v[i * 4 + q] * inv);
                qi = qi < -127 ? -127 : (qi > 127 ? 127 : qi);
                pk |= (unsigned)(qi & 0xFF) << (q * 8);
            }
            w[i] = pk;
        }
        *(uint4*)(tab + (isv ? 16384L * 1024 : 0L) + (long)e * 1024 + lane * 16) = make_uint4(w[0], w[1], w[2], w[3]);
        if (lane == 0) (isv ? sv : su)[e] = scale;
    }
}

template <int FROM_INPUT = 0>
__device__ __forceinline__ void ph_norm(CP& p, const float* __restrict__ w, const float* __restrict__ mods_l, int sh_off, int sc_off) {
    const int lane = ltid() & 63, wave = ltid() >> 6;
    const int nw = gridDim.x * 8;
    for (int row = lbid() * 8 + wave; row < T_TOK; row += nw) {
        const float* xr = FROM_INPUT ? (row < TP_TOK ? p.x_prompt + (long)row * DM : p.x_sample + (long)(row - TP_TOK) * DM) : p.out + (long)row * DM;
        float4 v[4];
        float ss = 0.f;
#pragma unroll
        for (int i = 0; i < 4; ++i) {
            v[i] = *(const float4*)(xr + i * 256 + lane * 4);
            ss += v[i].x * v[i].x + v[i].y * v[i].y + v[i].z * v[i].z + v[i].w * v[i].w;
        }
        ss = wave_sum(ss);
        const float r = rsqrtf(ss * (1.f / 1024.f) + 1e-6f);
        const float* mr = mods_l + (long)tok_modrow(row) * 6144;
        float4 ww[4], sc[4], sh[4];
#pragma unroll
        for (int i = 0; i < 4; ++i) {
            const int c = i * 256 + lane * 4;
            ww[i] = *(const float4*)(w + c); sc[i] = *(const float4*)(mr + sc_off + c); sh[i] = *(const float4*)(mr + sh_off + c);
        }
#pragma unroll
        for (int i = 0; i < 4; ++i) {
            const int c = i * 256 + lane * 4;
            const float h0 = v[i].x * r * ww[i].x * (1.f + sc[i].x) + sh[i].x;
            const float h1 = v[i].y * r * ww[i].y * (1.f + sc[i].y) + sh[i].y;
            const float h2 = v[i].z * r * ww[i].z * (1.f + sc[i].z) + sh[i].z;
            const float h3 = v[i].w * r * ww[i].w * (1.f + sc[i].w) + sh[i].w;
            *(uint2*)(p.H + (long)row * DM + c) = make_uint2(pack2(h0, h1), pack2(h2, h3));
        }
    }
}
#define ZA_OFF ((long)TP_TOK * 1024)
template <int PERM>
__device__ __forceinline__ void e_gemm_epi(CP& p, f32x4 (&acc)[2][2][4][2], int col0, int row0, int s0, int n20, int b) {
    const int tz = ltid(), wid = tz >> 6, lane = tz & 63, wr = wid >> 2, wc = wid & 3, fr = lane & 15, fq = lane >> 4;
#define EG_TOK(ai, m, i) (PERM ? s0 + 64 * ((m) * 16 + fq * 4 + (i)) + n20 + (ai) * 2 + wr : row0 + (ai) * 128 + wr * 64 + (m) * 16 + fq * 4 + (i))
    if (col0 + 256 <= 2048) {
        const bool isg = col0 >= 1536;
        bf16_t* const base = isg ? p.gate + (col0 - 1536) : p.qkvraw + col0;
        const long ld = isg ? 512 : 1536;
#pragma unroll
        for (int ai = 0; ai < 2; ++ai)
#pragma unroll
            for (int m = 0; m < 4; ++m)
#pragma unroll
                for (int i = 0; i < 4; ++i) {
                    bf16_t* d = base + (long)EG_TOK(ai, m, i) * ld + wc * 32 + fr;
#pragma unroll
                    for (int bj = 0; bj < 2; ++bj)
#pragma unroll
                        for (int n = 0; n < 2; ++n) d[bj * 128 + n * 16] = f2bf(acc[ai][bj][m][n][i]);
                }
    } else {
#pragma unroll
        for (int bj = 0; bj < 2; ++bj)
#pragma unroll
            for (int n = 0; n < 2; ++n) {
                const int col = col0 + bj * 128 + wc * 32 + n * 16 + fr;
                if (col < 2064) {
#pragma unroll
                    for (int ai = 0; ai < 2; ++ai)
#pragma unroll
                        for (int m = 0; m < 4; ++m)
#pragma unroll
                            for (int i = 0; i < 4; ++i) p.ba[(long)EG_TOK(ai, m, i) * 16 + (col - 2048)] = acc[ai][bj][m][n][i];
                } else if (col < 3088) {
                    const int cc = col - 2064, part = cc >> 9, cf = cc & 511;
#pragma unroll
                    for (int ai = 0; ai < 2; ++ai)
#pragma unroll
                        for (int m = 0; m < 4; ++m) {
                            const f32x4 v = acc[ai][bj][m][n];
                            bf16_t* dst;
                            if (PERM) dst = p.ZtA + ZA_OFF + (((((long)b * 512 + cf) * 64 + (n20 + ai * 2 + wr)) * 2 + part) * 64 + (m * 16 + fq * 4));
                            else dst = p.ZtA + (long)s0 * 1024 + ((long)cf * 2 + part) * 256 + (ai * 128 + wr * 64 + m * 16 + fq * 4);
                            *(uint2*)dst = make_uint2(pack2(v[0], v[1]), pack2(v[2], v[3]));
                        }
                }
            }
    }
#undef EG_TOK
}
__device__ __forceinline__ void ph_e_gemm(CP& p, int j, char* smem) {
    const int ntn = N_EIN / 256, ntm = T_TOK / 256;
    const bf16_t* Bt = p.wtE_in + (long)j * N_EIN * 1024;
#define EG_PROLOGUE(U)                                                                                             \
    {                                                                                                              \
        int tm_, tn_;                                                                                              \
        tile_map((U), ntm, ntn, tm_, tn_);                                                                         \
        if (tm_ < 16) g8_prologue<0>(p.H + (long)tm_ * 256 * DM, DM, Bt + (long)tn_ * 256 * 1024, 1024, (bf16_t*)smem);   \
        else { const int q_ = tm_ - 16; g8_prologue<1>(p.H + (long)(TP_TOK + (q_ >> 4) * 4096 + (q_ & 15) * 4) * DM, DM, Bt + (long)tn_ * 256 * 1024, 1024, (bf16_t*)smem); }   \
    }
    int u = lbid();
    if (u < ntn * ntm) EG_PROLOGUE(u)
    for (; u < ntn * ntm; u += gridDim.x) {
        int tm, tn;
        tile_map(u, ntm, ntn, tm, tn);
        const int col0 = tn * 256;
        const int un = u + gridDim.x;
        f32x4 acc[2][2][4][2];
        if (tm < 16) {
            const int row0 = tm * 256;
            gemm_tile256_acc<0, 1>(p.H + (long)row0 * DM, DM, Bt + (long)col0 * 1024, 1024, 1024, (bf16_t*)smem, acc);
            if (un < ntn * ntm) EG_PROLOGUE(un)
            e_gemm_epi<0>(p, acc, col0, row0, row0, 0, 0);
        } else {
            const int q = tm - 16, b = q >> 4, n20 = (q & 15) * 4;
            const int s0 = TP_TOK + b * 4096;
            gemm_tile256_acc<1, 1>(p.H + (long)(s0 + n20) * DM, DM, Bt + (long)col0 * 1024, 1024, 1024, (bf16_t*)smem, acc);
            if (un < ntn * ntm) EG_PROLOGUE(un)
            e_gemm_epi<1>(p, acc, col0, 0, s0, n20, b);
        }
    }
#undef EG_PROLOGUE
}

#define PREP_SMEM_BYTES (66048 + 34816 + 16384 + 2048 + 256 + 15360)
__device__ __forceinline__ void ph_e_prep(CP& p, int j, char* smem) {
    const float* cw = p.even_conv_w + (long)j * 3 * 1536;
    for (int u = lbid(); u < 576 * 4; u += gridDim.x) {
        const int cg = u >> 2, h = u & 3;
        const int t0 = cg * 64;
        const int s0 = tok_seq0(t0), L = tok_len(t0);
        int lz = 0, tid = ltid();
        asm volatile("" : "+s"(lz), "+v"(tid));
        const int lane = tid & 63, wave = tid >> 6;
        char* sm = smem + lz;
        bf16_t* raw = (bf16_t*)sm;
        float* KK = (float*)sm;
        float* QKr = KK + 64 * 65;
        float* Am = QKr + 64 * 65;
        bf16_t* qn = (bf16_t*)(sm + 66048);
        bf16_t* kn = qn + 64 * 136;
        bf16_t* vv = (bf16_t*)(sm + 66048 + 34816);
        float* sb = (float*)(sm + 66048 + 34816 + 16384);
        float* sg = sb + 128;
        float* sgr = sg + 128;
        float* seg = sgr + 128;
        float* sone = seg + 128;
        bf16_t* Dinv = (bf16_t*)(sm + 66048 + 34816 + 16384 + 2048 + 256);
        bf16_t* A10 = Dinv + 4 * 32 * 40;
        __syncthreads();
        for (int i = tid; i < 3 * 66 * 16; i += NTHREADS) {
            const int part = i / (66 * 16), rem = i % (66 * 16), rr = rem >> 4, ch = rem & 15;
            const int t = t0 - 1 + rr;
            uint4 v = make_uint4(0, 0, 0, 0);
            if (t >= s0 && t < s0 + L) v = *(const uint4*)(p.qkvraw + (long)t * 1536 + part * 512 + h * 128 + ch * 8);
            *(uint4*)(raw + (part * 66 + rr) * 128 + ch * 8) = v;
        }
        if (tid >= 128 && tid < 192) sone[tid - 128] = 1.f;
        if (tid < 128) {
            const int dir = tid >> 6, i = tid & 63;
            const int t = t0 + (dir ? 63 - i : i);
            const float* bar_ = p.ba + (long)t * 16;
            sb[dir * 64 + i] = sigmoid_f(bar_[dir * 4 + h]);
            const float a = __expf(p.gdn_a_log[(j * 2 + dir) * 4 + h]);
            sgr[dir * 64 + i] = -a * softplus_f(bar_[(2 + dir) * 4 + h] + p.gdn_dt_bias[(j * 2 + dir) * 4 + h]);
        }
        __syncthreads();
        if (tid < 128) {
            float v = sgr[tid];
#pragma unroll
            for (int off = 1; off < 64; off <<= 1) {
                const float o = __int_as_float(__builtin_amdgcn_ds_bpermute(((lane - off) & 63) << 2, __float_as_int(v)));
                v += lane >= off ? o : 0.f;
            }
            sg[tid] = v;
            seg[tid] = __expf(v);
        }
        {
            const int d = lane * 2;
#pragma unroll
            for (int part = 0; part < 3; ++part) {
                const int ch = part * 512 + h * 128 + d;
                const float w00 = cw[ch], w01 = cw[ch + 1], w10 = cw[1536 + ch], w11 = cw[1536 + ch + 1], w20 = cw[3072 + ch], w21 = cw[3072 + ch + 1];
                float y0[8], y1[8], ss[8];
#pragma unroll
                for (int r8 = 0; r8 < 8; ++r8) {
                    const int rr = wave * 8 + r8;
                    const unsigned x0 = *(const unsigned*)(raw + (part * 66 + rr) * 128 + d);
                    const unsigned x1 = *(const unsigned*)(raw + (part * 66 + rr + 1) * 128 + d);
                    const unsigned x2 = *(const unsigned*)(raw + (part * 66 + rr + 2) * 128 + d);
                    y0[r8] = silu_f(w00 * bflo(x0) + w10 * bflo(x1) + w20 * bflo(x2));
                    y1[r8] = silu_f(w01 * bfhi(x0) + w11 * bfhi(x1) + w21 * bfhi(x2));
                    ss[r8] = y0[r8] * y0[r8] + y1[r8] * y1[r8];
                }
                float tot = 0.f;
                if (part < 2) {
                    const bool b5 = (lane & 32) != 0, b4 = (lane & 16) != 0, b3 = (lane & 8) != 0;
                    float t4[4], t2[2];
#pragma unroll
                    for (int i = 0; i < 4; ++i) { const float snd = b5 ? ss[i] : ss[i + 4]; const float kp = b5 ? ss[i + 4] : ss[i]; t4[i] = kp + xshfl<32>(snd); }
#pragma unroll
                    for (int i = 0; i < 2; ++i) { const float snd = b4 ? t4[i] : t4[i + 2]; const float kp = b4 ? t4[i + 2] : t4[i]; t2[i] = kp + xshfl<16>(snd); }
                    { const float snd = b3 ? t2[0] : t2[1]; const float kp = b3 ? t2[1] : t2[0]; tot = kp + xshfl<8>(snd); }
                    tot += xshfl<4>(tot); tot += xshfl<2>(tot); tot += xshfl<1>(tot);
                    tot = rsqrtf(tot + 1e-6f);
                }
#pragma unroll
                for (int r8 = 0; r8 < 8; ++r8) {
                    const int rr = wave * 8 + r8;
                    float a0 = y0[r8], a1 = y1[r8];
                    if (part < 2) { const float rn = __int_as_float(__builtin_amdgcn_readlane(__float_as_int(tot), r8 * 8)); a0 *= rn; a1 *= rn; }
                    const unsigned pk = pack2(a0, a1);
                    if (part == 0) { *(unsigned*)(qn + rr * 136 + d) = pk; *(unsigned*)(p.qn + ((long)(t0 + rr) * 4 + h) * 128 + d) = pk; }
                    else if (part == 1) { *(unsigned*)(kn + rr * 136 + d) = pk; *(unsigned*)(p.kn + ((long)(t0 + rr) * 4 + h) * 128 + d) = pk; }
                    else { *(unsigned*)(vv + rr * 128 + d) = pk; }
                }
            }
        }
        __syncthreads();
        {
            const int mat = wave >> 2, rt = wave & 3;
            f32x4 acc[1][4];
#pragma unroll
            for (int n = 0; n < 4; ++n) acc[0][n] = (f32x4){0.f, 0.f, 0.f, 0.f};
            wave_mma<1, 4>(acc, (mat ? qn : kn) + rt * 16 * 136, 136, kn, 136, 128);
            float* dst = mat ? QKr : KK;
#pragma unroll
            for (int n = 0; n < 4; ++n)
#pragma unroll
                for (int r = 0; r < 4; ++r) dst[(rt * 16 + (lane >> 4) * 4 + r) * 65 + n * 16 + (lane & 15)] = acc[0][n][r];
        }
        __syncthreads();
        {
            const int dir = tid >> 8, q = tid & 255;
            const long ud = ((long)(dir ? (s0 + L - 64 - (t0 - s0)) / 64 : cg) * 4 + h) * 2 + dir;
            bf16_t* qkout = p.QKb + ud * 4096;
            for (int e = q; e < 4096; e += 256) {
                const int i = e >> 6, jj = e & 63;
                const int ti = dir ? 63 - i : i, tj = dir ? 63 - jj : jj;
                const float dec = jj <= i ? __expf(sg[dir * 64 + i] - sg[dir * 64 + jj]) : 0.f;
                Am[(dir * 64 + i) * 64 + jj] = jj < i ? sb[dir * 64 + i] * KK[ti * 65 + tj] * dec : 0.f;
                qkout[e] = f2bf(QKr[ti * 65 + tj] * 0.08838834764831845f * dec);
            }
            if (q < 64) p.gcb[ud * 64 + q] = sg[dir * 64 + q];
        }
        __syncthreads();
        if (tid < 128) {
            const int dir = tid >> 6, blk = (tid >> 5) & 1, c = tid & 31;
            const float* Dm = Am + (dir * 64 + blk * 32) * 64 + blk * 32;
            float x[32];
#pragma unroll
            for (int i = 0; i < 32; ++i) x[i] = (i == c) ? 1.f : 0.f;
#pragma unroll
            for (int i = 1; i < 32; ++i) {
                f32x4 dr[8];
#pragma unroll
                for (int q4 = 0; q4 < 8; ++q4) if (q4 * 4 < i) dr[q4] = *(const f32x4*)(Dm + i * 64 + q4 * 4);
                float a = x[i];
#pragma unroll
                for (int jj = 0; jj < i; ++jj) a -= dr[jj >> 2][jj & 3] * x[jj];
                x[i] = a;
            }
            bf16_t* dv = Dinv + (dir * 2 + blk) * 32 * 40 + c;
#pragma unroll
            for (int i = 0; i < 32; ++i) dv[i * 40] = f2bf(x[i]);
        }
        for (int e = tid; e < 2048; e += NTHREADS) {
            const int dir = e >> 10, i = (e >> 5) & 31, jj = e & 31;
            A10[(dir * 32 + i) * 40 + jj] = f2bf(Am[(dir * 64 + 32 + i) * 64 + jj]);
        }
        __syncthreads();
        {
            const int dir = wave >> 2, slab = wave & 3;
            const long ud = ((long)(dir ? (s0 + L - 64 - (t0 - s0)) / 64 : cg) * 4 + h) * 2 + dir;
            bf16_t* RT = (bf16_t*)sm + wave * 4096;
#define RT_AT(c_, i_) (RT + (c_) * 64 + (((((i_) >> 3) ^ ((c_) & 7))) << 3) + ((i_) & 7))
            const int c = slab * 64 + lane;
            const int g4 = (lane >> 4) * 4, cn = lane & 15, kg = (lane >> 4) * 8;
            {
                const bf16_t* src = c < 128 ? vv + c : kn + (c - 128);
                const int sst = c < 128 ? 128 : 136;
                const float* fac = c < 128 ? sone : seg + dir * 64;
                const float* fb = sb + dir * 64;
#pragma unroll
                for (int i8 = 0; i8 < 8; ++i8) {
                    unsigned w[4];
#pragma unroll
                    for (int e = 0; e < 4; ++e) {
                        float v[2];
#pragma unroll
                        for (int q = 0; q < 2; ++q) {
                            const int i = i8 * 8 + e * 2 + q;
                            const int ti = dir ? 63 - i : i;
                            const float f0 = bf2f(src[ti * sst]) * fb[i];
                            v[q] = f0 * fac[i];
                        }
                        w[e] = pack2(v[0], v[1]);
                    }
                    *(uint4*)RT_AT(lane, i8 * 8) = make_uint4(w[0], w[1], w[2], w[3]);
                }
            }
            asm volatile("s_waitcnt lgkmcnt(0)" ::: "memory");
            const bf16_t* D0 = Dinv + (dir * 2 + 0) * 32 * 40;
            const bf16_t* D1 = Dinv + (dir * 2 + 1) * 32 * 40;
            const bf16_t* A1 = A10 + dir * 32 * 40;
            bf16_t* dstb = (c < 128 ? p.Ub : p.Wb) + ud * 8192;
            const int cbase = (slab & 1) * 64;
            bf16x8 bfr[4];
            f32x4 X0[2][4];
#pragma unroll
            for (int nt = 0; nt < 4; ++nt) bfr[nt] = *(const bf16x8*)RT_AT(nt * 16 + cn, kg);
#pragma unroll
            for (int mt = 0; mt < 2; ++mt) {
                const bf16x8 af = *(const bf16x8*)(D0 + (mt * 16 + cn) * 40 + kg);
#pragma unroll
                for (int nt = 0; nt < 4; ++nt) X0[mt][nt] = __builtin_amdgcn_mfma_f32_16x16x32_bf16(af, bfr[nt], (f32x4){0.f, 0.f, 0.f, 0.f}, 0, 0, 0);
            }
#pragma unroll
            for (int mt = 0; mt < 2; ++mt)
#pragma unroll
                for (int nt = 0; nt < 4; ++nt) {
#pragma unroll
                    for (int r = 0; r < 4; ++r) dstb[(mt * 16 + g4 + r) * 128 + cbase + nt * 16 + cn] = f2bf(X0[mt][nt][r]);
                    *(uint2*)RT_AT(nt * 16 + cn, mt * 16 + g4) = make_uint2(pack2(X0[mt][nt][0], X0[mt][nt][1]), pack2(X0[mt][nt][2], X0[mt][nt][3]));
                }
            asm volatile("s_waitcnt lgkmcnt(0)" ::: "memory");
            f32x4 R1[2][4];
#pragma unroll
            for (int nt = 0; nt < 4; ++nt) bfr[nt] = *(const bf16x8*)RT_AT(nt * 16 + cn, kg);
#pragma unroll
            for (int mt = 0; mt < 2; ++mt) {
                const bf16x8 af = *(const bf16x8*)(A1 + (mt * 16 + cn) * 40 + kg);
#pragma unroll
                for (int nt = 0; nt < 4; ++nt) {
                    const f32x4 pr = __builtin_amdgcn_mfma_f32_16x16x32_bf16(af, bfr[nt], (f32x4){0.f, 0.f, 0.f, 0.f}, 0, 0, 0);
                    const uint2 rr = *(const uint2*)RT_AT(nt * 16 + cn, 32 + mt * 16 + g4);
                    R1[mt][nt][0] = bflo(rr.x) - pr[0]; R1[mt][nt][1] = bfhi(rr.x) - pr[1];
                    R1[mt][nt][2] = bflo(rr.y) - pr[2]; R1[mt][nt][3] = bfhi(rr.y) - pr[3];
                }
            }
            asm volatile("s_waitcnt lgkmcnt(0)" ::: "memory");
#pragma unroll
            for (int mt = 0; mt < 2; ++mt)
#pragma unroll
                for (int nt = 0; nt < 4; ++nt)
                    *(uint2*)RT_AT(nt * 16 + cn, 32 + mt * 16 + g4) = make_uint2(pack2(R1[mt][nt][0], R1[mt][nt][1]), pack2(R1[mt][nt][2], R1[mt][nt][3]));
            asm volatile("s_waitcnt lgkmcnt(0)" ::: "memory");
#pragma unroll
            for (int nt = 0; nt < 4; ++nt) bfr[nt] = *(const bf16x8*)RT_AT(nt * 16 + cn, 32 + kg);
#pragma unroll
            for (int mt = 0; mt < 2; ++mt) {
                const bf16x8 af = *(const bf16x8*)(D1 + (mt * 16 + cn) * 40 + kg);
#pragma unroll
                for (int nt = 0; nt < 4; ++nt) {
                    const f32x4 x1 = __builtin_amdgcn_mfma_f32_16x16x32_bf16(af, bfr[nt], (f32x4){0.f, 0.f, 0.f, 0.f}, 0, 0, 0);
#pragma unroll
                    for (int r = 0; r < 4; ++r) dstb[(32 + mt * 16 + g4 + r) * 128 + cbase + nt * 16 + cn] = f2bf(x1[r]);
                }
            }
        }
    }
#undef RT_AT
}
typedef short s16x4 __attribute__((ext_vector_type(4)));
#define SCAN_KOFF(r_, ch_) (256 * (r_) + 16 * ((ch_) ^ ((((r_) & 3) << 2) | (((r_) >> 2) & 3))))
#define SCAN_SMEM_BYTES (17408 + 17408 + 9216 + 18432 + 8 * 4352 + 8 * 2 * 2304 + 512)
__device__ __forceinline__ void ph_e_scan(CP& p, int j, char* smem) {
    for (int st = lbid(); st < 192; st += gridDim.x) {
        const int tid = ltid(), lane = tid & 63, wave = tid >> 6;
        bf16_t* Ws = (bf16_t*)smem;
        bf16_t* Qs = Ws + 64 * 136;
        bf16_t* QKs = Qs + 64 * 136;
        bf16_t* KnT = QKs + 64 * 72;
        bf16_t* St = KnT + 128 * 72 + wave * (16 * 136);
        bf16_t* VNt = KnT + 128 * 72 + 8 * (16 * 136) + wave * (2 * 16 * 72);
        bf16_t* VNs = VNt + 16 * 72;
        float* gcs = (float*)(smem + 17408 + 17408 + 9216 + 18432 + 8 * 4352 + 8 * 2 * 2304);
        const int g4 = (lane >> 4) * 4, cn = lane & 15;
        int seq, h, dir;
        if (st < 64) { seq = 16 + (st >> 3); h = (st >> 1) & 3; dir = st & 1; }
        else { const int q = st - 64; seq = q >> 3; h = (q >> 1) & 3; dir = q & 1; }
        const int L = seq < 16 ? 256 : 4096;
        const int s0 = seq < 16 ? seq * 256 : TP_TOK + (seq - 16) * 4096;
        const int nch = L / 64;
        f32x4 S[8][1];
        if (seq >= 16) {
            const float* sp = p.state_gdn + ((((long)(seq - 16) * 2 + j) * 2 + dir) * 4 + h) * 16384 + (g4 * 128 + wave * 16 + cn);
#pragma unroll
            for (int mt = 0; mt < 8; ++mt)
#pragma unroll
                for (int r = 0; r < 4; ++r) S[mt][0][r] = sp[(mt * 16 + r) * 128];
        } else {
#pragma unroll
            for (int mt = 0; mt < 8; ++mt) S[mt][0] = (f32x4){0.f, 0.f, 0.f, 0.f};
        }
        u32x4 pw[2], pq[2], pk[2], pqk;
        float pgc = 0.f;
        float pu[16];
#define SCAN_LOAD_MAIN(M)                                                                                              \
        {                                                                                                              \
            const long ud_ = ((long)(s0 / 64 + (M)) * 4 + h) * 2 + dir;                                               \
            _Pragma("unroll") for (int i_ = 0; i_ < 2; ++i_) {                                                       \
                const int id_ = tid + i_ * NTHREADS, c_ = id_ >> 4, ch_ = id_ & 15;                                   \
                const int t_ = dir ? s0 + L - 1 - ((M) * 64 + c_) : s0 + (M) * 64 + c_;                               \
                pw[i_] = *(const u32x4*)(p.Wb + ud_ * 8192 + c_ * 128 + ch_ * 8);                                     \
                pq[i_] = *(const u32x4*)(p.qn + ((long)t_ * 4 + h) * 128 + ch_ * 8);                                  \
                pk[i_] = *(const u32x4*)(p.kn + ((long)t_ * 4 + h) * 128 + ch_ * 8);                                  \
            }                                                                                                          \
            pqk = *(const u32x4*)(p.QKb + ud_ * 4096 + (tid >> 3) * 64 + (tid & 7) * 8);                              \
            if (tid < 64) pgc = p.gcb[ud_ * 64 + tid];                                                                \
        }
#define SCAN_LOAD_U(M)                                                                                                 \
        {                                                                                                              \
            const long ud_ = ((long)(s0 / 64 + (M)) * 4 + h) * 2 + dir;                                               \
            long uo_ = ud_ * 8192 + (g4 * 128 + wave * 16 + cn);                                                       \
            asm volatile("" : "+v"(uo_));        \
            const bf16_t* ub_ = p.Ub + uo_;                                                                            \
            _Pragma("unroll") for (int mt_ = 0; mt_ < 4; ++mt_)                                                      \
                _Pragma("unroll") for (int r_ = 0; r_ < 4; ++r_)                                                     \
                    pu[mt_ * 4 + r_] = bf2f(ub_[(mt_ * 16 + r_) * 128]);                                              \
        }
        SCAN_LOAD_MAIN(0)
        SCAN_LOAD_U(0)
        for (int m = 0; m < nch; ++m) {
            __syncthreads();
#pragma unroll
            for (int i = 0; i < 2; ++i) {
                const int id = tid + i * NTHREADS, c = id >> 4, ch = id & 15;
                *(u32x4*)(Ws + c * 136 + ch * 8) = pw[i];
                *(u32x4*)(Qs + c * 136 + ch * 8) = pq[i];
                *(u32x4*)((char*)KnT + SCAN_KOFF(c, ch)) = pk[i];
            }
            *(u32x4*)(QKs + (tid >> 3) * 72 + (tid & 7) * 8) = pqk;
            if (tid < 64) gcs[tid] = pgc;
#pragma unroll
            for (int mt = 0; mt < 8; ++mt)
                *(uint2*)(St + cn * 136 + mt * 16 + g4) = make_uint2(pack2(S[mt][0][0], S[mt][0][1]), pack2(S[mt][0][2], S[mt][0][3]));
            __syncthreads();
            if (m + 1 < nch) SCAN_LOAD_MAIN(m + 1)
            f32x4 ws[4][1], qs[4][1];
#pragma unroll
            for (int mt = 0; mt < 4; ++mt) { ws[mt][0] = (f32x4){0.f, 0.f, 0.f, 0.f}; qs[mt][0] = (f32x4){0.f, 0.f, 0.f, 0.f}; }
            wave_mma_u<4, 1, 4>(ws, Ws, 136, St, 136);
            wave_mma_u<4, 1, 4>(qs, Qs, 136, St, 136);
            const float glast = gcs[63];
            f32x4 vn[4];
#pragma unroll
            for (int mt = 0; mt < 4; ++mt) {
                float sc[4];
#pragma unroll
                for (int r = 0; r < 4; ++r) {
                    const int c = mt * 16 + g4 + r;
                    vn[mt][r] = pu[mt * 4 + r] - ws[mt][0][r];
                    sc[r] = vn[mt][r] * __expf(glast - gcs[c]);
                }
                *(uint2*)(VNt + cn * 72 + mt * 16 + g4) = make_uint2(pack2(vn[mt][0], vn[mt][1]), pack2(vn[mt][2], vn[mt][3]));
                *(uint2*)(VNs + cn * 72 + mt * 16 + g4) = make_uint2(pack2(sc[0], sc[1]), pack2(sc[2], sc[3]));
            }
            if (m + 1 < nch) SCAN_LOAD_U(m + 1)
            asm volatile("s_waitcnt lgkmcnt(0)" ::: "memory");
            f32x4 oo[4][1];
#pragma unroll
            for (int mt = 0; mt < 4; ++mt)
#pragma unroll
                for (int r = 0; r < 4; ++r) oo[mt][0][r] = 0.08838834764831845f * __expf(gcs[mt * 16 + g4 + r]) * qs[mt][0][r];
            wave_mma_u<4, 1, 2>(oo, QKs, 72, VNt, 72);
            {
                const int t0_ = dir ? s0 + L - 1 - (m * 64 + g4) : s0 + m * 64 + g4;
                long oo_ = ((long)t0_ * 4 + h) * 128 + wave * 16 + cn;
                asm volatile("" : "+v"(oo_));
                bf16_t* od = (dir ? p.ob : p.of) + oo_;
                if (dir) {
#pragma unroll
                    for (int mt = 0; mt < 4; ++mt)
#pragma unroll
                        for (int r = 0; r < 4; ++r) od[-(mt * 16 + r) * 512] = f2bf(oo[mt][0][r]);
                } else {
#pragma unroll
                    for (int mt = 0; mt < 4; ++mt)
#pragma unroll
                        for (int r = 0; r < 4; ++r) od[(mt * 16 + r) * 512] = f2bf(oo[mt][0][r]);
                }
            }
            const float eg = __expf(glast);
#pragma unroll
            for (int mt = 0; mt < 8; ++mt) S[mt][0] = S[mt][0] * eg;
            {
                const int q_ = (lane >> 2) & 3, pp_ = lane & 3, g_ = lane >> 4;
#pragma unroll
                for (int ks = 0; ks < 2; ++ks) {
                    const bf16x8 bfr = *(const bf16x8*)(VNs + cn * 72 + ks * 32 + g_ * 8);
                    s16x4 lo[8], hi[8];
#pragma unroll
                    for (int mt = 0; mt < 8; ++mt) {
                        const int r0 = ks * 32 + g_ * 8 + q_, chk = mt * 2 + (pp_ >> 1);
                        lo[mt] = __builtin_amdgcn_ds_read_tr16_b64_v4i16((__attribute__((address_space(3))) s16x4*)((char*)KnT + SCAN_KOFF(r0, chk) + 8 * (pp_ & 1)));
                        hi[mt] = __builtin_amdgcn_ds_read_tr16_b64_v4i16((__attribute__((address_space(3))) s16x4*)((char*)KnT + SCAN_KOFF(r0 + 4, chk) + 8 * (pp_ & 1)));
                    }
#pragma unroll
                    for (int mt = 0; mt < 8; ++mt) {
                        const bf16x8 afr = __builtin_shufflevector(lo[mt], hi[mt], 0, 1, 2, 3, 4, 5, 6, 7);
                        S[mt][0] = __builtin_amdgcn_mfma_f32_16x16x32_bf16(afr, bfr, S[mt][0], 0, 0, 0);
                    }
                }
            }
        }
#undef SCAN_LOAD_MAIN
#undef SCAN_LOAD_U
        if (seq < 16) {
            float* dp = p.out + OUT_STATE + ((((long)seq * 2 + j) * 2 + dir) * 4 + h) * 16384 + (g4 * 128 + wave * 16 + cn);
#pragma unroll
            for (int mt = 0; mt < 8; ++mt)
#pragma unroll
                for (int r = 0; r < 4; ++r) dp[(mt * 16 + r) * 128] = S[mt][0][r];
        }
    }
}

__device__ __forceinline__ void ph_fft_a(CP& p, char* smem) {
    __syncthreads();
    float* tws = (float*)(smem + GEMM_SMEM_BYTES);
    {
        const int t_ = ltid();
        f32x4 t4[4];
#pragma unroll
        for (int i = 0; i < 4; ++i) t4[i] = *(const f32x4*)(p.fftTW + (t_ + i * NTHREADS) * 4);
#pragma unroll
        for (int i = 0; i < 4; ++i) *(f32x4*)(tws + (t_ + i * NTHREADS) * 4) = t4[i];
    }
    __syncthreads();
    for (int u = lbid(); u < 1024; u += gridDim.x) {
        gemm_tile<0>(p.ZtA + ZA_OFF + (long)u * 256 * 128, 128, p.fftMA, 128, 128, (bf16_t*)smem, [&](int r, int c, f32x4 v) {
            const int gr = u * 256 + r;
            const int n2 = gr & 63, cf = (gr >> 6) & 511, b = gr >> 15;
            const int k1 = c >> 1, po = c & 1;
            f32x4 h;
#pragma unroll
            for (int i = 0; i < 4; ++i) {
                const float other = xshfl<1>(v[i]);
                const float2 tw = *(const float2*)(tws + ((n2 + i) * 64 + k1) * 2);
                h[i] = po == 0 ? (v[i] * tw.x + other * tw.y) : (v[i] * tw.x - other * tw.y);
            }
            bf16_t* dst = p.HB + (((((long)b * 64 + k1) * 512 + cf) * 2 + po) * 64 + n2);
            *(uint2*)dst = make_uint2(pack2(h[0], h[1]), pack2(h[2], h[3]));
        });
    }
}
__device__ __forceinline__ void ph_fft_b(CP& p, char* smem) {
    __syncthreads();
    const int nb = gridDim.x;
    for (int uu = lbid(); uu < 1024 + 64; uu += nb) {
        const int u = 1024 + 63 - uu;
        if (u < 0) continue;
        if (u < 1024) {
            gemm_tile<0>(p.HB + (long)u * 256 * 128, 128, p.fftMB, 128, 128, (bf16_t*)smem, [&](int r, int c, f32x4 v) {
                if (c < 64) {
                    const int gr = u * 256 + r;
                    const int cf = gr & 511, k1 = (gr >> 9) & 63, b = gr >> 15;
                    const long tok = TP_TOK + (long)b * 4096 + k1 + 64 * c;
                    *(uint2*)(p.mix + tok * DM + 512 + cf) = make_uint2(pack2(v[0], v[1]), pack2(v[2], v[3]));
                }
            });
        } else {
            const int q = u - 1024, seq = q >> 2, tm = (q >> 1) & 1, tn = q & 1;
            const int s0 = seq * 256;
            gemm_tile<0>(p.ZtA + (long)s0 * 1024 + (long)tm * 256 * 512, 512, p.dftP + (long)tn * 128 * 512, 512, 512, (bf16_t*)smem, [&](int r, int c, f32x4 v) {
                const int cf = tm * 256 + r, k = tn * 128 + c;
                *(uint2*)(p.mix + (long)(s0 + k) * DM + 512 + cf) = make_uint2(pack2(v[0], v[1]), pack2(v[2], v[3]));
            });
        }
    }
}

__device__ __forceinline__ void ph_e_mix(CP& p, int j) {
    const int lane = ltid() & 63, wave = ltid() >> 6;
    const float* onw = p.gdn_o_norm + j * 128;
    const float w0 = onw[lane * 2], w1 = onw[lane * 2 + 1];
    for (int row = lbid() * 8 + wave; row < T_TOK; row += gridDim.x * 8) {
        unsigned av[4], bv[4], gvv[4];
#pragma unroll
        for (int h = 0; h < 4; ++h) {
            av[h] = *(const unsigned*)(p.of + ((long)row * 4 + h) * 128 + lane * 2);
            bv[h] = *(const unsigned*)(p.ob + ((long)row * 4 + h) * 128 + lane * 2);
            gvv[h] = *(const unsigned*)(p.gate + (long)row * 512 + h * 128 + lane * 2);
        }
#pragma unroll
        for (int h = 0; h < 4; ++h) {
            const float o0 = bflo(av[h]) + bflo(bv[h]), o1 = bfhi(av[h]) + bfhi(bv[h]);
            const float ss = wave_sum(o0 * o0 + o1 * o1);
            const float r = rsqrtf(ss * (1.f / 128.f) + 1e-6f);
            *(unsigned*)(p.mix + (long)row * DM + h * 128 + lane * 2) = pack2(o0 * r * w0 * silu_f(bflo(gvv[h])), o1 * r * w1 * silu_f(bfhi(gvv[h])));
        }
    }
}

template <int FROM_INPUT = 0>
__device__ __forceinline__ void ph_out_gemm(CP& p, const bf16_t* A, const bf16_t* Wt, const float* mods_l, int g_off, char* smem, const float gscale = 1.f) {
    const int ntn = 4, ntm = T_TOK / 256;
#define OG_PROLOGUE(U) { int tm_, tn_; tile_map((U), ntm, ntn, tm_, tn_); g8_prologue<0>(A + (long)tm_ * 256 * DM, DM, Wt + (long)tn_ * 256 * 1024, 1024, (bf16_t*)smem); }
    int u = lbid();
    if (u < ntn * ntm) OG_PROLOGUE(u)
    for (; u < ntn * ntm; u += gridDim.x) {
        int tm, tn;
        tile_map(u, ntm, ntn, tm, tn);
        const int row0 = tm * 256, col0 = tn * 256;
        const float* gv = mods_l + (long)tok_modrow(row0) * 6144 + g_off;
        f32x4 acc[2][2][4][2];
        gemm_tile256_acc<0, 1>(A + (long)row0 * DM, DM, Wt + (long)col0 * 1024, 1024, 1024, (bf16_t*)smem, acc);
        if (u + (int)gridDim.x < ntn * ntm) OG_PROLOGUE(u + gridDim.x)
        const int tz = ltid(), wid = tz >> 6, lane = tz & 63, wr = wid >> 2, wc = wid & 3, fr = lane & 15, fq = lane >> 4;
#pragma unroll
        for (int ai = 0; ai < 2; ++ai)
#pragma unroll
            for (int bj = 0; bj < 2; ++bj) {
                const long xo = (long)(row0 + ai * 128 + wr * 64 + fq * 4) * DM + col0 + bj * 128 + wc * 32 + fr;
                float* xb = p.out + xo;
                const float* xs = FROM_INPUT ? (row0 < TP_TOK ? p.x_prompt + xo : p.x_sample + (xo - (long)TP_TOK * DM)) : xb;
                const float g0 = gv[col0 + bj * 128 + wc * 32 + fr] * gscale, g1 = gv[col0 + bj * 128 + wc * 32 + 16 + fr] * gscale;
                float xv[4][2][4];
#pragma unroll
                for (int m = 0; m < 4; ++m)
#pragma unroll
                    for (int n = 0; n < 2; ++n)
#pragma unroll
                        for (int i = 0; i < 4; ++i) xv[m][n][i] = xs[(long)(m * 16 + i) * DM + n * 16];
#pragma unroll
                for (int m = 0; m < 4; ++m)
#pragma unroll
                    for (int n = 0; n < 2; ++n)
#pragma unroll
                        for (int i = 0; i < 4; ++i) xb[(long)(m * 16 + i) * DM + n * 16] = xv[m][n][i] + (n ? g1 : g0) * acc[ai][bj][m][n][i];
            }
    }
#undef OG_PROLOGUE
}
__device__ __forceinline__ void ph_o_gemm1(CP& p, int j, char* smem) {
    const int ntn = N_OIN / 256, ntm = T_TOK / 256;
    const bf16_t* Bt = p.wtO_in + (long)j * N_OIN * 1024;
    for (int u = lbid(); u < ntn * ntm; u += gridDim.x) {
        int tm, tn;
        tile_map(u, ntm, ntn, tm, tn);
        const int row0 = tm * 256, col0 = tn * 256;
        gemm_tile256<0>(p.H + (long)row0 * DM, DM, Bt + (long)col0 * 1024, 1024, 1024, (bf16_t*)smem, [&](int r, int c, f32x4 v) {
            const int col = col0 + c;
            if (col < 832) {
#pragma unroll
                for (int i = 0; i < 4; ++i) p.Podd[(long)(row0 + r + i) * 832 + col] = v[i];
            }
        });
    }
}

__device__ __forceinline__ void ph_o_norm(CP& p, int j) {
    const int lane = ltid() & 63, wave = ltid() >> 6;
    float qw[8], kw[4];
#pragma unroll
    for (int i = 0; i < 8; ++i) qw[i] = p.mla_q_norm[j * 512 + i * 64 + lane];
#pragma unroll
    for (int i = 0; i < 4; ++i) kw[i] = p.mla_kv_norm[j * 256 + i * 64 + lane];
    for (int row = lbid() * 8 + wave; row < T_TOK + 2048; row += gridDim.x * 8) {
        if (row < T_TOK) {
            const float* pr = p.Podd + (long)row * 832;
            float q[8], k[4];
            float ssq = 0.f, ssk = 0.f;
#pragma unroll
            for (int i = 0; i < 8; ++i) { q[i] = pr[i * 64 + lane]; ssq += q[i] * q[i]; }
#pragma unroll
            for (int i = 0; i < 4; ++i) { k[i] = pr[512 + i * 64 + lane]; ssk += k[i] * k[i]; }
            const float kr = pr[768 + lane];
            ssq = wave_sum(ssq); ssk = wave_sum(ssk);
            const float rq = rsqrtf(ssq * (1.f / 512.f) + 1e-6f), rk = rsqrtf(ssk * (1.f / 256.f) + 1e-6f);
#pragma unroll
            for (int i = 0; i < 8; ++i) p.cq[(long)row * 512 + i * 64 + lane] = f2bf(q[i] * rq * qw[i]);
#pragma unroll
            for (int i = 0; i < 4; ++i) {
                const float v = k[i] * rk * kw[i];
                p.ckv_all[(long)row * 256 + i * 64 + lane] = f2bf(v);
                if (row < TP_TOK) p.out[OUT_CKV + (((long)(row >> 8) * 2 + j) * 256 + (row & 255)) * 256 + i * 64 + lane] = v;
            }
            p.kr_all[(long)row * 64 + lane] = kr;
            if (row < TP_TOK) p.out[OUT_KR + (((long)(row >> 8) * 2 + j) * 256 + (row & 255)) * 64 + lane] = kr;
        } else {
            const int rc = row - T_TOK, b = rc >> 8, t = rc & 255;
            const float* src = p.cache_ckv + (((long)b * 2 + j) * 256 + t) * 256;
#pragma unroll
            for (int i = 0; i < 4; ++i) p.ckv_all[(long)row * 256 + i * 64 + lane] = f2bf(src[i * 64 + lane]);
            p.kr_all[(long)row * 64 + lane] = p.cache_kr[(((long)b * 2 + j) * 256 + t) * 64 + lane];
        }
    }
}

#define KB_S (16L * 8 * 256 * 192)
#define VT_S (16L * 8 * 128 * 256)
__device__ __forceinline__ void ph_o_gemm2(CP& p, int j, char* smem) {
    const int nA = 6 * (T_TOK / 256);
    const int nB = 8 * ((T_TOK + 2048) / 256);
    for (int u = lbid(); u < nA + nB; u += gridDim.x) {
        if (u < nA) {
            int tm, tn;
            tile_map(u, T_TOK / 256, 6, tm, tn);
            const int row0 = tm * 256, col0 = tn * 256;
            const int s0 = tok_seq0(row0), L = tok_len(row0);
            f32x4 acc[2][2][4][2];
            gemm_tile256_acc<0, 0, 3>(p.cq + (long)row0 * 512, 512, p.wtUq + (long)j * 1536 * 512 + (long)col0 * 512, 512, 512, (bf16_t*)smem, acc);
            const int tz = ltid(), wid = tz >> 6, lane = tz & 63, wr = wid >> 2, wc = wid & 3, fr = lane & 15, fq = lane >> 4;
#pragma unroll
            for (int bj = 0; bj < 2; ++bj)
#pragma unroll
                for (int n = 0; n < 2; ++n) {
                    const int col = col0 + bj * 128 + wc * 32 + n * 16 + fq * 4, h = col / 192, d = col - h * 192;
                    bf16_t* qd = p.Qb + (long)s0 * 1536 + ((long)h * L + (row0 - s0) + wr * 64 + fr) * 192 + d;
#pragma unroll
                    for (int ai = 0; ai < 2; ++ai)
#pragma unroll
                        for (int m = 0; m < 4; ++m) {
                            const f32x4 v = acc[ai][bj][m][n];
                            *(uint2*)(qd + (ai * 128 + m * 16) * 192) = make_uint2(pack2(v[0], v[1]), pack2(v[2], v[3]));
                        }
                }
        } else {
            const int q = u - nA;
            int tm, tn;
            tile_map(q, (T_TOK + 2048) / 256, 8, tm, tn);
            const int row0 = tm * 256, col0 = tn * 256;
            long kbase, vbase; int Lk, pos0;
            if (row0 < TP_TOK) { const int s = row0 >> 8; kbase = (long)s * 8 * 256 * 192; vbase = (long)s * 8 * 128 * 256; Lk = 256; pos0 = 0; }
            else if (row0 < T_TOK) { const int b = (row0 - TP_TOK) >> 12; kbase = KB_S + (long)b * 8 * 4352 * 192; vbase = VT_S + (long)b * 8 * 128 * 4352; Lk = 4352; pos0 = (row0 - TP_TOK) & 4095; }
            else { const int b = (row0 - T_TOK) >> 8; kbase = KB_S + (long)b * 8 * 4352 * 192; vbase = VT_S + (long)b * 8 * 128 * 4352; Lk = 4352; pos0 = 4096; }
            f32x4 acc[2][2][4][2];
            gemm_tile256_acc<0, 0, 1>(p.ckv_all + (long)row0 * 256, 256, p.wtUkv + (long)j * 2048 * 256 + (long)col0 * 256, 256, 256, (bf16_t*)smem, acc);
            const int tz = ltid(), wid = tz >> 6, lane = tz & 63, wr = wid >> 2, wc = wid & 3, fr = lane & 15, fq = lane >> 4;
            const int h = tn;
            bf16_t* kd = p.Kb + kbase + ((long)h * Lk + pos0 + wr * 64 + fr) * 192 + wc * 32 + fq * 4;
#pragma unroll
            for (int ai = 0; ai < 2; ++ai)
#pragma unroll
                for (int m = 0; m < 4; ++m)
#pragma unroll
                    for (int n = 0; n < 2; ++n) {
                        const f32x4 v = acc[ai][0][m][n];
                        *(uint2*)(kd + (ai * 128 + m * 16) * 192 + n * 16) = make_uint2(pack2(v[0], v[1]), pack2(v[2], v[3]));
                    }
            bf16_t* vd = p.Vtb + vbase + ((long)h * 128 + wc * 32 + fr) * Lk;
#pragma unroll
            for (int ai = 0; ai < 2; ++ai)
#pragma unroll
                for (int m = 0; m < 4; ++m) {
                    const int kp = pos0 + ai * 128 + wr * 64 + m * 16 + fq * 4, kq = (kp & ~31) | (((kp >> 2) & 3) << 3) | (((kp >> 4) & 1) << 2);
#pragma unroll
                    for (int n = 0; n < 2; ++n) {
                        const f32x4 v = acc[ai][1][m][n];
                        *(uint2*)(vd + (long)n * 16 * Lk + kq) = make_uint2(pack2(v[0], v[1]), pack2(v[2], v[3]));
                    }
                }
        }
    }
}

__device__ __forceinline__ void ph_o_qknorm(CP& p, int j) {
    const int lane = ltid() & 63, wave = ltid() >> 6;
    const float* qnw = p.mla_q_headnorm + j * 192;
    const float* knw = p.mla_k_headnorm + j * 192;
    const float qw0 = qnw[lane], qw1 = qnw[64 + lane], qw2 = qnw[128 + lane];
    const float kw0 = knw[lane], kw1 = knw[64 + lane], kw2 = knw[128 + lane];
    const float inv = exp2f(-(float)(lane & 15) * 0.8304820237218406f);
    for (int row = lbid() * 8 + wave; row < T_TOK + 2048; row += gridDim.x * 8) {
        bool rope = false; float cs = 1.f, sn = 0.f;
        long kbase; int Lk, pos;
        if (row < TP_TOK) { const int s = row >> 8; kbase = (long)s * 8 * 256 * 192; Lk = 256; pos = row & 255; }
        else if (row < T_TOK) {
            const int b = (row - TP_TOK) >> 12; pos = (row - TP_TOK) & 4095; kbase = KB_S + (long)b * 8 * 4352 * 192; Lk = 4352; rope = true;
            const float ang = (float)((lane & 32) ? (pos & 63) : (pos >> 6)) * inv;
            sincosf(ang, &sn, &cs);
        } else { const int rc = row - T_TOK; const int b = rc >> 8; pos = 4096 + (rc & 255); kbase = KB_S + (long)b * 8 * 4352 * 192; Lk = 4352; }
        const float kr = p.kr_all[(long)row * 64 + lane];
        const bool hi = (lane & 16) != 0;
        const bool isq = row < T_TOK;
        const int s0 = isq ? tok_seq0(row) : 0, L = isq ? tok_len(row) : 1;
        bf16_t* kp0 = p.Kb + kbase + (long)pos * 192;
        bf16_t* qp0 = p.Qb + (long)s0 * 1536 + (long)(row - s0) * 192;
        float k0[8], k1[8], q0[8], q1[8], q2[8];
#pragma unroll
        for (int h = 0; h < 8; ++h) {
            const bf16_t* kp = kp0 + (long)h * Lk * 192;
            k0[h] = bf2f(kp[lane]); k1[h] = bf2f(kp[64 + lane]);
        }
        if (isq) {
#pragma unroll
            for (int h = 0; h < 8; ++h) {
                const bf16_t* qp = qp0 + (long)h * L * 192;
                q0[h] = bf2f(qp[lane]); q1[h] = bf2f(qp[64 + lane]); q2[h] = bf2f(qp[128 + lane]);
            }
        }
#pragma unroll
        for (int h = 0; h < 8; ++h) {
            bf16_t* kp = kp0 + (long)h * Lk * 192;
            const float ss = wave_sum(k0[h] * k0[h] + k1[h] * k1[h] + kr * kr);
            const float r = rsqrtf(ss * (1.f / 192.f) + 1e-6f);
            float y2 = kr * r * kw2;
            if (rope) {
                const float o = xshfl<16>(y2);
                y2 = hi ? (o * sn + y2 * cs) : (y2 * cs - o * sn);
            }
            kp[lane] = f2bf(k0[h] * r * kw0); kp[64 + lane] = f2bf(k1[h] * r * kw1); kp[128 + lane] = f2bf(y2);
        }
        if (isq) {
#pragma unroll
            for (int h = 0; h < 8; ++h) {
                bf16_t* qp = qp0 + (long)h * L * 192;
                const float ss = wave_sum(q0[h] * q0[h] + q1[h] * q1[h] + q2[h] * q2[h]);
                const float r = rsqrtf(ss * (1.f / 192.f) + 1e-6f) * 0.10411755f;
                float y2 = q2[h] * r * qw2;
                if (rope) {
                    const float o = xshfl<16>(y2);
                    y2 = hi ? (o * sn + y2 * cs) : (y2 * cs - o * sn);
                }
                qp[lane] = f2bf(q0[h] * r * qw0); qp[64 + lane] = f2bf(q1[h] * r * qw1); qp[128 + lane] = f2bf(y2);
            }
        }
    }
}

#define ATT_KLD 208
#define ATT_VLD 80
#define ATTN_SMEM_BYTES (2 * 64 * ATT_KLD * 2 + 3 * 128 * ATT_VLD * 2)
__device__ __forceinline__ void ph_o_attn(CP& p, char* smem) {
    for (int u = lbid(); u < 1152; u += gridDim.x) {
        int lz = 0, tid = ltid();
        asm volatile("" : "+s"(lz), "+v"(tid));
        const int lane = tid & 63, wave = tid >> 6;
        const int g = lane >> 4, cn = lane & 15, kg = g * 8;
        bf16_t* Ks = (bf16_t*)(smem + lz);
        bf16_t* Vs = Ks + 2 * 64 * ATT_KLD;
        int s0, L, Lk, h, q0; long kbase, vbase;
        if (u < 1024) { const int b = u >> 7; h = (u >> 4) & 7; q0 = (u & 15) * 256; s0 = TP_TOK + b * 4096; L = 4096; Lk = 4352; kbase = KB_S + (long)b * 8 * 4352 * 192; vbase = VT_S + (long)b * 8 * 128 * 4352; }
        else { const int q = u - 1024; const int s = q >> 3; h = q & 7; q0 = 0; s0 = s * 256; L = 256; Lk = 256; kbase = (long)s * 8 * 256 * 192; vbase = (long)s * 8 * 128 * 256; }
        const bf16_t* Qp = p.Qb + (long)s0 * 1536 + ((long)h * L + q0 + wave * 32) * 192;
        const bf16_t* Kp = p.Kb + kbase + (long)h * Lk * 192;
        const bf16_t* Vp = p.Vtb + vbase + (long)h * 128 * Lk;
        bf16x8 qb[2][6];
#pragma unroll
        for (int mt = 0; mt < 2; ++mt)
#pragma unroll
            for (int ks = 0; ks < 6; ++ks) qb[mt][ks] = *(const bf16x8*)(Qp + (mt * 16 + cn) * 192 + ks * 32 + kg);
        f32x4 o[8][2];
        f32x4 negm[2];
        float lrow[2];
#pragma unroll
        for (int mt = 0; mt < 2; ++mt) {
#pragma unroll
            for (int dt = 0; dt < 8; ++dt) o[dt][mt] = (f32x4){0.f, 0.f, 0.f, 0.f};
            negm[mt] = (f32x4){0.f, 0.f, 0.f, 0.f}; lrow[mt] = 0.f;
        }
        const int nkt = Lk / 64;
        u32x4 rk[3], rv[2];
        f32x4 s[4][2];
        bf16x8 pb[2][2];
        bf16x8 fa[2][4];
#define ATT_SB() __builtin_amdgcn_sched_barrier(0)
#define ATT_LDK(dst_, Kc_, ks_) _Pragma("unroll") for (int nt = 0; nt < 4; ++nt) dst_[nt] = *(const bf16x8*)((Kc_) + (nt * 16 + cn) * ATT_KLD + (ks_) * 32 + kg)
#define ATT_LDV(dst_, Vc_, b_) _Pragma("unroll") for (int d4 = 0; d4 < 4; ++d4) dst_[d4] = *(const bf16x8*)((Vc_) + ((((b_) & 1) * 4 + d4) * 16 + cn) * ATT_VLD + ((b_) >> 1) * 32 + kg)
        float pv[2][4][4];
#define ATT_LDK2(dst_, Kc_, h_, ks_) _Pragma("unroll") for (int n_ = 0; n_ < 2; ++n_) dst_[n_] = *(const bf16x8*)((Kc_) + ((2 * (h_) + n_) * 16 + cn) * ATT_KLD + (ks_) * 32 + kg)
#define ATT_PACK(mt_, k2_)                                                                                             \
        {                                                                                                              \
            u32x4 w_;                                                                                                  \
            w_[0] = pack2(pv[mt_][2 * (k2_)][0], pv[mt_][2 * (k2_)][1]); w_[1] = pack2(pv[mt_][2 * (k2_)][2], pv[mt_][2 * (k2_)][3]);   \
            w_[2] = pack2(pv[mt_][2 * (k2_) + 1][0], pv[mt_][2 * (k2_) + 1][1]); w_[3] = pack2(pv[mt_][2 * (k2_) + 1][2], pv[mt_][2 * (k2_) + 1][3]);   \
            pb[mt_][k2_] = __builtin_bit_cast(bf16x8, w_);                                                             \
        }
#define ATT_QK(Kc_, Vc_)                                                                                               \
        {                                                                                                              \
            ATT_LDK2(fa[0], Kc_, 0, 0);                                                                                \
            _Pragma("unroll") for (int t_ = 0; t_ < 12; ++t_) {                                                      \
                const int h_ = t_ / 6, ks = t_ % 6;                                                                    \
                if (t_ < 11) { ATT_LDK2(fa[(t_ + 1) & 1], Kc_, (t_ + 1) / 6, (t_ + 1) % 6); } else { ATT_LDV(fa[0], Vc_, 0); }   \
                ATT_SB();                                                                                              \
                _Pragma("unroll") for (int n_ = 0; n_ < 2; ++n_)                                                     \
                    _Pragma("unroll") for (int mt = 0; mt < 2; ++mt)                                                 \
                        s[2 * h_ + n_][mt] = __builtin_amdgcn_mfma_f32_16x16x32_bf16(fa[t_ & 1][n_], qb[mt][ks], ks == 0 ? negm[mt] : s[2 * h_ + n_][mt], 0, 0, 0);   \
                if (h_ == 1 && ks < 4) {                                                                               \
                    _Pragma("unroll") for (int r = 0; r < 4; ++r) pv[ks >> 1][ks & 1][r] = __builtin_amdgcn_exp2f(s[ks & 1][ks >> 1][r]);   \
                }                                                                                                      \
                if (h_ == 1 && ks >= 4) ATT_PACK(ks - 4, 0)                                                            \
                if (t_ < 11) ATT_SB();                                                                                 \
            }                                                                                                          \
        }
#define ATT_PBIG 4096.f
#define ATT_SOFTMAX(first_)                                                                                            \
        {                                                                                                              \
            float ps[2];                                                                                               \
            _Pragma("unroll") for (int mt = 0; mt < 2; ++mt) {                                                       \
                _Pragma("unroll") for (int nt = 2; nt < 4; ++nt)                                                     \
                    _Pragma("unroll") for (int r = 0; r < 4; ++r) pv[mt][nt][r] = __builtin_amdgcn_exp2f(s[nt][mt][r]);   \
                ps[mt] = 0.f;                                                                                          \
                _Pragma("unroll") for (int nt = 0; nt < 4; ++nt)                                                     \
                    _Pragma("unroll") for (int r = 0; r < 4; ++r) ps[mt] += pv[mt][nt][r];                           \
            }                                                                                                          \
            const bool ok = !(first_) && ps[0] <= ATT_PBIG && ps[1] <= ATT_PBIG;                                       \
            if (!__all(ok)) {                                                                                          \
                _Pragma("unroll") for (int mt = 0; mt < 2; ++mt) {                                                   \
                    float mx = fmaxf(fmaxf(s[0][mt][0], s[0][mt][1]), fmaxf(s[0][mt][2], s[0][mt][3]));               \
                    _Pragma("unroll") for (int nt = 1; nt < 4; ++nt) mx = fmaxf(mx, fmaxf(fmaxf(s[nt][mt][0], s[nt][mt][1]), fmaxf(s[nt][mt][2], s[nt][mt][3])));   \
                    mx = fmaxf(mx, xshfl<16>(mx));                                                                     \
                    mx = fmaxf(mx, xshfl<32>(mx));                                                                     \
                    const float dl = (first_) ? mx : fmaxf(mx, 0.f);                                                   \
                    const float al = (first_) ? 1.f : __builtin_amdgcn_exp2f(-dl);                                     \
                    negm[mt] = negm[mt] - dl;                                                                          \
                    lrow[mt] *= al;                                                                                    \
                    _Pragma("unroll") for (int dt = 0; dt < 8; ++dt) o[dt][mt] = o[dt][mt] * al;                     \
                    ps[mt] = 0.f;                                                                                      \
                    _Pragma("unroll") for (int nt = 0; nt < 4; ++nt)                                                 \
                        _Pragma("unroll") for (int r = 0; r < 4; ++r) { pv[mt][nt][r] = __builtin_amdgcn_exp2f(s[nt][mt][r] - dl); ps[mt] += pv[mt][nt][r]; }   \
                    ATT_PACK(mt, 0)                                                                                    \
                }                                                                                                      \
            }                                                                                                          \
            _Pragma("unroll") for (int mt = 0; mt < 2; ++mt) {                                                       \
                lrow[mt] += ps[mt];                                                                                    \
                ATT_PACK(mt, 1)                                                                                        \
            }                                                                                                          \
        }
#define ATT_PV(Vc_)                                                                                                    \
        {                                                                                                              \
            _Pragma("unroll") for (int b = 0; b < 4; ++b) {                                                          \
                if (b < 3) { ATT_LDV(fa[(b + 1) & 1], Vc_, b + 1); }                                                   \
                ATT_SB();                                                                                              \
                _Pragma("unroll") for (int d4 = 0; d4 < 4; ++d4)                                                     \
                    _Pragma("unroll") for (int mt = 0; mt < 2; ++mt) o[(b & 1) * 4 + d4][mt] = __builtin_amdgcn_mfma_f32_16x16x32_bf16(fa[b & 1][d4], pb[mt][b >> 1], o[(b & 1) * 4 + d4][mt], 0, 0, 0);   \
                ATT_SB();                                                                                              \
            }                                                                                                          \
        }
        __syncthreads();
#pragma unroll
        for (int i = 0; i < 3; ++i) { const int ch = tid + i * 512, row = ch / 24, kc = ch % 24; rk[i] = *(const u32x4*)(Kp + (long)row * 192 + kc * 8); }
#pragma unroll
        for (int i = 0; i < 2; ++i) { const int ch = tid + i * 512, row = ch >> 3, kc = ch & 7; rv[i] = *(const u32x4*)(Vp + (long)row * Lk + kc * 8); }
#pragma unroll
        for (int i = 0; i < 3; ++i) { const int ch = tid + i * 512, row = ch / 24, kc = ch % 24; *(u32x4*)(Ks + row * ATT_KLD + kc * 8) = rk[i]; }
#pragma unroll
        for (int i = 0; i < 2; ++i) { const int ch = tid + i * 512, row = ch >> 3, kc = ch & 7; *(u32x4*)(Vs + row * ATT_VLD + kc * 8) = rv[i]; }
        __syncthreads();
        for (int it = 0; it < nkt; ++it) {
            const int cur = it & 1;
            const bool more = it + 1 < nkt;
            const long key0 = (long)(it + 1) * 64;
            if (more) {
#pragma unroll
                for (int i = 0; i < 3; ++i) { const int ch = tid + i * 512, row = ch / 24, kc = ch % 24; rk[i] = *(const u32x4*)(Kp + (key0 + row) * 192 + kc * 8); }
#pragma unroll
                for (int i = 0; i < 2; ++i) { const int ch = tid + i * 512, row = ch >> 3, kc = ch & 7; rv[i] = *(const u32x4*)(Vp + (long)row * Lk + key0 + kc * 8); }
            }
            const bf16_t* Kc = Ks + cur * 64 * ATT_KLD;
            ATT_QK(Kc, Vs + cur * 128 * ATT_VLD) ATT_SOFTMAX(it == 0) ATT_PV(Vs + cur * 128 * ATT_VLD)
            if (more) {
                bf16_t* Kn = Ks + (cur ^ 1) * 64 * ATT_KLD;
                bf16_t* Vn = Vs + (cur ^ 1) * 128 * ATT_VLD;
#pragma unroll
                for (int i = 0; i < 3; ++i) { const int ch = tid + i * 512, row = ch / 24, kc = ch % 24; *(u32x4*)(Kn + row * ATT_KLD + kc * 8) = rk[i]; }
#pragma unroll
                for (int i = 0; i < 2; ++i) { const int ch = tid + i * 512, row = ch >> 3, kc = ch & 7; *(u32x4*)(Vn + row * ATT_VLD + kc * 8) = rv[i]; }
            }
            __syncthreads();
        }
#undef ATT_QK
#undef ATT_SB
#undef ATT_LDK
#undef ATT_LDV
#undef ATT_SOFTMAX
#undef ATT_LDK2
#undef ATT_PACK
#undef ATT_PBIG
#undef ATT_PV
#pragma unroll
        for (int mt = 0; mt < 2; ++mt) {
            float l = lrow[mt];
            l += xshfl<16>(l); l += xshfl<32>(l);
            const float il = __builtin_amdgcn_rcpf(l);
            bf16_t* op = p.Ob + (long)(s0 + q0 + wave * 32 + mt * 16 + cn) * DM + h * 128 + 4 * g;
#pragma unroll
            for (int dt = 0; dt < 8; ++dt)
                *(uint2*)(op + dt * 16) = make_uint2(pack2(o[dt][mt][0] * il, o[dt][mt][1] * il), pack2(o[dt][mt][2] * il, o[dt][mt][3] * il));
        }
    }
}
__device__ __forceinline__ unsigned f2ord(float f) { const unsigned u = __float_as_uint(f); return u ^ ((u >> 31) ? 0xFFFFFFFFu : 0x80000000u); }
__device__ __forceinline__ float ord2f(unsigned o) { const unsigned u = (o >> 31) ? (o ^ 0x80000000u) : ~o; return __uint_as_float(u); }

#define KCE(a, b) { const unsigned hi_ = max(a, b), lo_ = min(a, b); a = hi_; b = lo_; }
__device__ __forceinline__ void sort16_desc(unsigned (&v)[16]) {
#define S2(a, b) KCE(v[a], v[b])
    S2(0, 13) S2(1, 12) S2(2, 15) S2(3, 14) S2(4, 8) S2(5, 6) S2(7, 11) S2(9, 10)
    S2(0, 5) S2(1, 7) S2(2, 9) S2(3, 4) S2(6, 13) S2(8, 14) S2(10, 15) S2(11, 12)
    S2(0, 1) S2(2, 3) S2(4, 5) S2(6, 8) S2(7, 9) S2(10, 11) S2(12, 13) S2(14, 15)
    S2(0, 2) S2(1, 3) S2(4, 10) S2(5, 11) S2(6, 7) S2(8, 9) S2(12, 14) S2(13, 15)
    S2(1, 2) S2(3, 12) S2(4, 6) S2(5, 7) S2(8, 10) S2(9, 11) S2(13, 14)
    S2(1, 4) S2(2, 6) S2(5, 8) S2(7, 10) S2(9, 13) S2(11, 14)
    S2(2, 4) S2(3, 6) S2(9, 12) S2(11, 13)
    S2(3, 5) S2(6, 8) S2(7, 9) S2(10, 12)
    S2(3, 4) S2(5, 6) S2(7, 8) S2(9, 10) S2(11, 12)
    S2(6, 7) S2(8, 9)
#undef S2
}
#define KCF(a, b) { const float hi_ = __builtin_fmaxf(a, b), lo_ = __builtin_fminf(a, b); a = hi_; b = lo_; }
__device__ __forceinline__ void sort16f_desc(float (&v)[16]) {
#define S2(a, b) KCF(v[a], v[b])
    S2(0, 13) S2(1, 12) S2(2, 15) S2(3, 14) S2(4, 8) S2(5, 6) S2(7, 11) S2(9, 10)
    S2(0, 5) S2(1, 7) S2(2, 9) S2(3, 4) S2(6, 13) S2(8, 14) S2(10, 15) S2(11, 12)
    S2(0, 1) S2(2, 3) S2(4, 5) S2(6, 8) S2(7, 9) S2(10, 11) S2(12, 13) S2(14, 15)
    S2(0, 2) S2(1, 3) S2(4, 10) S2(5, 11) S2(6, 7) S2(8, 9) S2(12, 14) S2(13, 15)
    S2(1, 2) S2(3, 12) S2(4, 6) S2(5, 7) S2(8, 10) S2(9, 11) S2(13, 14)
    S2(1, 4) S2(2, 6) S2(5, 8) S2(7, 10) S2(9, 13) S2(11, 14)
    S2(2, 4) S2(3, 6) S2(9, 12) S2(11, 13)
    S2(3, 5) S2(6, 8) S2(7, 9) S2(10, 12)
    S2(3, 4) S2(5, 6) S2(7, 8) S2(9, 10) S2(11, 12)
    S2(6, 7) S2(8, 9)
#undef S2
}
__device__ __forceinline__ void merge16f_desc(float (&a)[16], const float (&b)[16]) {
#pragma unroll
    for (int i = 0; i < 16; ++i) a[i] = __builtin_fmaxf(a[i], b[15 - i]);
#pragma unroll
    for (int j = 8; j > 0; j >>= 1)
#pragma unroll
        for (int i = 0; i < 16; ++i) {
            const int l = i ^ j;
            if (l > i) { KCF(a[i], a[l]) }
        }
}
__device__ __forceinline__ void merge16_desc(unsigned (&a)[16], const unsigned (&b)[16]) {
#pragma unroll
    for (int i = 0; i < 16; ++i) a[i] = max(a[i], b[15 - i]);
#pragma unroll
    for (int j = 8; j > 0; j >>= 1)
#pragma unroll
        for (int i = 0; i < 16; ++i) {
            const int l = i ^ j;
            if (l > i) { KCE(a[i], a[l]) }
        }
}

#define RT_QLD 144
#define RT_SLD 130
#define ROUTE_SMEM_BYTES (256 * RT_SLD * 4 + 256 * 32)
__device__ __forceinline__ void ph_p_route(CP& p, int l, char* smem) {
    const int ntm = T_TOK / 256;
    const bf16_t* Bt = p.wtPq + (long)l * 2048 * 1024;
    for (int u = lbid(); u < 8 * ntm; u += gridDim.x) {
        int tm, h;
        tile_map(u, ntm, 8, tm, h);
        const int row0 = tm * 256;
        bf16_t* Qs = (bf16_t*)smem;
        bf16_t* SK = (bf16_t*)(smem + 65536);
        float* sc = (float*)smem;
        unsigned char* ib = (unsigned char*)smem + 256 * RT_SLD * 4;
        __syncthreads();
        f32x4 acc[2][2][4][2];
        gemm_tile256_acc<0>(p.H + (long)row0 * DM, DM, Bt + (long)h * 256 * 1024, 1024, 1024, (bf16_t*)smem, acc);
        const int tid = ltid(), lane = tid & 63, wave = tid >> 6;
        const int g4 = (lane >> 4) * 4, cn = lane & 15, kg = (lane >> 4) * 8;
        const int wr = wave >> 2, wc = wave & 3, fr = cn, fq = lane >> 4;
        const int trow = tid >> 1, half = tid & 1;
        float top[2][16];
#pragma unroll
        for (int pp = 0; pp < 2; ++pp) {
            __syncthreads();
#pragma unroll
            for (int ai = 0; ai < 2; ++ai)
#pragma unroll
                for (int m = 0; m < 4; ++m)
#pragma unroll
                    for (int n = 0; n < 2; ++n) {
                        const f32x4 v = acc[ai][pp][m][n];
                        *(uint2*)((char*)Qs + ai * 32768 + SCAN_KOFF(wc * 32 + n * 16 + fr, wr * 8 + m * 2 + (fq >> 1)) + (fq & 1) * 8) = make_uint2(pack2(v[0], v[1]), pack2(v[2], v[3]));
                    }
            {
                const bf16_t* skg = p.subk + ((long)l * 16 + h * 2 + pp) * 128 * 128;
                u32x4 kv[4];
#pragma unroll
                for (int i = 0; i < 4; ++i) kv[i] = *(const u32x4*)(skg + (tid + i * NTHREADS) * 8);
#pragma unroll
                for (int i = 0; i < 4; ++i) { const int ch = tid + i * NTHREADS; *(u32x4*)(SK + (ch >> 4) * RT_QLD + (ch & 15) * 8) = kv[i]; }
            }
            __syncthreads();
            f32x4 sacc[2][8];
#pragma unroll
            for (int mt = 0; mt < 2; ++mt)
#pragma unroll
                for (int nt = 0; nt < 8; ++nt) sacc[mt][nt] = (f32x4){0.f, 0.f, 0.f, 0.f};
            {
                const int q_ = (lane >> 2) & 3, pp_ = lane & 3;
                const char* qi = (const char*)Qs + (wave >> 2) * 32768;
#pragma unroll
                for (int ks = 0; ks < 4; ++ks) {
                    bf16x8 bfr[8];
#pragma unroll
                    for (int nt = 0; nt < 8; ++nt) bfr[nt] = *(const bf16x8*)(SK + (nt * 16 + cn) * RT_QLD + ks * 32 + kg);
#pragma unroll
                    for (int mt = 0; mt < 2; ++mt) {
                        const int d0 = ks * 32 + fq * 8 + q_, chk = (wave & 3) * 4 + mt * 2 + (pp_ >> 1);
                        const s16x4 lo = __builtin_amdgcn_ds_read_tr16_b64_v4i16((__attribute__((address_space(3))) s16x4*)(qi + SCAN_KOFF(d0, chk) + 8 * (pp_ & 1)));
                        const s16x4 hi = __builtin_amdgcn_ds_read_tr16_b64_v4i16((__attribute__((address_space(3))) s16x4*)(qi + SCAN_KOFF(d0 + 4, chk) + 8 * (pp_ & 1)));
                        const bf16x8 afr = __builtin_shufflevector(lo, hi, 0, 1, 2, 3, 4, 5, 6, 7);
#pragma unroll
                        for (int nt = 0; nt < 8; ++nt) sacc[mt][nt] = __builtin_amdgcn_mfma_f32_16x16x32_bf16(afr, bfr[nt], sacc[mt][nt], 0, 0, 0);
                    }
                }
            }
            __syncthreads();
#pragma unroll
            for (int mt = 0; mt < 2; ++mt)
#pragma unroll
                for (int nt = 0; nt < 8; ++nt)
#pragma unroll
                    for (int r = 0; r < 4; ++r) sc[(wave * 32 + mt * 16 + g4 + r) * RT_SLD + nt * 16 + cn] = sacc[mt][nt][r];
            __syncthreads();
            const float* srow = sc + trow * RT_SLD + half;
#pragma unroll
            for (int grp = 0; grp < 4; ++grp) {
                float v[16];
#pragma unroll
                for (int i = 0; i < 16; ++i) {
                    const int k = grp * 16 + i;
                    v[i] = __uint_as_float((__float_as_uint(srow[2 * k]) & 0xFFFFFF00u) | (unsigned)(2 * k));
                }
                sort16f_desc(v);
                if (grp == 0) {
#pragma unroll
                    for (int i = 0; i < 16; ++i) top[pp][i] = v[i];
                } else merge16f_desc(top[pp], v);
            }
            float oth[16];
#pragma unroll
            for (int i = 0; i < 16; ++i) top[pp][i] = __uint_as_float(__float_as_uint(top[pp][i]) | (unsigned)half);
#pragma unroll
            for (int i = 0; i < 16; ++i) oth[i] = xshfl<1>(top[pp][i]);
            merge16f_desc(top[pp], oth);
        }
        if (half == 0) {
            float s0[16], s1[16];
            unsigned iw[8];
#pragma unroll
            for (int i = 0; i < 8; ++i) iw[i] = 0u;
#pragma unroll
            for (int i = 0; i < 16; ++i) {
                s0[i] = __uint_as_float((__float_as_uint(top[0][i]) & 0xFFFFFF00u) | 0x80u);
                s1[i] = __uint_as_float((__float_as_uint(top[1][i]) & 0xFFFFFF00u) | 0x80u);
                iw[i >> 2] |= (__float_as_uint(top[0][i]) & 0xFFu) << ((i & 3) * 8);
                iw[4 + (i >> 2)] |= (__float_as_uint(top[1][i]) & 0xFFu) << ((i & 3) * 8);
            }
            unsigned* ibw = (unsigned*)(ib + trow * 32);
#pragma unroll
            for (int i = 0; i < 8; ++i) ibw[i] = iw[i];
            float ct[16];
            {
                float cg[4][16];
#pragma unroll
                for (int g_ = 0; g_ < 4; ++g_)
#pragma unroll
                    for (int i = 0; i < 16; ++i) cg[g_][i] = -3.0e38f;
                int cnt = 0;
#pragma unroll
                for (int a2 = 0; a2 < 16; ++a2)
#pragma unroll
                    for (int b2 = 0; b2 < 16; ++b2)
                        if ((a2 + 1) * (b2 + 1) <= 16) {
                            cg[cnt >> 4][cnt & 15] = __uint_as_float((__float_as_uint(s0[a2] + s1[b2]) & 0xFFFFFF00u) | (unsigned)(255 - (a2 * 16 + b2)));
                            ++cnt;
                        }
                if (s0[0] + s1[15] < 0.f) sort16f_desc(cg[0]);
                sort16f_desc(cg[1]); sort16f_desc(cg[2]);
                KCF(cg[3][0], cg[3][1])
#pragma unroll
                for (int i = 0; i < 16; ++i) ct[i] = cg[0][i];
                merge16f_desc(ct, cg[1]); merge16f_desc(ct, cg[2]); merge16f_desc(ct, cg[3]);
            }
            float cv[16];
#pragma unroll
            for (int i = 0; i < 16; ++i) cv[i] = __uint_as_float((__float_as_uint(ct[i]) & 0xFFFFFF00u) | 0x80u);
            const float mx = cv[0];
            float sum = 0.f;
#pragma unroll
            for (int i = 0; i < 16; ++i) { cv[i] = __expf(cv[i] - mx); sum += cv[i]; }
            const float inv = 1.f / sum;
            const long ob = ((long)(row0 + trow) * 8 + h) * 16;
            asm volatile("s_waitcnt lgkmcnt(0)" ::: "memory");
            const unsigned char* ibr = ib + trow * 32;
#pragma unroll
            for (int i = 0; i < 16; ++i) {
                const int fl = 255 - (int)(__float_as_uint(ct[i]) & 255u), a2 = fl >> 4, b2 = fl & 15;
                p.eidx[ob + i] = (int)ibr[a2] * 128 + (int)ibr[16 + b2];
                p.pgate[ob + i] = cv[i] * inv;
            }
        }
    }
}

#define PE_T 2
#define PE_LOADU(RA, BB, T_)                                                                                       \
    _Pragma("unroll") for (int k_ = 0; k_ < 8; ++k_) {                                                           \
        const int kk_ = (BB) * 8 + k_;                                                                           \
        const int e_ = __builtin_amdgcn_readlane((BB) < 8 ? e0[T_] : e1[T_], kk_ & 63);                          \
        RA[k_] = *(const u32x4*)(tabu + (long)e_ * 1024);                                                        \
    }
#define PE_LOADV(RA, BB, T_)                                                                                       \
    _Pragma("unroll") for (int k_ = 0; k_ < 8; ++k_) {                                                           \
        const int kk_ = (BB) * 8 + k_;                                                                           \
        const int e_ = __builtin_amdgcn_readlane((BB) < 8 ? e0[T_] : e1[T_], kk_ & 63);                          \
        RA[k_] = *(const u32x4*)(tabv + (long)e_ * 1024);                                                        \
    }
#define PE_X1(v_) __builtin_amdgcn_mov_dpp((int)(v_), 0xB1, 0xF, 0xF, true)
#define PE_X2(v_) __builtin_amdgcn_mov_dpp((int)(v_), 0x4E, 0xF, 0xF, true)
#define PE_X4(v_) __builtin_amdgcn_update_dpp(__builtin_amdgcn_update_dpp(0, (int)(v_), 0x104, 0xF, 0x5, false), (int)(v_), 0x114, 0xF, 0xA, false)
#define PE_X8(v_) __builtin_amdgcn_mov_dpp((int)(v_), 0x128, 0xF, 0xF, true)
#define PE_BREV(k_) ((((k_) & 1) << 2) | ((k_) & 2) | (((k_) >> 2) & 1))
#define PE_DOT(UA, BB, T_)                                                                                         \
    {                                                                                                              \
        int d_[8];                                                                                                 \
        _Pragma("unroll") for (int k_ = 0; k_ < 8; ++k_) {                                                       \
            int a_ = __builtin_amdgcn_sdot4((int)UA[k_][0], qx[T_][0], 0, false);                                \
            a_ = __builtin_amdgcn_sdot4((int)UA[k_][1], qx[T_][1], a_, false);                                   \
            a_ = __builtin_amdgcn_sdot4((int)UA[k_][2], qx[T_][2], a_, false);                                   \
            d_[k_] = __builtin_amdgcn_sdot4((int)UA[k_][3], qx[T_][3], a_, false);                               \
        }                                                                                                          \
               \
        int t4_[4], t2_[2], t1_;                                                                                   \
        _Pragma("unroll") for (int i_ = 0; i_ < 4; ++i_) { const int snd_ = b2 ? d_[i_] : d_[i_ + 4]; const int kp_ = b2 ? d_[i_ + 4] : d_[i_]; t4_[i_] = kp_ + PE_X4(snd_); } \
        _Pragma("unroll") for (int i_ = 0; i_ < 2; ++i_) { const int snd_ = b1 ? t4_[i_] : t4_[i_ + 2]; const int kp_ = b1 ? t4_[i_ + 2] : t4_[i_]; t2_[i_] = kp_ + PE_X2(snd_); } \
        { const int snd_ = b0 ? t2_[0] : t2_[1]; const int kp_ = b0 ? t2_[1] : t2_[0]; t1_ = kp_ + PE_X1(snd_); }  \
        t1_ += PE_X8(t1_);                                                                                         \
        t1_ += xshfl_i<16>(t1_);                                                                                       \
        t1_ += xshfl_i<32>(t1_);                                                                                       \
                                         \
        const bool mine_ = (lane >> 3) == ((BB) & 7);                                                              \
        hlo[T_] = (mine_ && (BB) < 8) ? t1_ : hlo[T_];                                                             \
        hhi[T_] = (mine_ && (BB) >= 8) ? t1_ : hhi[T_];                                                            \
    }
#define PE_AXPY(VA, BB, T_)                                                                                        \
    {                                                                                                              \
        const unsigned psel_ = (BB) < 8 ? pklo[T_] : pkhi[T_];                                                     \
        _Pragma("unroll") for (int h_ = 0; h_ < 2; ++h_) {                                                       \
            const int wp_ = __builtin_amdgcn_readlane((int)psel_, ((BB) & 7) * 8 + h_ * 4);                        \
            _Pragma("unroll") for (int i_ = 0; i_ < 4; ++i_) {                                                   \
                const unsigned a_ = VA[h_ * 4][i_], b_ = VA[h_ * 4 + 1][i_], c_ = VA[h_ * 4 + 2][i_], d_ = VA[h_ * 4 + 3][i_];   \
                const unsigned t0_ = __builtin_amdgcn_perm(b_, a_, 0x05010400u), t1_ = __builtin_amdgcn_perm(b_, a_, 0x07030602u);   \
                const unsigned t2_ = __builtin_amdgcn_perm(d_, c_, 0x05010400u), t3_ = __builtin_amdgcn_perm(d_, c_, 0x07030602u);   \
                acc[T_][i_ * 4 + 0] = __builtin_amdgcn_sdot4((int)__builtin_amdgcn_perm(t2_, t0_, 0x05040100u), wp_, acc[T_][i_ * 4 + 0], false);   \
                acc[T_][i_ * 4 + 1] = __builtin_amdgcn_sdot4((int)__builtin_amdgcn_perm(t2_, t0_, 0x07060302u), wp_, acc[T_][i_ * 4 + 1], false);   \
                acc[T_][i_ * 4 + 2] = __builtin_amdgcn_sdot4((int)__builtin_amdgcn_perm(t3_, t1_, 0x05040100u), wp_, acc[T_][i_ * 4 + 2], false);   \
                acc[T_][i_ * 4 + 3] = __builtin_amdgcn_sdot4((int)__builtin_amdgcn_perm(t3_, t1_, 0x07060302u), wp_, acc[T_][i_ * 4 + 3], false);   \
            }                                                                                                      \
        }                                                                                                          \
    }
template <int NEXT = 0>
__device__ __forceinline__ void ph_p_eval(CP& p, const float* mods_l, int l, const float* w_next, const float* mods_next, const float gscale = 1.f) {
    const int lane = ltid() & 63, wave = ltid() >> 6;
    const bool b0 = (lane & 1) != 0, b1 = (lane & 2) != 0, b2 = (lane & 4) != 0;
    const int rstride = gridDim.x * 8;
    const int first = lbid() * 8 + wave;
    const int ntok = (T_TOK - first + rstride - 1) / rstride;
    const int nsweep = __builtin_amdgcn_readfirstlane((T_TOK - lbid() * 8 + rstride - 1) / rstride + PE_T - 1) / PE_T;
    const unsigned char* tabu = p.tabU + (long)(l & 1) * 16384 * 2048 + lane * 16;
    const unsigned char* tabv = tabu + 16384L * 1024;
    const float* su_ = p.su + (l & 1) * 32768; const float* sv_ = su_ + 16384;
    u32x4 hpa[PE_T], hpb[PE_T]; unsigned kp0[PE_T], kp1[PE_T];
#define PE_PREFETCH(SW)                                                                                            \
    _Pragma("unroll") for (int t = 0; t < PE_T; ++t) {                                                           \
        const int ti_ = (SW) * PE_T + t;                                                                           \
        const long row_ = first + (ti_ < ntok ? ti_ : 0) * rstride;                                                \
        hpa[t] = *(const u32x4*)(p.H + row_ * DM + lane * 16); hpb[t] = *(const u32x4*)(p.H + row_ * DM + lane * 16 + 8);   \
        kp0[t] = (unsigned)p.eidx[row_ * 128 + lane]; kp1[t] = (unsigned)p.eidx[row_ * 128 + 64 + lane];          \
    }
    int e0[PE_T], e1[PE_T];
    float sgu0[PE_T], sgu1[PE_T], sgv0[PE_T], sgv1[PE_T];
    u32x4 rA[8], rB[8];
#define PE_SORT(SW)                                                                                                \
    _Pragma("unroll") for (int t = 0; t < PE_T; ++t) {                                                           \
        const int ti_ = (SW) * PE_T + t;                                                                           \
        const long row_ = first + (ti_ < ntok ? ti_ : 0) * rstride;                                                \
          \
        unsigned k0 = (kp0[t] << 7) | (unsigned)lane;                                                              \
        unsigned k1 = (kp1[t] << 7) | (unsigned)(64 + lane);                                                       \
        _Pragma("unroll") for (int size = 2; size <= 128; size <<= 1) {                                          \
            _Pragma("unroll") for (int stride = size >> 1; stride > 0; stride >>= 1) {                           \
                if (stride == 64) {                                                                                \
                    const unsigned lo = min(k0, k1), hi = max(k0, k1);                                             \
                    k0 = lo; k1 = hi;                                                                              \
                } else {                                                                                           \
                    unsigned o0, o1;                                                                               \
                    if (stride == 1) { o0 = (unsigned)PE_X1(k0); o1 = (unsigned)PE_X1(k1); }                       \
                    else if (stride == 2) { o0 = (unsigned)PE_X2(k0); o1 = (unsigned)PE_X2(k1); }                  \
                    else if (stride == 4) { o0 = (unsigned)PE_X4(k0); o1 = (unsigned)PE_X4(k1); }                  \
                    else if (stride == 8) { o0 = (unsigned)PE_X8(k0); o1 = (unsigned)PE_X8(k1); }                  \
                    else if (stride == 16) { o0 = (unsigned)xshfl_i<16>((int)k0); o1 = (unsigned)xshfl_i<16>((int)k1); }   \
                    else { o0 = (unsigned)xshfl_i<32>((int)k0); o1 = (unsigned)xshfl_i<32>((int)k1); }             \
                    const bool lower = (lane & stride) == 0;                                                       \
                    const bool asc0 = size == 128 ? true : ((lane & size) == 0);                                   \
                    const bool asc1 = size == 128 ? true : (((lane + 64) & size) == 0);                            \
                    k0 = (lower == asc0) ? min(k0, o0) : max(k0, o0);                                              \
                    k1 = (lower == asc1) ? min(k1, o1) : max(k1, o1);                                              \
                }                                                                                                  \
            }                                                                                                      \
        }                                                                                                          \
        e0[t] = (int)(k0 >> 7); e1[t] = (int)(k1 >> 7);                                                            \
        const int sl0 = (int)(k0 & 127u), sl1 = (int)(k1 & 127u);                                                  \
          \
        sgu0[t] = su_[e0[t]]; sgu1[t] = su_[e1[t]];                                                                \
        sgv0[t] = p.pgate[row_ * 128 + sl0] * sv_[e0[t]]; sgv1[t] = p.pgate[row_ * 128 + sl1] * sv_[e1[t]];        \
    }
    PE_PREFETCH(0)
    PE_SORT(0)
    PE_LOADU(rA, 0, 0)
    for (int sw = 0; sw < nsweep; ++sw) {
        __syncthreads();
        int rows[PE_T]; bool valid[PE_T];
        int qx[PE_T][4];
        float wlo[PE_T], whi[PE_T], swq[PE_T], sxv[PE_T];
        int hlo[PE_T], hhi[PE_T];
        int acc[PE_T][16];
        unsigned pklo[PE_T], pkhi[PE_T];
#pragma unroll
        for (int t = 0; t < PE_T; ++t) {
            const int ti = sw * PE_T + t;
            valid[t] = ti < ntok;
            const int row = first + (valid[t] ? ti : 0) * rstride;
            rows[t] = row;
            float x[16];
            {
                const u32x4 a = hpa[t], b = hpb[t];
#pragma unroll
                for (int i = 0; i < 4; ++i) { x[2 * i] = bflo(a[i]); x[2 * i + 1] = bfhi(a[i]); x[8 + 2 * i] = bflo(b[i]); x[8 + 2 * i + 1] = bfhi(b[i]); }
            }
            float mx = 0.f;
#pragma unroll
            for (int i = 0; i < 16; ++i) mx = fmaxf(mx, fabsf(x[i]));
            mx = wave_max(mx);
            const float sx = mx > 0.f ? mx * (1.f / 127.f) : 1.f;
            const float isx = 1.f / sx;
#pragma unroll
            for (int i = 0; i < 4; ++i) {
                unsigned pk = 0;
#pragma unroll
                for (int q = 0; q < 4; ++q) pk |= (unsigned)((int)rintf(x[i * 4 + q] * isx) & 0xFF) << (q * 8);
                qx[t][i] = (int)pk;
            }
            sxv[t] = sx;
            hlo[t] = 0; hhi[t] = 0;
#pragma unroll
            for (int i = 0; i < 16; ++i) acc[t][i] = 0;
        }
        for (int bb = 0; bb < 16; ++bb) {
            if ((bb & 3) == 0) __builtin_amdgcn_s_barrier();
            PE_LOADU(rB, bb, 1)
            PE_DOT(rA, bb, 0)
            if (bb + 1 < 16) { PE_LOADU(rA, bb + 1, 0) } else { PE_LOADV(rA, 0, 0) }
            PE_DOT(rB, bb, 1)
        }
#pragma unroll
        for (int t = 0; t < PE_T; ++t) {
            wlo[t] = sgv0[t] * gelu_tanh(sgu0[t] * sxv[t] * (float)hlo[t]); whi[t] = sgv1[t] * gelu_tanh(sgu1[t] * sxv[t] * (float)hhi[t]);
            float am = fmaxf(fabsf(wlo[t]), fabsf(whi[t]));
            am = wave_max(am);
            swq[t] = am > 0.f ? am * (1.f / 127.f) : 1.f;
            const float iw = 1.f / swq[t];
            const unsigned q0 = (unsigned)((int)rintf(wlo[t] * iw) & 0xFF), q1 = (unsigned)((int)rintf(whi[t] * iw) & 0xFF);
            const unsigned a0 = q0 | ((unsigned)xshfl_i<1>((int)q0) << 8);
            const unsigned a1 = q1 | ((unsigned)xshfl_i<1>((int)q1) << 8);
            pklo[t] = a0 | ((unsigned)xshfl_i<2>((int)a0) << 16);
            pkhi[t] = a1 | ((unsigned)xshfl_i<2>((int)a1) << 16);
        }
        if (sw + 1 < nsweep) { PE_PREFETCH(sw + 1) }
        f32x4 xvp[PE_T][4];
#pragma unroll
        for (int t = 0; t < PE_T; ++t)
#pragma unroll
            for (int q = 0; q < 4; ++q) xvp[t][q] = *(const f32x4*)(p.out + (long)rows[t] * DM + lane * 16 + q * 4);
        for (int bb = 0; bb < 16; ++bb) {
            if ((bb & 3) == 0) __builtin_amdgcn_s_barrier();
            PE_LOADV(rB, bb, 1)
            PE_AXPY(rA, bb, 0)
            if (bb + 1 < 16) { PE_LOADV(rA, bb + 1, 0) }
            PE_AXPY(rB, bb, 1)
        }
        if (sw + 1 < nsweep) { PE_SORT(sw + 1) PE_LOADU(rA, 0, 0) }
#pragma unroll
        for (int t = 0; t < PE_T; ++t) {
            if (!valid[t]) continue;
            const int row = rows[t];
            float y[16];
#pragma unroll
            for (int i = 0; i < 16; ++i) y[i] = swq[t] * (float)acc[t][i];
            const float* gv = mods_l + (long)tok_modrow(row) * 6144 + 5 * 1024;
            float* xr = p.out + (long)row * DM + lane * 16;
            float4 xv[4], gg[4];
#pragma unroll
            for (int q = 0; q < 4; ++q) { xv[q] = make_float4(xvp[t][q][0], xvp[t][q][1], xvp[t][q][2], xvp[t][q][3]); gg[q] = *(const float4*)(gv + lane * 16 + q * 4); }
            float4 nw[4], nsc[4], nsh[4];
            if (NEXT) {
                const float* mr = mods_next + (long)tok_modrow(row) * 6144;
#pragma unroll
                for (int q = 0; q < 4; ++q) { nw[q] = *(const float4*)(w_next + lane * 16 + q * 4); nsc[q] = *(const float4*)(mr + 1024 + lane * 16 + q * 4); nsh[q] = *(const float4*)(mr + lane * 16 + q * 4); }
            }
            float ss = 0.f;
#pragma unroll
            for (int q = 0; q < 4; ++q) {
                xv[q].x += gscale * gg[q].x * y[q * 4 + 0]; xv[q].y += gscale * gg[q].y * y[q * 4 + 1];
                xv[q].z += gscale * gg[q].z * y[q * 4 + 2]; xv[q].w += gscale * gg[q].w * y[q * 4 + 3];
                *(float4*)(xr + q * 4) = xv[q];
                ss += xv[q].x * xv[q].x + xv[q].y * xv[q].y + xv[q].z * xv[q].z + xv[q].w * xv[q].w;
            }
            if (NEXT) {
                ss = wave_sum(ss);
                const float r = rsqrtf(ss * (1.f / 1024.f) + 1e-6f);
#pragma unroll
                for (int q = 0; q < 4; ++q) {
                    const float h0 = xv[q].x * r * nw[q].x * (1.f + nsc[q].x) + nsh[q].x, h1 = xv[q].y * r * nw[q].y * (1.f + nsc[q].y) + nsh[q].y;
                    const float h2 = xv[q].z * r * nw[q].z * (1.f + nsc[q].z) + nsh[q].z, h3 = xv[q].w * r * nw[q].w * (1.f + nsc[q].w) + nsh[q].w;
                    *(uint2*)(p.H + (long)row * DM + lane * 16 + q * 4) = make_uint2(pack2(h0, h1), pack2(h2, h3));
                }
            }
        }
    }
}
#define SMEM_MAX 147456

#define BARRIER() do { XcdBarrier b_; b_.bar = p.bar; b_.x = xb_xcc_id(); b_.st = (volatile LAS unsigned*)(smem + SMEM_MAX); xcd_barrier(b_); } while (0)
__device__ __forceinline__ CP& kparams() {
    CP* kp = (CP*)__builtin_amdgcn_kernarg_segment_ptr();
    asm volatile("" : "+s"(kp));
    return *kp;
}
__global__ void __launch_bounds__(NTHREADS, 2) k_mega(Params p_unused) {
    extern __shared__ __attribute__((aligned(16))) char smem[];
#define p kparams()
    if (threadIdx.x == 0) *(uint4*)(smem + SMEM_MAX) = make_uint4(0u, 0u, 0u, 0u);
    __syncthreads();
    (void)xcd_barrier_post(p.bar, (volatile LAS unsigned*)(smem + SMEM_MAX));
    ph_init(p, smem);
    BARRIER();
#pragma unroll
    for (int l = 0; l < 4; ++l) {
        const int j = l >> 1;
#define mods_l (kparams().mods + (long)l * 9 * 6144)
        if (l == 0) {
            ph_norm<1>(p, p.norm_mix, mods_l, 0, 1024);
            BARRIER();
        }
        if ((l & 1) == 0) {
            ph_e_gemm(p, j, smem);
            BARRIER();
            ph_e_prep(p, j, smem);
            ph_fft_a(p, smem);
            BARRIER();
            ph_e_scan(p, j, smem);
            ph_fft_b(p, smem);
            ph_tab(p, l, 64);
            ph_tab(p, l + 1, 64);
            if (l == 0) ph_init2(p, smem, 64);
            BARRIER();
            ph_e_mix(p, j);
            BARRIER();
            if (l == 0) ph_out_gemm<1>(p, p.mix, p.wtE_out + (long)j * 1024 * 1024, mods_l, 2 * 1024, smem);
            else ph_out_gemm<0>(p, p.mix, p.wtE_out + (long)j * 1024 * 1024, mods_l, 2 * 1024, smem);
            BARRIER();
        } else {
            ph_o_gemm1(p, j, smem);
            BARRIER();
            ph_o_norm(p, j);
            BARRIER();
            ph_o_gemm2(p, j, smem);
            BARRIER();
            ph_o_qknorm(p, j);
            BARRIER();
            ph_o_attn(p, smem);
            BARRIER();
            ph_out_gemm(p, p.Ob, p.wtO_out + (long)j * 1024 * 1024, mods_l, 2 * 1024, smem);
            BARRIER();
        }
        ph_norm(p, p.norm_ffn + l * 1024, mods_l, 3 * 1024, 4 * 1024);
        BARRIER();
        ph_p_route(p, l, smem);
        BARRIER();
        if (l < 3) ph_p_eval<1>(p, mods_l, l, p.norm_mix + (l + 1) * 1024, p.mods + (long)(l + 1) * 9 * 6144);
        else ph_p_eval<0>(p, mods_l, l, p.norm_mix, p.mods);
        if (l < 3) BARRIER();
    }
#undef p
#undef mods_l
}

static inline size_t al256(size_t x) { return (x + 255) & ~(size_t)255; }

extern "C" void kernel_launch(void* const* d_in, const int* in_sizes, int n_in, void* d_out, int out_size, void* d_ws, size_t ws_size, hipStream_t stream) {
    Params p{};
    const float* const* in = (const float* const*)d_in;
    p.x_prompt = in[0]; p.x_sample = in[1]; p.state_gdn = in[2]; p.cache_ckv = in[3]; p.cache_kr = in[4]; p.c = in[5]; p.c_ctx = in[6];
    p.w_mod = in[7]; p.b_mod = in[8]; p.norm_mix = in[9]; p.norm_ffn = in[10];
    p.even_w_in = in[11]; p.even_conv_w = in[12]; p.gdn_a_log = in[13]; p.gdn_dt_bias = in[14]; p.gdn_o_norm = in[15]; p.even_w_out = in[16];
    p.odd_w_in = in[17]; p.mla_q_norm = in[18]; p.mla_kv_norm = in[19]; p.mla_w_uq = in[20]; p.mla_w_ukv = in[21]; p.mla_q_headnorm = in[22]; p.mla_k_headnorm = in[23]; p.odd_w_out = in[24];
    p.peer_w_q = in[25]; p.peer_sub_keys = in[26]; p.peer_u = in[27]; p.peer_v = in[28];
    p.out = (float*)d_out;
    char* ws = (char*)d_ws;
    size_t off = 0;
    auto take = [&](size_t bytes) { char* r = ws + off; off = al256(off + bytes); return r; };
    p.bar = (unsigned*)take(16384);
    p.mods = (float*)take(4L * 9 * 6144 * 4);
    p.wtE_in = (bf16_t*)take(2L * N_EIN * 1024 * 2);
    p.wtE_out = (bf16_t*)take(2L * 1024 * 1024 * 2);
    p.wtO_in = (bf16_t*)take(2L * N_OIN * 1024 * 2);
    p.wtUq = (bf16_t*)take(2L * 1536 * 512 * 2);
    p.wtUkv = (bf16_t*)take(2L * 2048 * 256 * 2);
    p.wtO_out = (bf16_t*)take(2L * 1024 * 1024 * 2);
    p.wtPq = (bf16_t*)take(4L * 2048 * 1024 * 2);
    p.subk = (bf16_t*)take(4L * 16 * 128 * 128 * 2);
    p.fftMA = (bf16_t*)take(128L * 128 * 2);
    p.fftMB = (bf16_t*)take(128L * 128 * 2);
    p.fftTW = (float*)take(4096L * 2 * 4);
    p.dftP = (bf16_t*)take(256L * 512 * 2);
    p.tabU = (unsigned char*)take(2L * 16384 * 2048);
    p.tabV = p.tabU;
    p.su = (float*)take(2L * 32768 * 4);
    p.sv = p.su;
    p.H = (bf16_t*)take((long)T_TOK * 1024 * 2);
    const size_t ubase = off;
    p.qkvraw = (bf16_t*)take((long)T_TOK * 1536 * 2);
    p.mix = p.qkvraw;
    p.gate = (bf16_t*)take((long)T_TOK * 512 * 2);
    p.ba = (float*)take((long)T_TOK * 16 * 4);
    p.ZtA = (bf16_t*)take((long)T_TOK * 1024 * 2);
    p.qn = (bf16_t*)take((long)T_TOK * 512 * 2);
    p.kn = (bf16_t*)take((long)T_TOK * 512 * 2);
    p.Wb = (bf16_t*)take(4608L * 8192 * 2);
    p.Ub = (bf16_t*)take(4608L * 8192 * 2);
    p.QKb = (bf16_t*)take(4608L * 4096 * 2);
    p.gcb = (float*)take(4608L * 64 * 4);
    p.of = (bf16_t*)take((long)T_TOK * 512 * 2);
    p.ob = (bf16_t*)take((long)T_TOK * 512 * 2);
    p.HB = (bf16_t*)take(8L * 64 * 512 * 2 * 64 * 2);
    const size_t even_end = off;
    off = ubase;
    p.Podd = (float*)take((long)T_TOK * 832 * 4);
    p.Ob = (bf16_t*)p.Podd;
    p.cq = (bf16_t*)take((long)T_TOK * 512 * 2);
    p.ckv_all = (bf16_t*)take((long)(T_TOK + 2048) * 256 * 2);
    p.kr_all = (float*)take((long)(T_TOK + 2048) * 64 * 4);
    p.Qb = (bf16_t*)take((long)T_TOK * 1536 * 2);
    p.Kb = (bf16_t*)take((KB_S + 8L * 8 * 4352 * 192) * 2);
    p.Vtb = (bf16_t*)take((VT_S + 8L * 8 * 128 * 4352) * 2);
    const size_t odd_end = off;
    off = ubase;
    p.eidx = (int*)take((long)T_TOK * 128 * 4);
    p.pgate = (float*)take((long)T_TOK * 128 * 4);
    const size_t peer_end = off;
    size_t need = even_end > odd_end ? even_end : odd_end;
    if (peer_end > need) need = peer_end;
    if (need > ws_size) return;

    static int grid = 0;
    if (!grid) {
        int dev = 0, cus = 0, per_cu = 0;
        hipGetDevice(&dev);
        hipDeviceGetAttribute(&cus, hipDeviceAttributeMultiprocessorCount, dev);
        if (hipFuncSetAttribute((const void*)k_mega, hipFuncAttributeMaxDynamicSharedMemorySize, SMEM_MAX + 16) != hipSuccess) return;
        if (hipOccupancyMaxActiveBlocksPerMultiprocessor(&per_cu, (const void*)k_mega, NTHREADS, SMEM_MAX + 16) != hipSuccess || per_cu < 1) return;
        grid = cus;
    }
    hipMemsetAsync(p.bar, 0, XCD_BAR_WORDS * sizeof(unsigned), stream);
    hipLaunchKernelGGL(k_mega, dim3(grid), dim3(NTHREADS), SMEM_MAX + 16, stream, p);
}
```

```cpp
#include <hip/hip_runtime.h>
#include <stdint.h>

typedef unsigned short bf16_t;
typedef short bf16x8 __attribute__((ext_vector_type(8)));
typedef float f32x4 __attribute__((ext_vector_type(4)));
typedef unsigned u32x4 __attribute__((ext_vector_type(4)));
typedef int i32x4 __attribute__((ext_vector_type(4)));

#define T_TOK   36864
#define TP_TOK  4096
#define DM      1024
#define NTHREADS 512
#define N_EIN   3328
#define N_OIN   1024
#define OUT_STATE 37748736L
#define OUT_CKV   41943040L
#define OUT_KR    44040192L

struct Params {
    const float *x_prompt, *x_sample, *state_gdn, *cache_ckv, *cache_kr, *c, *c_ctx, *w_mod, *b_mod, *norm_mix, *norm_ffn;
    const float *even_w_in, *even_conv_w, *gdn_a_log, *gdn_dt_bias, *gdn_o_norm, *even_w_out;
    const float *odd_w_in, *mla_q_norm, *mla_kv_norm, *mla_w_uq, *mla_w_ukv, *mla_q_headnorm, *mla_k_headnorm, *odd_w_out;
    const float *peer_w_q, *peer_sub_keys, *peer_u, *peer_v;
    float* out;
    unsigned* bar;
    float* mods;
    bf16_t *wtE_in, *wtE_out, *wtO_in, *wtUq, *wtUkv, *wtO_out, *wtPq, *subk, *dftP, *fftMA, *fftMB, *HB;
    float* fftTW;
    unsigned char *tabU, *tabV;
    float *su, *sv;
    bf16_t* H;
    bf16_t *qkvraw, *gate, *ZtA, *qn, *kn, *Wb, *Ub, *QKb, *of, *ob, *mix;
    float *ba, *gcb;
    float *Podd, *kr_all;
    bf16_t *cq, *ckv_all, *Qb, *Kb, *Vtb, *Ob;
    float* pgate;
    int* eidx;
};

typedef const Params __attribute__((address_space(4))) CP;

__device__ __forceinline__ int ltid() { int t = threadIdx.x; asm volatile("" : "+v"(t)); return t; }
__device__ __forceinline__ int lbid() { int b = blockIdx.x; asm volatile("" : "+s"(b)); return b; }
typedef __bf16 bf16v2 __attribute__((ext_vector_type(2)));
typedef float f32x2 __attribute__((ext_vector_type(2)));
__device__ __forceinline__ bf16_t f2bf(float f) { return __builtin_bit_cast(unsigned short, (__bf16)f); }
__device__ __forceinline__ float bf2f(bf16_t h) { return __uint_as_float(((unsigned)h) << 16); }
__device__ __forceinline__ unsigned pack2(float lo, float hi) { const f32x2 v = {lo, hi}; return __builtin_bit_cast(unsigned, __builtin_convertvector(v, bf16v2)); }
__device__ __forceinline__ float bflo(unsigned u) { return __uint_as_float(u << 16); }
__device__ __forceinline__ float bfhi(unsigned u) { return __uint_as_float(u & 0xFFFF0000u); }
__device__ __forceinline__ float silu_f(float x) { return x / (1.f + __expf(-x)); }
__device__ __forceinline__ float sigmoid_f(float x) { return 1.f / (1.f + __expf(-x)); }
__device__ __forceinline__ float softplus_f(float x) { return fmaxf(x, 0.f) + __logf(1.f + __expf(-fabsf(x))); }
__device__ __forceinline__ float gelu_tanh(float x) {
    const float u = 0.7978845608028654f * (x + 0.044715f * x * x * x);
    return 0.5f * x * (1.f + tanhf(u));
}
template <int M>
__device__ __forceinline__ int xshfl_i(int v) {
    if constexpr (M == 1) return __builtin_amdgcn_mov_dpp(v, 0xB1, 0xF, 0xF, true);
    else if constexpr (M == 2) return __builtin_amdgcn_mov_dpp(v, 0x4E, 0xF, 0xF, true);
    else if constexpr (M == 4) return __builtin_amdgcn_update_dpp(__builtin_amdgcn_update_dpp(0, v, 0x104, 0xF, 0x5, false), v, 0x114, 0xF, 0xA, false);
    else if constexpr (M == 8) return __builtin_amdgcn_mov_dpp(v, 0x128, 0xF, 0xF, true);
    else if constexpr (M == 16) { const auto r = __builtin_amdgcn_permlane16_swap((unsigned)v, (unsigned)v, false, false); return (int)(r[0] ^ r[1] ^ (unsigned)v); }
    else { const auto r = __builtin_amdgcn_permlane32_swap((unsigned)v, (unsigned)v, false, false); return (int)(r[0] ^ r[1] ^ (unsigned)v); }
}
template <int M>
__device__ __forceinline__ float xshfl(float v) { return __int_as_float(xshfl_i<M>(__float_as_int(v))); }
template <int CTRL> __device__ __forceinline__ float dppf(float v) { return __int_as_float(__builtin_amdgcn_mov_dpp(__float_as_int(v), CTRL, 0xF, 0xF, true)); }
__device__ __forceinline__ float wave_sum(float v) {
    v += dppf<0xB1>(v); v += dppf<0x4E>(v); v += dppf<0x141>(v); v += dppf<0x140>(v);
    { const auto r = __builtin_amdgcn_permlane16_swap(__float_as_uint(v), __float_as_uint(v), false, false); v = __uint_as_float(r[0]) + __uint_as_float(r[1]); }
    { const auto r = __builtin_amdgcn_permlane32_swap(__float_as_uint(v), __float_as_uint(v), false, false); v = __uint_as_float(r[0]) + __uint_as_float(r[1]); }
    return v;
}
__device__ __forceinline__ float wave_max(float v) {
    v = fmaxf(v, dppf<0xB1>(v)); v = fmaxf(v, dppf<0x4E>(v)); v = fmaxf(v, dppf<0x141>(v)); v = fmaxf(v, dppf<0x140>(v));
    { const auto r = __builtin_amdgcn_permlane16_swap(__float_as_uint(v), __float_as_uint(v), false, false); v = fmaxf(__uint_as_float(r[0]), __uint_as_float(r[1])); }
    { const auto r = __builtin_amdgcn_permlane32_swap(__float_as_uint(v), __float_as_uint(v), false, false); v = fmaxf(__uint_as_float(r[0]), __uint_as_float(r[1])); }
    return v;
}
__device__ __forceinline__ int tok_modrow(int t) { return t < TP_TOK ? 0 : 1 + ((t - TP_TOK) >> 12); }
__device__ __forceinline__ int tok_seq0(int t) { return t < TP_TOK ? (t & ~255) : (TP_TOK + ((t - TP_TOK) & ~4095)); }
__device__ __forceinline__ int tok_len(int t) { return t < TP_TOK ? 256 : 4096; }

template <int MT, int NT>
__device__ __forceinline__ void wave_mma(f32x4 (&acc)[MT][NT], const bf16_t* A, int lda, const bf16_t* B, int ldb, int K) {
    const int lane = ltid() & 63, r = lane & 15, kg = (lane >> 4) * 8;
#pragma unroll 1
    for (int k0 = 0; k0 < K; k0 += 32) {
        bf16x8 a[MT], b[NT];
#pragma unroll
        for (int m = 0; m < MT; ++m) a[m] = *(const bf16x8*)(A + (m * 16 + r) * lda + k0 + kg);
#pragma unroll
        for (int n = 0; n < NT; ++n) b[n] = *(const bf16x8*)(B + (n * 16 + r) * ldb + k0 + kg);
#pragma unroll
        for (int m = 0; m < MT; ++m)
#pragma unroll
            for (int n = 0; n < NT; ++n) acc[m][n] = __builtin_amdgcn_mfma_f32_16x16x32_bf16(a[m], b[n], acc[m][n], 0, 0, 0);
    }
}
template <int MT, int NT, int KSTEPS>
__device__ __forceinline__ void wave_mma_u(f32x4 (&acc)[MT][NT], const bf16_t* A, int lda, const bf16_t* B, int ldb) {
    const int lane = ltid() & 63, r = lane & 15, kg = (lane >> 4) * 8;
    bf16x8 a[KSTEPS][MT], b[KSTEPS][NT];
#pragma unroll
    for (int ks = 0; ks < KSTEPS; ++ks) {
#pragma unroll
        for (int m = 0; m < MT; ++m) a[ks][m] = *(const bf16x8*)(A + (m * 16 + r) * lda + ks * 32 + kg);
#pragma unroll
        for (int n = 0; n < NT; ++n) b[ks][n] = *(const bf16x8*)(B + (n * 16 + r) * ldb + ks * 32 + kg);
    }
#pragma unroll
    for (int ks = 0; ks < KSTEPS; ++ks)
#pragma unroll
        for (int m = 0; m < MT; ++m)
#pragma unroll
            for (int n = 0; n < NT; ++n) acc[m][n] = __builtin_amdgcn_mfma_f32_16x16x32_bf16(a[ks][m], b[ks][n], acc[m][n], 0, 0, 0);
}

#define GLD 72
#define GEMM_SMEM_BYTES (2 * (256 + 128) * GLD * 2)
template <int PERM = 0, class Epi>
__device__ __forceinline__ void gemm_tile(const bf16_t* __restrict__ A, long lda, const bf16_t* __restrict__ B, long ldb, int K, bf16_t* smem, Epi epi) {
    const int tid = ltid(), lane = tid & 63, wave = tid >> 6;
    const int wm = wave >> 1, wn = wave & 1;
    bf16_t* As = smem;
    bf16_t* Bs = smem + 2 * 256 * GLD;
    f32x4 acc[4][4];
#pragma unroll
    for (int m = 0; m < 4; ++m)
#pragma unroll
        for (int n = 0; n < 4; ++n) acc[m][n] = (f32x4){0.f, 0.f, 0.f, 0.f};
    uint4 ra[4], rb[2];
    const int lrow = tid >> 3, lkc = (tid & 7) * 8;
    const bf16_t* ap = A + (long)lrow * (PERM ? 64 : 1) * lda + lkc;
    const bf16_t* bp = B + (long)lrow * ldb + lkc;
    const long astep = (PERM ? 1 : 64) * lda;
#pragma unroll
    for (int i = 0; i < 4; ++i) ra[i] = *(const uint4*)(ap + (long)i * astep);
#pragma unroll
    for (int i = 0; i < 2; ++i) rb[i] = *(const uint4*)(bp + (long)i * 64 * ldb);
    __builtin_amdgcn_sched_barrier(0);
#pragma unroll
    for (int i = 0; i < 4; ++i) *(uint4*)(As + (i * 64 + lrow) * GLD + lkc) = ra[i];
#pragma unroll
    for (int i = 0; i < 2; ++i) *(uint4*)(Bs + (i * 64 + lrow) * GLD + lkc) = rb[i];
    __syncthreads();
    const int nk = K >> 6;
    for (int kt = 0; kt < nk; ++kt) {
        const int cur = kt & 1;
        if (kt + 1 < nk) {
            const long k0 = (long)(kt + 1) * 64;
#pragma unroll
            for (int i = 0; i < 4; ++i) ra[i] = *(const uint4*)(ap + (long)i * astep + k0);
#pragma unroll
            for (int i = 0; i < 2; ++i) rb[i] = *(const uint4*)(bp + (long)i * 64 * ldb + k0);
            __builtin_amdgcn_sched_barrier(0);
        }
        const bf16_t* Ac = As + cur * 256 * GLD + (wm * 64) * GLD;
        const bf16_t* Bc = Bs + cur * 128 * GLD + (wn * 64) * GLD;
        wave_mma<4, 4>(acc, Ac, GLD, Bc, GLD, 32);
        wave_mma<4, 4>(acc, Ac + 32, GLD, Bc + 32, GLD, 32);
        if (kt + 1 < nk) {
            bf16_t* An = As + (cur ^ 1) * 256 * GLD;
            bf16_t* Bn = Bs + (cur ^ 1) * 128 * GLD;
#pragma unroll
            for (int i = 0; i < 4; ++i) *(uint4*)(An + (i * 64 + lrow) * GLD + lkc) = ra[i];
#pragma unroll
            for (int i = 0; i < 2; ++i) *(uint4*)(Bn + (i * 64 + lrow) * GLD + lkc) = rb[i];
        }
        __syncthreads();
    }
#pragma unroll
    for (int m = 0; m < 4; ++m)
#pragma unroll
        for (int n = 0; n < 4; ++n) epi(wm * 64 + m * 16 + (lane >> 4) * 4, wn * 64 + n * 16 + (lane & 15), acc[m][n]);
}
namespace g8 {
constexpr int BK = 64, HALF = 128, HT = HALF * BK;
__device__ __forceinline__ int lds_byte(int r, int c) {
    const int st = (r >> 4) * 2 + (c >> 5), rr = r & 15, cc = c & 31, ob = rr * 64 + cc * 2;
    return st * 1024 + (ob ^ (((ob >> 9) & 1) << 5));
}
__device__ __forceinline__ void stage_rc(int b, int& R, int& C) {
    const int st = b / 1024, sb = b % 1024, swz = sb ^ (((sb >> 9) & 1) << 5);
    R = (st >> 1) * 16 + swz / 64; C = (st & 1) * 32 + (swz % 64) / 2;
}
}

template <int PERM = 0, int PRE = 0>
__device__ __forceinline__ void gemm_tile256_acc(const bf16_t* __restrict__ A, long lda, const bf16_t* __restrict__ Bt, long ldb, int K, bf16_t* shm, f32x4 (&acc)[2][2][4][2]) {
    using namespace g8;
#define G8_SA(b, h) (shm + ((b) * 2 + (h)) * HT)
#define G8_SB(b, h) (shm + (4 + (b) * 2 + (h)) * HT)
#define G8_STAGE_A(T, P, h, kt) do { for (int _i = 0; _i < 2; ++_i) { const int _b = (T) * 16 + _i * 8192; int _r, _c; stage_rc(_b, _r, _c); \
        const int _R = (h) * HALF + _r; const long _ar = PERM ? (long)((_R & 63) * 64 + (_R >> 6)) : (long)_R; \
        __builtin_amdgcn_global_load_lds((const unsigned*)(A + _ar * lda + (long)(kt) * BK + _c), (__attribute__((address_space(3))) unsigned*)((char*)(P) + _b), 16, 0, 0); } } while (0)
#define G8_STAGE_B(T, P, h, kt) do { for (int _i = 0; _i < 2; ++_i) { const int _b = (T) * 16 + _i * 8192; int _r, _c; stage_rc(_b, _r, _c); \
        __builtin_amdgcn_global_load_lds((const unsigned*)(Bt + (long)((h) * HALF + _r) * ldb + (long)(kt) * BK + _c), (__attribute__((address_space(3))) unsigned*)((char*)(P) + _b), 16, 0, 0); } } while (0)
#define G8_LDA(dst, b, h) _Pragma("unroll") for (int m = 0; m < 4; ++m) _Pragma("unroll") for (int k = 0; k < 2; ++k) \
        dst[m][k] = *reinterpret_cast<const bf16x8*>((char*)G8_SA(b, h) + lds_byte(wr * 64 + m * 16 + fr, k * 32 + fq * 8))
#define G8_LDB(dst, b, h) _Pragma("unroll") for (int n = 0; n < 2; ++n) _Pragma("unroll") for (int k = 0; k < 2; ++k) \
        dst[n][k] = *reinterpret_cast<const bf16x8*>((char*)G8_SB(b, h) + lds_byte(wc * 32 + n * 16 + fr, k * 32 + fq * 8))
#define G8_MMA(ai, bj, At_, Bt_) do { __builtin_amdgcn_s_setprio(1); \
        _Pragma("unroll") for (int m = 0; m < 4; ++m) _Pragma("unroll") for (int n = 0; n < 2; ++n) _Pragma("unroll") for (int k = 0; k < 2; ++k) \
            acc[ai][bj][m][n] = __builtin_amdgcn_mfma_f32_16x16x32_bf16(At_[m][k], Bt_[n][k], acc[ai][bj][m][n], 0, 0, 0); \
        __builtin_amdgcn_s_setprio(0); } while (0)
#define G8_WAIT_V(n) asm volatile("s_waitcnt vmcnt(" #n ")" ::: "memory")
#define G8_WAIT_L(n) asm volatile("s_waitcnt lgkmcnt(" #n ")" ::: "memory")
#define G8_BAR __builtin_amdgcn_s_barrier()
#define G8_SCHED __builtin_amdgcn_sched_barrier(0)
    int tz = ltid();
    int wid = tz >> 6, lane = tz & 63, wr = wid >> 2, wc = wid & 3, fr = lane & 15, fq = lane >> 4;
#pragma unroll
    for (int a = 0; a < 2; ++a)
#pragma unroll
        for (int b = 0; b < 2; ++b)
#pragma unroll
            for (int m = 0; m < 4; ++m)
#pragma unroll
                for (int n = 0; n < 2; ++n) acc[a][b][m][n] = (f32x4){0.f, 0.f, 0.f, 0.f};
    bf16x8 At[4][2], B0[2][2], B1[2][2];
    const int nt = K / BK;
    if (PRE) {
        if (wr == 1) G8_BAR;
        G8_WAIT_V(0); G8_BAR;
        G8_BAR;
    } else {
        G8_STAGE_B(tz, G8_SB(0, 0), 0, 0); G8_STAGE_A(tz, G8_SA(0, 0), 0, 0);
        G8_STAGE_B(tz, G8_SB(0, 1), 1, 0); G8_STAGE_A(tz, G8_SA(0, 1), 1, 0);
        if (wr == 1) G8_BAR;
        G8_WAIT_V(4); G8_BAR;
        G8_STAGE_B(tz, G8_SB(1, 0), 0, 1); G8_STAGE_A(tz, G8_SA(1, 0), 0, 1); G8_STAGE_B(tz, G8_SB(1, 1), 1, 1);
        G8_WAIT_V(6); G8_BAR;
    }
    for (int t = 0; t < nt - 2; t += 2) {
        G8_LDB(B0, 0, 0); G8_SCHED; G8_LDA(At, 0, 0); G8_STAGE_A(tz, G8_SA(1, 1), 1, t + 1);
        G8_WAIT_L(8); G8_BAR; G8_WAIT_L(0); G8_MMA(0, 0, At, B0); G8_BAR; G8_SCHED;
        G8_LDB(B1, 0, 1); G8_STAGE_B(tz, G8_SB(0, 0), 0, t + 2);
        G8_BAR; G8_WAIT_L(0); G8_MMA(0, 1, At, B1); G8_BAR;
        G8_LDA(At, 0, 1); G8_STAGE_A(tz, G8_SA(0, 0), 0, t + 2);
        G8_BAR; G8_WAIT_L(0); G8_MMA(1, 0, At, B0); G8_BAR; G8_SCHED;
        G8_STAGE_B(tz, G8_SB(0, 1), 1, t + 2);
        G8_WAIT_V(6); G8_BAR; G8_MMA(1, 1, At, B1); G8_BAR;
        G8_LDB(B0, 1, 0); G8_SCHED; G8_LDA(At, 1, 0); G8_STAGE_A(tz, G8_SA(0, 1), 1, t + 2);
        G8_WAIT_L(8); G8_BAR; G8_WAIT_L(0); G8_MMA(0, 0, At, B0); G8_BAR; G8_SCHED;
        G8_LDB(B1, 1, 1); G8_STAGE_B(tz, G8_SB(1, 0), 0, t + 3);
        G8_BAR; G8_WAIT_L(0); G8_MMA(0, 1, At, B1); G8_BAR;
        G8_LDA(At, 1, 1); G8_STAGE_A(tz, G8_SA(1, 0), 0, t + 3);
        G8_BAR; G8_WAIT_L(0); G8_MMA(1, 0, At, B0); G8_BAR; G8_SCHED;
        G8_STAGE_B(tz, G8_SB(1, 1), 1, t + 3);
        G8_WAIT_V(6); G8_BAR; G8_MMA(1, 1, At, B1); G8_BAR;
    }
    tz = ltid(); wid = tz >> 6; lane = tz & 63; wr = wid >> 2; wc = wid & 3; fr = lane & 15; fq = lane >> 4;
    { G8_LDB(B0, 0, 0); G8_WAIT_V(0); G8_LDA(At, 0, 0); G8_STAGE_A(tz, G8_SA(1, 1), 1, nt - 1);
      G8_BAR; G8_WAIT_L(0); G8_MMA(0, 0, At, B0); G8_BAR;
      G8_LDB(B1, 0, 1); G8_BAR; G8_WAIT_L(0); G8_MMA(0, 1, At, B1); G8_BAR;
      G8_LDA(At, 0, 1); G8_WAIT_V(4); G8_BAR; G8_WAIT_L(0); G8_MMA(1, 0, At, B0); G8_MMA(1, 1, At, B1); G8_BAR; }
    { G8_LDB(B0, 1, 0); G8_LDA(At, 1, 0); G8_WAIT_V(2); G8_BAR; G8_WAIT_L(0); G8_MMA(0, 0, At, B0); G8_BAR;
      G8_LDB(B1, 1, 1); G8_WAIT_V(0); G8_BAR; G8_WAIT_L(0); G8_MMA(0, 1, At, B1); G8_BAR;
      G8_LDA(At, 1, 1); G8_BAR; G8_WAIT_L(0); G8_MMA(1, 0, At, B0); G8_MMA(1, 1, At, B1); G8_BAR; }
    if (wr == 0) G8_BAR;
#undef G8_SA
#undef G8_SB
#undef G8_STAGE_A
#undef G8_STAGE_B
#undef G8_LDA
#undef G8_LDB
#undef G8_MMA
#undef G8_WAIT_V
#undef G8_WAIT_L
#undef G8_BAR
#undef G8_SCHED
}

template <int PERM = 0>
__device__ __forceinline__ void g8_prologue(const bf16_t* __restrict__ A, long lda, const bf16_t* __restrict__ Bt, long ldb, bf16_t* shm) {
    using namespace g8;
    const int tz = ltid();
#define G8P_STAGE_A(P, h, kt) do { for (int _i = 0; _i < 2; ++_i) { const int _b = tz * 16 + _i * 8192; int _r, _c; stage_rc(_b, _r, _c); \
        const int _R = (h) * HALF + _r; const long _ar = PERM ? (long)((_R & 63) * 64 + (_R >> 6)) : (long)_R; \
        __builtin_amdgcn_global_load_lds((const unsigned*)(A + _ar * lda + (long)(kt) * BK + _c), (__attribute__((address_space(3))) unsigned*)((char*)(P) + _b), 16, 0, 0); } } while (0)
#define G8P_STAGE_B(P, h, kt) do { for (int _i = 0; _i < 2; ++_i) { const int _b = tz * 16 + _i * 8192; int _r, _c; stage_rc(_b, _r, _c); \
        __builtin_amdgcn_global_load_lds((const unsigned*)(Bt + (long)((h) * HALF + _r) * ldb + (long)(kt) * BK + _c), (__attribute__((address_space(3))) unsigned*)((char*)(P) + _b), 16, 0, 0); } } while (0)
#define G8P_SA(b, h) (shm + ((b) * 2 + (h)) * HT)
#define G8P_SB(b, h) (shm + (4 + (b) * 2 + (h)) * HT)
    G8P_STAGE_B(G8P_SB(0, 0), 0, 0); G8P_STAGE_A(G8P_SA(0, 0), 0, 0);
    G8P_STAGE_B(G8P_SB(0, 1), 1, 0); G8P_STAGE_A(G8P_SA(0, 1), 1, 0);
    G8P_STAGE_B(G8P_SB(1, 0), 0, 1); G8P_STAGE_A(G8P_SA(1, 0), 0, 1); G8P_STAGE_B(G8P_SB(1, 1), 1, 1);
#undef G8P_STAGE_A
#undef G8P_STAGE_B
#undef G8P_SA
#undef G8P_SB
}

template <int PERM = 0, class Epi>
__device__ __forceinline__ void gemm_tile256(const bf16_t* __restrict__ A, long lda, const bf16_t* __restrict__ Bt, long ldb, int K, bf16_t* shm, Epi epi) {
    f32x4 acc[2][2][4][2];
    gemm_tile256_acc<PERM>(A, lda, Bt, ldb, K, shm, acc);
    const int tz = ltid(), wid = tz >> 6, lane = tz & 63, wr = wid >> 2, wc = wid & 3, fr = lane & 15, fq = lane >> 4;
#pragma unroll
    for (int ai = 0; ai < 2; ++ai)
#pragma unroll
        for (int bj = 0; bj < 2; ++bj)
#pragma unroll
            for (int m = 0; m < 4; ++m)
#pragma unroll
                for (int n = 0; n < 2; ++n) epi(ai * 128 + wr * 64 + m * 16 + fq * 4, bj * 128 + wc * 32 + n * 16 + fr, acc[ai][bj][m][n]);
}

__device__ __forceinline__ void tile_map(int u, int nM, int nN, int& pm, int& pn) {
    const int nwg = nM * nN;
    int wgid = u;
    { const int q = nwg / 8, r = nwg % 8, xcd = wgid % 8, off = wgid / 8; wgid = (xcd < r ? xcd * (q + 1) : r * (q + 1) + (xcd - r) * q) + off; }
    const int nig = 8 * nN, gid = wgid / nig, fm = gid * 8, gsz = (nM - fm) < 8 ? (nM - fm) : 8;
    pm = fm + ((wgid % nig) % gsz); pn = (wgid % nig) / gsz;
}
#define XB_TMO      128
#define XB_XCNT(j)  (256  + 64 * (j))
#define XB_XSUB(j)  (1280 + 64 * (j))
#define XB_XGEN(j)  (2304 + 64 * (j))
#define XB_TOP      3328
#define XB_TOPGEN   3392
#define XCD_BAR_WORDS 3456
#define XB_SPIN_CAP (1u << 18)
#define LAS __attribute__((address_space(3)))

__device__ __forceinline__ unsigned xb_ld(unsigned* p)              { return __hip_atomic_load(p, __ATOMIC_RELAXED, __HIP_MEMORY_SCOPE_AGENT); }
__device__ __forceinline__ unsigned xb_add(unsigned* p, unsigned v) { return __hip_atomic_fetch_add(p, v, __ATOMIC_RELAXED, __HIP_MEMORY_SCOPE_AGENT); }
__device__ __forceinline__ unsigned xb_xcc_id() { return (unsigned)__builtin_amdgcn_s_getreg((3 << 11) | 20) & 0xFu; }
#define XB_SPIN(cond, bar) do { unsigned _sp = 0; while (cond) { __builtin_amdgcn_s_sleep(1); \
    if ((++_sp & 255u) == 0u) { if (xb_ld(&(bar)[XB_TMO])) break; if (_sp > XB_SPIN_CAP) { atomicAdd(&(bar)[XB_TMO], 1u); break; } } } } while (0)

struct XcdBarrier {
    unsigned* bar; unsigned x;
    volatile LAS unsigned* st;
};

__device__ __forceinline__ XcdBarrier xcd_barrier_post(unsigned* bar, volatile LAS unsigned* st) {
    XcdBarrier b; b.bar = bar; b.x = xb_xcc_id(); b.st = st;
    if (threadIdx.x == 0) (void)xb_add(&bar[XB_XCNT(b.x)], 1u);
    return b;
}
__device__ __forceinline__ void xcd_barrier_complete(unsigned* bar, unsigned x, unsigned& nloc, unsigned& nx) {
    const unsigned G = gridDim.x * gridDim.y * gridDim.z;
    unsigned sum, cnt, mine, sp = 0u;
    for (;;) {
        sum = 0u; cnt = 0u; mine = 0u;
#pragma unroll
        for (unsigned j = 0; j < 16; ++j) { const unsigned c = xb_ld(&bar[XB_XCNT(j)]); sum += c; cnt += (c > 0u) ? 1u : 0u; mine = (j == x) ? c : mine; }
        if (sum == G) break;
        __builtin_amdgcn_s_sleep(1);
        if ((++sp & 255u) == 0u) { if (xb_ld(&bar[XB_TMO])) break; if (sp > XB_SPIN_CAP) { atomicAdd(&bar[XB_TMO], 1u); break; } }
    }
    nloc = mine > 0u ? mine : 1u; nx = cnt > 0u ? cnt : 1u;
}

__device__ __forceinline__ void xcd_barrier(const XcdBarrier& b) {
    asm volatile("s_waitcnt vmcnt(0)" ::: "memory");
    __syncthreads();
    if (threadIdx.x == 0) {
        unsigned* bar = b.bar;
        __builtin_amdgcn_s_waitcnt(0);
        unsigned nloc = b.st[0], nx = b.st[1];
        if (nloc == 0u) { xcd_barrier_complete(bar, b.x, nloc, nx); b.st[0] = nloc; b.st[1] = nx; }
        const unsigned old = xb_add(&bar[XB_XSUB(b.x)], 1u);
        const unsigned gen = old / nloc;
        if (old + 1u == (gen + 1u) * nloc) {
            __builtin_amdgcn_fence(__ATOMIC_RELEASE, "agent");
            asm volatile("s_waitcnt vmcnt(0)" ::: "memory");
            const unsigned og = xb_add(&bar[XB_TOP], 1u);
            const unsigned tg = og / nx;
            if (og + 1u == (tg + 1u) * nx) xb_add(&bar[XB_TOPGEN], 1u);
            else XB_SPIN(xb_ld(&bar[XB_TOPGEN]) == tg, bar);
            __builtin_amdgcn_fence(__ATOMIC_ACQUIRE, "agent");
            xb_add(&bar[XB_XGEN(b.x)], 1u);
            asm volatile("s_waitcnt vmcnt(0)" ::: "memory");
        } else {
            XB_SPIN(xb_ld(&bar[XB_XGEN(b.x)]) == gen, bar);
            __builtin_amdgcn_fence(__ATOMIC_ACQUIRE, "agent");
            asm volatile("s_waitcnt vmcnt(0)" ::: "memory");
        }
    }
    __syncthreads();
}

__device__ __forceinline__ void conv_t(const float* __restrict__ src, int ldsrc, int Nvalid, int Nstore, int K, bf16_t* __restrict__ dst, float* ts, int b0 = 0) {
    const int tid = ltid();
    const int ntn = (Nstore + 63) / 64, ntk = K / 64;
    for (int tile = lbid() - b0; tile < ntn * ntk; tile += gridDim.x - b0) {
        const int tn = tile % ntn, tk = tile / ntn;
        {
            const int kk = tid >> 3, n8 = (tid & 7) * 8;
#pragma unroll
            for (int i = 0; i < 8; ++i) {
                const int n = tn * 64 + n8 + i;
                ts[kk * 65 + n8 + i] = n < Nvalid ? src[(long)(tk * 64 + kk) * ldsrc + n] : 0.f;
            }
        }
        __syncthreads();
        {
            const int nn = tid >> 3, k8 = (tid & 7) * 8;
            const int n = tn * 64 + nn;
            if (n < Nstore) {
                uint4 v;
                v.x = pack2(ts[(k8 + 0) * 65 + nn], ts[(k8 + 1) * 65 + nn]);
                v.y = pack2(ts[(k8 + 2) * 65 + nn], ts[(k8 + 3) * 65 + nn]);
                v.z = pack2(ts[(k8 + 4) * 65 + nn], ts[(k8 + 5) * 65 + nn]);
                v.w = pack2(ts[(k8 + 6) * 65 + nn], ts[(k8 + 7) * 65 + nn]);
                *(uint4*)(dst + (long)n * K + tk * 64 + k8) = v;
            }
        }
        __syncthreads();
    }
}

__device__ __forceinline__ void fold_fourier(CP& p, int j, char* smem, int b0) {
    const int tid = ltid(), bid = lbid() - b0, nb = gridDim.x - b0;
    float* wt = (float*)smem;
    for (int unit = bid; unit < 256; unit += nb) {
        const int g = unit >> 6, kb = unit & 63;
        const int dq = ltid() & 127, kq = ltid() >> 7;
        const float rs = __builtin_amdgcn_sinf((float)dq * (1.f / 128.f)), rc = __builtin_amdgcn_cosf((float)dq * (1.f / 128.f));
        __syncthreads();
        for (int i = tid; i < 16 * 128; i += NTHREADS) {
            const int kk = i >> 7, d = i & 127;
            wt[kk * 129 + d] = p.even_w_in[((long)j * 1024 + kb * 16 + kk) * 2576 + 2064 + g * 128 + d];
        }
        __syncthreads();
        float ar[4], ai[4];
#pragma unroll
        for (int q = 0; q < 4; ++q) { ar[q] = 0.f; ai[q] = 0.f; }
        for (int d0 = 0; d0 < 128; d0 += 16) {
            float s = __builtin_amdgcn_sinf((float)((d0 * dq) & 127) * (1.f / 128.f)), c = __builtin_amdgcn_cosf((float)((d0 * dq) & 127) * (1.f / 128.f));
#pragma unroll
            for (int dd = 0; dd < 16; ++dd) {
#pragma unroll
                for (int q = 0; q < 4; ++q) {
                    const float w = wt[(kq * 4 + q) * 129 + d0 + dd];
                    ar[q] += w * c;
                    ai[q] -= w * s;
                }
                const float cn = c * rc - s * rs, sn = s * rc + c * rs;
                c = cn; s = sn;
            }
        }
        const float sc = 0.08838834764831845f;
        bf16_t* dst = p.wtE_in + (long)j * N_EIN * 1024;
#pragma unroll
        for (int q = 0; q < 4; ++q) {
            dst[(long)(2064 + g * 128 + dq) * 1024 + kb * 16 + kq * 4 + q] = f2bf(ar[q] * sc);
            dst[(long)(2576 + g * 128 + dq) * 1024 + kb * 16 + kq * 4 + q] = f2bf(ai[q] * sc);
        }
    }
    __syncthreads();
    for (long i = (long)bid * NTHREADS + tid; i < 240L * 1024; i += (long)nb * NTHREADS) p.wtE_in[(long)j * N_EIN * 1024 + 3088L * 1024 + i] = 0;
}
__device__ __forceinline__ void ph_init2(CP& p, char* smem, int b0) {
    if ((int)lbid() < b0) return;
    __syncthreads();
    float* ts = (float*)smem;
    conv_t(p.even_w_in + 1024L * 2576, 2576, 2064, 2064, 1024, p.wtE_in + (long)N_EIN * 1024, ts, b0);
    for (int j = 0; j < 2; ++j) {
        conv_t(p.even_w_out + (long)j * 1024 * 1024, 1024, 1024, 1024, 1024, p.wtE_out + (long)j * 1024 * 1024, ts, b0);
        conv_t(p.odd_w_in + (long)j * 1024 * 832, 832, 832, N_OIN, 1024, p.wtO_in + (long)j * N_OIN * 1024, ts, b0);
        conv_t(p.mla_w_uq + (long)j * 512 * 1536, 1536, 1536, 1536, 512, p.wtUq + (long)j * 1536 * 512, ts, b0);
        conv_t(p.mla_w_ukv + (long)j * 256 * 2048, 2048, 2048, 2048, 256, p.wtUkv + (long)j * 2048 * 256, ts, b0);
        conv_t(p.odd_w_out + (long)j * 1024 * 1024, 1024, 1024, 1024, 1024, p.wtO_out + (long)j * 1024 * 1024, ts, b0);
    }
    for (int l = 0; l < 4; ++l) conv_t(p.peer_w_q + (long)l * 1024 * 2048, 2048, 2048, 2048, 1024, p.wtPq + (long)l * 2048 * 1024, ts, b0);
    fold_fourier(p, 1, smem, b0);
}

__device__ __forceinline__ void ph_init(CP& p, char* smem) {
    const int tid = ltid(), bid = lbid(), nb = gridDim.x;
    {
        float* sl = (float*)smem;
        for (int i = tid; i < 9 * 1024; i += NTHREADS) {
            const int r = i >> 10, k = i & 1023;
            const float v = r == 0 ? p.c_ctx[k] : p.c[(r - 1) * 1024 + k];
            sl[i] = silu_f(v);
        }
        __syncthreads();
        float* part16 = sl + 9 * 1024;
        for (int unit = bid; unit < 192; unit += nb) {
            const int l = unit / 48, cb = unit % 48;
            const int c4 = (tid & 31) * 4, kq = tid >> 5;
            f32x4 acc[9];
#pragma unroll
            for (int r = 0; r < 9; ++r) acc[r] = (f32x4){0.f, 0.f, 0.f, 0.f};
            const float* wp = p.w_mod + ((long)l * 1024 + kq * 64) * 6144 + cb * 128 + c4;
            for (int k = 0; k < 64; k += 8) {
                f32x4 w[8];
#pragma unroll
                for (int q = 0; q < 8; ++q) w[q] = *(const f32x4*)(wp + (long)(k + q) * 6144);
#pragma unroll
                for (int q = 0; q < 8; ++q)
#pragma unroll
                    for (int r = 0; r < 9; ++r) acc[r] = acc[r] + w[q] * sl[r * 1024 + kq * 64 + k + q];
            }
#pragma unroll
            for (int r = 0; r < 9; ++r) *(f32x4*)(part16 + (kq * 9 + r) * 128 + c4) = acc[r];
            __syncthreads();
            if (tid < 128) {
                const int col = cb * 128 + tid;
                const float bias = p.b_mod[l * 6144 + col];
#pragma unroll
                for (int r = 0; r < 9; ++r) {
                    float s = bias;
#pragma unroll
                    for (int g = 0; g < 16; ++g) s += part16[(g * 9 + r) * 128 + tid];
                    p.mods[((long)l * 9 + r) * 6144 + col] = s;
                }
            }
            __syncthreads();
        }
    }
    {
        float* ts = (float*)smem;
        conv_t(p.even_w_in, 2576, 2064, 2064, 1024, p.wtE_in, ts);
    }
    fold_fourier(p, 0, smem, 0);
    for (long i = (long)bid * NTHREADS + tid; i < 4L * 8 * 2 * 128 * 128; i += (long)nb * NTHREADS) p.subk[i] = f2bf(p.peer_sub_keys[i]);
    for (int i = bid * NTHREADS + tid; i < 128 * 128; i += nb * NTHREADS) {
        const int jrow = i >> 7, kk = i & 127;
        {
            const int k1 = jrow >> 1, po = jrow & 1, pi = kk >> 6, n1 = kk & 63;
            float s, c;
            sincospif((float)((k1 * n1) & 63) / 32.f, &s, &c);
            const float v = po == 0 ? (pi == 0 ? c : s) : (pi == 0 ? -s : c);
            p.fftMA[i] = f2bf(v * 0.125f);
        }
        {
            const int k2 = jrow, pi = kk >> 6, n2 = kk & 63;
            float s, c;
            sincospif((float)((k2 * n2) & 63) / 32.f, &s, &c);
            p.fftMB[i] = jrow < 64 ? f2bf((pi == 0 ? c : s) * 0.125f) : (bf16_t)0;
        }
    }
    for (int i = bid * NTHREADS + tid; i < 4096; i += nb * NTHREADS) {
        const int n2 = i >> 6, k1 = i & 63;
        float s, c;
        sincospif((float)(n2 * k1) / 2048.f, &s, &c);
        p.fftTW[i * 2] = c; p.fftTW[i * 2 + 1] = s;
    }
    for (long i = (long)bid * NTHREADS + tid; i < 256L * 512; i += (long)nb * NTHREADS) {
        const int k = (int)(i >> 9), np = (int)(i & 511), n = np & 255;
        const int prod = (k * n) & 255;
        float s, c;
        sincospif((float)prod / 128.f, &s, &c);
        p.dftP[i] = f2bf(((np >> 8) ? s : c) * (1.f / 16.f));
    }
}

__device__ __forceinline__ void ph_tab(CP& p, int l, int b0) {
    const int lane = ltid() & 63, wave = ltid() >> 6;
    if ((int)lbid() < b0) return;
    unsigned char* tab = p.tabU + (long)(l & 1) * 16384 * 2048;
    float* su = p.su + (l & 1) * 32768; float* sv = su + 16384;
    const int rstep = (gridDim.x - b0) * 8;
    int row = (lbid() - b0) * 8 + wave;
    f32x4 nx[4];
#define TAB_SRC(R) ((((R) >= 16384) ? p.peer_v : p.peer_u) + ((long)l * 16384 + ((R) & 16383)) * 1024 + lane * 16)
    if (row < 32768) {
#pragma unroll
        for (int i = 0; i < 4; ++i) nx[i] = *(const f32x4*)(TAB_SRC(row) + i * 4);
    }
    for (; row < 32768; row += rstep) {
        const bool isv = row >= 16384;
        const int e = row & 16383;
        float v[16];
#pragma unroll
        for (int i = 0; i < 4; ++i) { v[i * 4] = nx[i][0]; v[i * 4 + 1] = nx[i][1]; v[i * 4 + 2] = nx[i][2]; v[i * 4 + 3] = nx[i][3]; }
        if (row + rstep < 32768) {
#pragma unroll
            for (int i = 0; i < 4; ++i) nx[i] = *(const f32x4*)(TAB_SRC(row + rstep) + i * 4);
        }
        float m = 0.f;
#pragma unroll
        for (int i = 0; i < 16; ++i) m = fmaxf(m, fabsf(v[i]));
        m = wave_max(m);
        const float scale = m > 0.f ? m * (1.f / 127.f) : 1.f;
        const float inv = 1.f / scale;
        unsigned w[4];
#pragma unroll
        for (int i = 0; i < 4; ++i) {
            unsigned pk = 0;
#pragma unroll
            for (int q = 0; q < 4; ++q) {
                int qi = (int)rintf(v[i * 4 + q] * inv);
                qi = qi < -127 ? -127 : (qi > 127 ? 127 : qi);
                pk |= (unsigned)(qi & 0xFF) << (q * 8);
            }
            w[i] = pk;
        }
        *(uint4*)(tab + (isv ? 16384L * 1024 : 0L) + (long)e * 1024 + lane * 16) = make_uint4(w[0], w[1], w[2], w[3]);
        if (lane == 0) (isv ? sv : su)[e] = scale;
    }
#undef TAB_SRC
}

template <int FROM_INPUT = 0>
__device__ __forceinline__ void ph_norm(CP& p, const float* __restrict__ w, const float* __restrict__ mods_l, int sh_off, int sc_off) {
    const int lane = ltid() & 63, wave = ltid() >> 6;
    const int nw = gridDim.x * 8;
    for (int row = lbid() * 8 + wave; row < T_TOK; row += nw) {
        const float* xr = FROM_INPUT ? (row < TP_TOK ? p.x_prompt + (long)row * DM : p.x_sample + (long)(row - TP_TOK) * DM) : p.out + (long)row * DM;
        float4 v[4];
        float ss = 0.f;
#pragma unroll
        for (int i = 0; i < 4; ++i) {
            v[i] = *(const float4*)(xr + i * 256 + lane * 4);
            ss += v[i].x * v[i].x + v[i].y * v[i].y + v[i].z * v[i].z + v[i].w * v[i].w;
        }
        ss = wave_sum(ss);
        const float r = rsqrtf(ss * (1.f / 1024.f) + 1e-6f);
        const float* mr = mods_l + (long)tok_modrow(row) * 6144;
        float4 ww[4], sc[4], sh[4];
#pragma unroll
        for (int i = 0; i < 4; ++i) {
            const int c = i * 256 + lane * 4;
            ww[i] = *(const float4*)(w + c); sc[i] = *(const float4*)(mr + sc_off + c); sh[i] = *(const float4*)(mr + sh_off + c);
        }
#pragma unroll
        for (int i = 0; i < 4; ++i) {
            const int c = i * 256 + lane * 4;
            const float h0 = v[i].x * r * ww[i].x * (1.f + sc[i].x) + sh[i].x;
            const float h1 = v[i].y * r * ww[i].y * (1.f + sc[i].y) + sh[i].y;
            const float h2 = v[i].z * r * ww[i].z * (1.f + sc[i].z) + sh[i].z;
            const float h3 = v[i].w * r * ww[i].w * (1.f + sc[i].w) + sh[i].w;
            *(uint2*)(p.H + (long)row * DM + c) = make_uint2(pack2(h0, h1), pack2(h2, h3));
        }
    }
}
#define ZA_OFF ((long)TP_TOK * 1024)
template <int PERM>
__device__ __forceinline__ void e_gemm_epi(CP& p, f32x4 (&acc)[2][2][4][2], int col0, int row0, int s0, int n20, int b) {
    const int tz = ltid(), wid = tz >> 6, lane = tz & 63, wr = wid >> 2, wc = wid & 3, fr = lane & 15, fq = lane >> 4;
#define EG_TOK(ai, m, i) (PERM ? s0 + 64 * ((m) * 16 + fq * 4 + (i)) + n20 + (ai) * 2 + wr : row0 + (ai) * 128 + wr * 64 + (m) * 16 + fq * 4 + (i))
    if (col0 + 256 <= 2048) {
        const bool isg = col0 >= 1536;
        bf16_t* const base = isg ? p.gate + (col0 - 1536) : p.qkvraw + col0;
        const long ld = isg ? 512 : 1536;
#pragma unroll
        for (int ai = 0; ai < 2; ++ai)
#pragma unroll
            for (int m = 0; m < 4; ++m)
#pragma unroll
                for (int i = 0; i < 4; ++i) {
                    bf16_t* d = base + (long)EG_TOK(ai, m, i) * ld + wc * 32 + fr;
#pragma unroll
                    for (int bj = 0; bj < 2; ++bj)
#pragma unroll
                        for (int n = 0; n < 2; ++n) d[bj * 128 + n * 16] = f2bf(acc[ai][bj][m][n][i]);
                }
    } else {
#pragma unroll
        for (int bj = 0; bj < 2; ++bj)
#pragma unroll
            for (int n = 0; n < 2; ++n) {
                const int col = col0 + bj * 128 + wc * 32 + n * 16 + fr;
                if (col < 2064) {
#pragma unroll
                    for (int ai = 0; ai < 2; ++ai)
#pragma unroll
                        for (int m = 0; m < 4; ++m)
#pragma unroll
                            for (int i = 0; i < 4; ++i) p.ba[(long)EG_TOK(ai, m, i) * 16 + (col - 2048)] = acc[ai][bj][m][n][i];
                } else if (col < 3088) {
                    const int cc = col - 2064, part = cc >> 9, cf = cc & 511;
#pragma unroll
                    for (int ai = 0; ai < 2; ++ai)
#pragma unroll
                        for (int m = 0; m < 4; ++m) {
                            const f32x4 v = acc[ai][bj][m][n];
                            bf16_t* dst;
                            if (PERM) dst = p.ZtA + ZA_OFF + (((((long)b * 512 + cf) * 64 + (n20 + ai * 2 + wr)) * 2 + part) * 64 + (m * 16 + fq * 4));
                            else dst = p.ZtA + (long)s0 * 1024 + ((long)cf * 2 + part) * 256 + (ai * 128 + wr * 64 + m * 16 + fq * 4);
                            *(uint2*)dst = make_uint2(pack2(v[0], v[1]), pack2(v[2], v[3]));
                        }
                }
            }
    }
#undef EG_TOK
}
__device__ __forceinline__ void ph_e_gemm(CP& p, int j, char* smem) {
    const int ntn = N_EIN / 256, ntm = T_TOK / 256;
    const bf16_t* Bt = p.wtE_in + (long)j * N_EIN * 1024;
#define EG_PROLOGUE(U)                                                                                             \
    {                                                                                                              \
        int tm_, tn_;                                                                                              \
        tile_map((U), ntm, ntn, tm_, tn_);                                                                         \
        if (tm_ < 16) g8_prologue<0>(p.H + (long)tm_ * 256 * DM, DM, Bt + (long)tn_ * 256 * 1024, 1024, (bf16_t*)smem);   \
        else { const int q_ = tm_ - 16; g8_prologue<1>(p.H + (long)(TP_TOK + (q_ >> 4) * 4096 + (q_ & 15) * 4) * DM, DM, Bt + (long)tn_ * 256 * 1024, 1024, (bf16_t*)smem); }   \
    }
    int u = lbid();
    if (u < ntn * ntm) EG_PROLOGUE(u)
    for (; u < ntn * ntm; u += gridDim.x) {
        int tm, tn;
        tile_map(u, ntm, ntn, tm, tn);
        const int col0 = tn * 256;
        const int un = u + gridDim.x;
        f32x4 acc[2][2][4][2];
        if (tm < 16) {
            const int row0 = tm * 256;
            gemm_tile256_acc<0, 1>(p.H + (long)row0 * DM, DM, Bt + (long)col0 * 1024, 1024, 1024, (bf16_t*)smem, acc);
            if (un < ntn * ntm) EG_PROLOGUE(un)
            e_gemm_epi<0>(p, acc, col0, row0, row0, 0, 0);
        } else {
            const int q = tm - 16, b = q >> 4, n20 = (q & 15) * 4;
            const int s0 = TP_TOK + b * 4096;
            gemm_tile256_acc<1, 1>(p.H + (long)(s0 + n20) * DM, DM, Bt + (long)col0 * 1024, 1024, 1024, (bf16_t*)smem, acc);
            if (un < ntn * ntm) EG_PROLOGUE(un)
            e_gemm_epi<1>(p, acc, col0, 0, s0, n20, b);
        }
    }
#undef EG_PROLOGUE
}

#define PREP_SMEM_BYTES (66048 + 34816 + 16384 + 2048 + 256 + 15360)
__device__ __forceinline__ void ph_e_prep(CP& p, int j, char* smem) {
    const float* cw = p.even_conv_w + (long)j * 3 * 1536;
    for (int u = lbid(); u < 576 * 4; u += gridDim.x) {
        const int cg = u >> 2, h = u & 3;
        const int t0 = cg * 64;
        const int s0 = tok_seq0(t0), L = tok_len(t0);
        int lz = 0, tid = ltid();
        asm volatile("" : "+s"(lz), "+v"(tid));
        const int lane = tid & 63, wave = tid >> 6;
        char* sm = smem + lz;
        bf16_t* raw = (bf16_t*)sm;
        float* KK = (float*)sm;
        float* QKr = KK + 64 * 65;
        float* Am = QKr + 64 * 65;
        bf16_t* qn = (bf16_t*)(sm + 66048);
        bf16_t* kn = qn + 64 * 136;
        bf16_t* vv = (bf16_t*)(sm + 66048 + 34816);
        float* sb = (float*)(sm + 66048 + 34816 + 16384);
        float* sg = sb + 128;
        float* sgr = sg + 128;
        float* seg = sgr + 128;
        float* sone = seg + 128;
        bf16_t* Dinv = (bf16_t*)(sm + 66048 + 34816 + 16384 + 2048 + 256);
        bf16_t* A10 = Dinv + 4 * 32 * 40;
        __syncthreads();
        for (int i = tid; i < 3 * 66 * 16; i += NTHREADS) {
            const int part = i / (66 * 16), rem = i % (66 * 16), rr = rem >> 4, ch = rem & 15;
            const int t = t0 - 1 + rr;
            uint4 v = make_uint4(0, 0, 0, 0);
            if (t >= s0 && t < s0 + L) v = *(const uint4*)(p.qkvraw + (long)t * 1536 + part * 512 + h * 128 + ch * 8);
            *(uint4*)(raw + (part * 66 + rr) * 128 + ch * 8) = v;
        }
        if (tid >= 128 && tid < 192) sone[tid - 128] = 1.f;
        if (tid < 128) {
            const int dir = tid >> 6, i = tid & 63;
            const int t = t0 + (dir ? 63 - i : i);
            const float* bar_ = p.ba + (long)t * 16;
            sb[dir * 64 + i] = sigmoid_f(bar_[dir * 4 + h]);
            const float a = __expf(p.gdn_a_log[(j * 2 + dir) * 4 + h]);
            sgr[dir * 64 + i] = -a * softplus_f(bar_[(2 + dir) * 4 + h] + p.gdn_dt_bias[(j * 2 + dir) * 4 + h]);
        }
        __syncthreads();
        if (tid < 128) {
            float v = sgr[tid];
#pragma unroll
            for (int off = 1; off < 64; off <<= 1) {
                const float o = __int_as_float(__builtin_amdgcn_ds_bpermute(((lane - off) & 63) << 2, __float_as_int(v)));
                v += lane >= off ? o : 0.f;
            }
            sg[tid] = v;
            seg[tid] = __expf(v);
        }
        {
            const int d = lane * 2;
#pragma unroll
            for (int part = 0; part < 3; ++part) {
                const int ch = part * 512 + h * 128 + d;
                const float w00 = cw[ch], w01 = cw[ch + 1], w10 = cw[1536 + ch], w11 = cw[1536 + ch + 1], w20 = cw[3072 + ch], w21 = cw[3072 + ch + 1];
                float y0[8], y1[8], ss[8];
#pragma unroll
                for (int r8 = 0; r8 < 8; ++r8) {
                    const int rr = wave * 8 + r8;
                    const unsigned x0 = *(const unsigned*)(raw + (part * 66 + rr) * 128 + d);
                    const unsigned x1 = *(const unsigned*)(raw + (part * 66 + rr + 1) * 128 + d);
                    const unsigned x2 = *(const unsigned*)(raw + (part * 66 + rr + 2) * 128 + d);
                    y0[r8] = silu_f(w00 * bflo(x0) + w10 * bflo(x1) + w20 * bflo(x2));
                    y1[r8] = silu_f(w01 * bfhi(x0) + w11 * bfhi(x1) + w21 * bfhi(x2));
                    ss[r8] = y0[r8] * y0[r8] + y1[r8] * y1[r8];
                }
                float tot = 0.f;
                if (part < 2) {
                    const bool b5 = (lane & 32) != 0, b4 = (lane & 16) != 0, b3 = (lane & 8) != 0;
                    float t4[4], t2[2];
#pragma unroll
                    for (int i = 0; i < 4; ++i) { const float snd = b5 ? ss[i] : ss[i + 4]; const float kp = b5 ? ss[i + 4] : ss[i]; t4[i] = kp + xshfl<32>(snd); }
#pragma unroll
                    for (int i = 0; i < 2; ++i) { const float snd = b4 ? t4[i] : t4[i + 2]; const float kp = b4 ? t4[i + 2] : t4[i]; t2[i] = kp + xshfl<16>(snd); }
                    { const float snd = b3 ? t2[0] : t2[1]; const float kp = b3 ? t2[1] : t2[0]; tot = kp + xshfl<8>(snd); }
                    tot += xshfl<4>(tot); tot += xshfl<2>(tot); tot += xshfl<1>(tot);
                    tot = rsqrtf(tot + 1e-6f);
                }
#pragma unroll
                for (int r8 = 0; r8 < 8; ++r8) {
                    const int rr = wave * 8 + r8;
                    float a0 = y0[r8], a1 = y1[r8];
                    if (part < 2) { const float rn = __int_as_float(__builtin_amdgcn_readlane(__float_as_int(tot), r8 * 8)); a0 *= rn; a1 *= rn; }
                    const unsigned pk = pack2(a0, a1);
                    if (part == 0) { *(unsigned*)(qn + rr * 136 + d) = pk; *(unsigned*)(p.qn + ((long)(t0 + rr) * 4 + h) * 128 + d) = pk; }
                    else if (part == 1) { *(unsigned*)(kn + rr * 136 + d) = pk; *(unsigned*)(p.kn + ((long)(t0 + rr) * 4 + h) * 128 + d) = pk; }
                    else { *(unsigned*)(vv + rr * 128 + d) = pk; }
                }
            }
        }
        __syncthreads();
        {
            const int mat = wave >> 2, rt = wave & 3;
            f32x4 acc[1][4];
#pragma unroll
            for (int n = 0; n < 4; ++n) acc[0][n] = (f32x4){0.f, 0.f, 0.f, 0.f};
            wave_mma<1, 4>(acc, (mat ? qn : kn) + rt * 16 * 136, 136, kn, 136, 128);
            float* dst = mat ? QKr : KK;
#pragma unroll
            for (int n = 0; n < 4; ++n)
#pragma unroll
                for (int r = 0; r < 4; ++r) dst[(rt * 16 + (lane >> 4) * 4 + r) * 65 + n * 16 + (lane & 15)] = acc[0][n][r];
        }
        __syncthreads();
        {
            const int dir = tid >> 8, q = tid & 255;
            const long ud = ((long)(dir ? (s0 + L - 64 - (t0 - s0)) / 64 : cg) * 4 + h) * 2 + dir;
            bf16_t* qkout = p.QKb + ud * 4096;
            for (int e = q; e < 4096; e += 256) {
                const int i = e >> 6, jj = e & 63;
                const int ti = dir ? 63 - i : i, tj = dir ? 63 - jj : jj;
                const float dec = jj <= i ? __expf(sg[dir * 64 + i] - sg[dir * 64 + jj]) : 0.f;
                Am[(dir * 64 + i) * 64 + jj] = jj < i ? sb[dir * 64 + i] * KK[ti * 65 + tj] * dec : 0.f;
                qkout[e] = f2bf(QKr[ti * 65 + tj] * 0.08838834764831845f * dec);
            }
            if (q < 64) p.gcb[ud * 64 + q] = sg[dir * 64 + q];
        }
        __syncthreads();
        if (tid < 128) {
            const int dir = tid >> 6, blk = (tid >> 5) & 1, c = tid & 31;
            const float* Dm = Am + (dir * 64 + blk * 32) * 64 + blk * 32;
            float x[32];
#pragma unroll
            for (int i = 0; i < 32; ++i) x[i] = (i == c) ? 1.f : 0.f;
#pragma unroll
            for (int i = 1; i < 32; ++i) {
                f32x4 dr[8];
#pragma unroll
                for (int q4 = 0; q4 < 8; ++q4) if (q4 * 4 < i) dr[q4] = *(const f32x4*)(Dm + i * 64 + q4 * 4);
                float a = x[i];
#pragma unroll
                for (int jj = 0; jj < i; ++jj) a -= dr[jj >> 2][jj & 3] * x[jj];
                x[i] = a;
            }
            bf16_t* dv = Dinv + (dir * 2 + blk) * 32 * 40 + c;
#pragma unroll
            for (int i = 0; i < 32; ++i) dv[i * 40] = f2bf(x[i]);
        }
        for (int e = tid; e < 2048; e += NTHREADS) {
            const int dir = e >> 10, i = (e >> 5) & 31, jj = e & 31;
            A10[(dir * 32 + i) * 40 + jj] = f2bf(Am[(dir * 64 + 32 + i) * 64 + jj]);
        }
        __syncthreads();
        {
            const int dir = wave >> 2, slab = wave & 3;
            const long ud = ((long)(dir ? (s0 + L - 64 - (t0 - s0)) / 64 : cg) * 4 + h) * 2 + dir;
            bf16_t* RT = (bf16_t*)sm + wave * 4096;
#define RT_AT(c_, i_) (RT + (c_) * 64 + (((((i_) >> 3) ^ ((c_) & 7))) << 3) + ((i_) & 7))
            const int c = slab * 64 + lane;
            const int g4 = (lane >> 4) * 4, cn = lane & 15, kg = (lane >> 4) * 8;
            {
                const bf16_t* src = c < 128 ? vv + c : kn + (c - 128);
                const int sst = c < 128 ? 128 : 136;
                const float* fac = c < 128 ? sone : seg + dir * 64;
                const float* fb = sb + dir * 64;
#pragma unroll
                for (int i8 = 0; i8 < 8; ++i8) {
                    unsigned w[4];
#pragma unroll
                    for (int e = 0; e < 4; ++e) {
                        float v[2];
#pragma unroll
                        for (int q = 0; q < 2; ++q) {
                            const int i = i8 * 8 + e * 2 + q;
                            const int ti = dir ? 63 - i : i;
                            const float f0 = bf2f(src[ti * sst]) * fb[i];
                            v[q] = f0 * fac[i];
                        }
                        w[e] = pack2(v[0], v[1]);
                    }
                    *(uint4*)RT_AT(lane, i8 * 8) = make_uint4(w[0], w[1], w[2], w[3]);
                }
            }
            asm volatile("s_waitcnt lgkmcnt(0)" ::: "memory");
            const bf16_t* D0 = Dinv + (dir * 2 + 0) * 32 * 40;
            const bf16_t* D1 = Dinv + (dir * 2 + 1) * 32 * 40;
            const bf16_t* A1 = A10 + dir * 32 * 40;
            bf16_t* dstb = (c < 128 ? p.Ub : p.Wb) + ud * 8192;
            const int cbase = (slab & 1) * 64;
            bf16x8 bfr[4];
            f32x4 X0[2][4];
#pragma unroll
            for (int nt = 0; nt < 4; ++nt) bfr[nt] = *(const bf16x8*)RT_AT(nt * 16 + cn, kg);
#pragma unroll
            for (int mt = 0; mt < 2; ++mt) {
                const bf16x8 af = *(const bf16x8*)(D0 + (mt * 16 + cn) * 40 + kg);
#pragma unroll
                for (int nt = 0; nt < 4; ++nt) X0[mt][nt] = __builtin_amdgcn_mfma_f32_16x16x32_bf16(af, bfr[nt], (f32x4){0.f, 0.f, 0.f, 0.f}, 0, 0, 0);
            }
#pragma unroll
            for (int mt = 0; mt < 2; ++mt)
#pragma unroll
                for (int nt = 0; nt < 4; ++nt) {
#pragma unroll
                    for (int r = 0; r < 4; ++r) dstb[(mt * 16 + g4 + r) * 128 + cbase + nt * 16 + cn] = f2bf(X0[mt][nt][r]);
                    *(uint2*)RT_AT(nt * 16 + cn, mt * 16 + g4) = make_uint2(pack2(X0[mt][nt][0], X0[mt][nt][1]), pack2(X0[mt][nt][2], X0[mt][nt][3]));
                }
            asm volatile("s_waitcnt lgkmcnt(0)" ::: "memory");
            f32x4 R1[2][4];
#pragma unroll
            for (int nt = 0; nt < 4; ++nt) bfr[nt] = *(const bf16x8*)RT_AT(nt * 16 + cn, kg);
#pragma unroll
            for (int mt = 0; mt < 2; ++mt) {
                const bf16x8 af = *(const bf16x8*)(A1 + (mt * 16 + cn) * 40 + kg);
#pragma unroll
                for (int nt = 0; nt < 4; ++nt) {
                    const f32x4 pr = __builtin_amdgcn_mfma_f32_16x16x32_bf16(af, bfr[nt], (f32x4){0.f, 0.f, 0.f, 0.f}, 0, 0, 0);
                    const uint2 rr = *(const uint2*)RT_AT(nt * 16 + cn, 32 + mt * 16 + g4);
                    R1[mt][nt][0] = bflo(rr.x) - pr[0]; R1[mt][nt][1] = bfhi(rr.x) - pr[1];
                    R1[mt][nt][2] = bflo(rr.y) - pr[2]; R1[mt][nt][3] = bfhi(rr.y) - pr[3];
                }
            }
            asm volatile("s_waitcnt lgkmcnt(0)" ::: "memory");
#pragma unroll
            for (int mt = 0; mt < 2; ++mt)
#pragma unroll
                for (int nt = 0; nt < 4; ++nt)
                    *(uint2*)RT_AT(nt * 16 + cn, 32 + mt * 16 + g4) = make_uint2(pack2(R1[mt][nt][0], R1[mt][nt][1]), pack2(R1[mt][nt][2], R1[mt][nt][3]));
            asm volatile("s_waitcnt lgkmcnt(0)" ::: "memory");
#pragma unroll
            for (int nt = 0; nt < 4; ++nt) bfr[nt] = *(const bf16x8*)RT_AT(nt * 16 + cn, 32 + kg);
#pragma unroll
            for (int mt = 0; mt < 2; ++mt) {
                const bf16x8 af = *(const bf16x8*)(D1 + (mt * 16 + cn) * 40 + kg);
#pragma unroll
                for (int nt = 0; nt < 4; ++nt) {
                    const f32x4 x1 = __builtin_amdgcn_mfma_f32_16x16x32_bf16(af, bfr[nt], (f32x4){0.f, 0.f, 0.f, 0.f}, 0, 0, 0);
#pragma unroll
                    for (int r = 0; r < 4; ++r) dstb[(32 + mt * 16 + g4 + r) * 128 + cbase + nt * 16 + cn] = f2bf(x1[r]);
                }
            }
        }
    }
#undef RT_AT
}
typedef short s16x4 __attribute__((ext_vector_type(4)));
#define SCAN_KOFF(r_, ch_) (256 * (r_) + 16 * ((ch_) ^ ((((r_) & 3) << 2) | (((r_) >> 2) & 3))))
#define SCAN_SMEM_BYTES (17408 + 17408 + 9216 + 18432 + 8 * 4352 + 8 * 2 * 2304 + 512)
__device__ __forceinline__ void ph_e_scan(CP& p, int j, char* smem) {
    for (int st = lbid(); st < 192; st += gridDim.x) {
        const int tid = ltid(), lane = tid & 63, wave = tid >> 6;
        bf16_t* Ws = (bf16_t*)smem;
        bf16_t* Qs = Ws + 64 * 136;
        bf16_t* QKs = Qs + 64 * 136;
        bf16_t* KnT = QKs + 64 * 72;
        bf16_t* St = KnT + 128 * 72 + wave * (16 * 136);
        bf16_t* VNt = KnT + 128 * 72 + 8 * (16 * 136) + wave * (2 * 16 * 72);
        bf16_t* VNs = VNt + 16 * 72;
        float* gcs = (float*)(smem + 17408 + 17408 + 9216 + 18432 + 8 * 4352 + 8 * 2 * 2304);
        const int g4 = (lane >> 4) * 4, cn = lane & 15;
        int seq, h, dir;
        if (st < 64) { seq = 16 + (st >> 3); h = (st >> 1) & 3; dir = st & 1; }
        else { const int q = st - 64; seq = q >> 3; h = (q >> 1) & 3; dir = q & 1; }
        const int L = seq < 16 ? 256 : 4096;
        const int s0 = seq < 16 ? seq * 256 : TP_TOK + (seq - 16) * 4096;
        const int nch = L / 64;
        f32x4 S[8][1];
        if (seq >= 16) {
            const float* sp = p.state_gdn + ((((long)(seq - 16) * 2 + j) * 2 + dir) * 4 + h) * 16384 + (g4 * 128 + wave * 16 + cn);
#pragma unroll
            for (int mt = 0; mt < 8; ++mt)
#pragma unroll
                for (int r = 0; r < 4; ++r) S[mt][0][r] = sp[(mt * 16 + r) * 128];
        } else {
#pragma unroll
            for (int mt = 0; mt < 8; ++mt) S[mt][0] = (f32x4){0.f, 0.f, 0.f, 0.f};
        }
        u32x4 pw[2], pq[2], pk[2], pqk;
        float pgc = 0.f;
        float pu[16];
#define SCAN_LOAD_MAIN(M)                                                                                              \
        {                                                                                                              \
            const long ud_ = ((long)(s0 / 64 + (M)) * 4 + h) * 2 + dir;                                               \
            _Pragma("unroll") for (int i_ = 0; i_ < 2; ++i_) {                                                       \
                const int id_ = tid + i_ * NTHREADS, c_ = id_ >> 4, ch_ = id_ & 15;                                   \
                const int t_ = dir ? s0 + L - 1 - ((M) * 64 + c_) : s0 + (M) * 64 + c_;                               \
                pw[i_] = *(const u32x4*)(p.Wb + ud_ * 8192 + c_ * 128 + ch_ * 8);                                     \
                pq[i_] = *(const u32x4*)(p.qn + ((long)t_ * 4 + h) * 128 + ch_ * 8);                                  \
                pk[i_] = *(const u32x4*)(p.kn + ((long)t_ * 4 + h) * 128 + ch_ * 8);                                  \
            }                                                                                                          \
            pqk = *(const u32x4*)(p.QKb + ud_ * 4096 + (tid >> 3) * 64 + (tid & 7) * 8);                              \
            if (tid < 64) pgc = p.gcb[ud_ * 64 + tid];                                                                \
        }
#define SCAN_LOAD_U(M)                                                                                                 \
        {                                                                                                              \
            const long ud_ = ((long)(s0 / 64 + (M)) * 4 + h) * 2 + dir;                                               \
            long uo_ = ud_ * 8192 + (g4 * 128 + wave * 16 + cn);                                                       \
            asm volatile("" : "+v"(uo_));        \
            const bf16_t* ub_ = p.Ub + uo_;                                                                            \
            _Pragma("unroll") for (int mt_ = 0; mt_ < 4; ++mt_)                                                      \
                _Pragma("unroll") for (int r_ = 0; r_ < 4; ++r_)                                                     \
                    pu[mt_ * 4 + r_] = bf2f(ub_[(mt_ * 16 + r_) * 128]);                                              \
        }
        SCAN_LOAD_MAIN(0)
        SCAN_LOAD_U(0)
        for (int m = 0; m < nch; ++m) {
            __syncthreads();
#pragma unroll
            for (int i = 0; i < 2; ++i) {
                const int id = tid + i * NTHREADS, c = id >> 4, ch = id & 15;
                *(u32x4*)(Ws + c * 136 + ch * 8) = pw[i];
                *(u32x4*)(Qs + c * 136 + ch * 8) = pq[i];
                *(u32x4*)((char*)KnT + SCAN_KOFF(c, ch)) = pk[i];
            }
            *(u32x4*)(QKs + (tid >> 3) * 72 + (tid & 7) * 8) = pqk;
            if (tid < 64) gcs[tid] = pgc;
#pragma unroll
            for (int mt = 0; mt < 8; ++mt)
                *(uint2*)(St + cn * 136 + mt * 16 + g4) = make_uint2(pack2(S[mt][0][0], S[mt][0][1]), pack2(S[mt][0][2], S[mt][0][3]));
            __syncthreads();
            if (m + 1 < nch) SCAN_LOAD_MAIN(m + 1)
            f32x4 ws[4][1], qs[4][1];
#pragma unroll
            for (int mt = 0; mt < 4; ++mt) { ws[mt][0] = (f32x4){0.f, 0.f, 0.f, 0.f}; qs[mt][0] = (f32x4){0.f, 0.f, 0.f, 0.f}; }
            wave_mma_u<4, 1, 4>(ws, Ws, 136, St, 136);
            wave_mma_u<4, 1, 4>(qs, Qs, 136, St, 136);
            const float glast = gcs[63];
            f32x4 vn[4];
#pragma unroll
            for (int mt = 0; mt < 4; ++mt) {
                float sc[4];
#pragma unroll
                for (int r = 0; r < 4; ++r) {
                    const int c = mt * 16 + g4 + r;
                    vn[mt][r] = pu[mt * 4 + r] - ws[mt][0][r];
                    sc[r] = vn[mt][r] * __expf(glast - gcs[c]);
                }
                *(uint2*)(VNt + cn * 72 + mt * 16 + g4) = make_uint2(pack2(vn[mt][0], vn[mt][1]), pack2(vn[mt][2], vn[mt][3]));
                *(uint2*)(VNs + cn * 72 + mt * 16 + g4) = make_uint2(pack2(sc[0], sc[1]), pack2(sc[2], sc[3]));
            }
            if (m + 1 < nch) SCAN_LOAD_U(m + 1)
            asm volatile("s_waitcnt lgkmcnt(0)" ::: "memory");
            f32x4 oo[4][1];
#pragma unroll
            for (int mt = 0; mt < 4; ++mt)
#pragma unroll
                for (int r = 0; r < 4; ++r) oo[mt][0][r] = 0.08838834764831845f * __expf(gcs[mt * 16 + g4 + r]) * qs[mt][0][r];
            wave_mma_u<4, 1, 2>(oo, QKs, 72, VNt, 72);
            {
                const int t0_ = dir ? s0 + L - 1 - (m * 64 + g4) : s0 + m * 64 + g4;
                long oo_ = ((long)t0_ * 4 + h) * 128 + wave * 16 + cn;
                asm volatile("" : "+v"(oo_));
                bf16_t* od = (dir ? p.ob : p.of) + oo_;
                if (dir) {
#pragma unroll
                    for (int mt = 0; mt < 4; ++mt)
#pragma unroll
                        for (int r = 0; r < 4; ++r) od[-(mt * 16 + r) * 512] = f2bf(oo[mt][0][r]);
                } else {
#pragma unroll
                    for (int mt = 0; mt < 4; ++mt)
#pragma unroll
                        for (int r = 0; r < 4; ++r) od[(mt * 16 + r) * 512] = f2bf(oo[mt][0][r]);
                }
            }
            const float eg = __expf(glast);
#pragma unroll
            for (int mt = 0; mt < 8; ++mt) S[mt][0] = S[mt][0] * eg;
            {
                const int q_ = (lane >> 2) & 3, pp_ = lane & 3, g_ = lane >> 4;
#pragma unroll
                for (int ks = 0; ks < 2; ++ks) {
                    const bf16x8 bfr = *(const bf16x8*)(VNs + cn * 72 + ks * 32 + g_ * 8);
                    s16x4 lo[8], hi[8];
#pragma unroll
                    for (int mt = 0; mt < 8; ++mt) {
                        const int r0 = ks * 32 + g_ * 8 + q_, chk = mt * 2 + (pp_ >> 1);
                        lo[mt] = __builtin_amdgcn_ds_read_tr16_b64_v4i16((__attribute__((address_space(3))) s16x4*)((char*)KnT + SCAN_KOFF(r0, chk) + 8 * (pp_ & 1)));
                        hi[mt] = __builtin_amdgcn_ds_read_tr16_b64_v4i16((__attribute__((address_space(3))) s16x4*)((char*)KnT + SCAN_KOFF(r0 + 4, chk) + 8 * (pp_ & 1)));
                    }
#pragma unroll
                    for (int mt = 0; mt < 8; ++mt) {
                        const bf16x8 afr = __builtin_shufflevector(lo[mt], hi[mt], 0, 1, 2, 3, 4, 5, 6, 7);
                        S[mt][0] = __builtin_amdgcn_mfma_f32_16x16x32_bf16(afr, bfr, S[mt][0], 0, 0, 0);
                    }
                }
            }
        }
#undef SCAN_LOAD_MAIN
#undef SCAN_LOAD_U
        if (seq < 16) {
            float* dp = p.out + OUT_STATE + ((((long)seq * 2 + j) * 2 + dir) * 4 + h) * 16384 + (g4 * 128 + wave * 16 + cn);
#pragma unroll
            for (int mt = 0; mt < 8; ++mt)
#pragma unroll
                for (int r = 0; r < 4; ++r) dp[(mt * 16 + r) * 128] = S[mt][0][r];
        }
    }
}

__device__ __forceinline__ void ph_fft_a(CP& p, char* smem) {
    __syncthreads();
    float* tws = (float*)(smem + GEMM_SMEM_BYTES);
    {
        const int t_ = ltid();
        f32x4 t4[4];
#pragma unroll
        for (int i = 0; i < 4; ++i) t4[i] = *(const f32x4*)(p.fftTW + (t_ + i * NTHREADS) * 4);
#pragma unroll
        for (int i = 0; i < 4; ++i) *(f32x4*)(tws + (t_ + i * NTHREADS) * 4) = t4[i];
    }
    __syncthreads();
    for (int u = lbid(); u < 1024; u += gridDim.x) {
        gemm_tile<0>(p.ZtA + ZA_OFF + (long)u * 256 * 128, 128, p.fftMA, 128, 128, (bf16_t*)smem, [&](int r, int c, f32x4 v) {
            const int gr = u * 256 + r;
            const int n2 = gr & 63, cf = (gr >> 6) & 511, b = gr >> 15;
            const int k1 = c >> 1, po = c & 1;
            f32x4 h;
#pragma unroll
            for (int i = 0; i < 4; ++i) {
                const float other = xshfl<1>(v[i]);
                const float2 tw = *(const float2*)(tws + ((n2 + i) * 64 + k1) * 2);
                h[i] = po == 0 ? (v[i] * tw.x + other * tw.y) : (v[i] * tw.x - other * tw.y);
            }
            bf16_t* dst = p.HB + (((((long)b * 64 + k1) * 512 + cf) * 2 + po) * 64 + n2);
            *(uint2*)dst = make_uint2(pack2(h[0], h[1]), pack2(h[2], h[3]));
        });
    }
}
__device__ __forceinline__ void ph_fft_b(CP& p, char* smem) {
    __syncthreads();
    const int nb = gridDim.x;
    for (int uu = lbid(); uu < 1024 + 64; uu += nb) {
        const int u = 1024 + 63 - uu;
        if (u < 0) continue;
        if (u < 1024) {
            gemm_tile<0>(p.HB + (long)u * 256 * 128, 128, p.fftMB, 128, 128, (bf16_t*)smem, [&](int r, int c, f32x4 v) {
                if (c < 64) {
                    const int gr = u * 256 + r;
                    const int cf = gr & 511, k1 = (gr >> 9) & 63, b = gr >> 15;
                    const long tok = TP_TOK + (long)b * 4096 + k1 + 64 * c;
                    *(uint2*)(p.mix + tok * DM + 512 + cf) = make_uint2(pack2(v[0], v[1]), pack2(v[2], v[3]));
                }
            });
        } else {
            const int q = u - 1024, seq = q >> 2, tm = (q >> 1) & 1, tn = q & 1;
            const int s0 = seq * 256;
            gemm_tile<0>(p.ZtA + (long)s0 * 1024 + (long)tm * 256 * 512, 512, p.dftP + (long)tn * 128 * 512, 512, 512, (bf16_t*)smem, [&](int r, int c, f32x4 v) {
                const int cf = tm * 256 + r, k = tn * 128 + c;
                *(uint2*)(p.mix + (long)(s0 + k) * DM + 512 + cf) = make_uint2(pack2(v[0], v[1]), pack2(v[2], v[3]));
            });
        }
    }
}

__device__ __forceinline__ void ph_e_mix(CP& p, int j) {
    const int lane = ltid() & 63, wave = ltid() >> 6;
    const float* onw = p.gdn_o_norm + j * 128;
    const float w0 = onw[lane * 2], w1 = onw[lane * 2 + 1];
    for (int row = lbid() * 8 + wave; row < T_TOK; row += gridDim.x * 8) {
        unsigned av[4], bv[4], gvv[4];
#pragma unroll
        for (int h = 0; h < 4; ++h) {
            av[h] = *(const unsigned*)(p.of + ((long)row * 4 + h) * 128 + lane * 2);
            bv[h] = *(const unsigned*)(p.ob + ((long)row * 4 + h) * 128 + lane * 2);
            gvv[h] = *(const unsigned*)(p.gate + (long)row * 512 + h * 128 + lane * 2);
        }
#pragma unroll
        for (int h = 0; h < 4; ++h) {
            const float o0 = bflo(av[h]) + bflo(bv[h]), o1 = bfhi(av[h]) + bfhi(bv[h]);
            const float ss = wave_sum(o0 * o0 + o1 * o1);
            const float r = rsqrtf(ss * (1.f / 128.f) + 1e-6f);
            *(unsigned*)(p.mix + (long)row * DM + h * 128 + lane * 2) = pack2(o0 * r * w0 * silu_f(bflo(gvv[h])), o1 * r * w1 * silu_f(bfhi(gvv[h])));
        }
    }
}

template <int FROM_INPUT = 0>
__device__ __forceinline__ void ph_out_gemm(CP& p, const bf16_t* A, const bf16_t* Wt, const float* mods_l, int g_off, char* smem, const float gscale = 1.f) {
    const int ntn = 4, ntm = T_TOK / 256;
#define OG_PROLOGUE(U) { int tm_, tn_; tile_map((U), ntm, ntn, tm_, tn_); g8_prologue<0>(A + (long)tm_ * 256 * DM, DM, Wt + (long)tn_ * 256 * 1024, 1024, (bf16_t*)smem); }
    int u = lbid();
    if (u < ntn * ntm) OG_PROLOGUE(u)
    for (; u < ntn * ntm; u += gridDim.x) {
        int tm, tn;
        tile_map(u, ntm, ntn, tm, tn);
        const int row0 = tm * 256, col0 = tn * 256;
        const float* gv = mods_l + (long)tok_modrow(row0) * 6144 + g_off;
        f32x4 acc[2][2][4][2];
        gemm_tile256_acc<0, 1>(A + (long)row0 * DM, DM, Wt + (long)col0 * 1024, 1024, 1024, (bf16_t*)smem, acc);
        if (u + (int)gridDim.x < ntn * ntm) OG_PROLOGUE(u + gridDim.x)
        const int tz = ltid(), wid = tz >> 6, lane = tz & 63, wr = wid >> 2, wc = wid & 3, fr = lane & 15, fq = lane >> 4;
#pragma unroll
        for (int ai = 0; ai < 2; ++ai)
#pragma unroll
            for (int bj = 0; bj < 2; ++bj) {
                const long xo = (long)(row0 + ai * 128 + wr * 64 + fq * 4) * DM + col0 + bj * 128 + wc * 32 + fr;
                float* xb = p.out + xo;
                const float* xs = FROM_INPUT ? (row0 < TP_TOK ? p.x_prompt + xo : p.x_sample + (xo - (long)TP_TOK * DM)) : xb;
                const float g0 = gv[col0 + bj * 128 + wc * 32 + fr] * gscale, g1 = gv[col0 + bj * 128 + wc * 32 + 16 + fr] * gscale;
                float xv[4][2][4];
#pragma unroll
                for (int m = 0; m < 4; ++m)
#pragma unroll
                    for (int n = 0; n < 2; ++n)
#pragma unroll
                        for (int i = 0; i < 4; ++i) xv[m][n][i] = xs[(long)(m * 16 + i) * DM + n * 16];
#pragma unroll
                for (int m = 0; m < 4; ++m)
#pragma unroll
                    for (int n = 0; n < 2; ++n)
#pragma unroll
                        for (int i = 0; i < 4; ++i) xb[(long)(m * 16 + i) * DM + n * 16] = xv[m][n][i] + (n ? g1 : g0) * acc[ai][bj][m][n][i];
            }
    }
#undef OG_PROLOGUE
}
__device__ __forceinline__ void ph_o_gemm1(CP& p, int j, char* smem) {
    const int ntn = N_OIN / 256, ntm = T_TOK / 256;
    const bf16_t* Bt = p.wtO_in + (long)j * N_OIN * 1024;
    for (int u = lbid(); u < ntn * ntm; u += gridDim.x) {
        int tm, tn;
        tile_map(u, ntm, ntn, tm, tn);
        const int row0 = tm * 256, col0 = tn * 256;
        gemm_tile256<0>(p.H + (long)row0 * DM, DM, Bt + (long)col0 * 1024, 1024, 1024, (bf16_t*)smem, [&](int r, int c, f32x4 v) {
            const int col = col0 + c;
            if (col < 832) {
#pragma unroll
                for (int i = 0; i < 4; ++i) p.Podd[(long)(row0 + r + i) * 832 + col] = v[i];
            }
        });
    }
}

__device__ __forceinline__ void ph_o_norm(CP& p, int j) {
    const int lane = ltid() & 63, wave = ltid() >> 6;
    float qw[8], kw[4];
#pragma unroll
    for (int i = 0; i < 8; ++i) qw[i] = p.mla_q_norm[j * 512 + i * 64 + lane];
#pragma unroll
    for (int i = 0; i < 4; ++i) kw[i] = p.mla_kv_norm[j * 256 + i * 64 + lane];
    for (int row = lbid() * 8 + wave; row < T_TOK + 2048; row += gridDim.x * 8) {
        if (row < T_TOK) {
            const float* pr = p.Podd + (long)row * 832;
            float q[8], k[4];
            float ssq = 0.f, ssk = 0.f;
#pragma unroll
            for (int i = 0; i < 8; ++i) { q[i] = pr[i * 64 + lane]; ssq += q[i] * q[i]; }
#pragma unroll
            for (int i = 0; i < 4; ++i) { k[i] = pr[512 + i * 64 + lane]; ssk += k[i] * k[i]; }
            const float kr = pr[768 + lane];
            ssq = wave_sum(ssq); ssk = wave_sum(ssk);
            const float rq = rsqrtf(ssq * (1.f / 512.f) + 1e-6f), rk = rsqrtf(ssk * (1.f / 256.f) + 1e-6f);
#pragma unroll
            for (int i = 0; i < 8; ++i) p.cq[(long)row * 512 + i * 64 + lane] = f2bf(q[i] * rq * qw[i]);
#pragma unroll
            for (int i = 0; i < 4; ++i) {
                const float v = k[i] * rk * kw[i];
                p.ckv_all[(long)row * 256 + i * 64 + lane] = f2bf(v);
                if (row < TP_TOK) p.out[OUT_CKV + (((long)(row >> 8) * 2 + j) * 256 + (row & 255)) * 256 + i * 64 + lane] = v;
            }
            p.kr_all[(long)row * 64 + lane] = kr;
            if (row < TP_TOK) p.out[OUT_KR + (((long)(row >> 8) * 2 + j) * 256 + (row & 255)) * 64 + lane] = kr;
        } else {
            const int rc = row - T_TOK, b = rc >> 8, t = rc & 255;
            const float* src = p.cache_ckv + (((long)b * 2 + j) * 256 + t) * 256;
#pragma unroll
            for (int i = 0; i < 4; ++i) p.ckv_all[(long)row * 256 + i * 64 + lane] = f2bf(src[i * 64 + lane]);
            p.kr_all[(long)row * 64 + lane] = p.cache_kr[(((long)b * 2 + j) * 256 + t) * 64 + lane];
        }
    }
}

#define KB_S (16L * 8 * 256 * 192)
#define VT_S (16L * 8 * 128 * 256)
__device__ __forceinline__ void ph_o_gemm2(CP& p, int j, char* smem) {
    const int nA = 6 * (T_TOK / 256);
    const int nB = 8 * ((T_TOK + 2048) / 256);
    for (int u = lbid(); u < nA + nB; u += gridDim.x) {
        if (u < nA) {
            int tm, tn;
            tile_map(u, T_TOK / 256, 6, tm, tn);
            const int row0 = tm * 256, col0 = tn * 256;
            const int s0 = tok_seq0(row0), L = tok_len(row0);
            f32x4 acc[2][2][4][2];
            gemm_tile256_acc<0>(p.cq + (long)row0 * 512, 512, p.wtUq + (long)j * 1536 * 512 + (long)col0 * 512, 512, 512, (bf16_t*)smem, acc);
            const int tz = ltid(), wid = tz >> 6, lane = tz & 63, wr = wid >> 2, wc = wid & 3, fr = lane & 15, fq = lane >> 4;
#pragma unroll
            for (int bj = 0; bj < 2; ++bj)
#pragma unroll
                for (int n = 0; n < 2; ++n) {
                    const int col = col0 + bj * 128 + wc * 32 + n * 16 + fr, h = col / 192, d = col - h * 192;
                    bf16_t* qd = p.Qb + (long)s0 * 1536 + ((long)h * L + (row0 - s0) + wr * 64 + fq * 4) * 192 + d;
#pragma unroll
                    for (int ai = 0; ai < 2; ++ai)
#pragma unroll
                        for (int m = 0; m < 4; ++m)
#pragma unroll
                            for (int i = 0; i < 4; ++i) qd[(ai * 128 + m * 16 + i) * 192] = f2bf(acc[ai][bj][m][n][i]);
                }
        } else {
            const int q = u - nA;
            int tm, tn;
            tile_map(q, (T_TOK + 2048) / 256, 8, tm, tn);
            const int row0 = tm * 256, col0 = tn * 256;
            long kbase, vbase; int Lk, pos0;
            if (row0 < TP_TOK) { const int s = row0 >> 8; kbase = (long)s * 8 * 256 * 192; vbase = (long)s * 8 * 128 * 256; Lk = 256; pos0 = 0; }
            else if (row0 < T_TOK) { const int b = (row0 - TP_TOK) >> 12; kbase = KB_S + (long)b * 8 * 4352 * 192; vbase = VT_S + (long)b * 8 * 128 * 4352; Lk = 4352; pos0 = (row0 - TP_TOK) & 4095; }
            else { const int b = (row0 - T_TOK) >> 8; kbase = KB_S + (long)b * 8 * 4352 * 192; vbase = VT_S + (long)b * 8 * 128 * 4352; Lk = 4352; pos0 = 4096; }
            f32x4 acc[2][2][4][2];
            gemm_tile256_acc<0>(p.ckv_all + (long)row0 * 256, 256, p.wtUkv + (long)j * 2048 * 256 + (long)col0 * 256, 256, 256, (bf16_t*)smem, acc);
            const int tz = ltid(), wid = tz >> 6, lane = tz & 63, wr = wid >> 2, wc = wid & 3, fr = lane & 15, fq = lane >> 4;
            const int h = tn;
            bf16_t* kd = p.Kb + kbase + ((long)h * Lk + pos0 + wr * 64 + fq * 4) * 192 + wc * 32 + fr;
#pragma unroll
            for (int ai = 0; ai < 2; ++ai)
#pragma unroll
                for (int m = 0; m < 4; ++m)
#pragma unroll
                    for (int i = 0; i < 4; ++i)
#pragma unroll
                        for (int n = 0; n < 2; ++n) kd[(ai * 128 + m * 16 + i) * 192 + n * 16] = f2bf(acc[ai][0][m][n][i]);
            bf16_t* vd = p.Vtb + vbase + ((long)h * 128 + wc * 32 + fr) * Lk;
#pragma unroll
            for (int ai = 0; ai < 2; ++ai)
#pragma unroll
                for (int m = 0; m < 4; ++m) {
                    const int kp = pos0 + ai * 128 + wr * 64 + m * 16 + fq * 4, kq = (kp & ~31) | (((kp >> 2) & 3) << 3) | (((kp >> 4) & 1) << 2);
#pragma unroll
                    for (int n = 0; n < 2; ++n) {
                        const f32x4 v = acc[ai][1][m][n];
                        *(uint2*)(vd + (long)n * 16 * Lk + kq) = make_uint2(pack2(v[0], v[1]), pack2(v[2], v[3]));
                    }
                }
        }
    }
}

__device__ __forceinline__ void ph_o_qknorm(CP& p, int j) {
    const int lane = ltid() & 63, wave = ltid() >> 6;
    const float* qnw = p.mla_q_headnorm + j * 192;
    const float* knw = p.mla_k_headnorm + j * 192;
    const float qw0 = qnw[lane], qw1 = qnw[64 + lane], qw2 = qnw[128 + lane];
    const float kw0 = knw[lane], kw1 = knw[64 + lane], kw2 = knw[128 + lane];
    const float inv = exp2f(-(float)(lane & 15) * 0.8304820237218406f);
    for (int row = lbid() * 8 + wave; row < T_TOK + 2048; row += gridDim.x * 8) {
        bool rope = false; float cs = 1.f, sn = 0.f;
        long kbase; int Lk, pos;
        if (row < TP_TOK) { const int s = row >> 8; kbase = (long)s * 8 * 256 * 192; Lk = 256; pos = row & 255; }
        else if (row < T_TOK) {
            const int b = (row - TP_TOK) >> 12; pos = (row - TP_TOK) & 4095; kbase = KB_S + (long)b * 8 * 4352 * 192; Lk = 4352; rope = true;
            const float ang = (float)((lane & 32) ? (pos & 63) : (pos >> 6)) * inv;
            sincosf(ang, &sn, &cs);
        } else { const int rc = row - T_TOK; const int b = rc >> 8; pos = 4096 + (rc & 255); kbase = KB_S + (long)b * 8 * 4352 * 192; Lk = 4352; }
        const float kr = p.kr_all[(long)row * 64 + lane];
        const bool hi = (lane & 16) != 0;
        const bool isq = row < T_TOK;
        const int s0 = isq ? tok_seq0(row) : 0, L = isq ? tok_len(row) : 1;
        bf16_t* kp0 = p.Kb + kbase + (long)pos * 192;
        bf16_t* qp0 = p.Qb + (long)s0 * 1536 + (long)(row - s0) * 192;
        float k0[8], k1[8], q0[8], q1[8], q2[8];
#pragma unroll
        for (int h = 0; h < 8; ++h) {
            const bf16_t* kp = kp0 + (long)h * Lk * 192;
            k0[h] = bf2f(kp[lane]); k1[h] = bf2f(kp[64 + lane]);
        }
        if (isq) {
#pragma unroll
            for (int h = 0; h < 8; ++h) {
                const bf16_t* qp = qp0 + (long)h * L * 192;
                q0[h] = bf2f(qp[lane]); q1[h] = bf2f(qp[64 + lane]); q2[h] = bf2f(qp[128 + lane]);
            }
        }
#pragma unroll
        for (int h = 0; h < 8; ++h) {
            bf16_t* kp = kp0 + (long)h * Lk * 192;
            const float ss = wave_sum(k0[h] * k0[h] + k1[h] * k1[h] + kr * kr);
            const float r = rsqrtf(ss * (1.f / 192.f) + 1e-6f);
            float y2 = kr * r * kw2;
            if (rope) {
                const float o = xshfl<16>(y2);
                y2 = hi ? (o * sn + y2 * cs) : (y2 * cs - o * sn);
            }
            kp[lane] = f2bf(k0[h] * r * kw0); kp[64 + lane] = f2bf(k1[h] * r * kw1); kp[128 + lane] = f2bf(y2);
        }
        if (isq) {
#pragma unroll
            for (int h = 0; h < 8; ++h) {
                bf16_t* qp = qp0 + (long)h * L * 192;
                const float ss = wave_sum(q0[h] * q0[h] + q1[h] * q1[h] + q2[h] * q2[h]);
                const float r = rsqrtf(ss * (1.f / 192.f) + 1e-6f) * 0.10411755f;
                float y2 = q2[h] * r * qw2;
                if (rope) {
                    const float o = xshfl<16>(y2);
                    y2 = hi ? (o * sn + y2 * cs) : (y2 * cs - o * sn);
                }
                qp[lane] = f2bf(q0[h] * r * qw0); qp[64 + lane] = f2bf(q1[h] * r * qw1); qp[128 + lane] = f2bf(y2);
            }
        }
    }
}

#define ATT_KLD 208
#define ATT_VLD 80
#define ATTN_SMEM_BYTES (2 * 64 * ATT_KLD * 2 + 3 * 128 * ATT_VLD * 2)
__device__ __forceinline__ void ph_o_attn(CP& p, char* smem) {
    for (int u = lbid(); u < 1152; u += gridDim.x) {
        int lz = 0, tid = ltid();
        asm volatile("" : "+s"(lz), "+v"(tid));
        const int lane = tid & 63, wave = tid >> 6;
        const int g = lane >> 4, cn = lane & 15, kg = g * 8;
        bf16_t* Ks = (bf16_t*)(smem + lz);
        bf16_t* Vs = Ks + 2 * 64 * ATT_KLD;
        int s0, L, Lk, h, q0; long kbase, vbase;
        if (u < 1024) { const int b = u >> 7; h = (u >> 4) & 7; q0 = (u & 15) * 256; s0 = TP_TOK + b * 4096; L = 4096; Lk = 4352; kbase = KB_S + (long)b * 8 * 4352 * 192; vbase = VT_S + (long)b * 8 * 128 * 4352; }
        else { const int q = u - 1024; const int s = q >> 3; h = q & 7; q0 = 0; s0 = s * 256; L = 256; Lk = 256; kbase = (long)s * 8 * 256 * 192; vbase = (long)s * 8 * 128 * 256; }
        const bf16_t* Qp = p.Qb + (long)s0 * 1536 + ((long)h * L + q0 + wave * 32) * 192;
        const bf16_t* Kp = p.Kb + kbase + (long)h * Lk * 192;
        const bf16_t* Vp = p.Vtb + vbase + (long)h * 128 * Lk;
        bf16x8 qb[2][6];
#pragma unroll
        for (int mt = 0; mt < 2; ++mt)
#pragma unroll
            for (int ks = 0; ks < 6; ++ks) qb[mt][ks] = *(const bf16x8*)(Qp + (mt * 16 + cn) * 192 + ks * 32 + kg);
        f32x4 o[8][2];
        f32x4 negm[2];
        float lrow[2];
#pragma unroll
        for (int mt = 0; mt < 2; ++mt) {
#pragma unroll
            for (int dt = 0; dt < 8; ++dt) o[dt][mt] = (f32x4){0.f, 0.f, 0.f, 0.f};
            negm[mt] = (f32x4){0.f, 0.f, 0.f, 0.f}; lrow[mt] = 0.f;
        }
        const int nkt = Lk / 64;
        u32x4 rk[3], rv[2];
        f32x4 s[4][2];
        bf16x8 pb[2][2];
        bf16x8 fa[2][4];
#define ATT_SB() __builtin_amdgcn_sched_barrier(0)
#define ATT_LDK(dst_, Kc_, ks_) _Pragma("unroll") for (int nt = 0; nt < 4; ++nt) dst_[nt] = *(const bf16x8*)((Kc_) + (nt * 16 + cn) * ATT_KLD + (ks_) * 32 + kg)
#define ATT_LDV(dst_, Vc_, b_) _Pragma("unroll") for (int d4 = 0; d4 < 4; ++d4) dst_[d4] = *(const bf16x8*)((Vc_) + ((((b_) & 1) * 4 + d4) * 16 + cn) * ATT_VLD + ((b_) >> 1) * 32 + kg)
        float pv[2][4][4];
#define ATT_LDK2(dst_, Kc_, h_, ks_) _Pragma("unroll") for (int n_ = 0; n_ < 2; ++n_) dst_[n_] = *(const bf16x8*)((Kc_) + ((2 * (h_) + n_) * 16 + cn) * ATT_KLD + (ks_) * 32 + kg)
#define ATT_PACK(mt_, k2_)                                                                                             \
        {                                                                                                              \
            u32x4 w_;                                                                                                  \
            w_[0] = pack2(pv[mt_][2 * (k2_)][0], pv[mt_][2 * (k2_)][1]); w_[1] = pack2(pv[mt_][2 * (k2_)][2], pv[mt_][2 * (k2_)][3]);   \
            w_[2] = pack2(pv[mt_][2 * (k2_) + 1][0], pv[mt_][2 * (k2_) + 1][1]); w_[3] = pack2(pv[mt_][2 * (k2_) + 1][2], pv[mt_][2 * (k2_) + 1][3]);   \
            pb[mt_][k2_] = __builtin_bit_cast(bf16x8, w_);                                                             \
        }
#define ATT_QK(Kc_, Vc_)                                                                                               \
        {                                                                                                              \
            ATT_LDK2(fa[0], Kc_, 0, 0);                                                                                \
            _Pragma("unroll") for (int t_ = 0; t_ < 12; ++t_) {                                                      \
                const int h_ = t_ / 6, ks = t_ % 6;                                                                    \
                if (t_ < 11) { ATT_LDK2(fa[(t_ + 1) & 1], Kc_, (t_ + 1) / 6, (t_ + 1) % 6); } else { ATT_LDV(fa[0], Vc_, 0); }   \
                ATT_SB();                                                                                              \
                _Pragma("unroll") for (int n_ = 0; n_ < 2; ++n_)                                                     \
                    _Pragma("unroll") for (int mt = 0; mt < 2; ++mt)                                                 \
                        s[2 * h_ + n_][mt] = __builtin_amdgcn_mfma_f32_16x16x32_bf16(fa[t_ & 1][n_], qb[mt][ks], ks == 0 ? negm[mt] : s[2 * h_ + n_][mt], 0, 0, 0);   \
                if (h_ == 1 && ks < 4) {                                                                               \
                    _Pragma("unroll") for (int r = 0; r < 4; ++r) pv[ks >> 1][ks & 1][r] = __builtin_amdgcn_exp2f(s[ks & 1][ks >> 1][r]);   \
                }                                                                                                      \
                if (h_ == 1 && ks >= 4) ATT_PACK(ks - 4, 0)                                                            \
                if (t_ < 11) ATT_SB();                                                                                 \
            }                                                                                                          \
        }
#define ATT_PBIG 4096.f
#define ATT_SOFTMAX(first_)                                                                                            \
        {                                                                                                              \
            float ps[2];                                                                                               \
            _Pragma("unroll") for (int mt = 0; mt < 2; ++mt) {                                                       \
                _Pragma("unroll") for (int nt = 2; nt < 4; ++nt)                                                     \
                    _Pragma("unroll") for (int r = 0; r < 4; ++r) pv[mt][nt][r] = __builtin_amdgcn_exp2f(s[nt][mt][r]);   \
                ps[mt] = 0.f;                                                                                          \
                _Pragma("unroll") for (int nt = 0; nt < 4; ++nt)                                                     \
                    _Pragma("unroll") for (int r = 0; r < 4; ++r) ps[mt] += pv[mt][nt][r];                           \
            }                                                                                                          \
            const bool ok = !(first_) && ps[0] <= ATT_PBIG && ps[1] <= ATT_PBIG;                                       \
            if (!__all(ok)) {                                                                                          \
                _Pragma("unroll") for (int mt = 0; mt < 2; ++mt) {                                                   \
                    float mx = fmaxf(fmaxf(s[0][mt][0], s[0][mt][1]), fmaxf(s[0][mt][2], s[0][mt][3]));               \
                    _Pragma("unroll") for (int nt = 1; nt < 4; ++nt) mx = fmaxf(mx, fmaxf(fmaxf(s[nt][mt][0], s[nt][mt][1]), fmaxf(s[nt][mt][2], s[nt][mt][3])));   \
                    mx = fmaxf(mx, xshfl<16>(mx));                                                                     \
                    mx = fmaxf(mx, xshfl<32>(mx));                                                                     \
                    const float dl = (first_) ? mx : fmaxf(mx, 0.f);                                                   \
                    const float al = (first_) ? 1.f : __builtin_amdgcn_exp2f(-dl);                                     \
                    negm[mt] = negm[mt] - dl;                                                                          \
                    lrow[mt] *= al;                                                                                    \
                    _Pragma("unroll") for (int dt = 0; dt < 8; ++dt) o[dt][mt] = o[dt][mt] * al;                     \
                    ps[mt] = 0.f;                                                                                      \
                    _Pragma("unroll") for (int nt = 0; nt < 4; ++nt)                                                 \
                        _Pragma("unroll") for (int r = 0; r < 4; ++r) { pv[mt][nt][r] = __builtin_amdgcn_exp2f(s[nt][mt][r] - dl); ps[mt] += pv[mt][nt][r]; }   \
                    ATT_PACK(mt, 0)                                                                                    \
                }                                                                                                      \
            }                                                                                                          \
            _Pragma("unroll") for (int mt = 0; mt < 2; ++mt) {                                                       \
                lrow[mt] += ps[mt];                                                                                    \
                ATT_PACK(mt, 1)                                                                                        \
            }                                                                                                          \
        }
#define ATT_PV(Vc_)                                                                                                    \
        {                                                                                                              \
            _Pragma("unroll") for (int b = 0; b < 4; ++b) {                                                          \
                if (b < 3) { ATT_LDV(fa[(b + 1) & 1], Vc_, b + 1); }                                                   \
                ATT_SB();                                                                                              \
                _Pragma("unroll") for (int d4 = 0; d4 < 4; ++d4)                                                     \
                    _Pragma("unroll") for (int mt = 0; mt < 2; ++mt) o[(b & 1) * 4 + d4][mt] = __builtin_amdgcn_mfma_f32_16x16x32_bf16(fa[b & 1][d4], pb[mt][b >> 1], o[(b & 1) * 4 + d4][mt], 0, 0, 0);   \
                ATT_SB();                                                                                              \
            }                                                                                                          \
        }
        __syncthreads();
#pragma unroll
        for (int i = 0; i < 3; ++i) { const int ch = tid + i * 512, row = ch / 24, kc = ch % 24; rk[i] = *(const u32x4*)(Kp + (long)row * 192 + kc * 8); }
#pragma unroll
        for (int i = 0; i < 2; ++i) { const int ch = tid + i * 512, row = ch >> 3, kc = ch & 7; rv[i] = *(const u32x4*)(Vp + (long)row * Lk + kc * 8); }
#pragma unroll
        for (int i = 0; i < 3; ++i) { const int ch = tid + i * 512, row = ch / 24, kc = ch % 24; *(u32x4*)(Ks + row * ATT_KLD + kc * 8) = rk[i]; }
#pragma unroll
        for (int i = 0; i < 2; ++i) { const int ch = tid + i * 512, row = ch >> 3, kc = ch & 7; *(u32x4*)(Vs + row * ATT_VLD + kc * 8) = rv[i]; }
        __syncthreads();
        for (int it = 0; it < nkt; ++it) {
            const int cur = it & 1;
            const bool more = it + 1 < nkt;
            const long key0 = (long)(it + 1) * 64;
            if (more) {
#pragma unroll
                for (int i = 0; i < 3; ++i) { const int ch = tid + i * 512, row = ch / 24, kc = ch % 24; rk[i] = *(const u32x4*)(Kp + (key0 + row) * 192 + kc * 8); }
#pragma unroll
                for (int i = 0; i < 2; ++i) { const int ch = tid + i * 512, row = ch >> 3, kc = ch & 7; rv[i] = *(const u32x4*)(Vp + (long)row * Lk + key0 + kc * 8); }
            }
            const bf16_t* Kc = Ks + cur * 64 * ATT_KLD;
            ATT_QK(Kc, Vs + cur * 128 * ATT_VLD) ATT_SOFTMAX(it == 0) ATT_PV(Vs + cur * 128 * ATT_VLD)
            if (more) {
                bf16_t* Kn = Ks + (cur ^ 1) * 64 * ATT_KLD;
                bf16_t* Vn = Vs + (cur ^ 1) * 128 * ATT_VLD;
#pragma unroll
                for (int i = 0; i < 3; ++i) { const int ch = tid + i * 512, row = ch / 24, kc = ch % 24; *(u32x4*)(Kn + row * ATT_KLD + kc * 8) = rk[i]; }
#pragma unroll
                for (int i = 0; i < 2; ++i) { const int ch = tid + i * 512, row = ch >> 3, kc = ch & 7; *(u32x4*)(Vn + row * ATT_VLD + kc * 8) = rv[i]; }
            }
            __syncthreads();
        }
#undef ATT_QK
#undef ATT_SB
#undef ATT_LDK
#undef ATT_LDV
#undef ATT_SOFTMAX
#undef ATT_LDK2
#undef ATT_PACK
#undef ATT_PBIG
#undef ATT_PV
#pragma unroll
        for (int mt = 0; mt < 2; ++mt) {
            float l = lrow[mt];
            l += xshfl<16>(l); l += xshfl<32>(l);
            const float il = __builtin_amdgcn_rcpf(l);
            bf16_t* op = p.Ob + (long)(s0 + q0 + wave * 32 + mt * 16 + cn) * DM + h * 128 + 4 * g;
#pragma unroll
            for (int dt = 0; dt < 8; ++dt)
                *(uint2*)(op + dt * 16) = make_uint2(pack2(o[dt][mt][0] * il, o[dt][mt][1] * il), pack2(o[dt][mt][2] * il, o[dt][mt][3] * il));
        }
    }
}
__device__ __forceinline__ unsigned f2ord(float f) { const unsigned u = __float_as_uint(f); return u ^ ((u >> 31) ? 0xFFFFFFFFu : 0x80000000u); }
__device__ __forceinline__ float ord2f(unsigned o) { const unsigned u = (o >> 31) ? (o ^ 0x80000000u) : ~o; return __uint_as_float(u); }

#define KCE(a, b) { const unsigned hi_ = max(a, b), lo_ = min(a, b); a = hi_; b = lo_; }
__device__ __forceinline__ void sort16_desc(unsigned (&v)[16]) {
#define S2(a, b) KCE(v[a], v[b])
    S2(0, 13) S2(1, 12) S2(2, 15) S2(3, 14) S2(4, 8) S2(5, 6) S2(7, 11) S2(9, 10)
    S2(0, 5) S2(1, 7) S2(2, 9) S2(3, 4) S2(6, 13) S2(8, 14) S2(10, 15) S2(11, 12)
    S2(0, 1) S2(2, 3) S2(4, 5) S2(6, 8) S2(7, 9) S2(10, 11) S2(12, 13) S2(14, 15)
    S2(0, 2) S2(1, 3) S2(4, 10) S2(5, 11) S2(6, 7) S2(8, 9) S2(12, 14) S2(13, 15)
    S2(1, 2) S2(3, 12) S2(4, 6) S2(5, 7) S2(8, 10) S2(9, 11) S2(13, 14)
    S2(1, 4) S2(2, 6) S2(5, 8) S2(7, 10) S2(9, 13) S2(11, 14)
    S2(2, 4) S2(3, 6) S2(9, 12) S2(11, 13)
    S2(3, 5) S2(6, 8) S2(7, 9) S2(10, 12)
    S2(3, 4) S2(5, 6) S2(7, 8) S2(9, 10) S2(11, 12)
    S2(6, 7) S2(8, 9)
#undef S2
}
#define KCF(a, b) { const float hi_ = __builtin_fmaxf(a, b), lo_ = __builtin_fminf(a, b); a = hi_; b = lo_; }
__device__ __forceinline__ void sort16f_desc(float (&v)[16]) {
#define S2(a, b) KCF(v[a], v[b])
    S2(0, 13) S2(1, 12) S2(2, 15) S2(3, 14) S2(4, 8) S2(5, 6) S2(7, 11) S2(9, 10)
    S2(0, 5) S2(1, 7) S2(2, 9) S2(3, 4) S2(6, 13) S2(8, 14) S2(10, 15) S2(11, 12)
    S2(0, 1) S2(2, 3) S2(4, 5) S2(6, 8) S2(7, 9) S2(10, 11) S2(12, 13) S2(14, 15)
    S2(0, 2) S2(1, 3) S2(4, 10) S2(5, 11) S2(6, 7) S2(8, 9) S2(12, 14) S2(13, 15)
    S2(1, 2) S2(3, 12) S2(4, 6) S2(5, 7) S2(8, 10) S2(9, 11) S2(13, 14)
    S2(1, 4) S2(2, 6) S2(5, 8) S2(7, 10) S2(9, 13) S2(11, 14)
    S2(2, 4) S2(3, 6) S2(9, 12) S2(11, 13)
    S2(3, 5) S2(6, 8) S2(7, 9) S2(10, 12)
    S2(3, 4) S2(5, 6) S2(7, 8) S2(9, 10) S2(11, 12)
    S2(6, 7) S2(8, 9)
#undef S2
}
__device__ __forceinline__ void merge16f_desc(float (&a)[16], const float (&b)[16]) {
#pragma unroll
    for (int i = 0; i < 16; ++i) a[i] = __builtin_fmaxf(a[i], b[15 - i]);
#pragma unroll
    for (int j = 8; j > 0; j >>= 1)
#pragma unroll
        for (int i = 0; i < 16; ++i) {
            const int l = i ^ j;
            if (l > i) { KCF(a[i], a[l]) }
        }
}
__device__ __forceinline__ void merge16_desc(unsigned (&a)[16], const unsigned (&b)[16]) {
#pragma unroll
    for (int i = 0; i < 16; ++i) a[i] = max(a[i], b[15 - i]);
#pragma unroll
    for (int j = 8; j > 0; j >>= 1)
#pragma unroll
        for (int i = 0; i < 16; ++i) {
            const int l = i ^ j;
            if (l > i) { KCE(a[i], a[l]) }
        }
}

#define RT_QLD 144
#define RT_SLD 130
#define ROUTE_SMEM_BYTES (256 * RT_SLD * 4 + 256 * 32)
__device__ __forceinline__ void ph_p_route(CP& p, int l, char* smem) {
    const int ntm = T_TOK / 256;
    const bf16_t* Bt = p.wtPq + (long)l * 2048 * 1024;
    for (int u = lbid(); u < 8 * ntm; u += gridDim.x) {
        int tm, h;
        tile_map(u, ntm, 8, tm, h);
        const int row0 = tm * 256;
        bf16_t* Qs = (bf16_t*)smem;
        bf16_t* SK = (bf16_t*)(smem + 65536);
        float* sc = (float*)smem;
        unsigned char* ib = (unsigned char*)smem + 256 * RT_SLD * 4;
        __syncthreads();
        f32x4 acc[2][2][4][2];
        gemm_tile256_acc<0>(p.H + (long)row0 * DM, DM, Bt + (long)h * 256 * 1024, 1024, 1024, (bf16_t*)smem, acc);
        const int tid = ltid(), lane = tid & 63, wave = tid >> 6;
        const int g4 = (lane >> 4) * 4, cn = lane & 15, kg = (lane >> 4) * 8;
        const int wr = wave >> 2, wc = wave & 3, fr = cn, fq = lane >> 4;
        const int trow = tid >> 1, half = tid & 1;
        float top[2][16];
#pragma unroll
        for (int pp = 0; pp < 2; ++pp) {
            __syncthreads();
#pragma unroll
            for (int ai = 0; ai < 2; ++ai)
#pragma unroll
                for (int m = 0; m < 4; ++m)
#pragma unroll
                    for (int n = 0; n < 2; ++n) {
                        const f32x4 v = acc[ai][pp][m][n];
                        *(uint2*)((char*)Qs + ai * 32768 + SCAN_KOFF(wc * 32 + n * 16 + fr, wr * 8 + m * 2 + (fq >> 1)) + (fq & 1) * 8) = make_uint2(pack2(v[0], v[1]), pack2(v[2], v[3]));
                    }
            {
                const bf16_t* skg = p.subk + ((long)l * 16 + h * 2 + pp) * 128 * 128;
                u32x4 kv[4];
#pragma unroll
                for (int i = 0; i < 4; ++i) kv[i] = *(const u32x4*)(skg + (tid + i * NTHREADS) * 8);
#pragma unroll
                for (int i = 0; i < 4; ++i) { const int ch = tid + i * NTHREADS; *(u32x4*)(SK + (ch >> 4) * RT_QLD + (ch & 15) * 8) = kv[i]; }
            }
            __syncthreads();
            f32x4 sacc[2][8];
#pragma unroll
            for (int mt = 0; mt < 2; ++mt)
#pragma unroll
                for (int nt = 0; nt < 8; ++nt) sacc[mt][nt] = (f32x4){0.f, 0.f, 0.f, 0.f};
            {
                const int q_ = (lane >> 2) & 3, pp_ = lane & 3;
                const char* qi = (const char*)Qs + (wave >> 2) * 32768;
#pragma unroll
                for (int ks = 0; ks < 4; ++ks) {
                    bf16x8 bfr[8];
#pragma unroll
                    for (int nt = 0; nt < 8; ++nt) bfr[nt] = *(const bf16x8*)(SK + (nt * 16 + cn) * RT_QLD + ks * 32 + kg);
#pragma unroll
                    for (int mt = 0; mt < 2; ++mt) {
                        const int d0 = ks * 32 + fq * 8 + q_, chk = (wave & 3) * 4 + mt * 2 + (pp_ >> 1);
                        const s16x4 lo = __builtin_amdgcn_ds_read_tr16_b64_v4i16((__attribute__((address_space(3))) s16x4*)(qi + SCAN_KOFF(d0, chk) + 8 * (pp_ & 1)));
                        const s16x4 hi = __builtin_amdgcn_ds_read_tr16_b64_v4i16((__attribute__((address_space(3))) s16x4*)(qi + SCAN_KOFF(d0 + 4, chk) + 8 * (pp_ & 1)));
                        const bf16x8 afr = __builtin_shufflevector(lo, hi, 0, 1, 2, 3, 4, 5, 6, 7);
#pragma unroll
                        for (int nt = 0; nt < 8; ++nt) sacc[mt][nt] = __builtin_amdgcn_mfma_f32_16x16x32_bf16(afr, bfr[nt], sacc[mt][nt], 0, 0, 0);
                    }
                }
            }
            __syncthreads();
#pragma unroll
            for (int mt = 0; mt < 2; ++mt)
#pragma unroll
                for (int nt = 0; nt < 8; ++nt)
#pragma unroll
                    for (int r = 0; r < 4; ++r) sc[(wave * 32 + mt * 16 + g4 + r) * RT_SLD + nt * 16 + cn] = sacc[mt][nt][r];
            __syncthreads();
            const float* srow = sc + trow * RT_SLD + half;
#pragma unroll
            for (int grp = 0; grp < 4; ++grp) {
                float v[16];
#pragma unroll
                for (int i = 0; i < 16; ++i) {
                    const int k = grp * 16 + i;
                    v[i] = __uint_as_float((__float_as_uint(srow[2 * k]) & 0xFFFFFF00u) | (unsigned)(2 * k));
                }
                sort16f_desc(v);
                if (grp == 0) {
#pragma unroll
                    for (int i = 0; i < 16; ++i) top[pp][i] = v[i];
                } else merge16f_desc(top[pp], v);
            }
            float oth[16];
#pragma unroll
            for (int i = 0; i < 16; ++i) top[pp][i] = __uint_as_float(__float_as_uint(top[pp][i]) | (unsigned)half);
#pragma unroll
            for (int i = 0; i < 16; ++i) oth[i] = xshfl<1>(top[pp][i]);
            merge16f_desc(top[pp], oth);
        }
        if (half == 0) {
            float s0[16], s1[16];
            unsigned iw[8];
#pragma unroll
            for (int i = 0; i < 8; ++i) iw[i] = 0u;
#pragma unroll
            for (int i = 0; i < 16; ++i) {
                s0[i] = __uint_as_float((__float_as_uint(top[0][i]) & 0xFFFFFF00u) | 0x80u);
                s1[i] = __uint_as_float((__float_as_uint(top[1][i]) & 0xFFFFFF00u) | 0x80u);
                iw[i >> 2] |= (__float_as_uint(top[0][i]) & 0xFFu) << ((i & 3) * 8);
                iw[4 + (i >> 2)] |= (__float_as_uint(top[1][i]) & 0xFFu) << ((i & 3) * 8);
            }
            unsigned* ibw = (unsigned*)(ib + trow * 32);
#pragma unroll
            for (int i = 0; i < 8; ++i) ibw[i] = iw[i];
            float ct[16];
            {
                float cg[4][16];
#pragma unroll
                for (int g_ = 0; g_ < 4; ++g_)
#pragma unroll
                    for (int i = 0; i < 16; ++i) cg[g_][i] = -3.0e38f;
                int cnt = 0;
#pragma unroll
                for (int a2 = 0; a2 < 16; ++a2)
#pragma unroll
                    for (int b2 = 0; b2 < 16; ++b2)
                        if ((a2 + 1) * (b2 + 1) <= 16) {
                            cg[cnt >> 4][cnt & 15] = __uint_as_float((__float_as_uint(s0[a2] + s1[b2]) & 0xFFFFFF00u) | (unsigned)(255 - (a2 * 16 + b2)));
                            ++cnt;
                        }
                if (s0[0] + s1[15] < 0.f) sort16f_desc(cg[0]);
                sort16f_desc(cg[1]); sort16f_desc(cg[2]);
                KCF(cg[3][0], cg[3][1])
#pragma unroll
                for (int i = 0; i < 16; ++i) ct[i] = cg[0][i];
                merge16f_desc(ct, cg[1]); merge16f_desc(ct, cg[2]); merge16f_desc(ct, cg[3]);
            }
            float cv[16];
#pragma unroll
            for (int i = 0; i < 16; ++i) cv[i] = __uint_as_float((__float_as_uint(ct[i]) & 0xFFFFFF00u) | 0x80u);
            const float mx = cv[0];
            float sum = 0.f;
#pragma unroll
            for (int i = 0; i < 16; ++i) { cv[i] = __expf(cv[i] - mx); sum += cv[i]; }
            const float inv = 1.f / sum;
            const long ob = ((long)(row0 + trow) * 8 + h) * 16;
            asm volatile("s_waitcnt lgkmcnt(0)" ::: "memory");
            const unsigned char* ibr = ib + trow * 32;
#pragma unroll
            for (int i = 0; i < 16; ++i) {
                const int fl = 255 - (int)(__float_as_uint(ct[i]) & 255u), a2 = fl >> 4, b2 = fl & 15;
                p.eidx[ob + i] = (int)ibr[a2] * 128 + (int)ibr[16 + b2];
                p.pgate[ob + i] = cv[i] * inv;
            }
        }
    }
}

#define PE_T 2
#define PE_LOADU(RA, BB, T_)                                                                                       \
    _Pragma("unroll") for (int k_ = 0; k_ < 8; ++k_) {                                                           \
        const int kk_ = (BB) * 8 + k_;                                                                           \
        const int e_ = __builtin_amdgcn_readlane((BB) < 8 ? e0[T_] : e1[T_], kk_ & 63);                          \
        RA[k_] = *(const u32x4*)(tabu + (long)e_ * 1024);                                                        \
    }
#define PE_LOADV(RA, BB, T_)                                                                                       \
    _Pragma("unroll") for (int k_ = 0; k_ < 8; ++k_) {                                                           \
        const int kk_ = (BB) * 8 + k_;                                                                           \
        const int e_ = __builtin_amdgcn_readlane((BB) < 8 ? e0[T_] : e1[T_], kk_ & 63);                          \
        RA[k_] = *(const u32x4*)(tabv + (long)e_ * 1024);                                                        \
    }
#define PE_X1(v_) __builtin_amdgcn_mov_dpp((int)(v_), 0xB1, 0xF, 0xF, true)
#define PE_X2(v_) __builtin_amdgcn_mov_dpp((int)(v_), 0x4E, 0xF, 0xF, true)
#define PE_X4(v_) __builtin_amdgcn_update_dpp(__builtin_amdgcn_update_dpp(0, (int)(v_), 0x104, 0xF, 0x5, false), (int)(v_), 0x114, 0xF, 0xA, false)
#define PE_X8(v_) __builtin_amdgcn_mov_dpp((int)(v_), 0x128, 0xF, 0xF, true)
#define PE_BREV(k_) ((((k_) & 1) << 2) | ((k_) & 2) | (((k_) >> 2) & 1))
#define PE_DOT(UA, BB, T_)                                                                                         \
    {                                                                                                              \
        int d_[8];                                                                                                 \
        _Pragma("unroll") for (int k_ = 0; k_ < 8; ++k_) {                                                       \
            int a_ = __builtin_amdgcn_sdot4((int)UA[k_][0], qx[T_][0], 0, false);                                \
            a_ = __builtin_amdgcn_sdot4((int)UA[k_][1], qx[T_][1], a_, false);                                   \
            a_ = __builtin_amdgcn_sdot4((int)UA[k_][2], qx[T_][2], a_, false);                                   \
            d_[k_] = __builtin_amdgcn_sdot4((int)UA[k_][3], qx[T_][3], a_, false);                               \
        }                                                                                                          \
               \
        int t4_[4], t2_[2], t1_;                                                                                   \
        _Pragma("unroll") for (int i_ = 0; i_ < 4; ++i_) { const int snd_ = b2 ? d_[i_] : d_[i_ + 4]; const int kp_ = b2 ? d_[i_ + 4] : d_[i_]; t4_[i_] = kp_ + PE_X4(snd_); } \
        _Pragma("unroll") for (int i_ = 0; i_ < 2; ++i_) { const int snd_ = b1 ? t4_[i_] : t4_[i_ + 2]; const int kp_ = b1 ? t4_[i_ + 2] : t4_[i_]; t2_[i_] = kp_ + PE_X2(snd_); } \
        { const int snd_ = b0 ? t2_[0] : t2_[1]; const int kp_ = b0 ? t2_[1] : t2_[0]; t1_ = kp_ + PE_X1(snd_); }  \
        t1_ += PE_X8(t1_);                                                                                         \
        t1_ += xshfl_i<16>(t1_);                                                                                       \
        t1_ += xshfl_i<32>(t1_);                                                                                       \
                                         \
        const bool mine_ = (lane >> 3) == ((BB) & 7);                                                              \
        hlo[T_] = (mine_ && (BB) < 8) ? t1_ : hlo[T_];                                                             \
        hhi[T_] = (mine_ && (BB) >= 8) ? t1_ : hhi[T_];                                                            \
    }
#define PE_AXPY(VA, BB, T_)                                                                                        \
    {                                                                                                              \
        const unsigned psel_ = (BB) < 8 ? pklo[T_] : pkhi[T_];                                                     \
        _Pragma("unroll") for (int h_ = 0; h_ < 2; ++h_) {                                                       \
            const int wp_ = __builtin_amdgcn_readlane((int)psel_, ((BB) & 7) * 8 + h_ * 4);                        \
            _Pragma("unroll") for (int i_ = 0; i_ < 4; ++i_) {                                                   \
                const unsigned a_ = VA[h_ * 4][i_], b_ = VA[h_ * 4 + 1][i_], c_ = VA[h_ * 4 + 2][i_], d_ = VA[h_ * 4 + 3][i_];   \
                const unsigned t0_ = __builtin_amdgcn_perm(b_, a_, 0x05010400u), t1_ = __builtin_amdgcn_perm(b_, a_, 0x07030602u);   \
                const unsigned t2_ = __builtin_amdgcn_perm(d_, c_, 0x05010400u), t3_ = __builtin_amdgcn_perm(d_, c_, 0x07030602u);   \
                acc[T_][i_ * 4 + 0] = __builtin_amdgcn_sdot4((int)__builtin_amdgcn_perm(t2_, t0_, 0x05040100u), wp_, acc[T_][i_ * 4 + 0], false);   \
                acc[T_][i_ * 4 + 1] = __builtin_amdgcn_sdot4((int)__builtin_amdgcn_perm(t2_, t0_, 0x07060302u), wp_, acc[T_][i_ * 4 + 1], false);   \
                acc[T_][i_ * 4 + 2] = __builtin_amdgcn_sdot4((int)__builtin_amdgcn_perm(t3_, t1_, 0x05040100u), wp_, acc[T_][i_ * 4 + 2], false);   \
                acc[T_][i_ * 4 + 3] = __builtin_amdgcn_sdot4((int)__builtin_amdgcn_perm(t3_, t1_, 0x07060302u), wp_, acc[T_][i_ * 4 + 3], false);   \
            }                                                                                                      \
        }                                                                                                          \
    }
template <int NEXT = 0>
__device__ __forceinline__ void ph_p_eval(CP& p, const float* mods_l, int l, const float* w_next, const float* mods_next, const float gscale = 1.f) {
    const int lane = ltid() & 63, wave = ltid() >> 6;
    const bool b0 = (lane & 1) != 0, b1 = (lane & 2) != 0, b2 = (lane & 4) != 0;
    const int rstride = gridDim.x * 8;
    const int first = lbid() * 8 + wave;
    const int ntok = (T_TOK - first + rstride - 1) / rstride;
    const int nsweep = __builtin_amdgcn_readfirstlane((T_TOK - lbid() * 8 + rstride - 1) / rstride + PE_T - 1) / PE_T;
    const unsigned char* tabu = p.tabU + (long)(l & 1) * 16384 * 2048 + lane * 16;
    const unsigned char* tabv = tabu + 16384L * 1024;
    const float* su_ = p.su + (l & 1) * 32768; const float* sv_ = su_ + 16384;
    u32x4 hpa[PE_T], hpb[PE_T]; unsigned kp0[PE_T], kp1[PE_T];
#define PE_PREFETCH(SW)                                                                                            \
    _Pragma("unroll") for (int t = 0; t < PE_T; ++t) {                                                           \
        const int ti_ = (SW) * PE_T + t;                                                                           \
        const long row_ = first + (ti_ < ntok ? ti_ : 0) * rstride;                                                \
        hpa[t] = *(const u32x4*)(p.H + row_ * DM + lane * 16); hpb[t] = *(const u32x4*)(p.H + row_ * DM + lane * 16 + 8);   \
        kp0[t] = (unsigned)p.eidx[row_ * 128 + lane]; kp1[t] = (unsigned)p.eidx[row_ * 128 + 64 + lane];          \
    }
    int e0[PE_T], e1[PE_T];
    float sgu0[PE_T], sgu1[PE_T], sgv0[PE_T], sgv1[PE_T];
    u32x4 rA[8], rB[8];
#define PE_SORT(SW)                                                                                                \
    _Pragma("unroll") for (int t = 0; t < PE_T; ++t) {                                                           \
        const int ti_ = (SW) * PE_T + t;                                                                           \
        const long row_ = first + (ti_ < ntok ? ti_ : 0) * rstride;                                                \
          \
        unsigned k0 = (kp0[t] << 7) | (unsigned)lane;                                                              \
        unsigned k1 = (kp1[t] << 7) | (unsigned)(64 + lane);                                                       \
        _Pragma("unroll") for (int size = 2; size <= 128; size <<= 1) {                                          \
            _Pragma("unroll") for (int stride = size >> 1; stride > 0; stride >>= 1) {                           \
                if (stride == 64) {                                                                                \
                    const unsigned lo = min(k0, k1), hi = max(k0, k1);                                             \
                    k0 = lo; k1 = hi;                                                                              \
                } else {                                                                                           \
                    unsigned o0, o1;                                                                               \
                    if (stride == 1) { o0 = (unsigned)PE_X1(k0); o1 = (unsigned)PE_X1(k1); }                       \
                    else if (stride == 2) { o0 = (unsigned)PE_X2(k0); o1 = (unsigned)PE_X2(k1); }                  \
                    else if (stride == 4) { o0 = (unsigned)PE_X4(k0); o1 = (unsigned)PE_X4(k1); }                  \
                    else if (stride == 8) { o0 = (unsigned)PE_X8(k0); o1 = (unsigned)PE_X8(k1); }                  \
                    else if (stride == 16) { o0 = (unsigned)xshfl_i<16>((int)k0); o1 = (unsigned)xshfl_i<16>((int)k1); }   \
                    else { o0 = (unsigned)xshfl_i<32>((int)k0); o1 = (unsigned)xshfl_i<32>((int)k1); }             \
                    const bool lower = (lane & stride) == 0;                                                       \
                    const bool asc0 = size == 128 ? true : ((lane & size) == 0);                                   \
                    const bool asc1 = size == 128 ? true : (((lane + 64) & size) == 0);                            \
                    k0 = (lower == asc0) ? min(k0, o0) : max(k0, o0);                                              \
                    k1 = (lower == asc1) ? min(k1, o1) : max(k1, o1);                                              \
                }                                                                                                  \
            }                                                                                                      \
        }                                                                                                          \
        e0[t] = (int)(k0 >> 7); e1[t] = (int)(k1 >> 7);                                                            \
        const int sl0 = (int)(k0 & 127u), sl1 = (int)(k1 & 127u);                                                  \
          \
        sgu0[t] = su_[e0[t]]; sgu1[t] = su_[e1[t]];                                                                \
        sgv0[t] = p.pgate[row_ * 128 + sl0] * sv_[e0[t]]; sgv1[t] = p.pgate[row_ * 128 + sl1] * sv_[e1[t]];        \
    }
    PE_PREFETCH(0)
    PE_SORT(0)
    PE_LOADU(rA, 0, 0)
    for (int sw = 0; sw < nsweep; ++sw) {
        __syncthreads();
        int rows[PE_T]; bool valid[PE_T];
        int qx[PE_T][4];
        float wlo[PE_T], whi[PE_T], swq[PE_T], sxv[PE_T];
        int hlo[PE_T], hhi[PE_T];
        int acc[PE_T][16];
        unsigned pklo[PE_T], pkhi[PE_T];
#pragma unroll
        for (int t = 0; t < PE_T; ++t) {
            const int ti = sw * PE_T + t;
            valid[t] = ti < ntok;
            const int row = first + (valid[t] ? ti : 0) * rstride;
            rows[t] = row;
            float x[16];
            {
                const u32x4 a = hpa[t], b = hpb[t];
#pragma unroll
                for (int i = 0; i < 4; ++i) { x[2 * i] = bflo(a[i]); x[2 * i + 1] = bfhi(a[i]); x[8 + 2 * i] = bflo(b[i]); x[8 + 2 * i + 1] = bfhi(b[i]); }
            }
            float mx = 0.f;
#pragma unroll
            for (int i = 0; i < 16; ++i) mx = fmaxf(mx, fabsf(x[i]));
            mx = wave_max(mx);
            const float sx = mx > 0.f ? mx * (1.f / 127.f) : 1.f;
            const float isx = 1.f / sx;
#pragma unroll
            for (int i = 0; i < 4; ++i) {
                unsigned pk = 0;
#pragma unroll
                for (int q = 0; q < 4; ++q) pk |= (unsigned)((int)rintf(x[i * 4 + q] * isx) & 0xFF) << (q * 8);
                qx[t][i] = (int)pk;
            }
            sxv[t] = sx;
            hlo[t] = 0; hhi[t] = 0;
#pragma unroll
            for (int i = 0; i < 16; ++i) acc[t][i] = 0;
        }
        for (int bb = 0; bb < 16; ++bb) {
            if ((bb & 3) == 0) __builtin_amdgcn_s_barrier();
            PE_LOADU(rB, bb, 1)
            PE_DOT(rA, bb, 0)
            if (bb + 1 < 16) { PE_LOADU(rA, bb + 1, 0) } else { PE_LOADV(rA, 0, 0) }
            PE_DOT(rB, bb, 1)
        }
#pragma unroll
        for (int t = 0; t < PE_T; ++t) {
            wlo[t] = sgv0[t] * gelu_tanh(sgu0[t] * sxv[t] * (float)hlo[t]); whi[t] = sgv1[t] * gelu_tanh(sgu1[t] * sxv[t] * (float)hhi[t]);
            float am = fmaxf(fabsf(wlo[t]), fabsf(whi[t]));
            am = wave_max(am);
            swq[t] = am > 0.f ? am * (1.f / 127.f) : 1.f;
            const float iw = 1.f / swq[t];
            const unsigned q0 = (unsigned)((int)rintf(wlo[t] * iw) & 0xFF), q1 = (unsigned)((int)rintf(whi[t] * iw) & 0xFF);
            const unsigned a0 = q0 | ((unsigned)xshfl_i<1>((int)q0) << 8);
            const unsigned a1 = q1 | ((unsigned)xshfl_i<1>((int)q1) << 8);
            pklo[t] = a0 | ((unsigned)xshfl_i<2>((int)a0) << 16);
            pkhi[t] = a1 | ((unsigned)xshfl_i<2>((int)a1) << 16);
        }
        if (sw + 1 < nsweep) { PE_PREFETCH(sw + 1) }
        f32x4 xvp[PE_T][4];
#pragma unroll
        for (int t = 0; t < PE_T; ++t)
#pragma unroll
            for (int q = 0; q < 4; ++q) xvp[t][q] = *(const f32x4*)(p.out + (long)rows[t] * DM + lane * 16 + q * 4);
        for (int bb = 0; bb < 16; ++bb) {
            if ((bb & 3) == 0) __builtin_amdgcn_s_barrier();
            PE_LOADV(rB, bb, 1)
            PE_AXPY(rA, bb, 0)
            if (bb + 1 < 16) { PE_LOADV(rA, bb + 1, 0) }
            PE_AXPY(rB, bb, 1)
        }
        if (sw + 1 < nsweep) { PE_SORT(sw + 1) PE_LOADU(rA, 0, 0) }
#pragma unroll
        for (int t = 0; t < PE_T; ++t) {
            if (!valid[t]) continue;
            const int row = rows[t];
            float y[16];
#pragma unroll
            for (int i = 0; i < 16; ++i) y[i] = swq[t] * (float)acc[t][i];
            const float* gv = mods_l + (long)tok_modrow(row) * 6144 + 5 * 1024;
            float* xr = p.out + (long)row * DM + lane * 16;
            float4 xv[4], gg[4];
#pragma unroll
            for (int q = 0; q < 4; ++q) { xv[q] = make_float4(xvp[t][q][0], xvp[t][q][1], xvp[t][q][2], xvp[t][q][3]); gg[q] = *(const float4*)(gv + lane * 16 + q * 4); }
            float4 nw[4], nsc[4], nsh[4];
            if (NEXT) {
                const float* mr = mods_next + (long)tok_modrow(row) * 6144;
#pragma unroll
                for (int q = 0; q < 4; ++q) { nw[q] = *(const float4*)(w_next + lane * 16 + q * 4); nsc[q] = *(const float4*)(mr + 1024 + lane * 16 + q * 4); nsh[q] = *(const float4*)(mr + lane * 16 + q * 4); }
            }
            float ss = 0.f;
#pragma unroll
            for (int q = 0; q < 4; ++q) {
                xv[q].x += gscale * gg[q].x * y[q * 4 + 0]; xv[q].y += gscale * gg[q].y * y[q * 4 + 1];
                xv[q].z += gscale * gg[q].z * y[q * 4 + 2]; xv[q].w += gscale * gg[q].w * y[q * 4 + 3];
                *(float4*)(xr + q * 4) = xv[q];
                ss += xv[q].x * xv[q].x + xv[q].y * xv[q].y + xv[q].z * xv[q].z + xv[q].w * xv[q].w;
            }
            if (NEXT) {
                ss = wave_sum(ss);
                const float r = rsqrtf(ss * (1.f / 1024.f) + 1e-6f);
#pragma unroll
                for (int q = 0; q < 4; ++q) {
                    const float h0 = xv[q].x * r * nw[q].x * (1.f + nsc[q].x) + nsh[q].x, h1 = xv[q].y * r * nw[q].y * (1.f + nsc[q].y) + nsh[q].y;
                    const float h2 = xv[q].z * r * nw[q].z * (1.f + nsc[q].z) + nsh[q].z, h3 = xv[q].w * r * nw[q].w * (1.f + nsc[q].w) + nsh[q].w;
                    *(uint2*)(p.H + (long)row * DM + lane * 16 + q * 4) = make_uint2(pack2(h0, h1), pack2(h2, h3));
                }
            }
        }
    }
}
#define SMEM_MAX 147456

#define BARRIER() do { XcdBarrier b_; b_.bar = p.bar; b_.x = xb_xcc_id(); b_.st = (volatile LAS unsigned*)(smem + SMEM_MAX); xcd_barrier(b_); } while (0)
__device__ __forceinline__ CP& kparams() {
    CP* kp = (CP*)__builtin_amdgcn_kernarg_segment_ptr();
    asm volatile("" : "+s"(kp));
    return *kp;
}
__global__ void __launch_bounds__(NTHREADS, 2) k_mega(Params p_unused) {
    extern __shared__ __attribute__((aligned(16))) char smem[];
#define p kparams()
    if (threadIdx.x == 0) *(uint4*)(smem + SMEM_MAX) = make_uint4(0u, 0u, 0u, 0u);
    __syncthreads();
    (void)xcd_barrier_post(p.bar, (volatile LAS unsigned*)(smem + SMEM_MAX));
    ph_init(p, smem);
    BARRIER();
#pragma unroll
    for (int l = 0; l < 4; ++l) {
        const int j = l >> 1;
#define mods_l (kparams().mods + (long)l * 9 * 6144)
        if (l == 0) {
            ph_norm<1>(p, p.norm_mix, mods_l, 0, 1024);
            BARRIER();
        }
        if ((l & 1) == 0) {
            ph_e_gemm(p, j, smem);
            BARRIER();
            ph_e_prep(p, j, smem);
            ph_fft_a(p, smem);
            BARRIER();
            ph_e_scan(p, j, smem);
            ph_fft_b(p, smem);
            ph_tab(p, l, 64);
            ph_tab(p, l + 1, 64);
            if (l == 0) ph_init2(p, smem, 64);
            BARRIER();
            ph_e_mix(p, j);
            BARRIER();
            if (l == 0) ph_out_gemm<1>(p, p.mix, p.wtE_out + (long)j * 1024 * 1024, mods_l, 2 * 1024, smem);
            else ph_out_gemm<0>(p, p.mix, p.wtE_out + (long)j * 1024 * 1024, mods_l, 2 * 1024, smem);
            BARRIER();
        } else {
            ph_o_gemm1(p, j, smem);
            BARRIER();
            ph_o_norm(p, j);
            BARRIER();
            ph_o_gemm2(p, j, smem);
            BARRIER();
            ph_o_qknorm(p, j);
            BARRIER();
            ph_o_attn(p, smem);
            BARRIER();
            ph_out_gemm(p, p.Ob, p.wtO_out + (long)j * 1024 * 1024, mods_l, 2 * 1024, smem);
            BARRIER();
        }
        ph_norm(p, p.norm_ffn + l * 1024, mods_l, 3 * 1024, 4 * 1024);
        BARRIER();
        ph_p_route(p, l, smem);
        BARRIER();
        if (l < 3) ph_p_eval<1>(p, mods_l, l, p.norm_mix + (l + 1) * 1024, p.mods + (long)(l + 1) * 9 * 6144);
        else ph_p_eval<0>(p, mods_l, l, p.norm_mix, p.mods);
        if (l < 3) BARRIER();
    }
#undef p
#undef mods_l
}

static inline size_t al256(size_t x) { return (x + 255) & ~(size_t)255; }

extern "C" void kernel_launch(void* const* d_in, const int* in_sizes, int n_in, void* d_out, int out_size, void* d_ws, size_t ws_size, hipStream_t stream) {
    Params p{};
    const float* const* in = (const float* const*)d_in;
    p.x_prompt = in[0]; p.x_sample = in[1]; p.state_gdn = in[2]; p.cache_ckv = in[3]; p.cache_kr = in[4]; p.c = in[5]; p.c_ctx = in[6];
    p.w_mod = in[7]; p.b_mod = in[8]; p.norm_mix = in[9]; p.norm_ffn = in[10];
    p.even_w_in = in[11]; p.even_conv_w = in[12]; p.gdn_a_log = in[13]; p.gdn_dt_bias = in[14]; p.gdn_o_norm = in[15]; p.even_w_out = in[16];
    p.odd_w_in = in[17]; p.mla_q_norm = in[18]; p.mla_kv_norm = in[19]; p.mla_w_uq = in[20]; p.mla_w_ukv = in[21]; p.mla_q_headnorm = in[22]; p.mla_k_headnorm = in[23]; p.odd_w_out = in[24];
    p.peer_w_q = in[25]; p.peer_sub_keys = in[26]; p.peer_u = in[27]; p.peer_v = in[28];
    p.out = (float*)d_out;
    char* ws = (char*)d_ws;
    size_t off = 0;
    auto take = [&](size_t bytes) { char* r = ws + off; off = al256(off + bytes); return r; };
    p.bar = (unsigned*)take(16384);
    p.mods = (float*)take(4L * 9 * 6144 * 4);
    p.wtE_in = (bf16_t*)take(2L * N_EIN * 1024 * 2);
    p.wtE_out = (bf16_t*)take(2L * 1024 * 1024 * 2);
    p.wtO_in = (bf16_t*)take(2L * N_OIN * 1024 * 2);
    p.wtUq = (bf16_t*)take(2L * 1536 * 512 * 2);
    p.wtUkv = (bf16_t*)take(2L * 2048 * 256 * 2);
    p.wtO_out = (bf16_t*)take(2L * 1024 * 1024 * 2);
    p.wtPq = (bf16_t*)take(4L * 2048 * 1024 * 2);
    p.subk = (bf16_t*)take(4L * 16 * 128 * 128 * 2);
    p.fftMA = (bf16_t*)take(128L * 128 * 2);
    p.fftMB = (bf16_t*)take(128L * 128 * 2);
    p.fftTW = (float*)take(4096L * 2 * 4);
    p.dftP = (bf16_t*)take(256L * 512 * 2);
    p.tabU = (unsigned char*)take(2L * 16384 * 2048);
    p.tabV = p.tabU;
    p.su = (float*)take(2L * 32768 * 4);
    p.sv = p.su;
    p.H = (bf16_t*)take((long)T_TOK * 1024 * 2);
    const size_t ubase = off;
    p.qkvraw = (bf16_t*)take((long)T_TOK * 1536 * 2);
    p.mix = p.qkvraw;
    p.gate = (bf16_t*)take((long)T_TOK * 512 * 2);
    p.ba = (float*)take((long)T_TOK * 16 * 4);
    p.ZtA = (bf16_t*)take((long)T_TOK * 1024 * 2);
    p.qn = (bf16_t*)take((long)T_TOK * 512 * 2);
    p.kn = (bf16_t*)take((long)T_TOK * 512 * 2);
    p.Wb = (bf16_t*)take(4608L * 8192 * 2);
    p.Ub = (bf16_t*)take(4608L * 8192 * 2);
    p.QKb = (bf16_t*)take(4608L * 4096 * 2);
    p.gcb = (float*)take(4608L * 64 * 4);
    p.of = (bf16_t*)take((long)T_TOK * 512 * 2);
    p.ob = (bf16_t*)take((long)T_TOK * 512 * 2);
    p.HB = (bf16_t*)take(8L * 64 * 512 * 2 * 64 * 2);
    const size_t even_end = off;
    off = ubase;
    p.Podd = (float*)take((long)T_TOK * 832 * 4);
    p.Ob = (bf16_t*)p.Podd;
    p.cq = (bf16_t*)take((long)T_TOK * 512 * 2);
    p.ckv_all = (bf16_t*)take((long)(T_TOK + 2048) * 256 * 2);
    p.kr_all = (float*)take((long)(T_TOK + 2048) * 64 * 4);
    p.Qb = (bf16_t*)take((long)T_TOK * 1536 * 2);
    p.Kb = (bf16_t*)take((KB_S + 8L * 8 * 4352 * 192) * 2);
    p.Vtb = (bf16_t*)take((VT_S + 8L * 8 * 128 * 4352) * 2);
    const size_t odd_end = off;
    off = ubase;
    p.eidx = (int*)take((long)T_TOK * 128 * 4);
    p.pgate = (float*)take((long)T_TOK * 128 * 4);
    const size_t peer_end = off;
    size_t need = even_end > odd_end ? even_end : odd_end;
    if (peer_end > need) need = peer_end;
    if (need > ws_size) return;

    static int grid = 0;
    if (!grid) {
        int dev = 0, cus = 0, per_cu = 0;
        hipGetDevice(&dev);
        hipDeviceGetAttribute(&cus, hipDeviceAttributeMultiprocessorCount, dev);
        if (hipFuncSetAttribute((const void*)k_mega, hipFuncAttributeMaxDynamicSharedMemorySize, SMEM_MAX + 16) != hipSuccess) return;
        if (hipOccupancyMaxActiveBlocksPerMultiprocessor(&per_cu, (const void*)k_mega, NTHREADS, SMEM_MAX + 16) != hipSuccess || per_cu < 1) return;
        grid = cus;
    }
    hipMemsetAsync(p.bar, 0, XCD_BAR_WORDS * sizeof(unsigned), stream);
    hipLaunchKernelGGL(k_mega, dim3(grid), dim3(NTHREADS), SMEM_MAX + 16, stream, p);
}
```

```cpp
#include <hip/hip_runtime.h>
#include <stdint.h>

typedef unsigned short bf16_t;
typedef short bf16x8 __attribute__((ext_vector_type(8)));
typedef float f32x4 __attribute__((ext_vector_type(4)));
typedef unsigned u32x4 __attribute__((ext_vector_type(4)));
typedef int i32x4 __attribute__((ext_vector_type(4)));

#define T_TOK   36864
#define TP_TOK  4096
#define DM      1024
#define NTHREADS 512
#define N_EIN   3328
#define N_OIN   1024
#define OUT_STATE 37748736L
#define OUT_CKV   41943040L
#define OUT_KR    44040192L

struct Params {
    const float *x_prompt, *x_sample, *state_gdn, *cache_ckv, *cache_kr, *c, *c_ctx, *w_mod, *b_mod, *norm_mix, *norm_ffn;
    const float *even_w_in, *even_conv_w, *gdn_a_log, *gdn_dt_bias, *gdn_o_norm, *even_w_out;
    const float *odd_w_in, *mla_q_norm, *mla_kv_norm, *mla_w_uq, *mla_w_ukv, *mla_q_headnorm, *mla_k_headnorm, *odd_w_out;
    const float *peer_w_q, *peer_sub_keys, *peer_u, *peer_v;
    float* out;
    unsigned* bar;
    float* mods;
    bf16_t *wtE_in, *wtE_out, *wtO_in, *wtUq, *wtUkv, *wtO_out, *wtPq, *subk, *dftP, *fftMA, *fftMB, *HB;
    float* fftTW;
    unsigned char *tabU, *tabV;
    float *su, *sv;
    bf16_t* H;
    bf16_t *qkvraw, *gate, *ZtA, *qn, *kn, *Wb, *Ub, *QKb, *of, *ob, *mix;
    float *ba, *gcb;
    float *Podd, *kr_all;
    bf16_t *cq, *ckv_all, *Qb, *Kb, *Vtb, *Ob;
    float* pgate;
    int* eidx;
};

typedef const Params __attribute__((address_space(4))) CP;

__device__ __forceinline__ int ltid() { int t = threadIdx.x; asm volatile("" : "+v"(t)); return t; }
__device__ __forceinline__ int lbid() { int b = blockIdx.x; asm volatile("" : "+s"(b)); return b; }
typedef __bf16 bf16v2 __attribute__((ext_vector_type(2)));
typedef float f32x2 __attribute__((ext_vector_type(2)));
__device__ __forceinline__ bf16_t f2bf(float f) { return __builtin_bit_cast(unsigned short, (__bf16)f); }
__device__ __forceinline__ float bf2f(bf16_t h) { return __uint_as_float(((unsigned)h) << 16); }
__device__ __forceinline__ unsigned pack2(float lo, float hi) { const f32x2 v = {lo, hi}; return __builtin_bit_cast(unsigned, __builtin_convertvector(v, bf16v2)); }
__device__ __forceinline__ float bflo(unsigned u) { return __uint_as_float(u << 16); }
__device__ __forceinline__ float bfhi(unsigned u) { return __uint_as_float(u & 0xFFFF0000u); }
__device__ __forceinline__ float silu_f(float x) { return x / (1.f + __expf(-x)); }
__device__ __forceinline__ float sigmoid_f(float x) { return 1.f / (1.f + __expf(-x)); }
__device__ __forceinline__ float softplus_f(float x) { return fmaxf(x, 0.f) + __logf(1.f + __expf(-fabsf(x))); }
__device__ __forceinline__ float gelu_tanh(float x) {
    const float u = 0.7978845608028654f * (x + 0.044715f * x * x * x);
    return 0.5f * x * (1.f + tanhf(u));
}
template <int M>
__device__ __forceinline__ int xshfl_i(int v) {
    if constexpr (M == 1) return __builtin_amdgcn_mov_dpp(v, 0xB1, 0xF, 0xF, true);
    else if constexpr (M == 2) return __builtin_amdgcn_mov_dpp(v, 0x4E, 0xF, 0xF, true);
    else if constexpr (M == 4) return __builtin_amdgcn_update_dpp(__builtin_amdgcn_update_dpp(0, v, 0x104, 0xF, 0x5, false), v, 0x114, 0xF, 0xA, false);
    else if constexpr (M == 8) return __builtin_amdgcn_mov_dpp(v, 0x128, 0xF, 0xF, true);
    else if constexpr (M == 16) { const auto r = __builtin_amdgcn_permlane16_swap((unsigned)v, (unsigned)v, false, false); return (int)(r[0] ^ r[1] ^ (unsigned)v); }
    else { const auto r = __builtin_amdgcn_permlane32_swap((unsigned)v, (unsigned)v, false, false); return (int)(r[0] ^ r[1] ^ (unsigned)v); }
}
template <int M>
__device__ __forceinline__ float xshfl(float v) { return __int_as_float(xshfl_i<M>(__float_as_int(v))); }
template <int CTRL> __device__ __forceinline__ float dppf(float v) { return __int_as_float(__builtin_amdgcn_mov_dpp(__float_as_int(v), CTRL, 0xF, 0xF, true)); }
__device__ __forceinline__ float wave_sum(float v) {
    v += dppf<0xB1>(v); v += dppf<0x4E>(v); v += dppf<0x141>(v); v += dppf<0x140>(v);
    { const auto r = __builtin_amdgcn_permlane16_swap(__float_as_uint(v), __float_as_uint(v), false, false); v = __uint_as_float(r[0]) + __uint_as_float(r[1]); }
    { const auto r = __builtin_amdgcn_permlane32_swap(__float_as_uint(v), __float_as_uint(v), false, false); v = __uint_as_float(r[0]) + __uint_as_float(r[1]); }
    return v;
}
__device__ __forceinline__ float wave_max(float v) {
    v = fmaxf(v, dppf<0xB1>(v)); v = fmaxf(v, dppf<0x4E>(v)); v = fmaxf(v, dppf<0x141>(v)); v = fmaxf(v, dppf<0x140>(v));
    { const auto r = __builtin_amdgcn_permlane16_swap(__float_as_uint(v), __float_as_uint(v), false, false); v = fmaxf(__uint_as_float(r[0]), __uint_as_float(r[1])); }
    { const auto r = __builtin_amdgcn_permlane32_swap(__float_as_uint(v), __float_as_uint(v), false, false); v = fmaxf(__uint_as_float(r[0]), __uint_as_float(r[1])); }
    return v;
}
__device__ __forceinline__ int tok_modrow(int t) { return t < TP_TOK ? 0 : 1 + ((t - TP_TOK) >> 12); }
__device__ __forceinline__ int tok_seq0(int t) { return t < TP_TOK ? (t & ~255) : (TP_TOK + ((t - TP_TOK) & ~4095)); }
__device__ __forceinline__ int tok_len(int t) { return t < TP_TOK ? 256 : 4096; }

template <int MT, int NT>
__device__ __forceinline__ void wave_mma(f32x4 (&acc)[MT][NT], const bf16_t* A, int lda, const bf16_t* B, int ldb, int K) {
    const int lane = ltid() & 63, r = lane & 15, kg = (lane >> 4) * 8;
#pragma unroll 1
    for (int k0 = 0; k0 < K; k0 += 32) {
        bf16x8 a[MT], b[NT];
#pragma unroll
        for (int m = 0; m < MT; ++m) a[m] = *(const bf16x8*)(A + (m * 16 + r) * lda + k0 + kg);
#pragma unroll
        for (int n = 0; n < NT; ++n) b[n] = *(const bf16x8*)(B + (n * 16 + r) * ldb + k0 + kg);
#pragma unroll
        for (int m = 0; m < MT; ++m)
#pragma unroll
            for (int n = 0; n < NT; ++n) acc[m][n] = __builtin_amdgcn_mfma_f32_16x16x32_bf16(a[m], b[n], acc[m][n], 0, 0, 0);
    }
}
template <int MT, int NT, int KSTEPS>
__device__ __forceinline__ void wave_mma_u(f32x4 (&acc)[MT][NT], const bf16_t* A, int lda, const bf16_t* B, int ldb) {
    const int lane = ltid() & 63, r = lane & 15, kg = (lane >> 4) * 8;
    bf16x8 a[KSTEPS][MT], b[KSTEPS][NT];
#pragma unroll
    for (int ks = 0; ks < KSTEPS; ++ks) {
#pragma unroll
        for (int m = 0; m < MT; ++m) a[ks][m] = *(const bf16x8*)(A + (m * 16 + r) * lda + ks * 32 + kg);
#pragma unroll
        for (int n = 0; n < NT; ++n) b[ks][n] = *(const bf16x8*)(B + (n * 16 + r) * ldb + ks * 32 + kg);
    }
#pragma unroll
    for (int ks = 0; ks < KSTEPS; ++ks)
#pragma unroll
        for (int m = 0; m < MT; ++m)
#pragma unroll
            for (int n = 0; n < NT; ++n) acc[m][n] = __builtin_amdgcn_mfma_f32_16x16x32_bf16(a[ks][m], b[ks][n], acc[m][n], 0, 0, 0);
}

#define GLD 72
#define GEMM_SMEM_BYTES (2 * (256 + 128) * GLD * 2)
template <int PERM = 0, class Epi>
__device__ __forceinline__ void gemm_tile(const bf16_t* __restrict__ A, long lda, const bf16_t* __restrict__ B, long ldb, int K, bf16_t* smem, Epi epi) {
    const int tid = ltid(), lane = tid & 63, wave = tid >> 6;
    const int wm = wave >> 1, wn = wave & 1;
    bf16_t* As = smem;
    bf16_t* Bs = smem + 2 * 256 * GLD;
    f32x4 acc[4][4];
#pragma unroll
    for (int m = 0; m < 4; ++m)
#pragma unroll
        for (int n = 0; n < 4; ++n) acc[m][n] = (f32x4){0.f, 0.f, 0.f, 0.f};
    uint4 ra[4], rb[2];
    const int lrow = tid >> 3, lkc = (tid & 7) * 8;
    const bf16_t* ap = A + (long)lrow * (PERM ? 64 : 1) * lda + lkc;
    const bf16_t* bp = B + (long)lrow * ldb + lkc;
    const long astep = (PERM ? 1 : 64) * lda;
#pragma unroll
    for (int i = 0; i < 4; ++i) ra[i] = *(const uint4*)(ap + (long)i * astep);
#pragma unroll
    for (int i = 0; i < 2; ++i) rb[i] = *(const uint4*)(bp + (long)i * 64 * ldb);
    __builtin_amdgcn_sched_barrier(0);
#pragma unroll
    for (int i = 0; i < 4; ++i) *(uint4*)(As + (i * 64 + lrow) * GLD + lkc) = ra[i];
#pragma unroll
    for (int i = 0; i < 2; ++i) *(uint4*)(Bs + (i * 64 + lrow) * GLD + lkc) = rb[i];
    __syncthreads();
    const int nk = K >> 6;
    for (int kt = 0; kt < nk; ++kt) {
        const int cur = kt & 1;
        if (kt + 1 < nk) {
            const long k0 = (long)(kt + 1) * 64;
#pragma unroll
            for (int i = 0; i < 4; ++i) ra[i] = *(const uint4*)(ap + (long)i * astep + k0);
#pragma unroll
            for (int i = 0; i < 2; ++i) rb[i] = *(const uint4*)(bp + (long)i * 64 * ldb + k0);
            __builtin_amdgcn_sched_barrier(0);
        }
        const bf16_t* Ac = As + cur * 256 * GLD + (wm * 64) * GLD;
        const bf16_t* Bc = Bs + cur * 128 * GLD + (wn * 64) * GLD;
        wave_mma<4, 4>(acc, Ac, GLD, Bc, GLD, 32);
        wave_mma<4, 4>(acc, Ac + 32, GLD, Bc + 32, GLD, 32);
        if (kt + 1 < nk) {
            bf16_t* An = As + (cur ^ 1) * 256 * GLD;
            bf16_t* Bn = Bs + (cur ^ 1) * 128 * GLD;
#pragma unroll
            for (int i = 0; i < 4; ++i) *(uint4*)(An + (i * 64 + lrow) * GLD + lkc) = ra[i];
#pragma unroll
            for (int i = 0; i < 2; ++i) *(uint4*)(Bn + (i * 64 + lrow) * GLD + lkc) = rb[i];
        }
        __syncthreads();
    }
#pragma unroll
    for (int m = 0; m < 4; ++m)
#pragma unroll
        for (int n = 0; n < 4; ++n) epi(wm * 64 + m * 16 + (lane >> 4) * 4, wn * 64 + n * 16 + (lane & 15), acc[m][n]);
}
namespace g8 {
constexpr int BK = 64, HALF = 128, HT = HALF * BK;
__device__ __forceinline__ int lds_byte(int r, int c) {
    const int st = (r >> 4) * 2 + (c >> 5), rr = r & 15, cc = c & 31, ob = rr * 64 + cc * 2;
    return st * 1024 + (ob ^ (((ob >> 9) & 1) << 5));
}
__device__ __forceinline__ void stage_rc(int b, int& R, int& C) {
    const int st = b / 1024, sb = b % 1024, swz = sb ^ (((sb >> 9) & 1) << 5);
    R = (st >> 1) * 16 + swz / 64; C = (st & 1) * 32 + (swz % 64) / 2;
}
}

template <int PERM = 0, int PRE = 0>
__device__ __forceinline__ void gemm_tile256_acc(const bf16_t* __restrict__ A, long lda, const bf16_t* __restrict__ Bt, long ldb, int K, bf16_t* shm, f32x4 (&acc)[2][2][4][2]) {
    using namespace g8;
#define G8_SA(b, h) (shm + ((b) * 2 + (h)) * HT)
#define G8_SB(b, h) (shm + (4 + (b) * 2 + (h)) * HT)
#define G8_STAGE_A(T, P, h, kt) do { for (int _i = 0; _i < 2; ++_i) { const int _b = (T) * 16 + _i * 8192; int _r, _c; stage_rc(_b, _r, _c); \
        const int _R = (h) * HALF + _r; const long _ar = PERM ? (long)((_R & 63) * 64 + (_R >> 6)) : (long)_R; \
        __builtin_amdgcn_global_load_lds((const unsigned*)(A + _ar * lda + (long)(kt) * BK + _c), (__attribute__((address_space(3))) unsigned*)((char*)(P) + _b), 16, 0, 0); } } while (0)
#define G8_STAGE_B(T, P, h, kt) do { for (int _i = 0; _i < 2; ++_i) { const int _b = (T) * 16 + _i * 8192; int _r, _c; stage_rc(_b, _r, _c); \
        __builtin_amdgcn_global_load_lds((const unsigned*)(Bt + (long)((h) * HALF + _r) * ldb + (long)(kt) * BK + _c), (__attribute__((address_space(3))) unsigned*)((char*)(P) + _b), 16, 0, 0); } } while (0)
#define G8_LDA(dst, b, h) _Pragma("unroll") for (int m = 0; m < 4; ++m) _Pragma("unroll") for (int k = 0; k < 2; ++k) \
        dst[m][k] = *reinterpret_cast<const bf16x8*>((char*)G8_SA(b, h) + lds_byte(wr * 64 + m * 16 + fr, k * 32 + fq * 8))
#define G8_LDB(dst, b, h) _Pragma("unroll") for (int n = 0; n < 2; ++n) _Pragma("unroll") for (int k = 0; k < 2; ++k) \
        dst[n][k] = *reinterpret_cast<const bf16x8*>((char*)G8_SB(b, h) + lds_byte(wc * 32 + n * 16 + fr, k * 32 + fq * 8))
#define G8_MMA(ai, bj, At_, Bt_) do { __builtin_amdgcn_s_setprio(1); \
        _Pragma("unroll") for (int m = 0; m < 4; ++m) _Pragma("unroll") for (int n = 0; n < 2; ++n) _Pragma("unroll") for (int k = 0; k < 2; ++k) \
            acc[ai][bj][m][n] = __builtin_amdgcn_mfma_f32_16x16x32_bf16(At_[m][k], Bt_[n][k], acc[ai][bj][m][n], 0, 0, 0); \
        __builtin_amdgcn_s_setprio(0); } while (0)
#define G8_WAIT_V(n) asm volatile("s_waitcnt vmcnt(" #n ")" ::: "memory")
#define G8_WAIT_L(n) asm volatile("s_waitcnt lgkmcnt(" #n ")" ::: "memory")
#define G8_BAR __builtin_amdgcn_s_barrier()
#define G8_SCHED __builtin_amdgcn_sched_barrier(0)
    int tz = ltid();
    int wid = tz >> 6, lane = tz & 63, wr = wid >> 2, wc = wid & 3, fr = lane & 15, fq = lane >> 4;
#pragma unroll
    for (int a = 0; a < 2; ++a)
#pragma unroll
        for (int b = 0; b < 2; ++b)
#pragma unroll
            for (int m = 0; m < 4; ++m)
#pragma unroll
                for (int n = 0; n < 2; ++n) acc[a][b][m][n] = (f32x4){0.f, 0.f, 0.f, 0.f};
    bf16x8 At[4][2], B0[2][2], B1[2][2];
    const int nt = K / BK;
    if (PRE) {
        if (wr == 1) G8_BAR;
        G8_WAIT_V(0); G8_BAR;
        G8_BAR;
    } else {
        G8_STAGE_B(tz, G8_SB(0, 0), 0, 0); G8_STAGE_A(tz, G8_SA(0, 0), 0, 0);
        G8_STAGE_B(tz, G8_SB(0, 1), 1, 0); G8_STAGE_A(tz, G8_SA(0, 1), 1, 0);
        if (wr == 1) G8_BAR;
        G8_WAIT_V(4); G8_BAR;
        G8_STAGE_B(tz, G8_SB(1, 0), 0, 1); G8_STAGE_A(tz, G8_SA(1, 0), 0, 1); G8_STAGE_B(tz, G8_SB(1, 1), 1, 1);
        G8_WAIT_V(6); G8_BAR;
    }
    for (int t = 0; t < nt - 2; t += 2) {
        G8_LDB(B0, 0, 0); G8_SCHED; G8_LDA(At, 0, 0); G8_STAGE_A(tz, G8_SA(1, 1), 1, t + 1);
        G8_WAIT_L(8); G8_BAR; G8_WAIT_L(0); G8_MMA(0, 0, At, B0); G8_BAR; G8_SCHED;
        G8_LDB(B1, 0, 1); G8_STAGE_B(tz, G8_SB(0, 0), 0, t + 2);
        G8_BAR; G8_WAIT_L(0); G8_MMA(0, 1, At, B1); G8_BAR;
        G8_LDA(At, 0, 1); G8_STAGE_A(tz, G8_SA(0, 0), 0, t + 2);
        G8_BAR; G8_WAIT_L(0); G8_MMA(1, 0, At, B0); G8_BAR; G8_SCHED;
        G8_STAGE_B(tz, G8_SB(0, 1), 1, t + 2);
        G8_WAIT_V(6); G8_BAR; G8_MMA(1, 1, At, B1); G8_BAR;
        G8_LDB(B0, 1, 0); G8_SCHED; G8_LDA(At, 1, 0); G8_STAGE_A(tz, G8_SA(0, 1), 1, t + 2);
        G8_WAIT_L(8); G8_BAR; G8_WAIT_L(0); G8_MMA(0, 0, At, B0); G8_BAR; G8_SCHED;
        G8_LDB(B1, 1, 1); G8_STAGE_B(tz, G8_SB(1, 0), 0, t + 3);
        G8_BAR; G8_WAIT_L(0); G8_MMA(0, 1, At, B1); G8_BAR;
        G8_LDA(At, 1, 1); G8_STAGE_A(tz, G8_SA(1, 0), 0, t + 3);
        G8_BAR; G8_WAIT_L(0); G8_MMA(1, 0, At, B0); G8_BAR; G8_SCHED;
        G8_STAGE_B(tz, G8_SB(1, 1), 1, t + 3);
        G8_WAIT_V(6); G8_BAR; G8_MMA(1, 1, At, B1); G8_BAR;
    }
    tz = ltid(); wid = tz >> 6; lane = tz & 63; wr = wid >> 2; wc = wid & 3; fr = lane & 15; fq = lane >> 4;
    { G8_LDB(B0, 0, 0); G8_WAIT_V(0); G8_LDA(At, 0, 0); G8_STAGE_A(tz, G8_SA(1, 1), 1, nt - 1);
      G8_BAR; G8_WAIT_L(0); G8_MMA(0, 0, At, B0); G8_BAR;
      G8_LDB(B1, 0, 1); G8_BAR; G8_WAIT_L(0); G8_MMA(0, 1, At, B1); G8_BAR;
      G8_LDA(At, 0, 1); G8_WAIT_V(4); G8_BAR; G8_WAIT_L(0); G8_MMA(1, 0, At, B0); G8_MMA(1, 1, At, B1); G8_BAR; }
    { G8_LDB(B0, 1, 0); G8_LDA(At, 1, 0); G8_WAIT_V(2); G8_BAR; G8_WAIT_L(0); G8_MMA(0, 0, At, B0); G8_BAR;
      G8_LDB(B1, 1, 1); G8_WAIT_V(0); G8_BAR; G8_WAIT_L(0); G8_MMA(0, 1, At, B1); G8_BAR;
      G8_LDA(At, 1, 1); G8_BAR; G8_WAIT_L(0); G8_MMA(1, 0, At, B0); G8_MMA(1, 1, At, B1); G8_BAR; }
    if (wr == 0) G8_BAR;
#undef G8_SA
#undef G8_SB
#undef G8_STAGE_A
#undef G8_STAGE_B
#undef G8_LDA
#undef G8_LDB
#undef G8_MMA
#undef G8_WAIT_V
#undef G8_WAIT_L
#undef G8_BAR
#undef G8_SCHED
}

template <int PERM = 0>
__device__ __forceinline__ void g8_prologue(const bf16_t* __restrict__ A, long lda, const bf16_t* __restrict__ Bt, long ldb, bf16_t* shm) {
    using namespace g8;
    const int tz = ltid();
#define G8P_STAGE_A(P, h, kt) do { for (int _i = 0; _i < 2; ++_i) { const int _b = tz * 16 + _i * 8192; int _r, _c; stage_rc(_b, _r, _c); \
        const int _R = (h) * HALF + _r; const long _ar = PERM ? (long)((_R & 63) * 64 + (_R >> 6)) : (long)_R; \
        __builtin_amdgcn_global_load_lds((const unsigned*)(A + _ar * lda + (long)(kt) * BK + _c), (__attribute__((address_space(3))) unsigned*)((char*)(P) + _b), 16, 0, 0); } } while (0)
#define G8P_STAGE_B(P, h, kt) do { for (int _i = 0; _i < 2; ++_i) { const int _b = tz * 16 + _i * 8192; int _r, _c; stage_rc(_b, _r, _c); \
        __builtin_amdgcn_global_load_lds((const unsigned*)(Bt + (long)((h) * HALF + _r) * ldb + (long)(kt) * BK + _c), (__attribute__((address_space(3))) unsigned*)((char*)(P) + _b), 16, 0, 0); } } while (0)
#define G8P_SA(b, h) (shm + ((b) * 2 + (h)) * HT)
#define G8P_SB(b, h) (shm + (4 + (b) * 2 + (h)) * HT)
    G8P_STAGE_B(G8P_SB(0, 0), 0, 0); G8P_STAGE_A(G8P_SA(0, 0), 0, 0);
    G8P_STAGE_B(G8P_SB(0, 1), 1, 0); G8P_STAGE_A(G8P_SA(0, 1), 1, 0);
    G8P_STAGE_B(G8P_SB(1, 0), 0, 1); G8P_STAGE_A(G8P_SA(1, 0), 0, 1); G8P_STAGE_B(G8P_SB(1, 1), 1, 1);
#undef G8P_STAGE_A
#undef G8P_STAGE_B
#undef G8P_SA
#undef G8P_SB
}

template <int PERM = 0, class Epi>
__device__ __forceinline__ void gemm_tile256(const bf16_t* __restrict__ A, long lda, const bf16_t* __restrict__ Bt, long ldb, int K, bf16_t* shm, Epi epi) {
    f32x4 acc[2][2][4][2];
    gemm_tile256_acc<PERM>(A, lda, Bt, ldb, K, shm, acc);
    const int tz = ltid(), wid = tz >> 6, lane = tz & 63, wr = wid >> 2, wc = wid & 3, fr = lane & 15, fq = lane >> 4;
#pragma unroll
    for (int ai = 0; ai < 2; ++ai)
#pragma unroll
        for (int bj = 0; bj < 2; ++bj)
#pragma unroll
            for (int m = 0; m < 4; ++m)
#pragma unroll
                for (int n = 0; n < 2; ++n) epi(ai * 128 + wr * 64 + m * 16 + fq * 4, bj * 128 + wc * 32 + n * 16 + fr, acc[ai][bj][m][n]);
}

__device__ __forceinline__ void tile_map(int u, int nM, int nN, int& pm, int& pn) {
    const int nwg = nM * nN;
    int wgid = u;
    { const int q = nwg / 8, r = nwg % 8, xcd = wgid % 8, off = wgid / 8; wgid = (xcd < r ? xcd * (q + 1) : r * (q + 1) + (xcd - r) * q) + off; }
    const int nig = 8 * nN, gid = wgid / nig, fm = gid * 8, gsz = (nM - fm) < 8 ? (nM - fm) : 8;
    pm = fm + ((wgid % nig) % gsz); pn = (wgid % nig) / gsz;
}
#define XB_TMO      128
#define XB_XCNT(j)  (256  + 64 * (j))
#define XB_XSUB(j)  (1280 + 64 * (j))
#define XB_XGEN(j)  (2304 + 64 * (j))
#define XB_TOP      3328
#define XB_TOPGEN   3392
#define XCD_BAR_WORDS 3456
#define XB_SPIN_CAP (1u << 18)
#define LAS __attribute__((address_space(3)))

__device__ __forceinline__ unsigned xb_ld(unsigned* p)              { return __hip_atomic_load(p, __ATOMIC_RELAXED, __HIP_MEMORY_SCOPE_AGENT); }
__device__ __forceinline__ unsigned xb_add(unsigned* p, unsigned v) { return __hip_atomic_fetch_add(p, v, __ATOMIC_RELAXED, __HIP_MEMORY_SCOPE_AGENT); }
__device__ __forceinline__ unsigned xb_xcc_id() { return (unsigned)__builtin_amdgcn_s_getreg((3 << 11) | 20) & 0xFu; }
#define XB_SPIN(cond, bar) do { unsigned _sp = 0; while (cond) { __builtin_amdgcn_s_sleep(1); \
    if ((++_sp & 255u) == 0u) { if (xb_ld(&(bar)[XB_TMO])) break; if (_sp > XB_SPIN_CAP) { atomicAdd(&(bar)[XB_TMO], 1u); break; } } } } while (0)

struct XcdBarrier {
    unsigned* bar; unsigned x;
    volatile LAS unsigned* st;
};

__device__ __forceinline__ XcdBarrier xcd_barrier_post(unsigned* bar, volatile LAS unsigned* st) {
    XcdBarrier b; b.bar = bar; b.x = xb_xcc_id(); b.st = st;
    if (threadIdx.x == 0) (void)xb_add(&bar[XB_XCNT(b.x)], 1u);
    return b;
}
__device__ __forceinline__ void xcd_barrier_complete(unsigned* bar, unsigned x, unsigned& nloc, unsigned& nx) {
    const unsigned G = gridDim.x * gridDim.y * gridDim.z;
    unsigned sum, cnt, mine, sp = 0u;
    for (;;) {
        sum = 0u; cnt = 0u; mine = 0u;
#pragma unroll
        for (unsigned j = 0; j < 16; ++j) { const unsigned c = xb_ld(&bar[XB_XCNT(j)]); sum += c; cnt += (c > 0u) ? 1u : 0u; mine = (j == x) ? c : mine; }
        if (sum == G) break;
        __builtin_amdgcn_s_sleep(1);
        if ((++sp & 255u) == 0u) { if (xb_ld(&bar[XB_TMO])) break; if (sp > XB_SPIN_CAP) { atomicAdd(&bar[XB_TMO], 1u); break; } }
    }
    nloc = mine > 0u ? mine : 1u; nx = cnt > 0u ? cnt : 1u;
}

__device__ __forceinline__ void xcd_barrier(const XcdBarrier& b) {
    asm volatile("s_waitcnt vmcnt(0)" ::: "memory");
    __syncthreads();
    if (threadIdx.x == 0) {
        unsigned* bar = b.bar;
        __builtin_amdgcn_s_waitcnt(0);
        unsigned nloc = b.st[0], nx = b.st[1];
        if (nloc == 0u) { xcd_barrier_complete(bar, b.x, nloc, nx); b.st[0] = nloc; b.st[1] = nx; }
        const unsigned old = xb_add(&bar[XB_XSUB(b.x)], 1u);
        const unsigned gen = old / nloc;
        if (old + 1u == (gen + 1u) * nloc) {
            __builtin_amdgcn_fence(__ATOMIC_RELEASE, "agent");
            asm volatile("s_waitcnt vmcnt(0)" ::: "memory");
            const unsigned og = xb_add(&bar[XB_TOP], 1u);
            const unsigned tg = og / nx;
            if (og + 1u == (tg + 1u) * nx) xb_add(&bar[XB_TOPGEN], 1u);
            else XB_SPIN(xb_ld(&bar[XB_TOPGEN]) == tg, bar);
            __builtin_amdgcn_fence(__ATOMIC_ACQUIRE, "agent");
            xb_add(&bar[XB_XGEN(b.x)], 1u);
            asm volatile("s_waitcnt vmcnt(0)" ::: "memory");
        } else {
            XB_SPIN(xb_ld(&bar[XB_XGEN(b.x)]) == gen, bar);
            __builtin_amdgcn_fence(__ATOMIC_ACQUIRE, "agent");
            asm volatile("s_waitcnt vmcnt(0)" ::: "memory");
        }
    }
    __syncthreads();
}

__device__ __forceinline__ void conv_t(const float* __restrict__ src, int ldsrc, int Nvalid, int Nstore, int K, bf16_t* __restrict__ dst, float* ts, int b0 = 0) {
    const int tid = ltid();
    const int ntn = (Nstore + 63) / 64, ntk = K / 64;
    for (int tile = lbid() - b0; tile < ntn * ntk; tile += gridDim.x - b0) {
        const int tn = tile % ntn, tk = tile / ntn;
        {
            const int kk = tid >> 3, n8 = (tid & 7) * 8;
#pragma unroll
            for (int i = 0; i < 8; ++i) {
                const int n = tn * 64 + n8 + i;
                ts[kk * 65 + n8 + i] = n < Nvalid ? src[(long)(tk * 64 + kk) * ldsrc + n] : 0.f;
            }
        }
        __syncthreads();
        {
            const int nn = tid >> 3, k8 = (tid & 7) * 8;
            const int n = tn * 64 + nn;
            if (n < Nstore) {
                uint4 v;
                v.x = pack2(ts[(k8 + 0) * 65 + nn], ts[(k8 + 1) * 65 + nn]);
                v.y = pack2(ts[(k8 + 2) * 65 + nn], ts[(k8 + 3) * 65 + nn]);
                v.z = pack2(ts[(k8 + 4) * 65 + nn], ts[(k8 + 5) * 65 + nn]);
                v.w = pack2(ts[(k8 + 6) * 65 + nn], ts[(k8 + 7) * 65 + nn]);
                *(uint4*)(dst + (long)n * K + tk * 64 + k8) = v;
            }
        }
        __syncthreads();
    }
}

__device__ __forceinline__ void fold_fourier(CP& p, int j, char* smem, int b0) {
    const int tid = ltid(), bid = lbid() - b0, nb = gridDim.x - b0;
    float* wt = (float*)smem;
    for (int unit = bid; unit < 256; unit += nb) {
        const int g = unit >> 6, kb = unit & 63;
        const int dq = ltid() & 127, kq = ltid() >> 7;
        const float rs = __builtin_amdgcn_sinf((float)dq * (1.f / 128.f)), rc = __builtin_amdgcn_cosf((float)dq * (1.f / 128.f));
        __syncthreads();
        for (int i = tid; i < 16 * 128; i += NTHREADS) {
            const int kk = i >> 7, d = i & 127;
            wt[kk * 129 + d] = p.even_w_in[((long)j * 1024 + kb * 16 + kk) * 2576 + 2064 + g * 128 + d];
        }
        __syncthreads();
        float ar[4], ai[4];
#pragma unroll
        for (int q = 0; q < 4; ++q) { ar[q] = 0.f; ai[q] = 0.f; }
        for (int d0 = 0; d0 < 128; d0 += 16) {
            float s = __builtin_amdgcn_sinf((float)((d0 * dq) & 127) * (1.f / 128.f)), c = __builtin_amdgcn_cosf((float)((d0 * dq) & 127) * (1.f / 128.f));
#pragma unroll
            for (int dd = 0; dd < 16; ++dd) {
#pragma unroll
                for (int q = 0; q < 4; ++q) {
                    const float w = wt[(kq * 4 + q) * 129 + d0 + dd];
                    ar[q] += w * c;
                    ai[q] -= w * s;
                }
                const float cn = c * rc - s * rs, sn = s * rc + c * rs;
                c = cn; s = sn;
            }
        }
        const float sc = 0.08838834764831845f;
        bf16_t* dst = p.wtE_in + (long)j * N_EIN * 1024;
#pragma unroll
        for (int q = 0; q < 4; ++q) {
            dst[(long)(2064 + g * 128 + dq) * 1024 + kb * 16 + kq * 4 + q] = f2bf(ar[q] * sc);
            dst[(long)(2576 + g * 128 + dq) * 1024 + kb * 16 + kq * 4 + q] = f2bf(ai[q] * sc);
        }
    }
    __syncthreads();
    for (long i = (long)bid * NTHREADS + tid; i < 240L * 1024; i += (long)nb * NTHREADS) p.wtE_in[(long)j * N_EIN * 1024 + 3088L * 1024 + i] = 0;
}
__device__ __forceinline__ void ph_init2(CP& p, char* smem, int b0) {
    if ((int)lbid() < b0) return;
    __syncthreads();
    float* ts = (float*)smem;
    conv_t(p.even_w_in + 1024L * 2576, 2576, 2064, 2064, 1024, p.wtE_in + (long)N_EIN * 1024, ts, b0);
    for (int j = 0; j < 2; ++j) {
        conv_t(p.even_w_out + (long)j * 1024 * 1024, 1024, 1024, 1024, 1024, p.wtE_out + (long)j * 1024 * 1024, ts, b0);
        conv_t(p.odd_w_in + (long)j * 1024 * 832, 832, 832, N_OIN, 1024, p.wtO_in + (long)j * N_OIN * 1024, ts, b0);
        conv_t(p.mla_w_uq + (long)j * 512 * 1536, 1536, 1536, 1536, 512, p.wtUq + (long)j * 1536 * 512, ts, b0);
        conv_t(p.mla_w_ukv + (long)j * 256 * 2048, 2048, 2048, 2048, 256, p.wtUkv + (long)j * 2048 * 256, ts, b0);
        conv_t(p.odd_w_out + (long)j * 1024 * 1024, 1024, 1024, 1024, 1024, p.wtO_out + (long)j * 1024 * 1024, ts, b0);
    }
    for (int l = 0; l < 4; ++l) conv_t(p.peer_w_q + (long)l * 1024 * 2048, 2048, 2048, 2048, 1024, p.wtPq + (long)l * 2048 * 1024, ts, b0);
    fold_fourier(p, 1, smem, b0);
}

__device__ __forceinline__ void ph_init(CP& p, char* smem) {
    const int tid = ltid(), bid = lbid(), nb = gridDim.x;
    {
        float* sl = (float*)smem;
        for (int i = tid; i < 9 * 1024; i += NTHREADS) {
            const int r = i >> 10, k = i & 1023;
            const float v = r == 0 ? p.c_ctx[k] : p.c[(r - 1) * 1024 + k];
            sl[i] = silu_f(v);
        }
        __syncthreads();
        float* part16 = sl + 9 * 1024;
        for (int unit = bid; unit < 192; unit += nb) {
            const int l = unit / 48, cb = unit % 48;
            const int c4 = (tid & 31) * 4, kq = tid >> 5;
            f32x4 acc[9];
#pragma unroll
            for (int r = 0; r < 9; ++r) acc[r] = (f32x4){0.f, 0.f, 0.f, 0.f};
            const float* wp = p.w_mod + ((long)l * 1024 + kq * 64) * 6144 + cb * 128 + c4;
            for (int k = 0; k < 64; k += 8) {
                f32x4 w[8];
#pragma unroll
                for (int q = 0; q < 8; ++q) w[q] = *(const f32x4*)(wp + (long)(k + q) * 6144);
#pragma unroll
                for (int q = 0; q < 8; ++q)
#pragma unroll
                    for (int r = 0; r < 9; ++r) acc[r] = acc[r] + w[q] * sl[r * 1024 + kq * 64 + k + q];
            }
#pragma unroll
            for (int r = 0; r < 9; ++r) *(f32x4*)(part16 + (kq * 9 + r) * 128 + c4) = acc[r];
            __syncthreads();
            if (tid < 128) {
                const int col = cb * 128 + tid;
                const float bias = p.b_mod[l * 6144 + col];
#pragma unroll
                for (int r = 0; r < 9; ++r) {
                    float s = bias;
#pragma unroll
                    for (int g = 0; g < 16; ++g) s += part16[(g * 9 + r) * 128 + tid];
                    p.mods[((long)l * 9 + r) * 6144 + col] = s;
                }
            }
            __syncthreads();
        }
    }
    {
        float* ts = (float*)smem;
        conv_t(p.even_w_in, 2576, 2064, 2064, 1024, p.wtE_in, ts);
    }
    fold_fourier(p, 0, smem, 0);
    for (long i = (long)bid * NTHREADS + tid; i < 4L * 8 * 2 * 128 * 128; i += (long)nb * NTHREADS) p.subk[i] = f2bf(p.peer_sub_keys[i]);
    for (int i = bid * NTHREADS + tid; i < 128 * 128; i += nb * NTHREADS) {
        const int jrow = i >> 7, kk = i & 127;
        {
            const int k1 = jrow >> 1, po = jrow & 1, pi = kk >> 6, n1 = kk & 63;
            float s, c;
            sincospif((float)((k1 * n1) & 63) / 32.f, &s, &c);
            const float v = po == 0 ? (pi == 0 ? c : s) : (pi == 0 ? -s : c);
            p.fftMA[i] = f2bf(v * 0.125f);
        }
        {
            const int k2 = jrow, pi = kk >> 6, n2 = kk & 63;
            float s, c;
            sincospif((float)((k2 * n2) & 63) / 32.f, &s, &c);
            p.fftMB[i] = jrow < 64 ? f2bf((pi == 0 ? c : s) * 0.125f) : (bf16_t)0;
        }
    }
    for (int i = bid * NTHREADS + tid; i < 4096; i += nb * NTHREADS) {
        const int n2 = i >> 6, k1 = i & 63;
        float s, c;
        sincospif((float)(n2 * k1) / 2048.f, &s, &c);
        p.fftTW[i * 2] = c; p.fftTW[i * 2 + 1] = s;
    }
    for (long i = (long)bid * NTHREADS + tid; i < 256L * 512; i += (long)nb * NTHREADS) {
        const int k = (int)(i >> 9), np = (int)(i & 511), n = np & 255;
        const int prod = (k * n) & 255;
        float s, c;
        sincospif((float)prod / 128.f, &s, &c);
        p.dftP[i] = f2bf(((np >> 8) ? s : c) * (1.f / 16.f));
    }
}

__device__ __forceinline__ void ph_tab(CP& p, int l, int b0) {
    const int lane = ltid() & 63, wave = ltid() >> 6;
    if ((int)lbid() < b0) return;
    unsigned char* tab = p.tabU + (long)(l & 1) * 16384 * 2048;
    float* su = p.su + (l & 1) * 32768; float* sv = su + 16384;
    const int rstep = (gridDim.x - b0) * 8;
    int row = (lbid() - b0) * 8 + wave;
    f32x4 nx[4];
#define TAB_SRC(R) ((((R) >= 16384) ? p.peer_v : p.peer_u) + ((long)l * 16384 + ((R) & 16383)) * 1024 + lane * 16)
    if (row < 32768) {
#pragma unroll
        for (int i = 0; i < 4; ++i) nx[i] = *(const f32x4*)(TAB_SRC(row) + i * 4);
    }
    for (; row < 32768; row += rstep) {
        const bool isv = row >= 16384;
        const int e = row & 16383;
        float v[16];
#pragma unroll
        for (int i = 0; i < 4; ++i) { v[i * 4] = nx[i][0]; v[i * 4 + 1] = nx[i][1]; v[i * 4 + 2] = nx[i][2]; v[i * 4 + 3] = nx[i][3]; }
        if (row + rstep < 32768) {
#pragma unroll
            for (int i = 0; i < 4; ++i) nx[i] = *(const f32x4*)(TAB_SRC(row + rstep) + i * 4);
        }
        float m = 0.f;
#pragma unroll
        for (int i = 0; i < 16; ++i) m = fmaxf(m, fabsf(v[i]));
        m = wave_max(m);
        const float scale = m > 0.f ? m * (1.f / 127.f) : 1.f;
        const float inv = 1.f / scale;
        unsigned w[4];
#pragma unroll
        for (int i = 0; i < 4; ++i) {
            unsigned pk = 0;
#pragma unroll
            for (int q = 0; q < 4; ++q) {
                int qi = (int)rintf(v[i * 4 + q] * inv);
                qi = qi < -127 ? -127 : (qi > 127 ? 127 : qi);
                pk |= (unsigned)(qi & 0xFF) << (q * 8);
            }
            w[i] = pk;
        }
        *(uint4*)(tab + (isv ? 16384L * 1024 : 0L) + (long)e * 1024 + lane * 16) = make_uint4(w[0], w[1], w[2], w[3]);
        if (lane == 0) (isv ? sv : su)[e] = scale;
    }
#undef TAB_SRC
}

template <int FROM_INPUT = 0>
__device__ __forceinline__ void ph_norm(CP& p, const float* __restrict__ w, const float* __restrict__ mods_l, int sh_off, int sc_off) {
    const int lane = ltid() & 63, wave = ltid() >> 6;
    const int nw = gridDim.x * 8;
    for (int row = lbid() * 8 + wave; row < T_TOK; row += nw) {
        const float* xr = FROM_INPUT ? (row < TP_TOK ? p.x_prompt + (long)row * DM : p.x_sample + (long)(row - TP_TOK) * DM) : p.out + (long)row * DM;
        float4 v[4];
        float ss = 0.f;
#pragma unroll
        for (int i = 0; i < 4; ++i) {
            v[i] = *(const float4*)(xr + i * 256 + lane * 4);
            ss += v[i].x * v[i].x + v[i].y * v[i].y + v[i].z * v[i].z + v[i].w * v[i].w;
        }
        ss = wave_sum(ss);
        const float r = rsqrtf(ss * (1.f / 1024.f) + 1e-6f);
        const float* mr = mods_l + (long)tok_modrow(row) * 6144;
        float4 ww[4], sc[4], sh[4];
#pragma unroll
        for (int i = 0; i < 4; ++i) {
            const int c = i * 256 + lane * 4;
            ww[i] = *(const float4*)(w + c); sc[i] = *(const float4*)(mr + sc_off + c); sh[i] = *(const float4*)(mr + sh_off + c);
        }
#pragma unroll
        for (int i = 0; i < 4; ++i) {
            const int c = i * 256 + lane * 4;
            const float h0 = v[i].x * r * ww[i].x * (1.f + sc[i].x) + sh[i].x;
            const float h1 = v[i].y * r * ww[i].y * (1.f + sc[i].y) + sh[i].y;
            const float h2 = v[i].z * r * ww[i].z * (1.f + sc[i].z) + sh[i].z;
            const float h3 = v[i].w * r * ww[i].w * (1.f + sc[i].w) + sh[i].w;
            *(uint2*)(p.H + (long)row * DM + c) = make_uint2(pack2(h0, h1), pack2(h2, h3));
        }
    }
}
#define ZA_OFF ((long)TP_TOK * 1024)
template <int PERM>
__device__ __forceinline__ void e_gemm_epi(CP& p, f32x4 (&acc)[2][2][4][2], int col0, int row0, int s0, int n20, int b) {
    const int tz = ltid(), wid = tz >> 6, lane = tz & 63, wr = wid >> 2, wc = wid & 3, fr = lane & 15, fq = lane >> 4;
#define EG_TOK(ai, m, i) (PERM ? s0 + 64 * ((m) * 16 + fq * 4 + (i)) + n20 + (ai) * 2 + wr : row0 + (ai) * 128 + wr * 64 + (m) * 16 + fq * 4 + (i))
    if (col0 + 256 <= 2048) {
        const bool isg = col0 >= 1536;
        bf16_t* const base = isg ? p.gate + (col0 - 1536) : p.qkvraw + col0;
        const long ld = isg ? 512 : 1536;
#pragma unroll
        for (int ai = 0; ai < 2; ++ai)
#pragma unroll
            for (int m = 0; m < 4; ++m)
#pragma unroll
                for (int i = 0; i < 4; ++i) {
                    bf16_t* d = base + (long)EG_TOK(ai, m, i) * ld + wc * 32 + fr;
#pragma unroll
                    for (int bj = 0; bj < 2; ++bj)
#pragma unroll
                        for (int n = 0; n < 2; ++n) d[bj * 128 + n * 16] = f2bf(acc[ai][bj][m][n][i]);
                }
    } else {
#pragma unroll
        for (int bj = 0; bj < 2; ++bj)
#pragma unroll
            for (int n = 0; n < 2; ++n) {
                const int col = col0 + bj * 128 + wc * 32 + n * 16 + fr;
                if (col < 2064) {
#pragma unroll
                    for (int ai = 0; ai < 2; ++ai)
#pragma unroll
                        for (int m = 0; m < 4; ++m)
#pragma unroll
                            for (int i = 0; i < 4; ++i) p.ba[(long)EG_TOK(ai, m, i) * 16 + (col - 2048)] = acc[ai][bj][m][n][i];
                } else if (col < 3088) {
                    const int cc = col - 2064, part = cc >> 9, cf = cc & 511;
#pragma unroll
                    for (int ai = 0; ai < 2; ++ai)
#pragma unroll
                        for (int m = 0; m < 4; ++m) {
                            const f32x4 v = acc[ai][bj][m][n];
                            bf16_t* dst;
                            if (PERM) dst = p.ZtA + ZA_OFF + (((((long)b * 512 + cf) * 64 + (n20 + ai * 2 + wr)) * 2 + part) * 64 + (m * 16 + fq * 4));
                            else dst = p.ZtA + (long)s0 * 1024 + ((long)cf * 2 + part) * 256 + (ai * 128 + wr * 64 + m * 16 + fq * 4);
                            *(uint2*)dst = make_uint2(pack2(v[0], v[1]), pack2(v[2], v[3]));
                        }
                }
            }
    }
#undef EG_TOK
}
__device__ __forceinline__ void ph_e_gemm(CP& p, int j, char* smem) {
    const int ntn = N_EIN / 256, ntm = T_TOK / 256;
    const bf16_t* Bt = p.wtE_in + (long)j * N_EIN * 1024;
#define EG_PROLOGUE(U)                                                                                             \
    {                                                                                                              \
        int tm_, tn_;                                                                                              \
        tile_map((U), ntm, ntn, tm_, tn_);                                                                         \
        if (tm_ < 16) g8_prologue<0>(p.H + (long)tm_ * 256 * DM, DM, Bt + (long)tn_ * 256 * 1024, 1024, (bf16_t*)smem);   \
        else { const int q_ = tm_ - 16; g8_prologue<1>(p.H + (long)(TP_TOK + (q_ >> 4) * 4096 + (q_ & 15) * 4) * DM, DM, Bt + (long)tn_ * 256 * 1024, 1024, (bf16_t*)smem); }   \
    }
    int u = lbid();
    if (u < ntn * ntm) EG_PROLOGUE(u)
    for (; u < ntn * ntm; u += gridDim.x) {
        int tm, tn;
        tile_map(u, ntm, ntn, tm, tn);
        const int col0 = tn * 256;
        const int un = u + gridDim.x;
        f32x4 acc[2][2][4][2];
        if (tm < 16) {
            const int row0 = tm * 256;
            gemm_tile256_acc<0, 1>(p.H + (long)row0 * DM, DM, Bt + (long)col0 * 1024, 1024, 1024, (bf16_t*)smem, acc);
            if (un < ntn * ntm) EG_PROLOGUE(un)
            e_gemm_epi<0>(p, acc, col0, row0, row0, 0, 0);
        } else {
            const int q = tm - 16, b = q >> 4, n20 = (q & 15) * 4;
            const int s0 = TP_TOK + b * 4096;
            gemm_tile256_acc<1, 1>(p.H + (long)(s0 + n20) * DM, DM, Bt + (long)col0 * 1024, 1024, 1024, (bf16_t*)smem, acc);
            if (un < ntn * ntm) EG_PROLOGUE(un)
            e_gemm_epi<1>(p, acc, col0, 0, s0, n20, b);
        }
    }
#undef EG_PROLOGUE
}

#define PREP_SMEM_BYTES (66048 + 34816 + 16384 + 2048 + 256 + 15360)
__device__ __forceinline__ void ph_e_prep(CP& p, int j, char* smem) {
    const float* cw = p.even_conv_w + (long)j * 3 * 1536;
    for (int u = lbid(); u < 576 * 4; u += gridDim.x) {
        const int cg = u >> 2, h = u & 3;
        const int t0 = cg * 64;
        const int s0 = tok_seq0(t0), L = tok_len(t0);
        int lz = 0, tid = ltid();
        asm volatile("" : "+s"(lz), "+v"(tid));
        const int lane = tid & 63, wave = tid >> 6;
        char* sm = smem + lz;
        bf16_t* raw = (bf16_t*)sm;
        float* KK = (float*)sm;
        float* QKr = KK + 64 * 65;
        float* Am = QKr + 64 * 65;
        bf16_t* qn = (bf16_t*)(sm + 66048);
        bf16_t* kn = qn + 64 * 136;
        bf16_t* vv = (bf16_t*)(sm + 66048 + 34816);
        float* sb = (float*)(sm + 66048 + 34816 + 16384);
        float* sg = sb + 128;
        float* sgr = sg + 128;
        float* seg = sgr + 128;
        float* sone = seg + 128;
        bf16_t* Dinv = (bf16_t*)(sm + 66048 + 34816 + 16384 + 2048 + 256);
        bf16_t* A10 = Dinv + 4 * 32 * 40;
        __syncthreads();
        for (int i = tid; i < 3 * 66 * 16; i += NTHREADS) {
            const int part = i / (66 * 16), rem = i % (66 * 16), rr = rem >> 4, ch = rem & 15;
            const int t = t0 - 1 + rr;
            uint4 v = make_uint4(0, 0, 0, 0);
            if (t >= s0 && t < s0 + L) v = *(const uint4*)(p.qkvraw + (long)t * 1536 + part * 512 + h * 128 + ch * 8);
            *(uint4*)(raw + (part * 66 + rr) * 128 + ch * 8) = v;
        }
        if (tid >= 128 && tid < 192) sone[tid - 128] = 1.f;
        if (tid < 128) {
            const int dir = tid >> 6, i = tid & 63;
            const int t = t0 + (dir ? 63 - i : i);
            const float* bar_ = p.ba + (long)t * 16;
            sb[dir * 64 + i] = sigmoid_f(bar_[dir * 4 + h]);
            const float a = __expf(p.gdn_a_log[(j * 2 + dir) * 4 + h]);
            sgr[dir * 64 + i] = -a * softplus_f(bar_[(2 + dir) * 4 + h] + p.gdn_dt_bias[(j * 2 + dir) * 4 + h]);
        }
        __syncthreads();
        if (tid < 128) {
            float v = sgr[tid];
#pragma unroll
            for (int off = 1; off < 64; off <<= 1) {
                const float o = __int_as_float(__builtin_amdgcn_ds_bpermute(((lane - off) & 63) << 2, __float_as_int(v)));
                v += lane >= off ? o : 0.f;
            }
            sg[tid] = v;
            seg[tid] = __expf(v);
        }
        {
            const int d = lane * 2;
#pragma unroll
            for (int part = 0; part < 3; ++part) {
                const int ch = part * 512 + h * 128 + d;
                const float w00 = cw[ch], w01 = cw[ch + 1], w10 = cw[1536 + ch], w11 = cw[1536 + ch + 1], w20 = cw[3072 + ch], w21 = cw[3072 + ch + 1];
                float y0[8], y1[8], ss[8];
#pragma unroll
                for (int r8 = 0; r8 < 8; ++r8) {
                    const int rr = wave * 8 + r8;
                    const unsigned x0 = *(const unsigned*)(raw + (part * 66 + rr) * 128 + d);
                    const unsigned x1 = *(const unsigned*)(raw + (part * 66 + rr + 1) * 128 + d);
                    const unsigned x2 = *(const unsigned*)(raw + (part * 66 + rr + 2) * 128 + d);
                    y0[r8] = silu_f(w00 * bflo(x0) + w10 * bflo(x1) + w20 * bflo(x2));
                    y1[r8] = silu_f(w01 * bfhi(x0) + w11 * bfhi(x1) + w21 * bfhi(x2));
                    ss[r8] = y0[r8] * y0[r8] + y1[r8] * y1[r8];
                }
                float tot = 0.f;
                if (part < 2) {
                    const bool b5 = (lane & 32) != 0, b4 = (lane & 16) != 0, b3 = (lane & 8) != 0;
                    float t4[4], t2[2];
#pragma unroll
                    for (int i = 0; i < 4; ++i) { const float snd = b5 ? ss[i] : ss[i + 4]; const float kp = b5 ? ss[i + 4] : ss[i]; t4[i] = kp + xshfl<32>(snd); }
#pragma unroll
                    for (int i = 0; i < 2; ++i) { const float snd = b4 ? t4[i] : t4[i + 2]; const float kp = b4 ? t4[i + 2] : t4[i]; t2[i] = kp + xshfl<16>(snd); }
                    { const float snd = b3 ? t2[0] : t2[1]; const float kp = b3 ? t2[1] : t2[0]; tot = kp + xshfl<8>(snd); }
                    tot += xshfl<4>(tot); tot += xshfl<2>(tot); tot += xshfl<1>(tot);
                    tot = rsqrtf(tot + 1e-6f);
                }
#pragma unroll
                for (int r8 = 0; r8 < 8; ++r8) {
                    const int rr = wave * 8 + r8;
                    float a0 = y0[r8], a1 = y1[r8];
                    if (part < 2) { const float rn = __int_as_float(__builtin_amdgcn_readlane(__float_as_int(tot), r8 * 8)); a0 *= rn; a1 *= rn; }
                    const unsigned pk = pack2(a0, a1);
                    if (part == 0) { *(unsigned*)(qn + rr * 136 + d) = pk; *(unsigned*)(p.qn + ((long)(t0 + rr) * 4 + h) * 128 + d) = pk; }
                    else if (part == 1) { *(unsigned*)(kn + rr * 136 + d) = pk; *(unsigned*)(p.kn + ((long)(t0 + rr) * 4 + h) * 128 + d) = pk; }
                    else { *(unsigned*)(vv + rr * 128 + d) = pk; }
                }
            }
        }
        __syncthreads();
        {
            const int mat = wave >> 2, rt = wave & 3;
            f32x4 acc[1][4];
#pragma unroll
            for (int n = 0; n < 4; ++n) acc[0][n] = (f32x4){0.f, 0.f, 0.f, 0.f};
            wave_mma<1, 4>(acc, (mat ? qn : kn) + rt * 16 * 136, 136, kn, 136, 128);
            float* dst = mat ? QKr : KK;
#pragma unroll
            for (int n = 0; n < 4; ++n)
#pragma unroll
                for (int r = 0; r < 4; ++r) dst[(rt * 16 + (lane >> 4) * 4 + r) * 65 + n * 16 + (lane & 15)] = acc[0][n][r];
        }
        __syncthreads();
        {
            const int dir = tid >> 8, q = tid & 255;
            const long ud = ((long)(dir ? (s0 + L - 64 - (t0 - s0)) / 64 : cg) * 4 + h) * 2 + dir;
            bf16_t* qkout = p.QKb + ud * 4096;
            for (int e = q; e < 4096; e += 256) {
                const int i = e >> 6, jj = e & 63;
                const int ti = dir ? 63 - i : i, tj = dir ? 63 - jj : jj;
                const float dec = jj <= i ? __expf(sg[dir * 64 + i] - sg[dir * 64 + jj]) : 0.f;
                Am[(dir * 64 + i) * 64 + jj] = jj < i ? sb[dir * 64 + i] * KK[ti * 65 + tj] * dec : 0.f;
                qkout[e] = f2bf(QKr[ti * 65 + tj] * 0.08838834764831845f * dec);
            }
            if (q < 64) {
                const float gq = sg[dir * 64 + q];
                p.gcb[ud * 192 + q] = gq;
                p.gcb[ud * 192 + 64 + q] = 0.08838834764831845f * __expf(gq);
                p.gcb[ud * 192 + 128 + q] = __expf(sg[dir * 64 + 63] - gq);
            }
        }
        __syncthreads();
        if (tid < 128) {
            const int dir = tid >> 6, blk = (tid >> 5) & 1, c = tid & 31;
            const float* Dm = Am + (dir * 64 + blk * 32) * 64 + blk * 32;
            float x[32];
#pragma unroll
            for (int i = 0; i < 32; ++i) x[i] = (i == c) ? 1.f : 0.f;
#pragma unroll
            for (int i = 1; i < 32; ++i) {
                f32x4 dr[8];
#pragma unroll
                for (int q4 = 0; q4 < 8; ++q4) if (q4 * 4 < i) dr[q4] = *(const f32x4*)(Dm + i * 64 + q4 * 4);
                float a = x[i];
#pragma unroll
                for (int jj = 0; jj < i; ++jj) a -= dr[jj >> 2][jj & 3] * x[jj];
                x[i] = a;
            }
            bf16_t* dv = Dinv + (dir * 2 + blk) * 32 * 40 + c;
#pragma unroll
            for (int i = 0; i < 32; ++i) dv[i * 40] = f2bf(x[i]);
        }
        for (int e = tid; e < 2048; e += NTHREADS) {
            const int dir = e >> 10, i = (e >> 5) & 31, jj = e & 31;
            A10[(dir * 32 + i) * 40 + jj] = f2bf(Am[(dir * 64 + 32 + i) * 64 + jj]);
        }
        __syncthreads();
        {
            const int dir = wave >> 2, slab = wave & 3;
            const long ud = ((long)(dir ? (s0 + L - 64 - (t0 - s0)) / 64 : cg) * 4 + h) * 2 + dir;
            bf16_t* RT = (bf16_t*)sm + wave * 4096;
#define RT_AT(c_, i_) (RT + (c_) * 64 + (((((i_) >> 3) ^ ((c_) & 7))) << 3) + ((i_) & 7))
            const int c = slab * 64 + lane;
            const int g4 = (lane >> 4) * 4, cn = lane & 15, kg = (lane >> 4) * 8;
            {
                const bf16_t* src = c < 128 ? vv + c : kn + (c - 128);
                const int sst = c < 128 ? 128 : 136;
                const float* fac = c < 128 ? sone : seg + dir * 64;
                const float* fb = sb + dir * 64;
#pragma unroll
                for (int i8 = 0; i8 < 8; ++i8) {
                    unsigned w[4];
#pragma unroll
                    for (int e = 0; e < 4; ++e) {
                        float v[2];
#pragma unroll
                        for (int q = 0; q < 2; ++q) {
                            const int i = i8 * 8 + e * 2 + q;
                            const int ti = dir ? 63 - i : i;
                            const float f0 = bf2f(src[ti * sst]) * fb[i];
                            v[q] = f0 * fac[i];
                        }
                        w[e] = pack2(v[0], v[1]);
                    }
                    *(uint4*)RT_AT(lane, i8 * 8) = make_uint4(w[0], w[1], w[2], w[3]);
                }
            }
            asm volatile("s_waitcnt lgkmcnt(0)" ::: "memory");
            const bf16_t* D0 = Dinv + (dir * 2 + 0) * 32 * 40;
            const bf16_t* D1 = Dinv + (dir * 2 + 1) * 32 * 40;
            const bf16_t* A1 = A10 + dir * 32 * 40;
            bf16_t* dstb = (c < 128 ? p.Ub : p.Wb) + ud * 8192;
            const int cbase = (slab & 1) * 64;
            bf16x8 bfr[4];
            f32x4 X0[2][4];
#pragma unroll
            for (int nt = 0; nt < 4; ++nt) bfr[nt] = *(const bf16x8*)RT_AT(nt * 16 + cn, kg);
#pragma unroll
            for (int mt = 0; mt < 2; ++mt) {
                const bf16x8 af = *(const bf16x8*)(D0 + (mt * 16 + cn) * 40 + kg);
#pragma unroll
                for (int nt = 0; nt < 4; ++nt) X0[mt][nt] = __builtin_amdgcn_mfma_f32_16x16x32_bf16(af, bfr[nt], (f32x4){0.f, 0.f, 0.f, 0.f}, 0, 0, 0);
            }
#pragma unroll
            for (int mt = 0; mt < 2; ++mt)
#pragma unroll
                for (int nt = 0; nt < 4; ++nt) {
#pragma unroll
                    for (int r = 0; r < 4; ++r) dstb[(mt * 16 + g4 + r) * 128 + cbase + nt * 16 + cn] = f2bf(X0[mt][nt][r]);
                    *(uint2*)RT_AT(nt * 16 + cn, mt * 16 + g4) = make_uint2(pack2(X0[mt][nt][0], X0[mt][nt][1]), pack2(X0[mt][nt][2], X0[mt][nt][3]));
                }
            asm volatile("s_waitcnt lgkmcnt(0)" ::: "memory");
            f32x4 R1[2][4];
#pragma unroll
            for (int nt = 0; nt < 4; ++nt) bfr[nt] = *(const bf16x8*)RT_AT(nt * 16 + cn, kg);
#pragma unroll
            for (int mt = 0; mt < 2; ++mt) {
                const bf16x8 af = *(const bf16x8*)(A1 + (mt * 16 + cn) * 40 + kg);
#pragma unroll
                for (int nt = 0; nt < 4; ++nt) {
                    const f32x4 pr = __builtin_amdgcn_mfma_f32_16x16x32_bf16(af, bfr[nt], (f32x4){0.f, 0.f, 0.f, 0.f}, 0, 0, 0);
                    const uint2 rr = *(const uint2*)RT_AT(nt * 16 + cn, 32 + mt * 16 + g4);
                    R1[mt][nt][0] = bflo(rr.x) - pr[0]; R1[mt][nt][1] = bfhi(rr.x) - pr[1];
                    R1[mt][nt][2] = bflo(rr.y) - pr[2]; R1[mt][nt][3] = bfhi(rr.y) - pr[3];
                }
            }
            asm volatile("s_waitcnt lgkmcnt(0)" ::: "memory");
#pragma unroll
            for (int mt = 0; mt < 2; ++mt)
#pragma unroll
                for (int nt = 0; nt < 4; ++nt)
                    *(uint2*)RT_AT(nt * 16 + cn, 32 + mt * 16 + g4) = make_uint2(pack2(R1[mt][nt][0], R1[mt][nt][1]), pack2(R1[mt][nt][2], R1[mt][nt][3]));
            asm volatile("s_waitcnt lgkmcnt(0)" ::: "memory");
#pragma unroll
            for (int nt = 0; nt < 4; ++nt) bfr[nt] = *(const bf16x8*)RT_AT(nt * 16 + cn, 32 + kg);
#pragma unroll
            for (int mt = 0; mt < 2; ++mt) {
                const bf16x8 af = *(const bf16x8*)(D1 + (mt * 16 + cn) * 40 + kg);
#pragma unroll
                for (int nt = 0; nt < 4; ++nt) {
                    const f32x4 x1 = __builtin_amdgcn_mfma_f32_16x16x32_bf16(af, bfr[nt], (f32x4){0.f, 0.f, 0.f, 0.f}, 0, 0, 0);
#pragma unroll
                    for (int r = 0; r < 4; ++r) dstb[(32 + mt * 16 + g4 + r) * 128 + cbase + nt * 16 + cn] = f2bf(x1[r]);
                }
            }
        }
    }
#undef RT_AT
}
typedef short s16x4 __attribute__((ext_vector_type(4)));
#define SCAN_KOFF(r_, ch_) (256 * (r_) + 16 * ((ch_) ^ ((((r_) & 3) << 2) | (((r_) >> 2) & 3))))
#define SCAN_SMEM_BYTES (17408 + 17408 + 9216 + 18432 + 8 * 4352 + 8 * 2 * 2304 + 512)
__device__ __forceinline__ void ph_e_scan(CP& p, int j, char* smem) {
    for (int st = lbid(); st < 192; st += gridDim.x) {
        const int tid = ltid(), lane = tid & 63, wave = tid >> 6;
        bf16_t* Ws = (bf16_t*)smem;
        bf16_t* Qs = Ws + 64 * 136;
        bf16_t* QKs = Qs + 64 * 136;
        bf16_t* KnT = QKs + 64 * 72;
        bf16_t* St = KnT + 128 * 72 + wave * (16 * 136);
        bf16_t* VNt = KnT + 128 * 72 + 8 * (16 * 136) + wave * (2 * 16 * 72);
        bf16_t* VNs = VNt + 16 * 72;
        float* gcs = (float*)((char*)KnT + 16384);
        const int g4 = (lane >> 4) * 4, cn = lane & 15;
        int seq, h, dir;
        if (st < 64) { seq = 16 + (st >> 3); h = (st >> 1) & 3; dir = st & 1; }
        else { const int q = st - 64; seq = q >> 3; h = (q >> 1) & 3; dir = q & 1; }
        const int L = seq < 16 ? 256 : 4096;
        const int s0 = seq < 16 ? seq * 256 : TP_TOK + (seq - 16) * 4096;
        const int nch = L / 64;
        f32x4 S[8][1];
        if (seq >= 16) {
            const float* sp = p.state_gdn + ((((long)(seq - 16) * 2 + j) * 2 + dir) * 4 + h) * 16384 + (g4 * 128 + wave * 16 + cn);
#pragma unroll
            for (int mt = 0; mt < 8; ++mt)
#pragma unroll
                for (int r = 0; r < 4; ++r) S[mt][0][r] = sp[(mt * 16 + r) * 128];
        } else {
#pragma unroll
            for (int mt = 0; mt < 8; ++mt) S[mt][0] = (f32x4){0.f, 0.f, 0.f, 0.f};
        }
        u32x4 pw[2], pq[2], pk[2], pqk;
        float pgc = 0.f;
        float pu[16];
#define SCAN_LOAD_MAIN(M)                                                                                              \
        {                                                                                                              \
            const long ud_ = ((long)(s0 / 64 + (M)) * 4 + h) * 2 + dir;                                               \
            _Pragma("unroll") for (int i_ = 0; i_ < 2; ++i_) {                                                       \
                const int id_ = tid + i_ * NTHREADS, c_ = id_ >> 4, ch_ = id_ & 15;                                   \
                const int t_ = dir ? s0 + L - 1 - ((M) * 64 + c_) : s0 + (M) * 64 + c_;                               \
                pw[i_] = *(const u32x4*)(p.Wb + ud_ * 8192 + c_ * 128 + ch_ * 8);                                     \
                pq[i_] = *(const u32x4*)(p.qn + ((long)t_ * 4 + h) * 128 + ch_ * 8);                                  \
                pk[i_] = *(const u32x4*)(p.kn + ((long)t_ * 4 + h) * 128 + ch_ * 8);                                  \
            }                                                                                                          \
            pqk = *(const u32x4*)(p.QKb + ud_ * 4096 + (tid >> 3) * 64 + (tid & 7) * 8);                              \
            if (tid < 192) pgc = p.gcb[ud_ * 192 + tid];                                                              \
        }
#define SCAN_LOAD_U(M)                                                                                                 \
        {                                                                                                              \
            const long ud_ = ((long)(s0 / 64 + (M)) * 4 + h) * 2 + dir;                                               \
            long uo_ = ud_ * 8192 + (g4 * 128 + wave * 16 + cn);                                                       \
            asm volatile("" : "+v"(uo_));        \
            const bf16_t* ub_ = p.Ub + uo_;                                                                            \
            _Pragma("unroll") for (int mt_ = 0; mt_ < 4; ++mt_)                                                      \
                _Pragma("unroll") for (int r_ = 0; r_ < 4; ++r_)                                                     \
                    pu[mt_ * 4 + r_] = bf2f(ub_[(mt_ * 16 + r_) * 128]);                                              \
        }
        SCAN_LOAD_MAIN(0)
        SCAN_LOAD_U(0)
        for (int m = 0; m < nch; ++m) {
            __syncthreads();
#pragma unroll
            for (int i = 0; i < 2; ++i) {
                const int id = tid + i * NTHREADS, c = id >> 4, ch = id & 15;
                *(u32x4*)(Ws + c * 136 + ch * 8) = pw[i];
                *(u32x4*)(Qs + c * 136 + ch * 8) = pq[i];
                *(u32x4*)((char*)KnT + SCAN_KOFF(c, ch)) = pk[i];
            }
            *(u32x4*)(QKs + (tid >> 3) * 72 + (tid & 7) * 8) = pqk;
            if (tid < 192) gcs[tid] = pgc;
#pragma unroll
            for (int mt = 0; mt < 8; ++mt)
                *(uint2*)(St + cn * 136 + mt * 16 + g4) = make_uint2(pack2(S[mt][0][0], S[mt][0][1]), pack2(S[mt][0][2], S[mt][0][3]));
            __syncthreads();
            if (m + 1 < nch) SCAN_LOAD_MAIN(m + 1)
            f32x4 ws[4][1], qs[4][1];
#pragma unroll
            for (int mt = 0; mt < 4; ++mt) { ws[mt][0] = (f32x4){0.f, 0.f, 0.f, 0.f}; qs[mt][0] = (f32x4){0.f, 0.f, 0.f, 0.f}; }
            wave_mma_u<4, 1, 4>(ws, Ws, 136, St, 136);
            wave_mma_u<4, 1, 4>(qs, Qs, 136, St, 136);
            const float glast = gcs[63];
            f32x4 vn[4];
#pragma unroll
            for (int mt = 0; mt < 4; ++mt) {
                float sc[4];
#pragma unroll
                for (int r = 0; r < 4; ++r) {
                    const int c = mt * 16 + g4 + r;
                    vn[mt][r] = pu[mt * 4 + r] - ws[mt][0][r];
                    sc[r] = vn[mt][r] * gcs[128 + c];
                }
                *(uint2*)(VNt + cn * 72 + mt * 16 + g4) = make_uint2(pack2(vn[mt][0], vn[mt][1]), pack2(vn[mt][2], vn[mt][3]));
                *(uint2*)(VNs + cn * 72 + mt * 16 + g4) = make_uint2(pack2(sc[0], sc[1]), pack2(sc[2], sc[3]));
            }
            if (m + 1 < nch) SCAN_LOAD_U(m + 1)
            asm volatile("s_waitcnt lgkmcnt(0)" ::: "memory");
            f32x4 oo[4][1];
#pragma unroll
            for (int mt = 0; mt < 4; ++mt)
#pragma unroll
                for (int r = 0; r < 4; ++r) oo[mt][0][r] = gcs[64 + mt * 16 + g4 + r] * qs[mt][0][r];
            wave_mma_u<4, 1, 2>(oo, QKs, 72, VNt, 72);
            {
                const int t0_ = dir ? s0 + L - 1 - (m * 64 + g4) : s0 + m * 64 + g4;
                long oo_ = ((long)t0_ * 4 + h) * 128 + wave * 16 + cn;
                asm volatile("" : "+v"(oo_));
                bf16_t* od = (dir ? p.ob : p.of) + oo_;
                if (dir) {
#pragma unroll
                    for (int mt = 0; mt < 4; ++mt)
#pragma unroll
                        for (int r = 0; r < 4; ++r) od[-(mt * 16 + r) * 512] = f2bf(oo[mt][0][r]);
                } else {
#pragma unroll
                    for (int mt = 0; mt < 4; ++mt)
#pragma unroll
                        for (int r = 0; r < 4; ++r) od[(mt * 16 + r) * 512] = f2bf(oo[mt][0][r]);
                }
            }
            const float eg = __expf(glast);
#pragma unroll
            for (int mt = 0; mt < 8; ++mt) S[mt][0] = S[mt][0] * eg;
            {
                const int q_ = (lane >> 2) & 3, pp_ = lane & 3, g_ = lane >> 4;
#pragma unroll
                for (int ks = 0; ks < 2; ++ks) {
                    const bf16x8 bfr = *(const bf16x8*)(VNs + cn * 72 + ks * 32 + g_ * 8);
                    s16x4 lo[8], hi[8];
#pragma unroll
                    for (int mt = 0; mt < 8; ++mt) {
                        const int r0 = ks * 32 + g_ * 8 + q_, chk = mt * 2 + (pp_ >> 1);
                        lo[mt] = __builtin_amdgcn_ds_read_tr16_b64_v4i16((__attribute__((address_space(3))) s16x4*)((char*)KnT + SCAN_KOFF(r0, chk) + 8 * (pp_ & 1)));
                        hi[mt] = __builtin_amdgcn_ds_read_tr16_b64_v4i16((__attribute__((address_space(3))) s16x4*)((char*)KnT + SCAN_KOFF(r0 + 4, chk) + 8 * (pp_ & 1)));
                    }
#pragma unroll
                    for (int mt = 0; mt < 8; ++mt) {
                        const bf16x8 afr = __builtin_shufflevector(lo[mt], hi[mt], 0, 1, 2, 3, 4, 5, 6, 7);
                        S[mt][0] = __builtin_amdgcn_mfma_f32_16x16x32_bf16(afr, bfr, S[mt][0], 0, 0, 0);
                    }
                }
            }
        }
#undef SCAN_LOAD_MAIN
#undef SCAN_LOAD_U
        if (seq < 16) {
            float* dp = p.out + OUT_STATE + ((((long)seq * 2 + j) * 2 + dir) * 4 + h) * 16384 + (g4 * 128 + wave * 16 + cn);
#pragma unroll
            for (int mt = 0; mt < 8; ++mt)
#pragma unroll
                for (int r = 0; r < 4; ++r) dp[(mt * 16 + r) * 128] = S[mt][0][r];
        }
    }
}

__device__ __forceinline__ void ph_fft_a(CP& p, char* smem) {
    __syncthreads();
    float* tws = (float*)(smem + GEMM_SMEM_BYTES);
    {
        const int t_ = ltid();
        f32x4 t4[4];
#pragma unroll
        for (int i = 0; i < 4; ++i) t4[i] = *(const f32x4*)(p.fftTW + (t_ + i * NTHREADS) * 4);
#pragma unroll
        for (int i = 0; i < 4; ++i) *(f32x4*)(tws + (t_ + i * NTHREADS) * 4) = t4[i];
    }
    __syncthreads();
    for (int u = lbid(); u < 1024; u += gridDim.x) {
        gemm_tile<0>(p.ZtA + ZA_OFF + (long)u * 256 * 128, 128, p.fftMA, 128, 128, (bf16_t*)smem, [&](int r, int c, f32x4 v) {
            const int gr = u * 256 + r;
            const int n2 = gr & 63, cf = (gr >> 6) & 511, b = gr >> 15;
            const int k1 = c >> 1, po = c & 1;
            f32x4 h;
#pragma unroll
            for (int i = 0; i < 4; ++i) {
                const float other = xshfl<1>(v[i]);
                const float2 tw = *(const float2*)(tws + ((n2 + i) * 64 + k1) * 2);
                h[i] = po == 0 ? (v[i] * tw.x + other * tw.y) : (v[i] * tw.x - other * tw.y);
            }
            bf16_t* dst = p.HB + (((((long)b * 64 + k1) * 512 + cf) * 2 + po) * 64 + n2);
            *(uint2*)dst = make_uint2(pack2(h[0], h[1]), pack2(h[2], h[3]));
        });
    }
}
__device__ __forceinline__ void ph_fft_b(CP& p, char* smem) {
    __syncthreads();
    const int nb = gridDim.x;
    for (int uu = lbid(); uu < 1024 + 64; uu += nb) {
        const int u = 1024 + 63 - uu;
        if (u < 0) continue;
        if (u < 1024) {
            gemm_tile<0>(p.HB + (long)u * 256 * 128, 128, p.fftMB, 128, 128, (bf16_t*)smem, [&](int r, int c, f32x4 v) {
                if (c < 64) {
                    const int gr = u * 256 + r;
                    const int cf = gr & 511, k1 = (gr >> 9) & 63, b = gr >> 15;
                    const long tok = TP_TOK + (long)b * 4096 + k1 + 64 * c;
                    *(uint2*)(p.mix + tok * DM + 512 + cf) = make_uint2(pack2(v[0], v[1]), pack2(v[2], v[3]));
                }
            });
        } else {
            const int q = u - 1024, seq = q >> 2, tm = (q >> 1) & 1, tn = q & 1;
            const int s0 = seq * 256;
            gemm_tile<0>(p.ZtA + (long)s0 * 1024 + (long)tm * 256 * 512, 512, p.dftP + (long)tn * 128 * 512, 512, 512, (bf16_t*)smem, [&](int r, int c, f32x4 v) {
                const int cf = tm * 256 + r, k = tn * 128 + c;
                *(uint2*)(p.mix + (long)(s0 + k) * DM + 512 + cf) = make_uint2(pack2(v[0], v[1]), pack2(v[2], v[3]));
            });
        }
    }
}

__device__ __forceinline__ void ph_e_mix(CP& p, int j) {
    const int lane = ltid() & 63, wave = ltid() >> 6;
    const float* onw = p.gdn_o_norm + j * 128;
    const float w0 = onw[lane * 2], w1 = onw[lane * 2 + 1];
    for (int row = lbid() * 8 + wave; row < T_TOK; row += gridDim.x * 8) {
        unsigned av[4], bv[4], gvv[4];
#pragma unroll
        for (int h = 0; h < 4; ++h) {
            av[h] = *(const unsigned*)(p.of + ((long)row * 4 + h) * 128 + lane * 2);
            bv[h] = *(const unsigned*)(p.ob + ((long)row * 4 + h) * 128 + lane * 2);
            gvv[h] = *(const unsigned*)(p.gate + (long)row * 512 + h * 128 + lane * 2);
        }
#pragma unroll
        for (int h = 0; h < 4; ++h) {
            const float o0 = bflo(av[h]) + bflo(bv[h]), o1 = bfhi(av[h]) + bfhi(bv[h]);
            const float ss = wave_sum(o0 * o0 + o1 * o1);
            const float r = rsqrtf(ss * (1.f / 128.f) + 1e-6f);
            *(unsigned*)(p.mix + (long)row * DM + h * 128 + lane * 2) = pack2(o0 * r * w0 * silu_f(bflo(gvv[h])), o1 * r * w1 * silu_f(bfhi(gvv[h])));
        }
    }
}

template <int FROM_INPUT = 0>
__device__ __forceinline__ void ph_out_gemm(CP& p, const bf16_t* A, const bf16_t* Wt, const float* mods_l, int g_off, char* smem, const float gscale = 1.f) {
    const int ntn = 4, ntm = T_TOK / 256;
#define OG_PROLOGUE(U) { int tm_, tn_; tile_map((U), ntm, ntn, tm_, tn_); g8_prologue<0>(A + (long)tm_ * 256 * DM, DM, Wt + (long)tn_ * 256 * 1024, 1024, (bf16_t*)smem); }
    int u = lbid();
    if (u < ntn * ntm) OG_PROLOGUE(u)
    for (; u < ntn * ntm; u += gridDim.x) {
        int tm, tn;
        tile_map(u, ntm, ntn, tm, tn);
        const int row0 = tm * 256, col0 = tn * 256;
        const float* gv = mods_l + (long)tok_modrow(row0) * 6144 + g_off;
        f32x4 acc[2][2][4][2];
        gemm_tile256_acc<0, 1>(A + (long)row0 * DM, DM, Wt + (long)col0 * 1024, 1024, 1024, (bf16_t*)smem, acc);
        if (u + (int)gridDim.x < ntn * ntm) OG_PROLOGUE(u + gridDim.x)
        const int tz = ltid(), wid = tz >> 6, lane = tz & 63, wr = wid >> 2, wc = wid & 3, fr = lane & 15, fq = lane >> 4;
#pragma unroll
        for (int ai = 0; ai < 2; ++ai)
#pragma unroll
            for (int bj = 0; bj < 2; ++bj) {
                const long xo = (long)(row0 + ai * 128 + wr * 64 + fq * 4) * DM + col0 + bj * 128 + wc * 32 + fr;
                float* xb = p.out + xo;
                const float* xs = FROM_INPUT ? (row0 < TP_TOK ? p.x_prompt + xo : p.x_sample + (xo - (long)TP_TOK * DM)) : xb;
                const float g0 = gv[col0 + bj * 128 + wc * 32 + fr] * gscale, g1 = gv[col0 + bj * 128 + wc * 32 + 16 + fr] * gscale;
                float xv[4][2][4];
#pragma unroll
                for (int m = 0; m < 4; ++m)
#pragma unroll
                    for (int n = 0; n < 2; ++n)
#pragma unroll
                        for (int i = 0; i < 4; ++i) xv[m][n][i] = xs[(long)(m * 16 + i) * DM + n * 16];
#pragma unroll
                for (int m = 0; m < 4; ++m)
#pragma unroll
                    for (int n = 0; n < 2; ++n)
#pragma unroll
                        for (int i = 0; i < 4; ++i) xb[(long)(m * 16 + i) * DM + n * 16] = xv[m][n][i] + (n ? g1 : g0) * acc[ai][bj][m][n][i];
            }
    }
#undef OG_PROLOGUE
}
__device__ __forceinline__ void ph_o_gemm1(CP& p, int j, char* smem) {
    const int ntn = N_OIN / 256, ntm = T_TOK / 256;
    const bf16_t* Bt = p.wtO_in + (long)j * N_OIN * 1024;
    for (int u = lbid(); u < ntn * ntm; u += gridDim.x) {
        int tm, tn;
        tile_map(u, ntm, ntn, tm, tn);
        const int row0 = tm * 256, col0 = tn * 256;
        gemm_tile256<0>(p.H + (long)row0 * DM, DM, Bt + (long)col0 * 1024, 1024, 1024, (bf16_t*)smem, [&](int r, int c, f32x4 v) {
            const int col = col0 + c;
            if (col < 832) {
#pragma unroll
                for (int i = 0; i < 4; ++i) p.Podd[(long)(row0 + r + i) * 832 + col] = v[i];
            }
        });
    }
}

__device__ __forceinline__ void ph_o_norm(CP& p, int j) {
    const int lane = ltid() & 63, wave = ltid() >> 6;
    float qw[8], kw[4];
#pragma unroll
    for (int i = 0; i < 8; ++i) qw[i] = p.mla_q_norm[j * 512 + i * 64 + lane];
#pragma unroll
    for (int i = 0; i < 4; ++i) kw[i] = p.mla_kv_norm[j * 256 + i * 64 + lane];
    for (int row = lbid() * 8 + wave; row < T_TOK + 2048; row += gridDim.x * 8) {
        if (row < T_TOK) {
            const float* pr = p.Podd + (long)row * 832;
            float q[8], k[4];
            float ssq = 0.f, ssk = 0.f;
#pragma unroll
            for (int i = 0; i < 8; ++i) { q[i] = pr[i * 64 + lane]; ssq += q[i] * q[i]; }
#pragma unroll
            for (int i = 0; i < 4; ++i) { k[i] = pr[512 + i * 64 + lane]; ssk += k[i] * k[i]; }
            const float kr = pr[768 + lane];
            ssq = wave_sum(ssq); ssk = wave_sum(ssk);
            const float rq = rsqrtf(ssq * (1.f / 512.f) + 1e-6f), rk = rsqrtf(ssk * (1.f / 256.f) + 1e-6f);
#pragma unroll
            for (int i = 0; i < 8; ++i) p.cq[(long)row * 512 + i * 64 + lane] = f2bf(q[i] * rq * qw[i]);
#pragma unroll
            for (int i = 0; i < 4; ++i) {
                const float v = k[i] * rk * kw[i];
                p.ckv_all[(long)row * 256 + i * 64 + lane] = f2bf(v);
                if (row < TP_TOK) p.out[OUT_CKV + (((long)(row >> 8) * 2 + j) * 256 + (row & 255)) * 256 + i * 64 + lane] = v;
            }
            p.kr_all[(long)row * 64 + lane] = kr;
            if (row < TP_TOK) p.out[OUT_KR + (((long)(row >> 8) * 2 + j) * 256 + (row & 255)) * 64 + lane] = kr;
        } else {
            const int rc = row - T_TOK, b = rc >> 8, t = rc & 255;
            const float* src = p.cache_ckv + (((long)b * 2 + j) * 256 + t) * 256;
#pragma unroll
            for (int i = 0; i < 4; ++i) p.ckv_all[(long)row * 256 + i * 64 + lane] = f2bf(src[i * 64 + lane]);
            p.kr_all[(long)row * 64 + lane] = p.cache_kr[(((long)b * 2 + j) * 256 + t) * 64 + lane];
        }
    }
}

#define KB_S (16L * 8 * 256 * 192)
#define VT_S (16L * 8 * 128 * 256)
__device__ __forceinline__ void ph_o_gemm2(CP& p, int j, char* smem) {
    const int nA = 6 * (T_TOK / 256);
    const int nB = 8 * ((T_TOK + 2048) / 256);
    for (int u = lbid(); u < nA + nB; u += gridDim.x) {
        if (u < nA) {
            int tm, tn;
            tile_map(u, T_TOK / 256, 6, tm, tn);
            const int row0 = tm * 256, col0 = tn * 256;
            const int s0 = tok_seq0(row0), L = tok_len(row0);
            f32x4 acc[2][2][4][2];
            gemm_tile256_acc<0>(p.cq + (long)row0 * 512, 512, p.wtUq + (long)j * 1536 * 512 + (long)col0 * 512, 512, 512, (bf16_t*)smem, acc);
            const int tz = ltid(), wid = tz >> 6, lane = tz & 63, wr = wid >> 2, wc = wid & 3, fr = lane & 15, fq = lane >> 4;
#pragma unroll
            for (int bj = 0; bj < 2; ++bj)
#pragma unroll
                for (int n = 0; n < 2; ++n) {
                    const int col = col0 + bj * 128 + wc * 32 + n * 16 + fr, h = col / 192, d = col - h * 192;
                    bf16_t* qd = p.Qb + (long)s0 * 1536 + ((long)h * L + (row0 - s0) + wr * 64 + fq * 4) * 192 + d;
#pragma unroll
                    for (int ai = 0; ai < 2; ++ai)
#pragma unroll
                        for (int m = 0; m < 4; ++m)
#pragma unroll
                            for (int i = 0; i < 4; ++i) qd[(ai * 128 + m * 16 + i) * 192] = f2bf(acc[ai][bj][m][n][i]);
                }
        } else {
            const int q = u - nA;
            int tm, tn;
            tile_map(q, (T_TOK + 2048) / 256, 8, tm, tn);
            const int row0 = tm * 256, col0 = tn * 256;
            long kbase, vbase; int Lk, pos0;
            if (row0 < TP_TOK) { const int s = row0 >> 8; kbase = (long)s * 8 * 256 * 192; vbase = (long)s * 8 * 128 * 256; Lk = 256; pos0 = 0; }
            else if (row0 < T_TOK) { const int b = (row0 - TP_TOK) >> 12; kbase = KB_S + (long)b * 8 * 4352 * 192; vbase = VT_S + (long)b * 8 * 128 * 4352; Lk = 4352; pos0 = (row0 - TP_TOK) & 4095; }
            else { const int b = (row0 - T_TOK) >> 8; kbase = KB_S + (long)b * 8 * 4352 * 192; vbase = VT_S + (long)b * 8 * 128 * 4352; Lk = 4352; pos0 = 4096; }
            f32x4 acc[2][2][4][2];
            gemm_tile256_acc<0>(p.ckv_all + (long)row0 * 256, 256, p.wtUkv + (long)j * 2048 * 256 + (long)col0 * 256, 256, 256, (bf16_t*)smem, acc);
            const int tz = ltid(), wid = tz >> 6, lane = tz & 63, wr = wid >> 2, wc = wid & 3, fr = lane & 15, fq = lane >> 4;
            const int h = tn;
            bf16_t* kd = p.Kb + kbase + ((long)h * Lk + pos0 + wr * 64 + fq * 4) * 192 + wc * 32 + fr;
#pragma unroll
            for (int ai = 0; ai < 2; ++ai)
#pragma unroll
                for (int m = 0; m < 4; ++m)
#pragma unroll
                    for (int i = 0; i < 4; ++i)
#pragma unroll
                        for (int n = 0; n < 2; ++n) kd[(ai * 128 + m * 16 + i) * 192 + n * 16] = f2bf(acc[ai][0][m][n][i]);
            bf16_t* vd = p.Vtb + vbase + ((long)h * 128 + wc * 32 + fr) * Lk;
#pragma unroll
            for (int ai = 0; ai < 2; ++ai)
#pragma unroll
                for (int m = 0; m < 4; ++m) {
                    const int kp = pos0 + ai * 128 + wr * 64 + m * 16 + fq * 4, kq = (kp & ~31) | (((kp >> 2) & 3) << 3) | (((kp >> 4) & 1) << 2);
#pragma unroll
                    for (int n = 0; n < 2; ++n) {
                        const f32x4 v = acc[ai][1][m][n];
                        *(uint2*)(vd + (long)n * 16 * Lk + kq) = make_uint2(pack2(v[0], v[1]), pack2(v[2], v[3]));
                    }
                }
        }
    }
}

__device__ __forceinline__ void ph_o_qknorm(CP& p, int j) {
    const int lane = ltid() & 63, wave = ltid() >> 6;
    const float* qnw = p.mla_q_headnorm + j * 192;
    const float* knw = p.mla_k_headnorm + j * 192;
    const float qw0 = qnw[lane], qw1 = qnw[64 + lane], qw2 = qnw[128 + lane];
    const float kw0 = knw[lane], kw1 = knw[64 + lane], kw2 = knw[128 + lane];
    const float inv = exp2f(-(float)(lane & 15) * 0.8304820237218406f);
    for (int row = lbid() * 8 + wave; row < T_TOK + 2048; row += gridDim.x * 8) {
        bool rope = false; float cs = 1.f, sn = 0.f;
        long kbase; int Lk, pos;
        if (row < TP_TOK) { const int s = row >> 8; kbase = (long)s * 8 * 256 * 192; Lk = 256; pos = row & 255; }
        else if (row < T_TOK) {
            const int b = (row - TP_TOK) >> 12; pos = (row - TP_TOK) & 4095; kbase = KB_S + (long)b * 8 * 4352 * 192; Lk = 4352; rope = true;
            const float ang = (float)((lane & 32) ? (pos & 63) : (pos >> 6)) * inv;
            sincosf(ang, &sn, &cs);
        } else { const int rc = row - T_TOK; const int b = rc >> 8; pos = 4096 + (rc & 255); kbase = KB_S + (long)b * 8 * 4352 * 192; Lk = 4352; }
        const float kr = p.kr_all[(long)row * 64 + lane];
        const bool hi = (lane & 16) != 0;
        const bool isq = row < T_TOK;
        const int s0 = isq ? tok_seq0(row) : 0, L = isq ? tok_len(row) : 1;
        bf16_t* kp0 = p.Kb + kbase + (long)pos * 192;
        bf16_t* qp0 = p.Qb + (long)s0 * 1536 + (long)(row - s0) * 192;
        float k0[8], k1[8], q0[8], q1[8], q2[8];
#pragma unroll
        for (int h = 0; h < 8; ++h) {
            const bf16_t* kp = kp0 + (long)h * Lk * 192;
            k0[h] = bf2f(kp[lane]); k1[h] = bf2f(kp[64 + lane]);
        }
        if (isq) {
#pragma unroll
            for (int h = 0; h < 8; ++h) {
                const bf16_t* qp = qp0 + (long)h * L * 192;
                q0[h] = bf2f(qp[lane]); q1[h] = bf2f(qp[64 + lane]); q2[h] = bf2f(qp[128 + lane]);
            }
        }
#pragma unroll
        for (int h = 0; h < 8; ++h) {
            bf16_t* kp = kp0 + (long)h * Lk * 192;
            const float ss = wave_sum(k0[h] * k0[h] + k1[h] * k1[h] + kr * kr);
            const float r = rsqrtf(ss * (1.f / 192.f) + 1e-6f);
            float y2 = kr * r * kw2;
            if (rope) {
                const float o = xshfl<16>(y2);
                y2 = hi ? (o * sn + y2 * cs) : (y2 * cs - o * sn);
            }
            kp[lane] = f2bf(k0[h] * r * kw0); kp[64 + lane] = f2bf(k1[h] * r * kw1); kp[128 + lane] = f2bf(y2);
        }
        if (isq) {
#pragma unroll
            for (int h = 0; h < 8; ++h) {
                bf16_t* qp = qp0 + (long)h * L * 192;
                const float ss = wave_sum(q0[h] * q0[h] + q1[h] * q1[h] + q2[h] * q2[h]);
                const float r = rsqrtf(ss * (1.f / 192.f) + 1e-6f) * 0.10411755f;
                float y2 = q2[h] * r * qw2;
                if (rope) {
                    const float o = xshfl<16>(y2);
                    y2 = hi ? (o * sn + y2 * cs) : (y2 * cs - o * sn);
                }
                qp[lane] = f2bf(q0[h] * r * qw0); qp[64 + lane] = f2bf(q1[h] * r * qw1); qp[128 + lane] = f2bf(y2);
            }
        }
    }
}

#define ATT_KLD 208
#define ATT_VLD 80
#define ATTN_SMEM_BYTES (2 * 64 * ATT_KLD * 2 + 3 * 128 * ATT_VLD * 2)
__device__ __forceinline__ void ph_o_attn(CP& p, char* smem) {
    for (int u = lbid(); u < 1152; u += gridDim.x) {
        int lz = 0, tid = ltid();
        asm volatile("" : "+s"(lz), "+v"(tid));
        const int lane = tid & 63, wave = tid >> 6;
        const int g = lane >> 4, cn = lane & 15, kg = g * 8;
        bf16_t* Ks = (bf16_t*)(smem + lz);
        bf16_t* Vs = Ks + 2 * 64 * ATT_KLD;
        int s0, L, Lk, h, q0; long kbase, vbase;
        if (u < 1024) { const int b = u >> 7; h = (u >> 4) & 7; q0 = (u & 15) * 256; s0 = TP_TOK + b * 4096; L = 4096; Lk = 4352; kbase = KB_S + (long)b * 8 * 4352 * 192; vbase = VT_S + (long)b * 8 * 128 * 4352; }
        else { const int q = u - 1024; const int s = q >> 3; h = q & 7; q0 = 0; s0 = s * 256; L = 256; Lk = 256; kbase = (long)s * 8 * 256 * 192; vbase = (long)s * 8 * 128 * 256; }
        const bf16_t* Qp = p.Qb + (long)s0 * 1536 + ((long)h * L + q0 + wave * 32) * 192;
        const bf16_t* Kp = p.Kb + kbase + (long)h * Lk * 192;
        const bf16_t* Vp = p.Vtb + vbase + (long)h * 128 * Lk;
        bf16x8 qb[2][6];
#pragma unroll
        for (int mt = 0; mt < 2; ++mt)
#pragma unroll
            for (int ks = 0; ks < 6; ++ks) qb[mt][ks] = *(const bf16x8*)(Qp + (mt * 16 + cn) * 192 + ks * 32 + kg);
        f32x4 o[8][2];
        f32x4 negm[2];
        float lrow[2];
#pragma unroll
        for (int mt = 0; mt < 2; ++mt) {
#pragma unroll
            for (int dt = 0; dt < 8; ++dt) o[dt][mt] = (f32x4){0.f, 0.f, 0.f, 0.f};
            negm[mt] = (f32x4){0.f, 0.f, 0.f, 0.f}; lrow[mt] = 0.f;
        }
        const int nkt = Lk / 64;
        u32x4 rk[3], rv[2];
        f32x4 s[4][2];
        bf16x8 pb[2][2];
        bf16x8 fa[2][4];
#define ATT_SB() __builtin_amdgcn_sched_barrier(0)
#define ATT_LDK(dst_, Kc_, ks_) _Pragma("unroll") for (int nt = 0; nt < 4; ++nt) dst_[nt] = *(const bf16x8*)((Kc_) + (nt * 16 + cn) * ATT_KLD + (ks_) * 32 + kg)
#define ATT_LDV(dst_, Vc_, b_) _Pragma("unroll") for (int d4 = 0; d4 < 4; ++d4) dst_[d4] = *(const bf16x8*)((Vc_) + ((((b_) & 1) * 4 + d4) * 16 + cn) * ATT_VLD + ((b_) >> 1) * 32 + kg)
        float pv[2][4][4];
#define ATT_LDK2(dst_, Kc_, h_, ks_) _Pragma("unroll") for (int n_ = 0; n_ < 2; ++n_) dst_[n_] = *(const bf16x8*)((Kc_) + ((2 * (h_) + n_) * 16 + cn) * ATT_KLD + (ks_) * 32 + kg)
#define ATT_PACK(mt_, k2_)                                                                                             \
        {                                                                                                              \
            u32x4 w_;                                                                                                  \
            w_[0] = pack2(pv[mt_][2 * (k2_)][0], pv[mt_][2 * (k2_)][1]); w_[1] = pack2(pv[mt_][2 * (k2_)][2], pv[mt_][2 * (k2_)][3]);   \
            w_[2] = pack2(pv[mt_][2 * (k2_) + 1][0], pv[mt_][2 * (k2_) + 1][1]); w_[3] = pack2(pv[mt_][2 * (k2_) + 1][2], pv[mt_][2 * (k2_) + 1][3]);   \
            pb[mt_][k2_] = __builtin_bit_cast(bf16x8, w_);                                                             \
        }
#define ATT_QK(Kc_, Vc_)                                                                                               \
        {                                                                                                              \
            ATT_LDK2(fa[0], Kc_, 0, 0);                                                                                \
            _Pragma("unroll") for (int t_ = 0; t_ < 12; ++t_) {                                                      \
                const int h_ = t_ / 6, ks = t_ % 6;                                                                    \
                if (t_ < 11) { ATT_LDK2(fa[(t_ + 1) & 1], Kc_, (t_ + 1) / 6, (t_ + 1) % 6); } else { ATT_LDV(fa[0], Vc_, 0); }   \
                ATT_SB();                                                                                              \
                _Pragma("unroll") for (int n_ = 0; n_ < 2; ++n_)                                                     \
                    _Pragma("unroll") for (int mt = 0; mt < 2; ++mt)                                                 \
                        s[2 * h_ + n_][mt] = __builtin_amdgcn_mfma_f32_16x16x32_bf16(fa[t_ & 1][n_], qb[mt][ks], ks == 0 ? negm[mt] : s[2 * h_ + n_][mt], 0, 0, 0);   \
                if (h_ == 1 && ks < 4) {                                                                               \
                    _Pragma("unroll") for (int r = 0; r < 4; ++r) pv[ks >> 1][ks & 1][r] = __builtin_amdgcn_exp2f(s[ks & 1][ks >> 1][r]);   \
                }                                                                                                      \
                if (h_ == 1 && ks >= 4) ATT_PACK(ks - 4, 0)                                                            \
                if (t_ < 11) ATT_SB();                                                                                 \
            }                                                                                                          \
        }
#define ATT_PBIG 4096.f
#define ATT_SOFTMAX(first_)                                                                                            \
        {                                                                                                              \
            float ps[2];                                                                                               \
            _Pragma("unroll") for (int mt = 0; mt < 2; ++mt) {                                                       \
                _Pragma("unroll") for (int nt = 2; nt < 4; ++nt)                                                     \
                    _Pragma("unroll") for (int r = 0; r < 4; ++r) pv[mt][nt][r] = __builtin_amdgcn_exp2f(s[nt][mt][r]);   \
                ps[mt] = 0.f;                                                                                          \
                _Pragma("unroll") for (int nt = 0; nt < 4; ++nt)                                                     \
                    _Pragma("unroll") for (int r = 0; r < 4; ++r) ps[mt] += pv[mt][nt][r];                           \
            }                                                                                                          \
            const bool ok = !(first_) && ps[0] <= ATT_PBIG && ps[1] <= ATT_PBIG;                                       \
            if (!__all(ok)) {                                                                                          \
                _Pragma("unroll") for (int mt = 0; mt < 2; ++mt) {                                                   \
                    float mx = fmaxf(fmaxf(s[0][mt][0], s[0][mt][1]), fmaxf(s[0][mt][2], s[0][mt][3]));               \
                    _Pragma("unroll") for (int nt = 1; nt < 4; ++nt) mx = fmaxf(mx, fmaxf(fmaxf(s[nt][mt][0], s[nt][mt][1]), fmaxf(s[nt][mt][2], s[nt][mt][3])));   \
                    mx = fmaxf(mx, xshfl<16>(mx));                                                                     \
                    mx = fmaxf(mx, xshfl<32>(mx));                                                                     \
                    const float dl = (first_) ? mx : fmaxf(mx, 0.f);                                                   \
                    const float al = (first_) ? 1.f : __builtin_amdgcn_exp2f(-dl);                                     \
                    negm[mt] = negm[mt] - dl;                                                                          \
                    lrow[mt] *= al;                                                                                    \
                    _Pragma("unroll") for (int dt = 0; dt < 8; ++dt) o[dt][mt] = o[dt][mt] * al;                     \
                    ps[mt] = 0.f;                                                                                      \
                    _Pragma("unroll") for (int nt = 0; nt < 4; ++nt)                                                 \
                        _Pragma("unroll") for (int r = 0; r < 4; ++r) { pv[mt][nt][r] = __builtin_amdgcn_exp2f(s[nt][mt][r] - dl); ps[mt] += pv[mt][nt][r]; }   \
                    ATT_PACK(mt, 0)                                                                                    \
                }                                                                                                      \
            }                                                                                                          \
            _Pragma("unroll") for (int mt = 0; mt < 2; ++mt) {                                                       \
                lrow[mt] += ps[mt];                                                                                    \
                ATT_PACK(mt, 1)                                                                                        \
            }                                                                                                          \
        }
#define ATT_PV(Vc_)                                                                                                    \
        {                                                                                                              \
            _Pragma("unroll") for (int b = 0; b < 4; ++b) {                                                          \
                if (b < 3) { ATT_LDV(fa[(b + 1) & 1], Vc_, b + 1); }                                                   \
                ATT_SB();                                                                                              \
                _Pragma("unroll") for (int d4 = 0; d4 < 4; ++d4)                                                     \
                    _Pragma("unroll") for (int mt = 0; mt < 2; ++mt) o[(b & 1) * 4 + d4][mt] = __builtin_amdgcn_mfma_f32_16x16x32_bf16(fa[b & 1][d4], pb[mt][b >> 1], o[(b & 1) * 4 + d4][mt], 0, 0, 0);   \
                ATT_SB();                                                                                              \
            }                                                                                                          \
        }
        __syncthreads();
#pragma unroll
        for (int i = 0; i < 3; ++i) { const int ch = tid + i * 512, row = ch / 24, kc = ch % 24; rk[i] = *(const u32x4*)(Kp + (long)row * 192 + kc * 8); }
#pragma unroll
        for (int i = 0; i < 2; ++i) { const int ch = tid + i * 512, row = ch >> 3, kc = ch & 7; rv[i] = *(const u32x4*)(Vp + (long)row * Lk + kc * 8); }
#pragma unroll
        for (int i = 0; i < 3; ++i) { const int ch = tid + i * 512, row = ch / 24, kc = ch % 24; *(u32x4*)(Ks + row * ATT_KLD + kc * 8) = rk[i]; }
#pragma unroll
        for (int i = 0; i < 2; ++i) { const int ch = tid + i * 512, row = ch >> 3, kc = ch & 7; *(u32x4*)(Vs + row * ATT_VLD + kc * 8) = rv[i]; }
        __syncthreads();
        for (int it = 0; it < nkt; ++it) {
            const int cur = it & 1;
            const bool more = it + 1 < nkt;
            const long key0 = (long)(it + 1) * 64;
            if (more) {
#pragma unroll
                for (int i = 0; i < 3; ++i) { const int ch = tid + i * 512, row = ch / 24, kc = ch % 24; rk[i] = *(const u32x4*)(Kp + (key0 + row) * 192 + kc * 8); }
#pragma unroll
                for (int i = 0; i < 2; ++i) { const int ch = tid + i * 512, row = ch >> 3, kc = ch & 7; rv[i] = *(const u32x4*)(Vp + (long)row * Lk + key0 + kc * 8); }
            }
            const bf16_t* Kc = Ks + cur * 64 * ATT_KLD;
            ATT_QK(Kc, Vs + cur * 128 * ATT_VLD) ATT_SOFTMAX(it == 0) ATT_PV(Vs + cur * 128 * ATT_VLD)
            if (more) {
                bf16_t* Kn = Ks + (cur ^ 1) * 64 * ATT_KLD;
                bf16_t* Vn = Vs + (cur ^ 1) * 128 * ATT_VLD;
#pragma unroll
                for (int i = 0; i < 3; ++i) { const int ch = tid + i * 512, row = ch / 24, kc = ch % 24; *(u32x4*)(Kn + row * ATT_KLD + kc * 8) = rk[i]; }
#pragma unroll
                for (int i = 0; i < 2; ++i) { const int ch = tid + i * 512, row = ch >> 3, kc = ch & 7; *(u32x4*)(Vn + row * ATT_VLD + kc * 8) = rv[i]; }
            }
            __syncthreads();
        }
#undef ATT_QK
#undef ATT_SB
#undef ATT_LDK
#undef ATT_LDV
#undef ATT_SOFTMAX
#undef ATT_LDK2
#undef ATT_PACK
#undef ATT_PBIG
#undef ATT_PV
#pragma unroll
        for (int mt = 0; mt < 2; ++mt) {
            float l = lrow[mt];
            l += xshfl<16>(l); l += xshfl<32>(l);
            const float il = __builtin_amdgcn_rcpf(l);
            bf16_t* op = p.Ob + (long)(s0 + q0 + wave * 32 + mt * 16 + cn) * DM + h * 128 + 4 * g;
#pragma unroll
            for (int dt = 0; dt < 8; ++dt)
                *(uint2*)(op + dt * 16) = make_uint2(pack2(o[dt][mt][0] * il, o[dt][mt][1] * il), pack2(o[dt][mt][2] * il, o[dt][mt][3] * il));
        }
    }
}
__device__ __forceinline__ unsigned f2ord(float f) { const unsigned u = __float_as_uint(f); return u ^ ((u >> 31) ? 0xFFFFFFFFu : 0x80000000u); }
__device__ __forceinline__ float ord2f(unsigned o) { const unsigned u = (o >> 31) ? (o ^ 0x80000000u) : ~o; return __uint_as_float(u); }

#define KCE(a, b) { const unsigned hi_ = max(a, b), lo_ = min(a, b); a = hi_; b = lo_; }
__device__ __forceinline__ void sort16_desc(unsigned (&v)[16]) {
#define S2(a, b) KCE(v[a], v[b])
    S2(0, 13) S2(1, 12) S2(2, 15) S2(3, 14) S2(4, 8) S2(5, 6) S2(7, 11) S2(9, 10)
    S2(0, 5) S2(1, 7) S2(2, 9) S2(3, 4) S2(6, 13) S2(8, 14) S2(10, 15) S2(11, 12)
    S2(0, 1) S2(2, 3) S2(4, 5) S2(6, 8) S2(7, 9) S2(10, 11) S2(12, 13) S2(14, 15)
    S2(0, 2) S2(1, 3) S2(4, 10) S2(5, 11) S2(6, 7) S2(8, 9) S2(12, 14) S2(13, 15)
    S2(1, 2) S2(3, 12) S2(4, 6) S2(5, 7) S2(8, 10) S2(9, 11) S2(13, 14)
    S2(1, 4) S2(2, 6) S2(5, 8) S2(7, 10) S2(9, 13) S2(11, 14)
    S2(2, 4) S2(3, 6) S2(9, 12) S2(11, 13)
    S2(3, 5) S2(6, 8) S2(7, 9) S2(10, 12)
    S2(3, 4) S2(5, 6) S2(7, 8) S2(9, 10) S2(11, 12)
    S2(6, 7) S2(8, 9)
#undef S2
}
#define KCF(a, b) { const float hi_ = __builtin_fmaxf(a, b), lo_ = __builtin_fminf(a, b); a = hi_; b = lo_; }
__device__ __forceinline__ void sort16f_desc(float (&v)[16]) {
#define S2(a, b) KCF(v[a], v[b])
    S2(0, 13) S2(1, 12) S2(2, 15) S2(3, 14) S2(4, 8) S2(5, 6) S2(7, 11) S2(9, 10)
    S2(0, 5) S2(1, 7) S2(2, 9) S2(3, 4) S2(6, 13) S2(8, 14) S2(10, 15) S2(11, 12)
    S2(0, 1) S2(2, 3) S2(4, 5) S2(6, 8) S2(7, 9) S2(10, 11) S2(12, 13) S2(14, 15)
    S2(0, 2) S2(1, 3) S2(4, 10) S2(5, 11) S2(6, 7) S2(8, 9) S2(12, 14) S2(13, 15)
    S2(1, 2) S2(3, 12) S2(4, 6) S2(5, 7) S2(8, 10) S2(9, 11) S2(13, 14)
    S2(1, 4) S2(2, 6) S2(5, 8) S2(7, 10) S2(9, 13) S2(11, 14)
    S2(2, 4) S2(3, 6) S2(9, 12) S2(11, 13)
    S2(3, 5) S2(6, 8) S2(7, 9) S2(10, 12)
    S2(3, 4) S2(5, 6) S2(7, 8) S2(9, 10) S2(11, 12)
    S2(6, 7) S2(8, 9)
#undef S2
}
__device__ __forceinline__ void merge16f_desc(float (&a)[16], const float (&b)[16]) {
#pragma unroll
    for (int i = 0; i < 16; ++i) a[i] = __builtin_fmaxf(a[i], b[15 - i]);
#pragma unroll
    for (int j = 8; j > 0; j >>= 1)
#pragma unroll
        for (int i = 0; i < 16; ++i) {
            const int l = i ^ j;
            if (l > i) { KCF(a[i], a[l]) }
        }
}
__device__ __forceinline__ void merge16_desc(unsigned (&a)[16], const unsigned (&b)[16]) {
#pragma unroll
    for (int i = 0; i < 16; ++i) a[i] = max(a[i], b[15 - i]);
#pragma unroll
    for (int j = 8; j > 0; j >>= 1)
#pragma unroll
        for (int i = 0; i < 16; ++i) {
            const int l = i ^ j;
            if (l > i) { KCE(a[i], a[l]) }
        }
}

#define RT_QLD 144
#define RT_SLD 130
#define ROUTE_SMEM_BYTES (256 * RT_SLD * 4 + 256 * 32)
__device__ __forceinline__ void ph_p_route(CP& p, int l, char* smem) {
    const int ntm = T_TOK / 256;
    const bf16_t* Bt = p.wtPq + (long)l * 2048 * 1024;
    for (int u = lbid(); u < 8 * ntm; u += gridDim.x) {
        int tm, h;
        tile_map(u, ntm, 8, tm, h);
        const int row0 = tm * 256;
        bf16_t* Qs = (bf16_t*)smem;
        bf16_t* SK = (bf16_t*)(smem + 65536);
        float* sc = (float*)smem;
        unsigned char* ib = (unsigned char*)smem + 256 * RT_SLD * 4;
        __syncthreads();
        f32x4 acc[2][2][4][2];
        gemm_tile256_acc<0>(p.H + (long)row0 * DM, DM, Bt + (long)h * 256 * 1024, 1024, 1024, (bf16_t*)smem, acc);
        const int tid = ltid(), lane = tid & 63, wave = tid >> 6;
        const int g4 = (lane >> 4) * 4, cn = lane & 15, kg = (lane >> 4) * 8;
        const int wr = wave >> 2, wc = wave & 3, fr = cn, fq = lane >> 4;
        const int trow = tid >> 1, half = tid & 1;
        float top[2][16];
#pragma unroll
        for (int pp = 0; pp < 2; ++pp) {
            __syncthreads();
#pragma unroll
            for (int ai = 0; ai < 2; ++ai)
#pragma unroll
                for (int m = 0; m < 4; ++m)
#pragma unroll
                    for (int n = 0; n < 2; ++n) {
                        const f32x4 v = acc[ai][pp][m][n];
                        *(uint2*)((char*)Qs + ai * 32768 + SCAN_KOFF(wc * 32 + n * 16 + fr, wr * 8 + m * 2 + (fq >> 1)) + (fq & 1) * 8) = make_uint2(pack2(v[0], v[1]), pack2(v[2], v[3]));
                    }
            {
                const bf16_t* skg = p.subk + ((long)l * 16 + h * 2 + pp) * 128 * 128;
                u32x4 kv[4];
#pragma unroll
                for (int i = 0; i < 4; ++i) kv[i] = *(const u32x4*)(skg + (tid + i * NTHREADS) * 8);
#pragma unroll
                for (int i = 0; i < 4; ++i) { const int ch = tid + i * NTHREADS; *(u32x4*)(SK + (ch >> 4) * RT_QLD + (ch & 15) * 8) = kv[i]; }
            }
            __syncthreads();
            f32x4 sacc[2][8];
#pragma unroll
            for (int mt = 0; mt < 2; ++mt)
#pragma unroll
                for (int nt = 0; nt < 8; ++nt) sacc[mt][nt] = (f32x4){0.f, 0.f, 0.f, 0.f};
            {
                const int q_ = (lane >> 2) & 3, pp_ = lane & 3;
                const char* qi = (const char*)Qs + (wave >> 2) * 32768;
#pragma unroll
                for (int ks = 0; ks < 4; ++ks) {
                    bf16x8 bfr[8];
#pragma unroll
                    for (int nt = 0; nt < 8; ++nt) bfr[nt] = *(const bf16x8*)(SK + (nt * 16 + cn) * RT_QLD + ks * 32 + kg);
#pragma unroll
                    for (int mt = 0; mt < 2; ++mt) {
                        const int d0 = ks * 32 + fq * 8 + q_, chk = (wave & 3) * 4 + mt * 2 + (pp_ >> 1);
                        const s16x4 lo = __builtin_amdgcn_ds_read_tr16_b64_v4i16((__attribute__((address_space(3))) s16x4*)(qi + SCAN_KOFF(d0, chk) + 8 * (pp_ & 1)));
                        const s16x4 hi = __builtin_amdgcn_ds_read_tr16_b64_v4i16((__attribute__((address_space(3))) s16x4*)(qi + SCAN_KOFF(d0 + 4, chk) + 8 * (pp_ & 1)));
                        const bf16x8 afr = __builtin_shufflevector(lo, hi, 0, 1, 2, 3, 4, 5, 6, 7);
#pragma unroll
                        for (int nt = 0; nt < 8; ++nt) sacc[mt][nt] = __builtin_amdgcn_mfma_f32_16x16x32_bf16(afr, bfr[nt], sacc[mt][nt], 0, 0, 0);
                    }
                }
            }
            __syncthreads();
#pragma unroll
            for (int mt = 0; mt < 2; ++mt)
#pragma unroll
                for (int nt = 0; nt < 8; ++nt)
#pragma unroll
                    for (int r = 0; r < 4; ++r) sc[(wave * 32 + mt * 16 + g4 + r) * RT_SLD + nt * 16 + cn] = sacc[mt][nt][r];
            __syncthreads();
            const float* srow = sc + trow * RT_SLD + half;
#pragma unroll
            for (int grp = 0; grp < 4; ++grp) {
                float v[16];
#pragma unroll
                for (int i = 0; i < 16; ++i) {
                    const int k = grp * 16 + i;
                    v[i] = __uint_as_float((__float_as_uint(srow[2 * k]) & 0xFFFFFF00u) | (unsigned)(2 * k));
                }
                sort16f_desc(v);
                if (grp == 0) {
#pragma unroll
                    for (int i = 0; i < 16; ++i) top[pp][i] = v[i];
                } else merge16f_desc(top[pp], v);
            }
            float oth[16];
#pragma unroll
            for (int i = 0; i < 16; ++i) top[pp][i] = __uint_as_float(__float_as_uint(top[pp][i]) | (unsigned)half);
#pragma unroll
            for (int i = 0; i < 16; ++i) oth[i] = xshfl<1>(top[pp][i]);
            merge16f_desc(top[pp], oth);
        }
        if (half == 0) {
            float s0[16], s1[16];
            unsigned iw[8];
#pragma unroll
            for (int i = 0; i < 8; ++i) iw[i] = 0u;
#pragma unroll
            for (int i = 0; i < 16; ++i) {
                s0[i] = __uint_as_float((__float_as_uint(top[0][i]) & 0xFFFFFF00u) | 0x80u);
                s1[i] = __uint_as_float((__float_as_uint(top[1][i]) & 0xFFFFFF00u) | 0x80u);
                iw[i >> 2] |= (__float_as_uint(top[0][i]) & 0xFFu) << ((i & 3) * 8);
                iw[4 + (i >> 2)] |= (__float_as_uint(top[1][i]) & 0xFFu) << ((i & 3) * 8);
            }
            unsigned* ibw = (unsigned*)(ib + trow * 32);
#pragma unroll
            for (int i = 0; i < 8; ++i) ibw[i] = iw[i];
            float ct[16];
            {
                float cg[4][16];
#pragma unroll
                for (int g_ = 0; g_ < 4; ++g_)
#pragma unroll
                    for (int i = 0; i < 16; ++i) cg[g_][i] = -3.0e38f;
                int cnt = 0;
#pragma unroll
                for (int a2 = 0; a2 < 16; ++a2)
#pragma unroll
                    for (int b2 = 0; b2 < 16; ++b2)
                        if ((a2 + 1) * (b2 + 1) <= 16) {
                            cg[cnt >> 4][cnt & 15] = __uint_as_float((__float_as_uint(s0[a2] + s1[b2]) & 0xFFFFFF00u) | (unsigned)(255 - (a2 * 16 + b2)));
                            ++cnt;
                        }
                if (s0[0] + s1[15] < 0.f) sort16f_desc(cg[0]);
                sort16f_desc(cg[1]); sort16f_desc(cg[2]);
                KCF(cg[3][0], cg[3][1])
#pragma unroll
                for (int i = 0; i < 16; ++i) ct[i] = cg[0][i];
                merge16f_desc(ct, cg[1]); merge16f_desc(ct, cg[2]); merge16f_desc(ct, cg[3]);
            }
            float cv[16];
#pragma unroll
            for (int i = 0; i < 16; ++i) cv[i] = __uint_as_float((__float_as_uint(ct[i]) & 0xFFFFFF00u) | 0x80u);
            const float mx = cv[0];
            float sum = 0.f;
#pragma unroll
            for (int i = 0; i < 16; ++i) { cv[i] = __expf(cv[i] - mx); sum += cv[i]; }
            const float inv = 1.f / sum;
            const long ob = ((long)(row0 + trow) * 8 + h) * 16;
            asm volatile("s_waitcnt lgkmcnt(0)" ::: "memory");
            const unsigned char* ibr = ib + trow * 32;
#pragma unroll
            for (int i = 0; i < 16; ++i) {
                const int fl = 255 - (int)(__float_as_uint(ct[i]) & 255u), a2 = fl >> 4, b2 = fl & 15;
                p.eidx[ob + i] = (int)ibr[a2] * 128 + (int)ibr[16 + b2];
                p.pgate[ob + i] = cv[i] * inv;
            }
        }
    }
}

#define PE_T 2
#define PE_LOADU(RA, BB, T_)                                                                                       \
    _Pragma("unroll") for (int k_ = 0; k_ < 8; ++k_) {                                                           \
        const int kk_ = (BB) * 8 + k_;                                                                           \
        const int e_ = __builtin_amdgcn_readlane((BB) < 8 ? e0[T_] : e1[T_], kk_ & 63);                          \
        RA[k_] = *(const u32x4*)(tabu + (long)e_ * 1024);                                                        \
    }
#define PE_LOADV(RA, BB, T_)                                                                                       \
    _Pragma("unroll") for (int k_ = 0; k_ < 8; ++k_) {                                                           \
        const int kk_ = (BB) * 8 + k_;                                                                           \
        const int e_ = __builtin_amdgcn_readlane((BB) < 8 ? e0[T_] : e1[T_], kk_ & 63);                          \
        RA[k_] = *(const u32x4*)(tabv + (long)e_ * 1024);                                                        \
    }
#define PE_X1(v_) __builtin_amdgcn_mov_dpp((int)(v_), 0xB1, 0xF, 0xF, true)
#define PE_X2(v_) __builtin_amdgcn_mov_dpp((int)(v_), 0x4E, 0xF, 0xF, true)
#define PE_X4(v_) __builtin_amdgcn_update_dpp(__builtin_amdgcn_update_dpp(0, (int)(v_), 0x104, 0xF, 0x5, false), (int)(v_), 0x114, 0xF, 0xA, false)
#define PE_X8(v_) __builtin_amdgcn_mov_dpp((int)(v_), 0x128, 0xF, 0xF, true)
#define PE_BREV(k_) ((((k_) & 1) << 2) | ((k_) & 2) | (((k_) >> 2) & 1))
#define PE_DOT(UA, BB, T_)                                                                                         \
    {                                                                                                              \
        int d_[8];                                                                                                 \
        _Pragma("unroll") for (int k_ = 0; k_ < 8; ++k_) {                                                       \
            int a_ = __builtin_amdgcn_sdot4((int)UA[k_][0], qx[T_][0], 0, false);                                \
            a_ = __builtin_amdgcn_sdot4((int)UA[k_][1], qx[T_][1], a_, false);                                   \
            a_ = __builtin_amdgcn_sdot4((int)UA[k_][2], qx[T_][2], a_, false);                                   \
            d_[k_] = __builtin_amdgcn_sdot4((int)UA[k_][3], qx[T_][3], a_, false);                               \
        }                                                                                                          \
               \
        int t4_[4], t2_[2], t1_;                                                                                   \
        _Pragma("unroll") for (int i_ = 0; i_ < 4; ++i_) { const int snd_ = b2 ? d_[i_] : d_[i_ + 4]; const int kp_ = b2 ? d_[i_ + 4] : d_[i_]; t4_[i_] = kp_ + PE_X4(snd_); } \
        _Pragma("unroll") for (int i_ = 0; i_ < 2; ++i_) { const int snd_ = b1 ? t4_[i_] : t4_[i_ + 2]; const int kp_ = b1 ? t4_[i_ + 2] : t4_[i_]; t2_[i_] = kp_ + PE_X2(snd_); } \
        { const int snd_ = b0 ? t2_[0] : t2_[1]; const int kp_ = b0 ? t2_[1] : t2_[0]; t1_ = kp_ + PE_X1(snd_); }  \
        t1_ += PE_X8(t1_);                                                                                         \
        t1_ += xshfl_i<16>(t1_);                                                                                       \
        t1_ += xshfl_i<32>(t1_);                                                                                       \
                                         \
        const bool mine_ = (lane >> 3) == ((BB) & 7);                                                              \
        hlo[T_] = (mine_ && (BB) < 8) ? t1_ : hlo[T_];                                                             \
        hhi[T_] = (mine_ && (BB) >= 8) ? t1_ : hhi[T_];                                                            \
    }
#define PE_AXPY(VA, BB, T_)                                                                                        \
    {                                                                                                              \
        const unsigned psel_ = (BB) < 8 ? pklo[T_] : pkhi[T_];                                                     \
        _Pragma("unroll") for (int h_ = 0; h_ < 2; ++h_) {                                                       \
            const int wp_ = __builtin_amdgcn_readlane((int)psel_, ((BB) & 7) * 8 + h_ * 4);                        \
            _Pragma("unroll") for (int i_ = 0; i_ < 4; ++i_) {                                                   \
                const unsigned a_ = VA[h_ * 4][i_], b_ = VA[h_ * 4 + 1][i_], c_ = VA[h_ * 4 + 2][i_], d_ = VA[h_ * 4 + 3][i_];   \
                const unsigned t0_ = __builtin_amdgcn_perm(b_, a_, 0x05010400u), t1_ = __builtin_amdgcn_perm(b_, a_, 0x07030602u);   \
                const unsigned t2_ = __builtin_amdgcn_perm(d_, c_, 0x05010400u), t3_ = __builtin_amdgcn_perm(d_, c_, 0x07030602u);   \
                acc[T_][i_ * 4 + 0] = __builtin_amdgcn_sdot4((int)__builtin_amdgcn_perm(t2_, t0_, 0x05040100u), wp_, acc[T_][i_ * 4 + 0], false);   \
                acc[T_][i_ * 4 + 1] = __builtin_amdgcn_sdot4((int)__builtin_amdgcn_perm(t2_, t0_, 0x07060302u), wp_, acc[T_][i_ * 4 + 1], false);   \
                acc[T_][i_ * 4 + 2] = __builtin_amdgcn_sdot4((int)__builtin_amdgcn_perm(t3_, t1_, 0x05040100u), wp_, acc[T_][i_ * 4 + 2], false);   \
                acc[T_][i_ * 4 + 3] = __builtin_amdgcn_sdot4((int)__builtin_amdgcn_perm(t3_, t1_, 0x07060302u), wp_, acc[T_][i_ * 4 + 3], false);   \
            }                                                                                                      \
        }                                                                                                          \
    }
template <int NEXT = 0>
__device__ __forceinline__ void ph_p_eval(CP& p, const float* mods_l, int l, const float* w_next, const float* mods_next, const float gscale = 1.f) {
    const int lane = ltid() & 63, wave = ltid() >> 6;
    const bool b0 = (lane & 1) != 0, b1 = (lane & 2) != 0, b2 = (lane & 4) != 0;
    const int rstride = gridDim.x * 8;
    const int first = lbid() * 8 + wave;
    const int ntok = (T_TOK - first + rstride - 1) / rstride;
    const int nsweep = __builtin_amdgcn_readfirstlane((T_TOK - lbid() * 8 + rstride - 1) / rstride + PE_T - 1) / PE_T;
    const unsigned char* tabu = p.tabU + (long)(l & 1) * 16384 * 2048 + lane * 16;
    const unsigned char* tabv = tabu + 16384L * 1024;
    const float* su_ = p.su + (l & 1) * 32768; const float* sv_ = su_ + 16384;
    u32x4 hpa[PE_T], hpb[PE_T]; unsigned kp0[PE_T], kp1[PE_T];
#define PE_PREFETCH(SW)                                                                                            \
    _Pragma("unroll") for (int t = 0; t < PE_T; ++t) {                                                           \
        const int ti_ = (SW) * PE_T + t;                                                                           \
        const long row_ = first + (ti_ < ntok ? ti_ : 0) * rstride;                                                \
        hpa[t] = *(const u32x4*)(p.H + row_ * DM + lane * 16); hpb[t] = *(const u32x4*)(p.H + row_ * DM + lane * 16 + 8);   \
        kp0[t] = (unsigned)p.eidx[row_ * 128 + lane]; kp1[t] = (unsigned)p.eidx[row_ * 128 + 64 + lane];          \
    }
    int e0[PE_T], e1[PE_T];
    float sgu0[PE_T], sgu1[PE_T], sgv0[PE_T], sgv1[PE_T];
    u32x4 rA[8], rB[8];
#define PE_SORT(SW)                                                                                                \
    _Pragma("unroll") for (int t = 0; t < PE_T; ++t) {                                                           \
        const int ti_ = (SW) * PE_T + t;                                                                           \
        const long row_ = first + (ti_ < ntok ? ti_ : 0) * rstride;                                                \
          \
        unsigned k0 = (kp0[t] << 7) | (unsigned)lane;                                                              \
        unsigned k1 = (kp1[t] << 7) | (unsigned)(64 + lane);                                                       \
        _Pragma("unroll") for (int size = 2; size <= 128; size <<= 1) {                                          \
            _Pragma("unroll") for (int stride = size >> 1; stride > 0; stride >>= 1) {                           \
                if (stride == 64) {                                                                                \
                    const unsigned lo = min(k0, k1), hi = max(k0, k1);                                             \
                    k0 = lo; k1 = hi;                                                                              \
                } else {                                                                                           \
                    unsigned o0, o1;                                                                               \
                    if (stride == 1) { o0 = (unsigned)PE_X1(k0); o1 = (unsigned)PE_X1(k1); }                       \
                    else if (stride == 2) { o0 = (unsigned)PE_X2(k0); o1 = (unsigned)PE_X2(k1); }                  \
                    else if (stride == 4) { o0 = (unsigned)PE_X4(k0); o1 = (unsigned)PE_X4(k1); }                  \
                    else if (stride == 8) { o0 = (unsigned)PE_X8(k0); o1 = (unsigned)PE_X8(k1); }                  \
                    else if (stride == 16) { o0 = (unsigned)xshfl_i<16>((int)k0); o1 = (unsigned)xshfl_i<16>((int)k1); }   \
                    else { o0 = (unsigned)xshfl_i<32>((int)k0); o1 = (unsigned)xshfl_i<32>((int)k1); }             \
                    const bool lower = (lane & stride) == 0;                                                       \
                    const bool asc0 = size == 128 ? true : ((lane & size) == 0);                                   \
                    const bool asc1 = size == 128 ? true : (((lane + 64) & size) == 0);                            \
                    k0 = (lower == asc0) ? min(k0, o0) : max(k0, o0);                                              \
                    k1 = (lower == asc1) ? min(k1, o1) : max(k1, o1);                                              \
                }                                                                                                  \
            }                                                                                                      \
        }                                                                                                          \
        e0[t] = (int)(k0 >> 7); e1[t] = (int)(k1 >> 7);                                                            \
        const int sl0 = (int)(k0 & 127u), sl1 = (int)(k1 & 127u);                                                  \
          \
        sgu0[t] = su_[e0[t]]; sgu1[t] = su_[e1[t]];                                                                \
        sgv0[t] = p.pgate[row_ * 128 + sl0] * sv_[e0[t]]; sgv1[t] = p.pgate[row_ * 128 + sl1] * sv_[e1[t]];        \
    }
    PE_PREFETCH(0)
    PE_SORT(0)
    PE_LOADU(rA, 0, 0)
    for (int sw = 0; sw < nsweep; ++sw) {
        __syncthreads();
        int rows[PE_T]; bool valid[PE_T];
        int qx[PE_T][4];
        float wlo[PE_T], whi[PE_T], swq[PE_T], sxv[PE_T];
        int hlo[PE_T], hhi[PE_T];
        int acc[PE_T][16];
        unsigned pklo[PE_T], pkhi[PE_T];
#pragma unroll
        for (int t = 0; t < PE_T; ++t) {
            const int ti = sw * PE_T + t;
            valid[t] = ti < ntok;
            const int row = first + (valid[t] ? ti : 0) * rstride;
            rows[t] = row;
            float x[16];
            {
                const u32x4 a = hpa[t], b = hpb[t];
#pragma unroll
                for (int i = 0; i < 4; ++i) { x[2 * i] = bflo(a[i]); x[2 * i + 1] = bfhi(a[i]); x[8 + 2 * i] = bflo(b[i]); x[8 + 2 * i + 1] = bfhi(b[i]); }
            }
            float mx = 0.f;
#pragma unroll
            for (int i = 0; i < 16; ++i) mx = fmaxf(mx, fabsf(x[i]));
            mx = wave_max(mx);
            const float sx = mx > 0.f ? mx * (1.f / 127.f) : 1.f;
            const float isx = 1.f / sx;
#pragma unroll
            for (int i = 0; i < 4; ++i) {
                unsigned pk = 0;
#pragma unroll
                for (int q = 0; q < 4; ++q) pk |= (unsigned)((int)rintf(x[i * 4 + q] * isx) & 0xFF) << (q * 8);
                qx[t][i] = (int)pk;
            }
            sxv[t] = sx;
            hlo[t] = 0; hhi[t] = 0;
#pragma unroll
            for (int i = 0; i < 16; ++i) acc[t][i] = 0;
        }
        for (int bb = 0; bb < 16; ++bb) {
            if ((bb & 3) == 0) __builtin_amdgcn_s_barrier();
            PE_LOADU(rB, bb, 1)
            PE_DOT(rA, bb, 0)
            if (bb + 1 < 16) { PE_LOADU(rA, bb + 1, 0) } else { PE_LOADV(rA, 0, 0) }
            PE_DOT(rB, bb, 1)
        }
#pragma unroll
        for (int t = 0; t < PE_T; ++t) {
            wlo[t] = sgv0[t] * gelu_tanh(sgu0[t] * sxv[t] * (float)hlo[t]); whi[t] = sgv1[t] * gelu_tanh(sgu1[t] * sxv[t] * (float)hhi[t]);
            float am = fmaxf(fabsf(wlo[t]), fabsf(whi[t]));
            am = wave_max(am);
            swq[t] = am > 0.f ? am * (1.f / 127.f) : 1.f;
            const float iw = 1.f / swq[t];
            const unsigned q0 = (unsigned)((int)rintf(wlo[t] * iw) & 0xFF), q1 = (unsigned)((int)rintf(whi[t] * iw) & 0xFF);
            const unsigned a0 = q0 | ((unsigned)xshfl_i<1>((int)q0) << 8);
            const unsigned a1 = q1 | ((unsigned)xshfl_i<1>((int)q1) << 8);
            pklo[t] = a0 | ((unsigned)xshfl_i<2>((int)a0) << 16);
            pkhi[t] = a1 | ((unsigned)xshfl_i<2>((int)a1) << 16);
        }
        if (sw + 1 < nsweep) { PE_PREFETCH(sw + 1) }
        f32x4 xvp[PE_T][4];
#pragma unroll
        for (int t = 0; t < PE_T; ++t)
#pragma unroll
            for (int q = 0; q < 4; ++q) xvp[t][q] = *(const f32x4*)(p.out + (long)rows[t] * DM + lane * 16 + q * 4);
        for (int bb = 0; bb < 16; ++bb) {
            if ((bb & 3) == 0) __builtin_amdgcn_s_barrier();
            PE_LOADV(rB, bb, 1)
            PE_AXPY(rA, bb, 0)
            if (bb + 1 < 16) { PE_LOADV(rA, bb + 1, 0) }
            PE_AXPY(rB, bb, 1)
        }
        if (sw + 1 < nsweep) { PE_SORT(sw + 1) PE_LOADU(rA, 0, 0) }
#pragma unroll
        for (int t = 0; t < PE_T; ++t) {
            if (!valid[t]) continue;
            const int row = rows[t];
            float y[16];
#pragma unroll
            for (int i = 0; i < 16; ++i) y[i] = swq[t] * (float)acc[t][i];
            const float* gv = mods_l + (long)tok_modrow(row) * 6144 + 5 * 1024;
            float* xr = p.out + (long)row * DM + lane * 16;
            float4 xv[4], gg[4];
#pragma unroll
            for (int q = 0; q < 4; ++q) { xv[q] = make_float4(xvp[t][q][0], xvp[t][q][1], xvp[t][q][2], xvp[t][q][3]); gg[q] = *(const float4*)(gv + lane * 16 + q * 4); }
            float4 nw[4], nsc[4], nsh[4];
            if (NEXT) {
                const float* mr = mods_next + (long)tok_modrow(row) * 6144;
#pragma unroll
                for (int q = 0; q < 4; ++q) { nw[q] = *(const float4*)(w_next + lane * 16 + q * 4); nsc[q] = *(const float4*)(mr + 1024 + lane * 16 + q * 4); nsh[q] = *(const float4*)(mr + lane * 16 + q * 4); }
            }
            float ss = 0.f;
#pragma unroll
            for (int q = 0; q < 4; ++q) {
                xv[q].x += gscale * gg[q].x * y[q * 4 + 0]; xv[q].y += gscale * gg[q].y * y[q * 4 + 1];
                xv[q].z += gscale * gg[q].z * y[q * 4 + 2]; xv[q].w += gscale * gg[q].w * y[q * 4 + 3];
                *(float4*)(xr + q * 4) = xv[q];
                ss += xv[q].x * xv[q].x + xv[q].y * xv[q].y + xv[q].z * xv[q].z + xv[q].w * xv[q].w;
            }
            if (NEXT) {
                ss = wave_sum(ss);
                const float r = rsqrtf(ss * (1.f / 1024.f) + 1e-6f);
#pragma unroll
                for (int q = 0; q < 4; ++q) {
                    const float h0 = xv[q].x * r * nw[q].x * (1.f + nsc[q].x) + nsh[q].x, h1 = xv[q].y * r * nw[q].y * (1.f + nsc[q].y) + nsh[q].y;
                    const float h2 = xv[q].z * r * nw[q].z * (1.f + nsc[q].z) + nsh[q].z, h3 = xv[q].w * r * nw[q].w * (1.f + nsc[q].w) + nsh[q].w;
                    *(uint2*)(p.H + (long)row * DM + lane * 16 + q * 4) = make_uint2(pack2(h0, h1), pack2(h2, h3));
                }
            }
        }
    }
}
#define SMEM_MAX 147456

#define BARRIER() do { XcdBarrier b_; b_.bar = p.bar; b_.x = xb_xcc_id(); b_.st = (volatile LAS unsigned*)(smem + SMEM_MAX); xcd_barrier(b_); } while (0)
__device__ __forceinline__ CP& kparams() {
    CP* kp = (CP*)__builtin_amdgcn_kernarg_segment_ptr();
    asm volatile("" : "+s"(kp));
    return *kp;
}
__global__ void __launch_bounds__(NTHREADS, 2) k_mega(Params p_unused) {
    extern __shared__ __attribute__((aligned(16))) char smem[];
#define p kparams()
    if (threadIdx.x == 0) *(uint4*)(smem + SMEM_MAX) = make_uint4(0u, 0u, 0u, 0u);
    __syncthreads();
    (void)xcd_barrier_post(p.bar, (volatile LAS unsigned*)(smem + SMEM_MAX));
    ph_init(p, smem);
    BARRIER();
#pragma unroll
    for (int l = 0; l < 4; ++l) {
        const int j = l >> 1;
#define mods_l (kparams().mods + (long)l * 9 * 6144)
        if (l == 0) {
            ph_norm<1>(p, p.norm_mix, mods_l, 0, 1024);
            BARRIER();
        }
        if ((l & 1) == 0) {
            ph_e_gemm(p, j, smem);
            BARRIER();
            ph_e_prep(p, j, smem);
            ph_fft_a(p, smem);
            BARRIER();
            ph_e_scan(p, j, smem);
            ph_fft_b(p, smem);
            ph_tab(p, l, 64);
            ph_tab(p, l + 1, 64);
            if (l == 0) ph_init2(p, smem, 64);
            BARRIER();
            ph_e_mix(p, j);
            BARRIER();
            if (l == 0) ph_out_gemm<1>(p, p.mix, p.wtE_out + (long)j * 1024 * 1024, mods_l, 2 * 1024, smem);
            else ph_out_gemm<0>(p, p.mix, p.wtE_out + (long)j * 1024 * 1024, mods_l, 2 * 1024, smem);
            BARRIER();
        } else {
            ph_o_gemm1(p, j, smem);
            BARRIER();
            ph_o_norm(p, j);
            BARRIER();
            ph_o_gemm2(p, j, smem);
            BARRIER();
            ph_o_qknorm(p, j);
            BARRIER();
            ph_o_attn(p, smem);
            BARRIER();
            ph_out_gemm(p, p.Ob, p.wtO_out + (long)j * 1024 * 1024, mods_l, 2 * 1024, smem);
            BARRIER();
        }
        ph_norm(p, p.norm_ffn + l * 1024, mods_l, 3 * 1024, 4 * 1024);
        BARRIER();
        ph_p_route(p, l, smem);
        BARRIER();
        if (l < 3) ph_p_eval<1>(p, mods_l, l, p.norm_mix + (l + 1) * 1024, p.mods + (long)(l + 1) * 9 * 6144);
        else ph_p_eval<0>(p, mods_l, l, p.norm_mix, p.mods);
        if (l < 3) BARRIER();
    }
#undef p
#undef mods_l
}

static inline size_t al256(size_t x) { return (x + 255) & ~(size_t)255; }

extern "C" void kernel_launch(void* const* d_in, const int* in_sizes, int n_in, void* d_out, int out_size, void* d_ws, size_t ws_size, hipStream_t stream) {
    Params p{};
    const float* const* in = (const float* const*)d_in;
    p.x_prompt = in[0]; p.x_sample = in[1]; p.state_gdn = in[2]; p.cache_ckv = in[3]; p.cache_kr = in[4]; p.c = in[5]; p.c_ctx = in[6];
    p.w_mod = in[7]; p.b_mod = in[8]; p.norm_mix = in[9]; p.norm_ffn = in[10];
    p.even_w_in = in[11]; p.even_conv_w = in[12]; p.gdn_a_log = in[13]; p.gdn_dt_bias = in[14]; p.gdn_o_norm = in[15]; p.even_w_out = in[16];
    p.odd_w_in = in[17]; p.mla_q_norm = in[18]; p.mla_kv_norm = in[19]; p.mla_w_uq = in[20]; p.mla_w_ukv = in[21]; p.mla_q_headnorm = in[22]; p.mla_k_headnorm = in[23]; p.odd_w_out = in[24];
    p.peer_w_q = in[25]; p.peer_sub_keys = in[26]; p.peer_u = in[27]; p.peer_v = in[28];
    p.out = (float*)d_out;
    char* ws = (char*)d_ws;
    size_t off = 0;
    auto take = [&](size_t bytes) { char* r = ws + off; off = al256(off + bytes); return r; };
    p.bar = (unsigned*)take(16384);
    p.mods = (float*)take(4L * 9 * 6144 * 4);
    p.wtE_in = (bf16_t*)take(2L * N_EIN * 1024 * 2);
    p.wtE_out = (bf16_t*)take(2L * 1024 * 1024 * 2);
    p.wtO_in = (bf16_t*)take(2L * N_OIN * 1024 * 2);
    p.wtUq = (bf16_t*)take(2L * 1536 * 512 * 2);
    p.wtUkv = (bf16_t*)take(2L * 2048 * 256 * 2);
    p.wtO_out = (bf16_t*)take(2L * 1024 * 1024 * 2);
    p.wtPq = (bf16_t*)take(4L * 2048 * 1024 * 2);
    p.subk = (bf16_t*)take(4L * 16 * 128 * 128 * 2);
    p.fftMA = (bf16_t*)take(128L * 128 * 2);
    p.fftMB = (bf16_t*)take(128L * 128 * 2);
    p.fftTW = (float*)take(4096L * 2 * 4);
    p.dftP = (bf16_t*)take(256L * 512 * 2);
    p.tabU = (unsigned char*)take(2L * 16384 * 2048);
    p.tabV = p.tabU;
    p.su = (float*)take(2L * 32768 * 4);
    p.sv = p.su;
    p.H = (bf16_t*)take((long)T_TOK * 1024 * 2);
    const size_t ubase = off;
    p.qkvraw = (bf16_t*)take((long)T_TOK * 1536 * 2);
    p.mix = p.qkvraw;
    p.gate = (bf16_t*)take((long)T_TOK * 512 * 2);
    p.ba = (float*)take((long)T_TOK * 16 * 4);
    p.ZtA = (bf16_t*)take((long)T_TOK * 1024 * 2);
    p.qn = (bf16_t*)take((long)T_TOK * 512 * 2);
    p.kn = (bf16_t*)take((long)T_TOK * 512 * 2);
    p.Wb = (bf16_t*)take(4608L * 8192 * 2);
    p.Ub = (bf16_t*)take(4608L * 8192 * 2);
    p.QKb = (bf16_t*)take(4608L * 4096 * 2);
    p.gcb = (float*)take(4608L * 192 * 4);
    p.of = (bf16_t*)take((long)T_TOK * 512 * 2);
    p.ob = (bf16_t*)take((long)T_TOK * 512 * 2);
    p.HB = (bf16_t*)take(8L * 64 * 512 * 2 * 64 * 2);
    const size_t even_end = off;
    off = ubase;
    p.Podd = (float*)take((long)T_TOK * 832 * 4);
    p.Ob = (bf16_t*)p.Podd;
    p.cq = (bf16_t*)take((long)T_TOK * 512 * 2);
    p.ckv_all = (bf16_t*)take((long)(T_TOK + 2048) * 256 * 2);
    p.kr_all = (float*)take((long)(T_TOK + 2048) * 64 * 4);
    p.Qb = (bf16_t*)take((long)T_TOK * 1536 * 2);
    p.Kb = (bf16_t*)take((KB_S + 8L * 8 * 4352 * 192) * 2);
    p.Vtb = (bf16_t*)take((VT_S + 8L * 8 * 128 * 4352) * 2);
    const size_t odd_end = off;
    off = ubase;
    p.eidx = (int*)take((long)T_TOK * 128 * 4);
    p.pgate = (float*)take((long)T_TOK * 128 * 4);
    const size_t peer_end = off;
    size_t need = even_end > odd_end ? even_end : odd_end;
    if (peer_end > need) need = peer_end;
    if (need > ws_size) return;

    static int grid = 0;
    if (!grid) {
        int dev = 0, cus = 0, per_cu = 0;
        hipGetDevice(&dev);
        hipDeviceGetAttribute(&cus, hipDeviceAttributeMultiprocessorCount, dev);
        if (hipFuncSetAttribute((const void*)k_mega, hipFuncAttributeMaxDynamicSharedMemorySize, SMEM_MAX + 16) != hipSuccess) return;
        if (hipOccupancyMaxActiveBlocksPerMultiprocessor(&per_cu, (const void*)k_mega, NTHREADS, SMEM_MAX + 16) != hipSuccess || per_cu < 1) return;
        grid = cus;
    }
    hipMemsetAsync(p.bar, 0, XCD_BAR_WORDS * sizeof(unsigned), stream);
    hipLaunchKernelGGL(k_mega, dim3(grid), dim3(NTHREADS), SMEM_MAX + 16, stream, p);
}
```

```cpp
#include <hip/hip_runtime.h>
#include <stdint.h>

typedef unsigned short bf16_t;
typedef short bf16x8 __attribute__((ext_vector_type(8)));
typedef float f32x4 __attribute__((ext_vector_type(4)));
typedef unsigned u32x4 __attribute__((ext_vector_type(4)));
typedef int i32x4 __attribute__((ext_vector_type(4)));

#define T_TOK   36864
#define TP_TOK  4096
#define DM      1024
#define NTHREADS 512
#define N_EIN   3328
#define N_OIN   1024
#define OUT_STATE 37748736L
#define OUT_CKV   41943040L
#define OUT_KR    44040192L

struct Params {
    const float *x_prompt, *x_sample, *state_gdn, *cache_ckv, *cache_kr, *c, *c_ctx, *w_mod, *b_mod, *norm_mix, *norm_ffn;
    const float *even_w_in, *even_conv_w, *gdn_a_log, *gdn_dt_bias, *gdn_o_norm, *even_w_out;
    const float *odd_w_in, *mla_q_norm, *mla_kv_norm, *mla_w_uq, *mla_w_ukv, *mla_q_headnorm, *mla_k_headnorm, *odd_w_out;
    const float *peer_w_q, *peer_sub_keys, *peer_u, *peer_v;
    float* out;
    unsigned* bar;
    float* mods;
    bf16_t *wtE_in, *wtE_out, *wtO_in, *wtUq, *wtUkv, *wtO_out, *wtPq, *subk, *dftP, *fftMA, *fftMB, *HB;
    float* fftTW;
    unsigned char *tabU, *tabV;
    float *su, *sv;
    bf16_t* H;
    bf16_t *qkvraw, *gate, *ZtA, *qn, *kn, *Wb, *Ub, *QKb, *of, *ob, *mix;
    float *ba, *gcb;
    float *Podd, *kr_all;
    bf16_t *cq, *ckv_all, *Qb, *Kb, *Vtb, *Ob;
    float* pgate;
    int* eidx;
};

typedef const Params __attribute__((address_space(4))) CP;

__device__ __forceinline__ int ltid() { int t = threadIdx.x; asm volatile("" : "+v"(t)); return t; }
__device__ __forceinline__ int lbid() { int b = blockIdx.x; asm volatile("" : "+s"(b)); return b; }
typedef __bf16 bf16v2 __attribute__((ext_vector_type(2)));
typedef float f32x2 __attribute__((ext_vector_type(2)));
__device__ __forceinline__ bf16_t f2bf(float f) { return __builtin_bit_cast(unsigned short, (__bf16)f); }
__device__ __forceinline__ float bf2f(bf16_t h) { return __uint_as_float(((unsigned)h) << 16); }
__device__ __forceinline__ unsigned pack2(float lo, float hi) { const f32x2 v = {lo, hi}; return __builtin_bit_cast(unsigned, __builtin_convertvector(v, bf16v2)); }
__device__ __forceinline__ float bflo(unsigned u) { return __uint_as_float(u << 16); }
__device__ __forceinline__ float bfhi(unsigned u) { return __uint_as_float(u & 0xFFFF0000u); }
__device__ __forceinline__ float silu_f(float x) { return x / (1.f + __expf(-x)); }
__device__ __forceinline__ float sigmoid_f(float x) { return 1.f / (1.f + __expf(-x)); }
__device__ __forceinline__ float softplus_f(float x) { return fmaxf(x, 0.f) + __logf(1.f + __expf(-fabsf(x))); }
__device__ __forceinline__ float gelu_tanh(float x) {
    const float u = 0.7978845608028654f * (x + 0.044715f * x * x * x);
    return 0.5f * x * (1.f + tanhf(u));
}
template <int M>
__device__ __forceinline__ int xshfl_i(int v) {
    if constexpr (M == 1) return __builtin_amdgcn_mov_dpp(v, 0xB1, 0xF, 0xF, true);
    else if constexpr (M == 2) return __builtin_amdgcn_mov_dpp(v, 0x4E, 0xF, 0xF, true);
    else if constexpr (M == 4) return __builtin_amdgcn_update_dpp(__builtin_amdgcn_update_dpp(0, v, 0x104, 0xF, 0x5, false), v, 0x114, 0xF, 0xA, false);
    else if constexpr (M == 8) return __builtin_amdgcn_mov_dpp(v, 0x128, 0xF, 0xF, true);
    else if constexpr (M == 16) { const auto r = __builtin_amdgcn_permlane16_swap((unsigned)v, (unsigned)v, false, false); return (int)(r[0] ^ r[1] ^ (unsigned)v); }
    else { const auto r = __builtin_amdgcn_permlane32_swap((unsigned)v, (unsigned)v, false, false); return (int)(r[0] ^ r[1] ^ (unsigned)v); }
}
template <int M>
__device__ __forceinline__ float xshfl(float v) { return __int_as_float(xshfl_i<M>(__float_as_int(v))); }
template <int CTRL> __device__ __forceinline__ float dppf(float v) { return __int_as_float(__builtin_amdgcn_mov_dpp(__float_as_int(v), CTRL, 0xF, 0xF, true)); }
__device__ __forceinline__ float wave_sum(float v) {
    v += dppf<0xB1>(v); v += dppf<0x4E>(v); v += dppf<0x141>(v); v += dppf<0x140>(v);
    { const auto r = __builtin_amdgcn_permlane16_swap(__float_as_uint(v), __float_as_uint(v), false, false); v = __uint_as_float(r[0]) + __uint_as_float(r[1]); }
    { const auto r = __builtin_amdgcn_permlane32_swap(__float_as_uint(v), __float_as_uint(v), false, false); v = __uint_as_float(r[0]) + __uint_as_float(r[1]); }
    return v;
}
__device__ __forceinline__ float wave_max(float v) {
    v = fmaxf(v, dppf<0xB1>(v)); v = fmaxf(v, dppf<0x4E>(v)); v = fmaxf(v, dppf<0x141>(v)); v = fmaxf(v, dppf<0x140>(v));
    { const auto r = __builtin_amdgcn_permlane16_swap(__float_as_uint(v), __float_as_uint(v), false, false); v = fmaxf(__uint_as_float(r[0]), __uint_as_float(r[1])); }
    { const auto r = __builtin_amdgcn_permlane32_swap(__float_as_uint(v), __float_as_uint(v), false, false); v = fmaxf(__uint_as_float(r[0]), __uint_as_float(r[1])); }
    return v;
}
__device__ __forceinline__ int tok_modrow(int t) { return t < TP_TOK ? 0 : 1 + ((t - TP_TOK) >> 12); }
__device__ __forceinline__ int tok_seq0(int t) { return t < TP_TOK ? (t & ~255) : (TP_TOK + ((t - TP_TOK) & ~4095)); }
__device__ __forceinline__ int tok_len(int t) { return t < TP_TOK ? 256 : 4096; }

template <int MT, int NT>
__device__ __forceinline__ void wave_mma(f32x4 (&acc)[MT][NT], const bf16_t* A, int lda, const bf16_t* B, int ldb, int K) {
    const int lane = ltid() & 63, r = lane & 15, kg = (lane >> 4) * 8;
#pragma unroll 1
    for (int k0 = 0; k0 < K; k0 += 32) {
        bf16x8 a[MT], b[NT];
#pragma unroll
        for (int m = 0; m < MT; ++m) a[m] = *(const bf16x8*)(A + (m * 16 + r) * lda + k0 + kg);
#pragma unroll
        for (int n = 0; n < NT; ++n) b[n] = *(const bf16x8*)(B + (n * 16 + r) * ldb + k0 + kg);
#pragma unroll
        for (int m = 0; m < MT; ++m)
#pragma unroll
            for (int n = 0; n < NT; ++n) acc[m][n] = __builtin_amdgcn_mfma_f32_16x16x32_bf16(a[m], b[n], acc[m][n], 0, 0, 0);
    }
}
template <int MT, int NT, int KSTEPS>
__device__ __forceinline__ void wave_mma_u(f32x4 (&acc)[MT][NT], const bf16_t* A, int lda, const bf16_t* B, int ldb) {
    const int lane = ltid() & 63, r = lane & 15, kg = (lane >> 4) * 8;
    bf16x8 a[KSTEPS][MT], b[KSTEPS][NT];
#pragma unroll
    for (int ks = 0; ks < KSTEPS; ++ks) {
#pragma unroll
        for (int m = 0; m < MT; ++m) a[ks][m] = *(const bf16x8*)(A + (m * 16 + r) * lda + ks * 32 + kg);
#pragma unroll
        for (int n = 0; n < NT; ++n) b[ks][n] = *(const bf16x8*)(B + (n * 16 + r) * ldb + ks * 32 + kg);
    }
#pragma unroll
    for (int ks = 0; ks < KSTEPS; ++ks)
#pragma unroll
        for (int m = 0; m < MT; ++m)
#pragma unroll
            for (int n = 0; n < NT; ++n) acc[m][n] = __builtin_amdgcn_mfma_f32_16x16x32_bf16(a[ks][m], b[ks][n], acc[m][n], 0, 0, 0);
}

#define GLD 72
#define GEMM_SMEM_BYTES (2 * (256 + 128) * GLD * 2)
template <int PERM = 0, class Epi>
__device__ __forceinline__ void gemm_tile(const bf16_t* __restrict__ A, long lda, const bf16_t* __restrict__ B, long ldb, int K, bf16_t* smem, Epi epi) {
    const int tid = ltid(), lane = tid & 63, wave = tid >> 6;
    const int wm = wave >> 1, wn = wave & 1;
    bf16_t* As = smem;
    bf16_t* Bs = smem + 2 * 256 * GLD;
    f32x4 acc[4][4];
#pragma unroll
    for (int m = 0; m < 4; ++m)
#pragma unroll
        for (int n = 0; n < 4; ++n) acc[m][n] = (f32x4){0.f, 0.f, 0.f, 0.f};
    uint4 ra[4], rb[2];
    const int lrow = tid >> 3, lkc = (tid & 7) * 8;
    const bf16_t* ap = A + (long)lrow * (PERM ? 64 : 1) * lda + lkc;
    const bf16_t* bp = B + (long)lrow * ldb + lkc;
    const long astep = (PERM ? 1 : 64) * lda;
#pragma unroll
    for (int i = 0; i < 4; ++i) ra[i] = *(const uint4*)(ap + (long)i * astep);
#pragma unroll
    for (int i = 0; i < 2; ++i) rb[i] = *(const uint4*)(bp + (long)i * 64 * ldb);
    __builtin_amdgcn_sched_barrier(0);
#pragma unroll
    for (int i = 0; i < 4; ++i) *(uint4*)(As + (i * 64 + lrow) * GLD + lkc) = ra[i];
#pragma unroll
    for (int i = 0; i < 2; ++i) *(uint4*)(Bs + (i * 64 + lrow) * GLD + lkc) = rb[i];
    __syncthreads();
    const int nk = K >> 6;
    for (int kt = 0; kt < nk; ++kt) {
        const int cur = kt & 1;
        if (kt + 1 < nk) {
            const long k0 = (long)(kt + 1) * 64;
#pragma unroll
            for (int i = 0; i < 4; ++i) ra[i] = *(const uint4*)(ap + (long)i * astep + k0);
#pragma unroll
            for (int i = 0; i < 2; ++i) rb[i] = *(const uint4*)(bp + (long)i * 64 * ldb + k0);
            __builtin_amdgcn_sched_barrier(0);
        }
        const bf16_t* Ac = As + cur * 256 * GLD + (wm * 64) * GLD;
        const bf16_t* Bc = Bs + cur * 128 * GLD + (wn * 64) * GLD;
        wave_mma<4, 4>(acc, Ac, GLD, Bc, GLD, 32);
        wave_mma<4, 4>(acc, Ac + 32, GLD, Bc + 32, GLD, 32);
        if (kt + 1 < nk) {
            bf16_t* An = As + (cur ^ 1) * 256 * GLD;
            bf16_t* Bn = Bs + (cur ^ 1) * 128 * GLD;
#pragma unroll
            for (int i = 0; i < 4; ++i) *(uint4*)(An + (i * 64 + lrow) * GLD + lkc) = ra[i];
#pragma unroll
            for (int i = 0; i < 2; ++i) *(uint4*)(Bn + (i * 64 + lrow) * GLD + lkc) = rb[i];
        }
        __syncthreads();
    }
#pragma unroll
    for (int m = 0; m < 4; ++m)
#pragma unroll
        for (int n = 0; n < 4; ++n) epi(wm * 64 + m * 16 + (lane >> 4) * 4, wn * 64 + n * 16 + (lane & 15), acc[m][n]);
}
namespace g8 {
constexpr int BK = 64, HALF = 128, HT = HALF * BK;
__device__ __forceinline__ int lds_byte(int r, int c) {
    const int st = (r >> 4) * 2 + (c >> 5), rr = r & 15, cc = c & 31, ob = rr * 64 + cc * 2;
    return st * 1024 + (ob ^ (((ob >> 9) & 1) << 5));
}
__device__ __forceinline__ void stage_rc(int b, int& R, int& C) {
    const int st = b / 1024, sb = b % 1024, swz = sb ^ (((sb >> 9) & 1) << 5);
    R = (st >> 1) * 16 + swz / 64; C = (st & 1) * 32 + (swz % 64) / 2;
}
}

template <int PERM = 0, int PRE = 0>
__device__ __forceinline__ void gemm_tile256_acc(const bf16_t* __restrict__ A, long lda, const bf16_t* __restrict__ Bt, long ldb, int K, bf16_t* shm, f32x4 (&acc)[2][2][4][2]) {
    using namespace g8;
#define G8_SA(b, h) (shm + ((b) * 2 + (h)) * HT)
#define G8_SB(b, h) (shm + (4 + (b) * 2 + (h)) * HT)
#define G8_STAGE_A(T, P, h, kt) do { for (int _i = 0; _i < 2; ++_i) { const int _b = (T) * 16 + _i * 8192; int _r, _c; stage_rc(_b, _r, _c); \
        const int _R = (h) * HALF + _r; const long _ar = PERM ? (long)((_R & 63) * 64 + (_R >> 6)) : (long)_R; \
        __builtin_amdgcn_global_load_lds((const unsigned*)(A + _ar * lda + (long)(kt) * BK + _c), (__attribute__((address_space(3))) unsigned*)((char*)(P) + _b), 16, 0, 0); } } while (0)
#define G8_STAGE_B(T, P, h, kt) do { for (int _i = 0; _i < 2; ++_i) { const int _b = (T) * 16 + _i * 8192; int _r, _c; stage_rc(_b, _r, _c); \
        __builtin_amdgcn_global_load_lds((const unsigned*)(Bt + (long)((h) * HALF + _r) * ldb + (long)(kt) * BK + _c), (__attribute__((address_space(3))) unsigned*)((char*)(P) + _b), 16, 0, 0); } } while (0)
#define G8_LDA(dst, b, h) _Pragma("unroll") for (int m = 0; m < 4; ++m) _Pragma("unroll") for (int k = 0; k < 2; ++k) \
        dst[m][k] = *reinterpret_cast<const bf16x8*>((char*)G8_SA(b, h) + lds_byte(wr * 64 + m * 16 + fr, k * 32 + fq * 8))
#define G8_LDB(dst, b, h) _Pragma("unroll") for (int n = 0; n < 2; ++n) _Pragma("unroll") for (int k = 0; k < 2; ++k) \
        dst[n][k] = *reinterpret_cast<const bf16x8*>((char*)G8_SB(b, h) + lds_byte(wc * 32 + n * 16 + fr, k * 32 + fq * 8))
#define G8_MMA(ai, bj, At_, Bt_) do { __builtin_amdgcn_s_setprio(1); \
        _Pragma("unroll") for (int m = 0; m < 4; ++m) _Pragma("unroll") for (int n = 0; n < 2; ++n) _Pragma("unroll") for (int k = 0; k < 2; ++k) \
            acc[ai][bj][m][n] = __builtin_amdgcn_mfma_f32_16x16x32_bf16(At_[m][k], Bt_[n][k], acc[ai][bj][m][n], 0, 0, 0); \
        __builtin_amdgcn_s_setprio(0); } while (0)
#define G8_WAIT_V(n) asm volatile("s_waitcnt vmcnt(" #n ")" ::: "memory")
#define G8_WAIT_L(n) asm volatile("s_waitcnt lgkmcnt(" #n ")" ::: "memory")
#define G8_BAR __builtin_amdgcn_s_barrier()
#define G8_SCHED __builtin_amdgcn_sched_barrier(0)
    int tz = ltid();
    int wid = tz >> 6, lane = tz & 63, wr = wid >> 2, wc = wid & 3, fr = lane & 15, fq = lane >> 4;
#pragma unroll
    for (int a = 0; a < 2; ++a)
#pragma unroll
        for (int b = 0; b < 2; ++b)
#pragma unroll
            for (int m = 0; m < 4; ++m)
#pragma unroll
                for (int n = 0; n < 2; ++n) acc[a][b][m][n] = (f32x4){0.f, 0.f, 0.f, 0.f};
    bf16x8 At[4][2], B0[2][2], B1[2][2];
    const int nt = K / BK;
    if (PRE) {
        if (wr == 1) G8_BAR;
        G8_WAIT_V(0); G8_BAR;
        G8_BAR;
    } else {
        G8_STAGE_B(tz, G8_SB(0, 0), 0, 0); G8_STAGE_A(tz, G8_SA(0, 0), 0, 0);
        G8_STAGE_B(tz, G8_SB(0, 1), 1, 0); G8_STAGE_A(tz, G8_SA(0, 1), 1, 0);
        if (wr == 1) G8_BAR;
        G8_WAIT_V(4); G8_BAR;
        G8_STAGE_B(tz, G8_SB(1, 0), 0, 1); G8_STAGE_A(tz, G8_SA(1, 0), 0, 1); G8_STAGE_B(tz, G8_SB(1, 1), 1, 1);
        G8_WAIT_V(6); G8_BAR;
    }
    for (int t = 0; t < nt - 2; t += 2) {
        G8_LDB(B0, 0, 0); G8_SCHED; G8_LDA(At, 0, 0); G8_STAGE_A(tz, G8_SA(1, 1), 1, t + 1);
        G8_WAIT_L(8); G8_BAR; G8_WAIT_L(0); G8_MMA(0, 0, At, B0); G8_BAR; G8_SCHED;
        G8_LDB(B1, 0, 1); G8_STAGE_B(tz, G8_SB(0, 0), 0, t + 2);
        G8_BAR; G8_WAIT_L(0); G8_MMA(0, 1, At, B1); G8_BAR;
        G8_LDA(At, 0, 1); G8_STAGE_A(tz, G8_SA(0, 0), 0, t + 2);
        G8_BAR; G8_WAIT_L(0); G8_MMA(1, 0, At, B0); G8_BAR; G8_SCHED;
        G8_STAGE_B(tz, G8_SB(0, 1), 1, t + 2);
        G8_WAIT_V(6); G8_BAR; G8_MMA(1, 1, At, B1); G8_BAR;
        G8_LDB(B0, 1, 0); G8_SCHED; G8_LDA(At, 1, 0); G8_STAGE_A(tz, G8_SA(0, 1), 1, t + 2);
        G8_WAIT_L(8); G8_BAR; G8_WAIT_L(0); G8_MMA(0, 0, At, B0); G8_BAR; G8_SCHED;
        G8_LDB(B1, 1, 1); G8_STAGE_B(tz, G8_SB(1, 0), 0, t + 3);
        G8_BAR; G8_WAIT_L(0); G8_MMA(0, 1, At, B1); G8_BAR;
        G8_LDA(At, 1, 1); G8_STAGE_A(tz, G8_SA(1, 0), 0, t + 3);
        G8_BAR; G8_WAIT_L(0); G8_MMA(1, 0, At, B0); G8_BAR; G8_SCHED;
        G8_STAGE_B(tz, G8_SB(1, 1), 1, t + 3);
        G8_WAIT_V(6); G8_BAR; G8_MMA(1, 1, At, B1); G8_BAR;
    }
    tz = ltid(); wid = tz >> 6; lane = tz & 63; wr = wid >> 2; wc = wid & 3; fr = lane & 15; fq = lane >> 4;
    { G8_LDB(B0, 0, 0); G8_WAIT_V(0); G8_LDA(At, 0, 0); G8_STAGE_A(tz, G8_SA(1, 1), 1, nt - 1);
      G8_BAR; G8_WAIT_L(0); G8_MMA(0, 0, At, B0); G8_BAR;
      G8_LDB(B1, 0, 1); G8_BAR; G8_WAIT_L(0); G8_MMA(0, 1, At, B1); G8_BAR;
      G8_LDA(At, 0, 1); G8_WAIT_V(4); G8_BAR; G8_WAIT_L(0); G8_MMA(1, 0, At, B0); G8_MMA(1, 1, At, B1); G8_BAR; }
    { G8_LDB(B0, 1, 0); G8_LDA(At, 1, 0); G8_WAIT_V(2); G8_BAR; G8_WAIT_L(0); G8_MMA(0, 0, At, B0); G8_BAR;
      G8_LDB(B1, 1, 1); G8_WAIT_V(0); G8_BAR; G8_WAIT_L(0); G8_MMA(0, 1, At, B1); G8_BAR;
      G8_LDA(At, 1, 1); G8_BAR; G8_WAIT_L(0); G8_MMA(1, 0, At, B0); G8_MMA(1, 1, At, B1); G8_BAR; }
    if (wr == 0) G8_BAR;
#undef G8_SA
#undef G8_SB
#undef G8_STAGE_A
#undef G8_STAGE_B
#undef G8_LDA
#undef G8_LDB
#undef G8_MMA
#undef G8_WAIT_V
#undef G8_WAIT_L
#undef G8_BAR
#undef G8_SCHED
}

template <int PERM = 0>
__device__ __forceinline__ void g8_prologue(const bf16_t* __restrict__ A, long lda, const bf16_t* __restrict__ Bt, long ldb, bf16_t* shm) {
    using namespace g8;
    const int tz = ltid();
#define G8P_STAGE_A(P, h, kt) do { for (int _i = 0; _i < 2; ++_i) { const int _b = tz * 16 + _i * 8192; int _r, _c; stage_rc(_b, _r, _c); \
        const int _R = (h) * HALF + _r; const long _ar = PERM ? (long)((_R & 63) * 64 + (_R >> 6)) : (long)_R; \
        __builtin_amdgcn_global_load_lds((const unsigned*)(A + _ar * lda + (long)(kt) * BK + _c), (__attribute__((address_space(3))) unsigned*)((char*)(P) + _b), 16, 0, 0); } } while (0)
#define G8P_STAGE_B(P, h, kt) do { for (int _i = 0; _i < 2; ++_i) { const int _b = tz * 16 + _i * 8192; int _r, _c; stage_rc(_b, _r, _c); \
        __builtin_amdgcn_global_load_lds((const unsigned*)(Bt + (long)((h) * HALF + _r) * ldb + (long)(kt) * BK + _c), (__attribute__((address_space(3))) unsigned*)((char*)(P) + _b), 16, 0, 0); } } while (0)
#define G8P_SA(b, h) (shm + ((b) * 2 + (h)) * HT)
#define G8P_SB(b, h) (shm + (4 + (b) * 2 + (h)) * HT)
    G8P_STAGE_B(G8P_SB(0, 0), 0, 0); G8P_STAGE_A(G8P_SA(0, 0), 0, 0);
    G8P_STAGE_B(G8P_SB(0, 1), 1, 0); G8P_STAGE_A(G8P_SA(0, 1), 1, 0);
    G8P_STAGE_B(G8P_SB(1, 0), 0, 1); G8P_STAGE_A(G8P_SA(1, 0), 0, 1); G8P_STAGE_B(G8P_SB(1, 1), 1, 1);
#undef G8P_STAGE_A
#undef G8P_STAGE_B
#undef G8P_SA
#undef G8P_SB
}

template <int PERM = 0, class Epi>
__device__ __forceinline__ void gemm_tile256(const bf16_t* __restrict__ A, long lda, const bf16_t* __restrict__ Bt, long ldb, int K, bf16_t* shm, Epi epi) {
    f32x4 acc[2][2][4][2];
    gemm_tile256_acc<PERM>(A, lda, Bt, ldb, K, shm, acc);
    const int tz = ltid(), wid = tz >> 6, lane = tz & 63, wr = wid >> 2, wc = wid & 3, fr = lane & 15, fq = lane >> 4;
#pragma unroll
    for (int ai = 0; ai < 2; ++ai)
#pragma unroll
        for (int bj = 0; bj < 2; ++bj)
#pragma unroll
            for (int m = 0; m < 4; ++m)
#pragma unroll
                for (int n = 0; n < 2; ++n) epi(ai * 128 + wr * 64 + m * 16 + fq * 4, bj * 128 + wc * 32 + n * 16 + fr, acc[ai][bj][m][n]);
}

__device__ __forceinline__ void tile_map(int u, int nM, int nN, int& pm, int& pn) {
    const int nwg = nM * nN;
    int wgid = u;
    { const int q = nwg / 8, r = nwg % 8, xcd = wgid % 8, off = wgid / 8; wgid = (xcd < r ? xcd * (q + 1) : r * (q + 1) + (xcd - r) * q) + off; }
    const int nig = 8 * nN, gid = wgid / nig, fm = gid * 8, gsz = (nM - fm) < 8 ? (nM - fm) : 8;
    pm = fm + ((wgid % nig) % gsz); pn = (wgid % nig) / gsz;
}
#define XB_TMO      128
#define XB_XCNT(j)  (256  + 64 * (j))
#define XB_XSUB(j)  (1280 + 64 * (j))
#define XB_XGEN(j)  (2304 + 64 * (j))
#define XB_TOP      3328
#define XB_TOPGEN   3392
#define XCD_BAR_WORDS 3456
#define XB_SPIN_CAP (1u << 18)
#define LAS __attribute__((address_space(3)))

__device__ __forceinline__ unsigned xb_ld(unsigned* p)              { return __hip_atomic_load(p, __ATOMIC_RELAXED, __HIP_MEMORY_SCOPE_AGENT); }
__device__ __forceinline__ unsigned xb_add(unsigned* p, unsigned v) { return __hip_atomic_fetch_add(p, v, __ATOMIC_RELAXED, __HIP_MEMORY_SCOPE_AGENT); }
__device__ __forceinline__ unsigned xb_xcc_id() { return (unsigned)__builtin_amdgcn_s_getreg((3 << 11) | 20) & 0xFu; }
#define XB_SPIN(cond, bar) do { unsigned _sp = 0; while (cond) { __builtin_amdgcn_s_sleep(1); \
    if ((++_sp & 255u) == 0u) { if (xb_ld(&(bar)[XB_TMO])) break; if (_sp > XB_SPIN_CAP) { atomicAdd(&(bar)[XB_TMO], 1u); break; } } } } while (0)

struct XcdBarrier {
    unsigned* bar; unsigned x;
    volatile LAS unsigned* st;
};

__device__ __forceinline__ XcdBarrier xcd_barrier_post(unsigned* bar, volatile LAS unsigned* st) {
    XcdBarrier b; b.bar = bar; b.x = xb_xcc_id(); b.st = st;
    if (threadIdx.x == 0) (void)xb_add(&bar[XB_XCNT(b.x)], 1u);
    return b;
}
__device__ __forceinline__ void xcd_barrier_complete(unsigned* bar, unsigned x, unsigned& nloc, unsigned& nx) {
    const unsigned G = gridDim.x * gridDim.y * gridDim.z;
    unsigned sum, cnt, mine, sp = 0u;
    for (;;) {
        sum = 0u; cnt = 0u; mine = 0u;
#pragma unroll
        for (unsigned j = 0; j < 16; ++j) { const unsigned c = xb_ld(&bar[XB_XCNT(j)]); sum += c; cnt += (c > 0u) ? 1u : 0u; mine = (j == x) ? c : mine; }
        if (sum == G) break;
        __builtin_amdgcn_s_sleep(1);
        if ((++sp & 255u) == 0u) { if (xb_ld(&bar[XB_TMO])) break; if (sp > XB_SPIN_CAP) { atomicAdd(&bar[XB_TMO], 1u); break; } }
    }
    nloc = mine > 0u ? mine : 1u; nx = cnt > 0u ? cnt : 1u;
}

__device__ __forceinline__ void xcd_barrier(const XcdBarrier& b) {
    asm volatile("s_waitcnt vmcnt(0)" ::: "memory");
    __syncthreads();
    if (threadIdx.x == 0) {
        unsigned* bar = b.bar;
        __builtin_amdgcn_s_waitcnt(0);
        unsigned nloc = b.st[0], nx = b.st[1];
        if (nloc == 0u) { xcd_barrier_complete(bar, b.x, nloc, nx); b.st[0] = nloc; b.st[1] = nx; }
        const unsigned old = xb_add(&bar[XB_XSUB(b.x)], 1u);
        const unsigned gen = old / nloc;
        if (old + 1u == (gen + 1u) * nloc) {
            __builtin_amdgcn_fence(__ATOMIC_RELEASE, "agent");
            asm volatile("s_waitcnt vmcnt(0)" ::: "memory");
            const unsigned og = xb_add(&bar[XB_TOP], 1u);
            const unsigned tg = og / nx;
            if (og + 1u == (tg + 1u) * nx) xb_add(&bar[XB_TOPGEN], 1u);
            else XB_SPIN(xb_ld(&bar[XB_TOPGEN]) == tg, bar);
            __builtin_amdgcn_fence(__ATOMIC_ACQUIRE, "agent");
            xb_add(&bar[XB_XGEN(b.x)], 1u);
            asm volatile("s_waitcnt vmcnt(0)" ::: "memory");
        } else {
            XB_SPIN(xb_ld(&bar[XB_XGEN(b.x)]) == gen, bar);
            __builtin_amdgcn_fence(__ATOMIC_ACQUIRE, "agent");
            asm volatile("s_waitcnt vmcnt(0)" ::: "memory");
        }
    }
    __syncthreads();
}

__device__ __forceinline__ void conv_t(const float* __restrict__ src, int ldsrc, int Nvalid, int Nstore, int K, bf16_t* __restrict__ dst, float* ts, int b0 = 0) {
    const int tid = ltid();
    const int ntn = (Nstore + 63) / 64, ntk = K / 64;
    for (int tile = lbid() - b0; tile < ntn * ntk; tile += gridDim.x - b0) {
        const int tn = tile % ntn, tk = tile / ntn;
        {
            const int kk = tid >> 3, n8 = (tid & 7) * 8;
#pragma unroll
            for (int i = 0; i < 8; ++i) {
                const int n = tn * 64 + n8 + i;
                ts[kk * 65 + n8 + i] = n < Nvalid ? src[(long)(tk * 64 + kk) * ldsrc + n] : 0.f;
            }
        }
        __syncthreads();
        {
            const int nn = tid >> 3, k8 = (tid & 7) * 8;
            const int n = tn * 64 + nn;
            if (n < Nstore) {
                uint4 v;
                v.x = pack2(ts[(k8 + 0) * 65 + nn], ts[(k8 + 1) * 65 + nn]);
                v.y = pack2(ts[(k8 + 2) * 65 + nn], ts[(k8 + 3) * 65 + nn]);
                v.z = pack2(ts[(k8 + 4) * 65 + nn], ts[(k8 + 5) * 65 + nn]);
                v.w = pack2(ts[(k8 + 6) * 65 + nn], ts[(k8 + 7) * 65 + nn]);
                *(uint4*)(dst + (long)n * K + tk * 64 + k8) = v;
            }
        }
        __syncthreads();
    }
}

__device__ __forceinline__ void fold_fourier(CP& p, int j, char* smem, int b0) {
    const int tid = ltid(), bid = lbid() - b0, nb = gridDim.x - b0;
    float* wt = (float*)smem;
    for (int unit = bid; unit < 256; unit += nb) {
        const int g = unit >> 6, kb = unit & 63;
        const int dq = ltid() & 127, kq = ltid() >> 7;
        const float rs = __builtin_amdgcn_sinf((float)dq * (1.f / 128.f)), rc = __builtin_amdgcn_cosf((float)dq * (1.f / 128.f));
        __syncthreads();
        for (int i = tid; i < 16 * 128; i += NTHREADS) {
            const int kk = i >> 7, d = i & 127;
            wt[kk * 129 + d] = p.even_w_in[((long)j * 1024 + kb * 16 + kk) * 2576 + 2064 + g * 128 + d];
        }
        __syncthreads();
        float ar[4], ai[4];
#pragma unroll
        for (int q = 0; q < 4; ++q) { ar[q] = 0.f; ai[q] = 0.f; }
        for (int d0 = 0; d0 < 128; d0 += 16) {
            float s = __builtin_amdgcn_sinf((float)((d0 * dq) & 127) * (1.f / 128.f)), c = __builtin_amdgcn_cosf((float)((d0 * dq) & 127) * (1.f / 128.f));
#pragma unroll
            for (int dd = 0; dd < 16; ++dd) {
#pragma unroll
                for (int q = 0; q < 4; ++q) {
                    const float w = wt[(kq * 4 + q) * 129 + d0 + dd];
                    ar[q] += w * c;
                    ai[q] -= w * s;
                }
                const float cn = c * rc - s * rs, sn = s * rc + c * rs;
                c = cn; s = sn;
            }
        }
        const float sc = 0.08838834764831845f;
        bf16_t* dst = p.wtE_in + (long)j * N_EIN * 1024;
#pragma unroll
        for (int q = 0; q < 4; ++q) {
            dst[(long)(2064 + g * 128 + dq) * 1024 + kb * 16 + kq * 4 + q] = f2bf(ar[q] * sc);
            dst[(long)(2576 + g * 128 + dq) * 1024 + kb * 16 + kq * 4 + q] = f2bf(ai[q] * sc);
        }
    }
    __syncthreads();
    for (long i = (long)bid * NTHREADS + tid; i < 240L * 1024; i += (long)nb * NTHREADS) p.wtE_in[(long)j * N_EIN * 1024 + 3088L * 1024 + i] = 0;
}
__device__ __forceinline__ void ph_init2(CP& p, char* smem, int b0) {
    if ((int)lbid() < b0) return;
    __syncthreads();
    float* ts = (float*)smem;
    conv_t(p.even_w_in + 1024L * 2576, 2576, 2064, 2064, 1024, p.wtE_in + (long)N_EIN * 1024, ts, b0);
    for (int j = 0; j < 2; ++j) {
        conv_t(p.even_w_out + (long)j * 1024 * 1024, 1024, 1024, 1024, 1024, p.wtE_out + (long)j * 1024 * 1024, ts, b0);
        conv_t(p.odd_w_in + (long)j * 1024 * 832, 832, 832, N_OIN, 1024, p.wtO_in + (long)j * N_OIN * 1024, ts, b0);
        conv_t(p.mla_w_uq + (long)j * 512 * 1536, 1536, 1536, 1536, 512, p.wtUq + (long)j * 1536 * 512, ts, b0);
        conv_t(p.mla_w_ukv + (long)j * 256 * 2048, 2048, 2048, 2048, 256, p.wtUkv + (long)j * 2048 * 256, ts, b0);
        conv_t(p.odd_w_out + (long)j * 1024 * 1024, 1024, 1024, 1024, 1024, p.wtO_out + (long)j * 1024 * 1024, ts, b0);
    }
    for (int l = 0; l < 4; ++l) conv_t(p.peer_w_q + (long)l * 1024 * 2048, 2048, 2048, 2048, 1024, p.wtPq + (long)l * 2048 * 1024, ts, b0);
    fold_fourier(p, 1, smem, b0);
}

__device__ __forceinline__ void ph_init(CP& p, char* smem) {
    const int tid = ltid(), bid = lbid(), nb = gridDim.x;
    {
        float* sl = (float*)smem;
        for (int i = tid; i < 9 * 1024; i += NTHREADS) {
            const int r = i >> 10, k = i & 1023;
            const float v = r == 0 ? p.c_ctx[k] : p.c[(r - 1) * 1024 + k];
            sl[i] = silu_f(v);
        }
        __syncthreads();
        float* part16 = sl + 9 * 1024;
        for (int unit = bid; unit < 192; unit += nb) {
            const int l = unit / 48, cb = unit % 48;
            const int c4 = (tid & 31) * 4, kq = tid >> 5;
            f32x4 acc[9];
#pragma unroll
            for (int r = 0; r < 9; ++r) acc[r] = (f32x4){0.f, 0.f, 0.f, 0.f};
            const float* wp = p.w_mod + ((long)l * 1024 + kq * 64) * 6144 + cb * 128 + c4;
            for (int k = 0; k < 64; k += 8) {
                f32x4 w[8];
#pragma unroll
                for (int q = 0; q < 8; ++q) w[q] = *(const f32x4*)(wp + (long)(k + q) * 6144);
#pragma unroll
                for (int q = 0; q < 8; ++q)
#pragma unroll
                    for (int r = 0; r < 9; ++r) acc[r] = acc[r] + w[q] * sl[r * 1024 + kq * 64 + k + q];
            }
#pragma unroll
            for (int r = 0; r < 9; ++r) *(f32x4*)(part16 + (kq * 9 + r) * 128 + c4) = acc[r];
            __syncthreads();
            if (tid < 128) {
                const int col = cb * 128 + tid;
                const float bias = p.b_mod[l * 6144 + col];
#pragma unroll
                for (int r = 0; r < 9; ++r) {
                    float s = bias;
#pragma unroll
                    for (int g = 0; g < 16; ++g) s += part16[(g * 9 + r) * 128 + tid];
                    p.mods[((long)l * 9 + r) * 6144 + col] = s;
                }
            }
            __syncthreads();
        }
    }
    {
        float* ts = (float*)smem;
        conv_t(p.even_w_in, 2576, 2064, 2064, 1024, p.wtE_in, ts);
    }
    fold_fourier(p, 0, smem, 0);
    for (long i = (long)bid * NTHREADS + tid; i < 4L * 8 * 2 * 128 * 128; i += (long)nb * NTHREADS) p.subk[i] = f2bf(p.peer_sub_keys[i]);
    for (int i = bid * NTHREADS + tid; i < 128 * 128; i += nb * NTHREADS) {
        const int jrow = i >> 7, kk = i & 127;
        {
            const int k1 = jrow >> 1, po = jrow & 1, pi = kk >> 6, n1 = kk & 63;
            float s, c;
            sincospif((float)((k1 * n1) & 63) / 32.f, &s, &c);
            const float v = po == 0 ? (pi == 0 ? c : s) : (pi == 0 ? -s : c);
            p.fftMA[i] = f2bf(v * 0.125f);
        }
        {
            const int k2 = jrow, pi = kk >> 6, n2 = kk & 63;
            float s, c;
            sincospif((float)((k2 * n2) & 63) / 32.f, &s, &c);
            p.fftMB[i] = jrow < 64 ? f2bf((pi == 0 ? c : s) * 0.125f) : (bf16_t)0;
        }
    }
    for (int i = bid * NTHREADS + tid; i < 4096; i += nb * NTHREADS) {
        const int n2 = i >> 6, k1 = i & 63;
        float s, c;
        sincospif((float)(n2 * k1) / 2048.f, &s, &c);
        p.fftTW[i * 2] = c; p.fftTW[i * 2 + 1] = s;
    }
    for (long i = (long)bid * NTHREADS + tid; i < 256L * 512; i += (long)nb * NTHREADS) {
        const int k = (int)(i >> 9), np = (int)(i & 511), n = np & 255;
        const int prod = (k * n) & 255;
        float s, c;
        sincospif((float)prod / 128.f, &s, &c);
        p.dftP[i] = f2bf(((np >> 8) ? s : c) * (1.f / 16.f));
    }
}

__device__ __forceinline__ void ph_tab(CP& p, int l, int b0) {
    const int lane = ltid() & 63, wave = ltid() >> 6;
    if ((int)lbid() < b0) return;
    unsigned char* tab = p.tabU + (long)(l & 1) * 16384 * 2048;
    float* su = p.su + (l & 1) * 32768; float* sv = su + 16384;
    const int rstep = (gridDim.x - b0) * 8;
    int row = (lbid() - b0) * 8 + wave;
    f32x4 nx[4];
#define TAB_SRC(R) ((((R) >= 16384) ? p.peer_v : p.peer_u) + ((long)l * 16384 + ((R) & 16383)) * 1024 + lane * 16)
    if (row < 32768) {
#pragma unroll
        for (int i = 0; i < 4; ++i) nx[i] = *(const f32x4*)(TAB_SRC(row) + i * 4);
    }
    for (; row < 32768; row += rstep) {
        const bool isv = row >= 16384;
        const int e = row & 16383;
        float v[16];
#pragma unroll
        for (int i = 0; i < 4; ++i) { v[i * 4] = nx[i][0]; v[i * 4 + 1] = nx[i][1]; v[i * 4 + 2] = nx[i][2]; v[i * 4 + 3] = nx[i][3]; }
        if (row + rstep < 32768) {
#pragma unroll
            for (int i = 0; i < 4; ++i) nx[i] = *(const f32x4*)(TAB_SRC(row + rstep) + i * 4);
        }
        float m = 0.f;
#pragma unroll
        for (int i = 0; i < 16; ++i) m = fmaxf(m, fabsf(v[i]));
        m = wave_max(m);
        const float scale = m > 0.f ? m * (1.f / 127.f) : 1.f;
        const float inv = 1.f / scale;
        unsigned w[4];
#pragma unroll
        for (int i = 0; i < 4; ++i) {
            unsigned pk = 0;
#pragma unroll
            for (int q = 0; q < 4; ++q) {
                int qi = (int)rintf(v[i * 4 + q] * inv);
                qi = qi < -127 ? -127 : (qi > 127 ? 127 : qi);
                pk |= (unsigned)(qi & 0xFF) << (q * 8);
            }
            w[i] = pk;
        }
        *(uint4*)(tab + (isv ? 16384L * 1024 : 0L) + (long)e * 1024 + lane * 16) = make_uint4(w[0], w[1], w[2], w[3]);
        if (lane == 0) (isv ? sv : su)[e] = scale;
    }
#undef TAB_SRC
}

template <int FROM_INPUT = 0>
__device__ __forceinline__ void ph_norm(CP& p, const float* __restrict__ w, const float* __restrict__ mods_l, int sh_off, int sc_off) {
    const int lane = ltid() & 63, wave = ltid() >> 6;
    const int nw = gridDim.x * 8;
    for (int row = lbid() * 8 + wave; row < T_TOK; row += nw) {
        const float* xr = FROM_INPUT ? (row < TP_TOK ? p.x_prompt + (long)row * DM : p.x_sample + (long)(row - TP_TOK) * DM) : p.out + (long)row * DM;
        float4 v[4];
        float ss = 0.f;
#pragma unroll
        for (int i = 0; i < 4; ++i) {
            v[i] = *(const float4*)(xr + i * 256 + lane * 4);
            ss += v[i].x * v[i].x + v[i].y * v[i].y + v[i].z * v[i].z + v[i].w * v[i].w;
        }
        ss = wave_sum(ss);
        const float r = rsqrtf(ss * (1.f / 1024.f) + 1e-6f);
        const float* mr = mods_l + (long)tok_modrow(row) * 6144;
        float4 ww[4], sc[4], sh[4];
#pragma unroll
        for (int i = 0; i < 4; ++i) {
            const int c = i * 256 + lane * 4;
            ww[i] = *(const float4*)(w + c); sc[i] = *(const float4*)(mr + sc_off + c); sh[i] = *(const float4*)(mr + sh_off + c);
        }
#pragma unroll
        for (int i = 0; i < 4; ++i) {
            const int c = i * 256 + lane * 4;
            const float h0 = v[i].x * r * ww[i].x * (1.f + sc[i].x) + sh[i].x;
            const float h1 = v[i].y * r * ww[i].y * (1.f + sc[i].y) + sh[i].y;
            const float h2 = v[i].z * r * ww[i].z * (1.f + sc[i].z) + sh[i].z;
            const float h3 = v[i].w * r * ww[i].w * (1.f + sc[i].w) + sh[i].w;
            *(uint2*)(p.H + (long)row * DM + c) = make_uint2(pack2(h0, h1), pack2(h2, h3));
        }
    }
}
#define SCAN_KPERM(k_) (((k_) & ~31) | ((((k_) >> 2) & 3) << 3) | ((((k_) >> 4) & 1) << 2) | ((k_) & 3))
#define ZA_OFF ((long)TP_TOK * 1024)
template <int PERM>
__device__ __forceinline__ void e_gemm_epi(CP& p, f32x4 (&acc)[2][2][4][2], int col0, int row0, int s0, int n20, int b) {
    const int tz = ltid(), wid = tz >> 6, lane = tz & 63, wr = wid >> 2, wc = wid & 3, fr = lane & 15, fq = lane >> 4;
#define EG_TOK(ai, m, i) (PERM ? s0 + 64 * ((m) * 16 + fq * 4 + (i)) + n20 + (ai) * 2 + wr : row0 + (ai) * 128 + wr * 64 + (m) * 16 + fq * 4 + (i))
    if (col0 + 256 <= 2048) {
        const bool isg = col0 >= 1536;
        bf16_t* const base = isg ? p.gate + (col0 - 1536) : p.qkvraw + col0;
        const long ld = isg ? 512 : 1536;
#pragma unroll
        for (int ai = 0; ai < 2; ++ai)
#pragma unroll
            for (int m = 0; m < 4; ++m)
#pragma unroll
                for (int i = 0; i < 4; ++i) {
                    bf16_t* d = base + (long)EG_TOK(ai, m, i) * ld + wc * 32 + fr;
#pragma unroll
                    for (int bj = 0; bj < 2; ++bj)
#pragma unroll
                        for (int n = 0; n < 2; ++n) d[bj * 128 + n * 16] = f2bf(acc[ai][bj][m][n][i]);
                }
    } else {
#pragma unroll
        for (int bj = 0; bj < 2; ++bj)
#pragma unroll
            for (int n = 0; n < 2; ++n) {
                const int col = col0 + bj * 128 + wc * 32 + n * 16 + fr;
                if (col < 2064) {
#pragma unroll
                    for (int ai = 0; ai < 2; ++ai)
#pragma unroll
                        for (int m = 0; m < 4; ++m)
#pragma unroll
                            for (int i = 0; i < 4; ++i) p.ba[(long)EG_TOK(ai, m, i) * 16 + (col - 2048)] = acc[ai][bj][m][n][i];
                } else if (col < 3088) {
                    const int cc = col - 2064, part = cc >> 9, cf = cc & 511;
#pragma unroll
                    for (int ai = 0; ai < 2; ++ai)
#pragma unroll
                        for (int m = 0; m < 4; ++m) {
                            const f32x4 v = acc[ai][bj][m][n];
                            bf16_t* dst;
                            if (PERM) dst = p.ZtA + ZA_OFF + (((((long)b * 512 + cf) * 64 + (n20 + ai * 2 + wr)) * 2 + part) * 64 + (m * 16 + fq * 4));
                            else dst = p.ZtA + (long)s0 * 1024 + ((long)cf * 2 + part) * 256 + (ai * 128 + wr * 64 + m * 16 + fq * 4);
                            *(uint2*)dst = make_uint2(pack2(v[0], v[1]), pack2(v[2], v[3]));
                        }
                }
            }
    }
#undef EG_TOK
}
__device__ __forceinline__ void ph_e_gemm(CP& p, int j, char* smem) {
    const int ntn = N_EIN / 256, ntm = T_TOK / 256;
    const bf16_t* Bt = p.wtE_in + (long)j * N_EIN * 1024;
#define EG_PROLOGUE(U)                                                                                             \
    {                                                                                                              \
        int tm_, tn_;                                                                                              \
        tile_map((U), ntm, ntn, tm_, tn_);                                                                         \
        if (tm_ < 16) g8_prologue<0>(p.H + (long)tm_ * 256 * DM, DM, Bt + (long)tn_ * 256 * 1024, 1024, (bf16_t*)smem);   \
        else { const int q_ = tm_ - 16; g8_prologue<1>(p.H + (long)(TP_TOK + (q_ >> 4) * 4096 + (q_ & 15) * 4) * DM, DM, Bt + (long)tn_ * 256 * 1024, 1024, (bf16_t*)smem); }   \
    }
    int u = lbid();
    if (u < ntn * ntm) EG_PROLOGUE(u)
    for (; u < ntn * ntm; u += gridDim.x) {
        int tm, tn;
        tile_map(u, ntm, ntn, tm, tn);
        const int col0 = tn * 256;
        const int un = u + gridDim.x;
        f32x4 acc[2][2][4][2];
        if (tm < 16) {
            const int row0 = tm * 256;
            gemm_tile256_acc<0, 1>(p.H + (long)row0 * DM, DM, Bt + (long)col0 * 1024, 1024, 1024, (bf16_t*)smem, acc);
            if (un < ntn * ntm) EG_PROLOGUE(un)
            e_gemm_epi<0>(p, acc, col0, row0, row0, 0, 0);
        } else {
            const int q = tm - 16, b = q >> 4, n20 = (q & 15) * 4;
            const int s0 = TP_TOK + b * 4096;
            gemm_tile256_acc<1, 1>(p.H + (long)(s0 + n20) * DM, DM, Bt + (long)col0 * 1024, 1024, 1024, (bf16_t*)smem, acc);
            if (un < ntn * ntm) EG_PROLOGUE(un)
            e_gemm_epi<1>(p, acc, col0, 0, s0, n20, b);
        }
    }
#undef EG_PROLOGUE
}

#define PREP_SMEM_BYTES (66048 + 34816 + 16384 + 2048 + 256 + 15360)
__device__ __forceinline__ void ph_e_prep(CP& p, int j, char* smem) {
    const float* cw = p.even_conv_w + (long)j * 3 * 1536;
    for (int u = lbid(); u < 576 * 4; u += gridDim.x) {
        const int cg = u >> 2, h = u & 3;
        const int t0 = cg * 64;
        const int s0 = tok_seq0(t0), L = tok_len(t0);
        int lz = 0, tid = ltid();
        asm volatile("" : "+s"(lz), "+v"(tid));
        const int lane = tid & 63, wave = tid >> 6;
        char* sm = smem + lz;
        bf16_t* raw = (bf16_t*)sm;
        float* KK = (float*)sm;
        float* QKr = KK + 64 * 65;
        float* Am = QKr + 64 * 65;
        bf16_t* qn = (bf16_t*)(sm + 66048);
        bf16_t* kn = qn + 64 * 136;
        bf16_t* vv = (bf16_t*)(sm + 66048 + 34816);
        float* sb = (float*)(sm + 66048 + 34816 + 16384);
        float* sg = sb + 128;
        float* sgr = sg + 128;
        float* seg = sgr + 128;
        float* sone = seg + 128;
        bf16_t* Dinv = (bf16_t*)(sm + 66048 + 34816 + 16384 + 2048 + 256);
        bf16_t* A10 = Dinv + 4 * 32 * 40;
        __syncthreads();
        for (int i = tid; i < 3 * 66 * 16; i += NTHREADS) {
            const int part = i / (66 * 16), rem = i % (66 * 16), rr = rem >> 4, ch = rem & 15;
            const int t = t0 - 1 + rr;
            uint4 v = make_uint4(0, 0, 0, 0);
            if (t >= s0 && t < s0 + L) v = *(const uint4*)(p.qkvraw + (long)t * 1536 + part * 512 + h * 128 + ch * 8);
            *(uint4*)(raw + (part * 66 + rr) * 128 + ch * 8) = v;
        }
        if (tid >= 128 && tid < 192) sone[tid - 128] = 1.f;
        if (tid < 128) {
            const int dir = tid >> 6, i = tid & 63;
            const int t = t0 + (dir ? 63 - i : i);
            const float* bar_ = p.ba + (long)t * 16;
            sb[dir * 64 + i] = sigmoid_f(bar_[dir * 4 + h]);
            const float a = __expf(p.gdn_a_log[(j * 2 + dir) * 4 + h]);
            sgr[dir * 64 + i] = -a * softplus_f(bar_[(2 + dir) * 4 + h] + p.gdn_dt_bias[(j * 2 + dir) * 4 + h]);
        }
        __syncthreads();
        if (tid < 128) {
            float v = sgr[tid];
#pragma unroll
            for (int off = 1; off < 64; off <<= 1) {
                const float o = __int_as_float(__builtin_amdgcn_ds_bpermute(((lane - off) & 63) << 2, __float_as_int(v)));
                v += lane >= off ? o : 0.f;
            }
            sg[tid] = v;
            seg[tid] = __expf(v);
        }
        {
            const int d = lane * 2;
#pragma unroll
            for (int part = 0; part < 3; ++part) {
                const int ch = part * 512 + h * 128 + d;
                const float w00 = cw[ch], w01 = cw[ch + 1], w10 = cw[1536 + ch], w11 = cw[1536 + ch + 1], w20 = cw[3072 + ch], w21 = cw[3072 + ch + 1];
                float y0[8], y1[8], ss[8];
#pragma unroll
                for (int r8 = 0; r8 < 8; ++r8) {
                    const int rr = wave * 8 + r8;
                    const unsigned x0 = *(const unsigned*)(raw + (part * 66 + rr) * 128 + d);
                    const unsigned x1 = *(const unsigned*)(raw + (part * 66 + rr + 1) * 128 + d);
                    const unsigned x2 = *(const unsigned*)(raw + (part * 66 + rr + 2) * 128 + d);
                    y0[r8] = silu_f(w00 * bflo(x0) + w10 * bflo(x1) + w20 * bflo(x2));
                    y1[r8] = silu_f(w01 * bfhi(x0) + w11 * bfhi(x1) + w21 * bfhi(x2));
                    ss[r8] = y0[r8] * y0[r8] + y1[r8] * y1[r8];
                }
                float tot = 0.f;
                if (part < 2) {
                    const bool b5 = (lane & 32) != 0, b4 = (lane & 16) != 0, b3 = (lane & 8) != 0;
                    float t4[4], t2[2];
#pragma unroll
                    for (int i = 0; i < 4; ++i) { const float snd = b5 ? ss[i] : ss[i + 4]; const float kp = b5 ? ss[i + 4] : ss[i]; t4[i] = kp + xshfl<32>(snd); }
#pragma unroll
                    for (int i = 0; i < 2; ++i) { const float snd = b4 ? t4[i] : t4[i + 2]; const float kp = b4 ? t4[i + 2] : t4[i]; t2[i] = kp + xshfl<16>(snd); }
                    { const float snd = b3 ? t2[0] : t2[1]; const float kp = b3 ? t2[1] : t2[0]; tot = kp + xshfl<8>(snd); }
                    tot += xshfl<4>(tot); tot += xshfl<2>(tot); tot += xshfl<1>(tot);
                    tot = rsqrtf(tot + 1e-6f);
                }
#pragma unroll
                for (int r8 = 0; r8 < 8; ++r8) {
                    const int rr = wave * 8 + r8;
                    float a0 = y0[r8], a1 = y1[r8];
                    if (part < 2) { const float rn = __int_as_float(__builtin_amdgcn_readlane(__float_as_int(tot), r8 * 8)); a0 *= rn; a1 *= rn; }
                    const unsigned pk = pack2(a0, a1);
                    if (part == 0) { *(unsigned*)(qn + rr * 136 + d) = pk; *(unsigned*)(p.qn + ((long)(t0 + rr) * 4 + h) * 128 + SCAN_KPERM(d)) = pk; }
                    else if (part == 1) { *(unsigned*)(kn + rr * 136 + d) = pk; *(unsigned*)(p.kn + ((long)(t0 + rr) * 4 + h) * 128 + d) = pk; }
                    else { *(unsigned*)(vv + rr * 128 + d) = pk; }
                }
            }
        }
        __syncthreads();
        {
            const int mat = wave >> 2, rt = wave & 3;
            f32x4 acc[1][4];
#pragma unroll
            for (int n = 0; n < 4; ++n) acc[0][n] = (f32x4){0.f, 0.f, 0.f, 0.f};
            wave_mma<1, 4>(acc, (mat ? qn : kn) + rt * 16 * 136, 136, kn, 136, 128);
            float* dst = mat ? QKr : KK;
#pragma unroll
            for (int n = 0; n < 4; ++n)
#pragma unroll
                for (int r = 0; r < 4; ++r) dst[(rt * 16 + (lane >> 4) * 4 + r) * 65 + n * 16 + (lane & 15)] = acc[0][n][r];
        }
        __syncthreads();
        {
            const int dir = tid >> 8, q = tid & 255;
            const long ud = ((long)(dir ? (s0 + L - 64 - (t0 - s0)) / 64 : cg) * 4 + h) * 2 + dir;
            bf16_t* qkout = p.QKb + ud * 4096;
            for (int e = q; e < 4096; e += 256) {
                const int i = e >> 6, jj = e & 63;
                const int ti = dir ? 63 - i : i, tj = dir ? 63 - jj : jj;
                const float dec = jj <= i ? __expf(sg[dir * 64 + i] - sg[dir * 64 + jj]) : 0.f;
                Am[(dir * 64 + i) * 64 + jj] = jj < i ? sb[dir * 64 + i] * KK[ti * 65 + tj] * dec : 0.f;
                qkout[e] = f2bf(QKr[ti * 65 + tj] * 0.08838834764831845f * dec);
            }
            if (q < 64) {
                const float gq = sg[dir * 64 + q];
                p.gcb[ud * 192 + q] = gq;
                p.gcb[ud * 192 + 64 + q] = 0.08838834764831845f * __expf(gq);
                p.gcb[ud * 192 + 128 + q] = __expf(sg[dir * 64 + 63] - gq);
            }
        }
        __syncthreads();
        if (tid < 128) {
            const int dir = tid >> 6, blk = (tid >> 5) & 1, c = tid & 31;
            const float* Dm = Am + (dir * 64 + blk * 32) * 64 + blk * 32;
            float x[32];
#pragma unroll
            for (int i = 0; i < 32; ++i) x[i] = (i == c) ? 1.f : 0.f;
#pragma unroll
            for (int i = 1; i < 32; ++i) {
                f32x4 dr[8];
#pragma unroll
                for (int q4 = 0; q4 < 8; ++q4) if (q4 * 4 < i) dr[q4] = *(const f32x4*)(Dm + i * 64 + q4 * 4);
                float a = x[i];
#pragma unroll
                for (int jj = 0; jj < i; ++jj) a -= dr[jj >> 2][jj & 3] * x[jj];
                x[i] = a;
            }
            bf16_t* dv = Dinv + (dir * 2 + blk) * 32 * 40 + c;
#pragma unroll
            for (int i = 0; i < 32; ++i) dv[i * 40] = f2bf(x[i]);
        }
        for (int e = tid; e < 2048; e += NTHREADS) {
            const int dir = e >> 10, i = (e >> 5) & 31, jj = e & 31;
            A10[(dir * 32 + i) * 40 + jj] = f2bf(Am[(dir * 64 + 32 + i) * 64 + jj]);
        }
        __syncthreads();
        {
            const int dir = wave >> 2, slab = wave & 3;
            const long ud = ((long)(dir ? (s0 + L - 64 - (t0 - s0)) / 64 : cg) * 4 + h) * 2 + dir;
            bf16_t* RT = (bf16_t*)sm + wave * 4096;
#define RT_AT(c_, i_) (RT + (c_) * 64 + (((((i_) >> 3) ^ ((c_) & 7))) << 3) + ((i_) & 7))
            const int c = slab * 64 + lane;
            const int g4 = (lane >> 4) * 4, cn = lane & 15, kg = (lane >> 4) * 8;
            {
                const bf16_t* src = c < 128 ? vv + c : kn + (c - 128);
                const int sst = c < 128 ? 128 : 136;
                const float* fac = c < 128 ? sone : seg + dir * 64;
                const float* fb = sb + dir * 64;
#pragma unroll
                for (int i8 = 0; i8 < 8; ++i8) {
                    unsigned w[4];
#pragma unroll
                    for (int e = 0; e < 4; ++e) {
                        float v[2];
#pragma unroll
                        for (int q = 0; q < 2; ++q) {
                            const int i = i8 * 8 + e * 2 + q;
                            const int ti = dir ? 63 - i : i;
                            const float f0 = bf2f(src[ti * sst]) * fb[i];
                            v[q] = f0 * fac[i];
                        }
                        w[e] = pack2(v[0], v[1]);
                    }
                    *(uint4*)RT_AT(lane, i8 * 8) = make_uint4(w[0], w[1], w[2], w[3]);
                }
            }
            asm volatile("s_waitcnt lgkmcnt(0)" ::: "memory");
            const bf16_t* D0 = Dinv + (dir * 2 + 0) * 32 * 40;
            const bf16_t* D1 = Dinv + (dir * 2 + 1) * 32 * 40;
            const bf16_t* A1 = A10 + dir * 32 * 40;
            bf16_t* dstb = (c < 128 ? p.Ub : p.Wb) + ud * 8192;
            const int cbase = (slab & 1) * 64;
            int wcol[4];
#pragma unroll
            for (int nt = 0; nt < 4; ++nt) { const int k_ = cbase + nt * 16 + cn; wcol[nt] = c < 128 ? k_ : SCAN_KPERM(k_); }
            bf16x8 bfr[4];
            f32x4 X0[2][4];
#pragma unroll
            for (int nt = 0; nt < 4; ++nt) bfr[nt] = *(const bf16x8*)RT_AT(nt * 16 + cn, kg);
#pragma unroll
            for (int mt = 0; mt < 2; ++mt) {
                const bf16x8 af = *(const bf16x8*)(D0 + (mt * 16 + cn) * 40 + kg);
#pragma unroll
                for (int nt = 0; nt < 4; ++nt) X0[mt][nt] = __builtin_amdgcn_mfma_f32_16x16x32_bf16(af, bfr[nt], (f32x4){0.f, 0.f, 0.f, 0.f}, 0, 0, 0);
            }
#pragma unroll
            for (int mt = 0; mt < 2; ++mt)
#pragma unroll
                for (int nt = 0; nt < 4; ++nt) {
#pragma unroll
                    for (int r = 0; r < 4; ++r) dstb[(mt * 16 + g4 + r) * 128 + wcol[nt]] = f2bf(X0[mt][nt][r]);
                    *(uint2*)RT_AT(nt * 16 + cn, mt * 16 + g4) = make_uint2(pack2(X0[mt][nt][0], X0[mt][nt][1]), pack2(X0[mt][nt][2], X0[mt][nt][3]));
                }
            asm volatile("s_waitcnt lgkmcnt(0)" ::: "memory");
            f32x4 R1[2][4];
#pragma unroll
            for (int nt = 0; nt < 4; ++nt) bfr[nt] = *(const bf16x8*)RT_AT(nt * 16 + cn, kg);
#pragma unroll
            for (int mt = 0; mt < 2; ++mt) {
                const bf16x8 af = *(const bf16x8*)(A1 + (mt * 16 + cn) * 40 + kg);
#pragma unroll
                for (int nt = 0; nt < 4; ++nt) {
                    const f32x4 pr = __builtin_amdgcn_mfma_f32_16x16x32_bf16(af, bfr[nt], (f32x4){0.f, 0.f, 0.f, 0.f}, 0, 0, 0);
                    const uint2 rr = *(const uint2*)RT_AT(nt * 16 + cn, 32 + mt * 16 + g4);
                    R1[mt][nt][0] = bflo(rr.x) - pr[0]; R1[mt][nt][1] = bfhi(rr.x) - pr[1];
                    R1[mt][nt][2] = bflo(rr.y) - pr[2]; R1[mt][nt][3] = bfhi(rr.y) - pr[3];
                }
            }
            asm volatile("s_waitcnt lgkmcnt(0)" ::: "memory");
#pragma unroll
            for (int mt = 0; mt < 2; ++mt)
#pragma unroll
                for (int nt = 0; nt < 4; ++nt)
                    *(uint2*)RT_AT(nt * 16 + cn, 32 + mt * 16 + g4) = make_uint2(pack2(R1[mt][nt][0], R1[mt][nt][1]), pack2(R1[mt][nt][2], R1[mt][nt][3]));
            asm volatile("s_waitcnt lgkmcnt(0)" ::: "memory");
#pragma unroll
            for (int nt = 0; nt < 4; ++nt) bfr[nt] = *(const bf16x8*)RT_AT(nt * 16 + cn, 32 + kg);
#pragma unroll
            for (int mt = 0; mt < 2; ++mt) {
                const bf16x8 af = *(const bf16x8*)(D1 + (mt * 16 + cn) * 40 + kg);
#pragma unroll
                for (int nt = 0; nt < 4; ++nt) {
                    const f32x4 x1 = __builtin_amdgcn_mfma_f32_16x16x32_bf16(af, bfr[nt], (f32x4){0.f, 0.f, 0.f, 0.f}, 0, 0, 0);
#pragma unroll
                    for (int r = 0; r < 4; ++r) dstb[(32 + mt * 16 + g4 + r) * 128 + wcol[nt]] = f2bf(x1[r]);
                }
            }
        }
    }
#undef RT_AT
}
typedef short s16x4 __attribute__((ext_vector_type(4)));
#define SCAN_KOFF(r_, ch_) (256 * (r_) + 16 * ((ch_) ^ ((((r_) & 3) << 2) | (((r_) >> 2) & 3))))
#define SCAN_SMEM_BYTES (17408 + 17408 + 9216 + 18432 + 8 * 4352 + 8 * 2 * 2304 + 512)
__device__ __forceinline__ void ph_e_scan(CP& p, int j, char* smem) {
    for (int st = lbid(); st < 192; st += gridDim.x) {
        const int tid = ltid(), lane = tid & 63, wave = tid >> 6;
        bf16_t* Ws = (bf16_t*)smem;
        bf16_t* Qs = Ws + 64 * 136;
        bf16_t* QKs = Qs + 64 * 136;
        bf16_t* KnT = QKs + 64 * 72;
        bf16_t* St = KnT + 128 * 72 + wave * (16 * 136);
        bf16_t* VNt = KnT + 128 * 72 + 8 * (16 * 136) + wave * (2 * 16 * 72);
        bf16_t* VNs = VNt + 16 * 72;
        float* gcs = (float*)((char*)KnT + 16384);
        const int g4 = (lane >> 4) * 4, cn = lane & 15;
        int seq, h, dir;
        if (st < 64) { seq = 16 + (st >> 3); h = (st >> 1) & 3; dir = st & 1; }
        else { const int q = st - 64; seq = q >> 3; h = (q >> 1) & 3; dir = q & 1; }
        const int L = seq < 16 ? 256 : 4096;
        const int s0 = seq < 16 ? seq * 256 : TP_TOK + (seq - 16) * 4096;
        const int nch = L / 64;
        f32x4 S[8][1];
        if (seq >= 16) {
            const float* sp = p.state_gdn + ((((long)(seq - 16) * 2 + j) * 2 + dir) * 4 + h) * 16384 + (g4 * 128 + wave * 16 + cn);
#pragma unroll
            for (int mt = 0; mt < 8; ++mt)
#pragma unroll
                for (int r = 0; r < 4; ++r) S[mt][0][r] = sp[(mt * 16 + r) * 128];
        } else {
#pragma unroll
            for (int mt = 0; mt < 8; ++mt) S[mt][0] = (f32x4){0.f, 0.f, 0.f, 0.f};
        }
        u32x4 pw[2], pq[2], pk[2], pqk;
        float pgc = 0.f;
        float pu[16];
#define SCAN_LOAD_MAIN(M)                                                                                              \
        {                                                                                                              \
            const long ud_ = ((long)(s0 / 64 + (M)) * 4 + h) * 2 + dir;                                               \
            _Pragma("unroll") for (int i_ = 0; i_ < 2; ++i_) {                                                       \
                const int id_ = tid + i_ * NTHREADS, c_ = id_ >> 4, ch_ = id_ & 15;                                   \
                const int t_ = dir ? s0 + L - 1 - ((M) * 64 + c_) : s0 + (M) * 64 + c_;                               \
                pw[i_] = *(const u32x4*)(p.Wb + ud_ * 8192 + c_ * 128 + ch_ * 8);                                     \
                pq[i_] = *(const u32x4*)(p.qn + ((long)t_ * 4 + h) * 128 + ch_ * 8);                                  \
                pk[i_] = *(const u32x4*)(p.kn + ((long)t_ * 4 + h) * 128 + ch_ * 8);                                  \
            }                                                                                                          \
            pqk = *(const u32x4*)(p.QKb + ud_ * 4096 + (tid >> 3) * 64 + (tid & 7) * 8);                              \
            if (tid < 192) pgc = p.gcb[ud_ * 192 + tid];                                                              \
        }
#define SCAN_LOAD_U(M)                                                                                                 \
        {                                                                                                              \
            const long ud_ = ((long)(s0 / 64 + (M)) * 4 + h) * 2 + dir;                                               \
            long uo_ = ud_ * 8192 + (g4 * 128 + wave * 16 + cn);                                                       \
            asm volatile("" : "+v"(uo_));        \
            const bf16_t* ub_ = p.Ub + uo_;                                                                            \
            _Pragma("unroll") for (int mt_ = 0; mt_ < 4; ++mt_)                                                      \
                _Pragma("unroll") for (int r_ = 0; r_ < 4; ++r_)                                                     \
                    pu[mt_ * 4 + r_] = bf2f(ub_[(mt_ * 16 + r_) * 128]);                                              \
        }
        SCAN_LOAD_MAIN(0)
        SCAN_LOAD_U(0)
        for (int m = 0; m < nch; ++m) {
            __syncthreads();
#pragma unroll
            for (int i = 0; i < 2; ++i) {
                const int id = tid + i * NTHREADS, c = id >> 4, ch = id & 15;
                *(u32x4*)(Ws + c * 136 + ch * 8) = pw[i];
                *(u32x4*)(Qs + c * 136 + ch * 8) = pq[i];
                *(u32x4*)((char*)KnT + SCAN_KOFF(c, ch)) = pk[i];
            }
            *(u32x4*)(QKs + (tid >> 3) * 72 + (tid & 7) * 8) = pqk;
            if (tid < 192) gcs[tid] = pgc;
            __syncthreads();
            if (m + 1 < nch) SCAN_LOAD_MAIN(m + 1)
            f32x4 ws[4][1], qs[4][1];
#pragma unroll
            for (int mt = 0; mt < 4; ++mt) { ws[mt][0] = (f32x4){0.f, 0.f, 0.f, 0.f}; qs[mt][0] = (f32x4){0.f, 0.f, 0.f, 0.f}; }
            {
                bf16x8 sb[4];
#pragma unroll
                for (int ks = 0; ks < 4; ++ks) {
                    u32x4 w_;
                    w_[0] = pack2(S[2 * ks][0][0], S[2 * ks][0][1]); w_[1] = pack2(S[2 * ks][0][2], S[2 * ks][0][3]);
                    w_[2] = pack2(S[2 * ks + 1][0][0], S[2 * ks + 1][0][1]); w_[3] = pack2(S[2 * ks + 1][0][2], S[2 * ks + 1][0][3]);
                    sb[ks] = __builtin_bit_cast(bf16x8, w_);
                }
                const int kg_ = (lane >> 4) * 8;
                bf16x8 aw[4][4], aq[4][4];
#pragma unroll
                for (int ks = 0; ks < 4; ++ks)
#pragma unroll
                    for (int mt = 0; mt < 4; ++mt) {
                        aw[ks][mt] = *(const bf16x8*)(Ws + (mt * 16 + cn) * 136 + ks * 32 + kg_);
                        aq[ks][mt] = *(const bf16x8*)(Qs + (mt * 16 + cn) * 136 + ks * 32 + kg_);
                    }
#pragma unroll
                for (int ks = 0; ks < 4; ++ks)
#pragma unroll
                    for (int mt = 0; mt < 4; ++mt) {
                        ws[mt][0] = __builtin_amdgcn_mfma_f32_16x16x32_bf16(aw[ks][mt], sb[ks], ws[mt][0], 0, 0, 0);
                        qs[mt][0] = __builtin_amdgcn_mfma_f32_16x16x32_bf16(aq[ks][mt], sb[ks], qs[mt][0], 0, 0, 0);
                    }
            }
            const float glast = gcs[63];
            f32x4 vn[4];
#pragma unroll
            for (int mt = 0; mt < 4; ++mt) {
                float sc[4];
#pragma unroll
                for (int r = 0; r < 4; ++r) {
                    const int c = mt * 16 + g4 + r;
                    vn[mt][r] = pu[mt * 4 + r] - ws[mt][0][r];
                    sc[r] = vn[mt][r] * gcs[128 + c];
                }
                *(uint2*)(VNt + cn * 72 + mt * 16 + g4) = make_uint2(pack2(vn[mt][0], vn[mt][1]), pack2(vn[mt][2], vn[mt][3]));
                *(uint2*)(VNs + cn * 72 + mt * 16 + g4) = make_uint2(pack2(sc[0], sc[1]), pack2(sc[2], sc[3]));
            }
            if (m + 1 < nch) SCAN_LOAD_U(m + 1)
            asm volatile("s_waitcnt lgkmcnt(0)" ::: "memory");
            f32x4 oo[4][1];
#pragma unroll
            for (int mt = 0; mt < 4; ++mt)
#pragma unroll
                for (int r = 0; r < 4; ++r) oo[mt][0][r] = gcs[64 + mt * 16 + g4 + r] * qs[mt][0][r];
            wave_mma_u<4, 1, 2>(oo, QKs, 72, VNt, 72);
            {
                const int t0_ = dir ? s0 + L - 1 - (m * 64 + g4) : s0 + m * 64 + g4;
                long oo_ = ((long)t0_ * 4 + h) * 128 + wave * 16 + cn;
                asm volatile("" : "+v"(oo_));
                bf16_t* od = (dir ? p.ob : p.of) + oo_;
                if (dir) {
#pragma unroll
                    for (int mt = 0; mt < 4; ++mt)
#pragma unroll
                        for (int r = 0; r < 4; ++r) od[-(mt * 16 + r) * 512] = f2bf(oo[mt][0][r]);
                } else {
#pragma unroll
                    for (int mt = 0; mt < 4; ++mt)
#pragma unroll
                        for (int r = 0; r < 4; ++r) od[(mt * 16 + r) * 512] = f2bf(oo[mt][0][r]);
                }
            }
            const float eg = __expf(glast);
#pragma unroll
            for (int mt = 0; mt < 8; ++mt) S[mt][0] = S[mt][0] * eg;
            {
                const int q_ = (lane >> 2) & 3, pp_ = lane & 3, g_ = lane >> 4;
#pragma unroll
                for (int ks = 0; ks < 2; ++ks) {
                    const bf16x8 bfr = *(const bf16x8*)(VNs + cn * 72 + ks * 32 + g_ * 8);
                    s16x4 lo[8], hi[8];
#pragma unroll
                    for (int mt = 0; mt < 8; ++mt) {
                        const int r0 = ks * 32 + g_ * 8 + q_, chk = mt * 2 + (pp_ >> 1);
                        lo[mt] = __builtin_amdgcn_ds_read_tr16_b64_v4i16((__attribute__((address_space(3))) s16x4*)((char*)KnT + SCAN_KOFF(r0, chk) + 8 * (pp_ & 1)));
                        hi[mt] = __builtin_amdgcn_ds_read_tr16_b64_v4i16((__attribute__((address_space(3))) s16x4*)((char*)KnT + SCAN_KOFF(r0 + 4, chk) + 8 * (pp_ & 1)));
                    }
#pragma unroll
                    for (int mt = 0; mt < 8; ++mt) {
                        const bf16x8 afr = __builtin_shufflevector(lo[mt], hi[mt], 0, 1, 2, 3, 4, 5, 6, 7);
                        S[mt][0] = __builtin_amdgcn_mfma_f32_16x16x32_bf16(afr, bfr, S[mt][0], 0, 0, 0);
                    }
                }
            }
        }
#undef SCAN_LOAD_MAIN
#undef SCAN_LOAD_U
        if (seq < 16) {
            float* dp = p.out + OUT_STATE + ((((long)seq * 2 + j) * 2 + dir) * 4 + h) * 16384 + (g4 * 128 + wave * 16 + cn);
#pragma unroll
            for (int mt = 0; mt < 8; ++mt)
#pragma unroll
                for (int r = 0; r < 4; ++r) dp[(mt * 16 + r) * 128] = S[mt][0][r];
        }
    }
}

__device__ __forceinline__ void ph_fft_a(CP& p, char* smem) {
    __syncthreads();
    float* tws = (float*)(smem + GEMM_SMEM_BYTES);
    {
        const int t_ = ltid();
        f32x4 t4[4];
#pragma unroll
        for (int i = 0; i < 4; ++i) t4[i] = *(const f32x4*)(p.fftTW + (t_ + i * NTHREADS) * 4);
#pragma unroll
        for (int i = 0; i < 4; ++i) *(f32x4*)(tws + (t_ + i * NTHREADS) * 4) = t4[i];
    }
    __syncthreads();
    for (int u = lbid(); u < 1024; u += gridDim.x) {
        gemm_tile<0>(p.ZtA + ZA_OFF + (long)u * 256 * 128, 128, p.fftMA, 128, 128, (bf16_t*)smem, [&](int r, int c, f32x4 v) {
            const int gr = u * 256 + r;
            const int n2 = gr & 63, cf = (gr >> 6) & 511, b = gr >> 15;
            const int k1 = c >> 1, po = c & 1;
            f32x4 h;
#pragma unroll
            for (int i = 0; i < 4; ++i) {
                const float other = xshfl<1>(v[i]);
                const float2 tw = *(const float2*)(tws + ((n2 + i) * 64 + k1) * 2);
                h[i] = po == 0 ? (v[i] * tw.x + other * tw.y) : (v[i] * tw.x - other * tw.y);
            }
            bf16_t* dst = p.HB + (((((long)b * 64 + k1) * 512 + cf) * 2 + po) * 64 + n2);
            *(uint2*)dst = make_uint2(pack2(h[0], h[1]), pack2(h[2], h[3]));
        });
    }
}
__device__ __forceinline__ void ph_fft_b(CP& p, char* smem) {
    __syncthreads();
    const int nb = gridDim.x;
    for (int uu = lbid(); uu < 1024 + 64; uu += nb) {
        const int u = 1024 + 63 - uu;
        if (u < 0) continue;
        if (u < 1024) {
            gemm_tile<0>(p.HB + (long)u * 256 * 128, 128, p.fftMB, 128, 128, (bf16_t*)smem, [&](int r, int c, f32x4 v) {
                if (c < 64) {
                    const int gr = u * 256 + r;
                    const int cf = gr & 511, k1 = (gr >> 9) & 63, b = gr >> 15;
                    const long tok = TP_TOK + (long)b * 4096 + k1 + 64 * c;
                    *(uint2*)(p.mix + tok * DM + 512 + cf) = make_uint2(pack2(v[0], v[1]), pack2(v[2], v[3]));
                }
            });
        } else {
            const int q = u - 1024, seq = q >> 2, tm = (q >> 1) & 1, tn = q & 1;
            const int s0 = seq * 256;
            gemm_tile<0>(p.ZtA + (long)s0 * 1024 + (long)tm * 256 * 512, 512, p.dftP + (long)tn * 128 * 512, 512, 512, (bf16_t*)smem, [&](int r, int c, f32x4 v) {
                const int cf = tm * 256 + r, k = tn * 128 + c;
                *(uint2*)(p.mix + (long)(s0 + k) * DM + 512 + cf) = make_uint2(pack2(v[0], v[1]), pack2(v[2], v[3]));
            });
        }
    }
}

__device__ __forceinline__ void ph_e_mix(CP& p, int j) {
    const int lane = ltid() & 63, wave = ltid() >> 6;
    const float* onw = p.gdn_o_norm + j * 128;
    const float w0 = onw[lane * 2], w1 = onw[lane * 2 + 1];
    for (int row = lbid() * 8 + wave; row < T_TOK; row += gridDim.x * 8) {
        unsigned av[4], bv[4], gvv[4];
#pragma unroll
        for (int h = 0; h < 4; ++h) {
            av[h] = *(const unsigned*)(p.of + ((long)row * 4 + h) * 128 + lane * 2);
            bv[h] = *(const unsigned*)(p.ob + ((long)row * 4 + h) * 128 + lane * 2);
            gvv[h] = *(const unsigned*)(p.gate + (long)row * 512 + h * 128 + lane * 2);
        }
#pragma unroll
        for (int h = 0; h < 4; ++h) {
            const float o0 = bflo(av[h]) + bflo(bv[h]), o1 = bfhi(av[h]) + bfhi(bv[h]);
            const float ss = wave_sum(o0 * o0 + o1 * o1);
            const float r = rsqrtf(ss * (1.f / 128.f) + 1e-6f);
            *(unsigned*)(p.mix + (long)row * DM + h * 128 + lane * 2) = pack2(o0 * r * w0 * silu_f(bflo(gvv[h])), o1 * r * w1 * silu_f(bfhi(gvv[h])));
        }
    }
}

template <int FROM_INPUT = 0>
__device__ __forceinline__ void ph_out_gemm(CP& p, const bf16_t* A, const bf16_t* Wt, const float* mods_l, int g_off, char* smem, const float gscale = 1.f) {
    const int ntn = 4, ntm = T_TOK / 256;
#define OG_PROLOGUE(U) { int tm_, tn_; tile_map((U), ntm, ntn, tm_, tn_); g8_prologue<0>(A + (long)tm_ * 256 * DM, DM, Wt + (long)tn_ * 256 * 1024, 1024, (bf16_t*)smem); }
    int u = lbid();
    if (u < ntn * ntm) OG_PROLOGUE(u)
    for (; u < ntn * ntm; u += gridDim.x) {
        int tm, tn;
        tile_map(u, ntm, ntn, tm, tn);
        const int row0 = tm * 256, col0 = tn * 256;
        const float* gv = mods_l + (long)tok_modrow(row0) * 6144 + g_off;
        f32x4 acc[2][2][4][2];
        gemm_tile256_acc<0, 1>(A + (long)row0 * DM, DM, Wt + (long)col0 * 1024, 1024, 1024, (bf16_t*)smem, acc);
        if (u + (int)gridDim.x < ntn * ntm) OG_PROLOGUE(u + gridDim.x)
        const int tz = ltid(), wid = tz >> 6, lane = tz & 63, wr = wid >> 2, wc = wid & 3, fr = lane & 15, fq = lane >> 4;
#pragma unroll
        for (int ai = 0; ai < 2; ++ai)
#pragma unroll
            for (int bj = 0; bj < 2; ++bj) {
                const long xo = (long)(row0 + ai * 128 + wr * 64 + fq * 4) * DM + col0 + bj * 128 + wc * 32 + fr;
                float* xb = p.out + xo;
                const float* xs = FROM_INPUT ? (row0 < TP_TOK ? p.x_prompt + xo : p.x_sample + (xo - (long)TP_TOK * DM)) : xb;
                const float g0 = gv[col0 + bj * 128 + wc * 32 + fr] * gscale, g1 = gv[col0 + bj * 128 + wc * 32 + 16 + fr] * gscale;
                float xv[4][2][4];
#pragma unroll
                for (int m = 0; m < 4; ++m)
#pragma unroll
                    for (int n = 0; n < 2; ++n)
#pragma unroll
                        for (int i = 0; i < 4; ++i) xv[m][n][i] = xs[(long)(m * 16 + i) * DM + n * 16];
#pragma unroll
                for (int m = 0; m < 4; ++m)
#pragma unroll
                    for (int n = 0; n < 2; ++n)
#pragma unroll
                        for (int i = 0; i < 4; ++i) xb[(long)(m * 16 + i) * DM + n * 16] = xv[m][n][i] + (n ? g1 : g0) * acc[ai][bj][m][n][i];
            }
    }
#undef OG_PROLOGUE
}
__device__ __forceinline__ void ph_o_gemm1(CP& p, int j, char* smem) {
    const int ntn = N_OIN / 256, ntm = T_TOK / 256;
    const bf16_t* Bt = p.wtO_in + (long)j * N_OIN * 1024;
    for (int u = lbid(); u < ntn * ntm; u += gridDim.x) {
        int tm, tn;
        tile_map(u, ntm, ntn, tm, tn);
        const int row0 = tm * 256, col0 = tn * 256;
        gemm_tile256<0>(p.H + (long)row0 * DM, DM, Bt + (long)col0 * 1024, 1024, 1024, (bf16_t*)smem, [&](int r, int c, f32x4 v) {
            const int col = col0 + c;
            if (col < 832) {
#pragma unroll
                for (int i = 0; i < 4; ++i) p.Podd[(long)(row0 + r + i) * 832 + col] = v[i];
            }
        });
    }
}

__device__ __forceinline__ void ph_o_norm(CP& p, int j) {
    const int lane = ltid() & 63, wave = ltid() >> 6;
    float qw[8], kw[4];
#pragma unroll
    for (int i = 0; i < 8; ++i) qw[i] = p.mla_q_norm[j * 512 + i * 64 + lane];
#pragma unroll
    for (int i = 0; i < 4; ++i) kw[i] = p.mla_kv_norm[j * 256 + i * 64 + lane];
    for (int row = lbid() * 8 + wave; row < T_TOK + 2048; row += gridDim.x * 8) {
        if (row < T_TOK) {
            const float* pr = p.Podd + (long)row * 832;
            float q[8], k[4];
            float ssq = 0.f, ssk = 0.f;
#pragma unroll
            for (int i = 0; i < 8; ++i) { q[i] = pr[i * 64 + lane]; ssq += q[i] * q[i]; }
#pragma unroll
            for (int i = 0; i < 4; ++i) { k[i] = pr[512 + i * 64 + lane]; ssk += k[i] * k[i]; }
            const float kr = pr[768 + lane];
            ssq = wave_sum(ssq); ssk = wave_sum(ssk);
            const float rq = rsqrtf(ssq * (1.f / 512.f) + 1e-6f), rk = rsqrtf(ssk * (1.f / 256.f) + 1e-6f);
#pragma unroll
            for (int i = 0; i < 8; ++i) p.cq[(long)row * 512 + i * 64 + lane] = f2bf(q[i] * rq * qw[i]);
#pragma unroll
            for (int i = 0; i < 4; ++i) {
                const float v = k[i] * rk * kw[i];
                p.ckv_all[(long)row * 256 + i * 64 + lane] = f2bf(v);
                if (row < TP_TOK) p.out[OUT_CKV + (((long)(row >> 8) * 2 + j) * 256 + (row & 255)) * 256 + i * 64 + lane] = v;
            }
            p.kr_all[(long)row * 64 + lane] = kr;
            if (row < TP_TOK) p.out[OUT_KR + (((long)(row >> 8) * 2 + j) * 256 + (row & 255)) * 64 + lane] = kr;
        } else {
            const int rc = row - T_TOK, b = rc >> 8, t = rc & 255;
            const float* src = p.cache_ckv + (((long)b * 2 + j) * 256 + t) * 256;
#pragma unroll
            for (int i = 0; i < 4; ++i) p.ckv_all[(long)row * 256 + i * 64 + lane] = f2bf(src[i * 64 + lane]);
            p.kr_all[(long)row * 64 + lane] = p.cache_kr[(((long)b * 2 + j) * 256 + t) * 64 + lane];
        }
    }
}

#define KB_S (16L * 8 * 256 * 192)
#define VT_S (16L * 8 * 128 * 256)
__device__ __forceinline__ void ph_o_gemm2(CP& p, int j, char* smem) {
    const int nA = 6 * (T_TOK / 256);
    const int nB = 8 * ((T_TOK + 2048) / 256);
    for (int u = lbid(); u < nA + nB; u += gridDim.x) {
        if (u < nA) {
            int tm, tn;
            tile_map(u, T_TOK / 256, 6, tm, tn);
            const int row0 = tm * 256, col0 = tn * 256;
            const int s0 = tok_seq0(row0), L = tok_len(row0);
            f32x4 acc[2][2][4][2];
            gemm_tile256_acc<0>(p.cq + (long)row0 * 512, 512, p.wtUq + (long)j * 1536 * 512 + (long)col0 * 512, 512, 512, (bf16_t*)smem, acc);
            const int tz = ltid(), wid = tz >> 6, lane = tz & 63, wr = wid >> 2, wc = wid & 3, fr = lane & 15, fq = lane >> 4;
#pragma unroll
            for (int bj = 0; bj < 2; ++bj)
#pragma unroll
                for (int n = 0; n < 2; ++n) {
                    const int col = col0 + bj * 128 + wc * 32 + n * 16 + fr, h = col / 192, d = col - h * 192;
                    bf16_t* qd = p.Qb + (long)s0 * 1536 + ((long)h * L + (row0 - s0) + wr * 64 + fq * 4) * 192 + d;
#pragma unroll
                    for (int ai = 0; ai < 2; ++ai)
#pragma unroll
                        for (int m = 0; m < 4; ++m)
#pragma unroll
                            for (int i = 0; i < 4; ++i) qd[(ai * 128 + m * 16 + i) * 192] = f2bf(acc[ai][bj][m][n][i]);
                }
        } else {
            const int q = u - nA;
            int tm, tn;
            tile_map(q, (T_TOK + 2048) / 256, 8, tm, tn);
            const int row0 = tm * 256, col0 = tn * 256;
            long kbase, vbase; int Lk, pos0;
            if (row0 < TP_TOK) { const int s = row0 >> 8; kbase = (long)s * 8 * 256 * 192; vbase = (long)s * 8 * 128 * 256; Lk = 256; pos0 = 0; }
            else if (row0 < T_TOK) { const int b = (row0 - TP_TOK) >> 12; kbase = KB_S + (long)b * 8 * 4352 * 192; vbase = VT_S + (long)b * 8 * 128 * 4352; Lk = 4352; pos0 = (row0 - TP_TOK) & 4095; }
            else { const int b = (row0 - T_TOK) >> 8; kbase = KB_S + (long)b * 8 * 4352 * 192; vbase = VT_S + (long)b * 8 * 128 * 4352; Lk = 4352; pos0 = 4096; }
            f32x4 acc[2][2][4][2];
            gemm_tile256_acc<0>(p.ckv_all + (long)row0 * 256, 256, p.wtUkv + (long)j * 2048 * 256 + (long)col0 * 256, 256, 256, (bf16_t*)smem, acc);
            const int tz = ltid(), wid = tz >> 6, lane = tz & 63, wr = wid >> 2, wc = wid & 3, fr = lane & 15, fq = lane >> 4;
            const int h = tn;
            bf16_t* kd = p.Kb + kbase + ((long)h * Lk + pos0 + wr * 64 + fq * 4) * 192 + wc * 32 + fr;
#pragma unroll
            for (int ai = 0; ai < 2; ++ai)
#pragma unroll
                for (int m = 0; m < 4; ++m)
#pragma unroll
                    for (int i = 0; i < 4; ++i)
#pragma unroll
                        for (int n = 0; n < 2; ++n) kd[(ai * 128 + m * 16 + i) * 192 + n * 16] = f2bf(acc[ai][0][m][n][i]);
            bf16_t* vd = p.Vtb + vbase + ((long)h * 128 + wc * 32 + fr) * Lk;
#pragma unroll
            for (int ai = 0; ai < 2; ++ai)
#pragma unroll
                for (int m = 0; m < 4; ++m) {
                    const int kp = pos0 + ai * 128 + wr * 64 + m * 16 + fq * 4, kq = (kp & ~31) | (((kp >> 2) & 3) << 3) | (((kp >> 4) & 1) << 2);
#pragma unroll
                    for (int n = 0; n < 2; ++n) {
                        const f32x4 v = acc[ai][1][m][n];
                        *(uint2*)(vd + (long)n * 16 * Lk + kq) = make_uint2(pack2(v[0], v[1]), pack2(v[2], v[3]));
                    }
                }
        }
    }
}

__device__ __forceinline__ void ph_o_qknorm(CP& p, int j) {
    const int lane = ltid() & 63, wave = ltid() >> 6;
    const float* qnw = p.mla_q_headnorm + j * 192;
    const float* knw = p.mla_k_headnorm + j * 192;
    const float qw0 = qnw[lane], qw1 = qnw[64 + lane], qw2 = qnw[128 + lane];
    const float kw0 = knw[lane], kw1 = knw[64 + lane], kw2 = knw[128 + lane];
    const float inv = exp2f(-(float)(lane & 15) * 0.8304820237218406f);
    for (int row = lbid() * 8 + wave; row < T_TOK + 2048; row += gridDim.x * 8) {
        bool rope = false; float cs = 1.f, sn = 0.f;
        long kbase; int Lk, pos;
        if (row < TP_TOK) { const int s = row >> 8; kbase = (long)s * 8 * 256 * 192; Lk = 256; pos = row & 255; }
        else if (row < T_TOK) {
            const int b = (row - TP_TOK) >> 12; pos = (row - TP_TOK) & 4095; kbase = KB_S + (long)b * 8 * 4352 * 192; Lk = 4352; rope = true;
            const float ang = (float)((lane & 32) ? (pos & 63) : (pos >> 6)) * inv;
            sincosf(ang, &sn, &cs);
        } else { const int rc = row - T_TOK; const int b = rc >> 8; pos = 4096 + (rc & 255); kbase = KB_S + (long)b * 8 * 4352 * 192; Lk = 4352; }
        const float kr = p.kr_all[(long)row * 64 + lane];
        const bool hi = (lane & 16) != 0;
        const bool isq = row < T_TOK;
        const int s0 = isq ? tok_seq0(row) : 0, L = isq ? tok_len(row) : 1;
        bf16_t* kp0 = p.Kb + kbase + (long)pos * 192;
        bf16_t* qp0 = p.Qb + (long)s0 * 1536 + (long)(row - s0) * 192;
        float k0[8], k1[8], q0[8], q1[8], q2[8];
#pragma unroll
        for (int h = 0; h < 8; ++h) {
            const bf16_t* kp = kp0 + (long)h * Lk * 192;
            k0[h] = bf2f(kp[lane]); k1[h] = bf2f(kp[64 + lane]);
        }
        if (isq) {
#pragma unroll
            for (int h = 0; h < 8; ++h) {
                const bf16_t* qp = qp0 + (long)h * L * 192;
                q0[h] = bf2f(qp[lane]); q1[h] = bf2f(qp[64 + lane]); q2[h] = bf2f(qp[128 + lane]);
            }
        }
#pragma unroll
        for (int h = 0; h < 8; ++h) {
            bf16_t* kp = kp0 + (long)h * Lk * 192;
            const float ss = wave_sum(k0[h] * k0[h] + k1[h] * k1[h] + kr * kr);
            const float r = rsqrtf(ss * (1.f / 192.f) + 1e-6f);
            float y2 = kr * r * kw2;
            if (rope) {
                const float o = xshfl<16>(y2);
                y2 = hi ? (o * sn + y2 * cs) : (y2 * cs - o * sn);
            }
            kp[lane] = f2bf(k0[h] * r * kw0); kp[64 + lane] = f2bf(k1[h] * r * kw1); kp[128 + lane] = f2bf(y2);
        }
        if (isq) {
#pragma unroll
            for (int h = 0; h < 8; ++h) {
                bf16_t* qp = qp0 + (long)h * L * 192;
                const float ss = wave_sum(q0[h] * q0[h] + q1[h] * q1[h] + q2[h] * q2[h]);
                const float r = rsqrtf(ss * (1.f / 192.f) + 1e-6f) * 0.10411755f;
                float y2 = q2[h] * r * qw2;
                if (rope) {
                    const float o = xshfl<16>(y2);
                    y2 = hi ? (o * sn + y2 * cs) : (y2 * cs - o * sn);
                }
                qp[lane] = f2bf(q0[h] * r * qw0); qp[64 + lane] = f2bf(q1[h] * r * qw1); qp[128 + lane] = f2bf(y2);
            }
        }
    }
}

#define ATT_KLD 208
#define ATT_VLD 80
#define ATTN_SMEM_BYTES (2 * 64 * ATT_KLD * 2 + 3 * 128 * ATT_VLD * 2)
__device__ __forceinline__ void ph_o_attn(CP& p, char* smem) {
    for (int u = lbid(); u < 1152; u += gridDim.x) {
        int lz = 0, tid = ltid();
        asm volatile("" : "+s"(lz), "+v"(tid));
        const int lane = tid & 63, wave = tid >> 6;
        const int g = lane >> 4, cn = lane & 15, kg = g * 8;
        bf16_t* Ks = (bf16_t*)(smem + lz);
        bf16_t* Vs = Ks + 2 * 64 * ATT_KLD;
        int s0, L, Lk, h, q0; long kbase, vbase;
        if (u < 1024) { const int b = u >> 7; h = (u >> 4) & 7; q0 = (u & 15) * 256; s0 = TP_TOK + b * 4096; L = 4096; Lk = 4352; kbase = KB_S + (long)b * 8 * 4352 * 192; vbase = VT_S + (long)b * 8 * 128 * 4352; }
        else { const int q = u - 1024; const int s = q >> 3; h = q & 7; q0 = 0; s0 = s * 256; L = 256; Lk = 256; kbase = (long)s * 8 * 256 * 192; vbase = (long)s * 8 * 128 * 256; }
        const bf16_t* Qp = p.Qb + (long)s0 * 1536 + ((long)h * L + q0 + wave * 32) * 192;
        const bf16_t* Kp = p.Kb + kbase + (long)h * Lk * 192;
        const bf16_t* Vp = p.Vtb + vbase + (long)h * 128 * Lk;
        bf16x8 qb[2][6];
#pragma unroll
        for (int mt = 0; mt < 2; ++mt)
#pragma unroll
            for (int ks = 0; ks < 6; ++ks) qb[mt][ks] = *(const bf16x8*)(Qp + (mt * 16 + cn) * 192 + ks * 32 + kg);
        f32x4 o[8][2];
        f32x4 negm[2];
        float lrow[2];
#pragma unroll
        for (int mt = 0; mt < 2; ++mt) {
#pragma unroll
            for (int dt = 0; dt < 8; ++dt) o[dt][mt] = (f32x4){0.f, 0.f, 0.f, 0.f};
            negm[mt] = (f32x4){0.f, 0.f, 0.f, 0.f}; lrow[mt] = 0.f;
        }
        const int nkt = Lk / 64;
        u32x4 rk[3], rv[2];
        f32x4 s[4][2];
        bf16x8 pb[2][2];
        bf16x8 fa[2][4];
#define ATT_SB() __builtin_amdgcn_sched_barrier(0)
#define ATT_LDK(dst_, Kc_, ks_) _Pragma("unroll") for (int nt = 0; nt < 4; ++nt) dst_[nt] = *(const bf16x8*)((Kc_) + (nt * 16 + cn) * ATT_KLD + (ks_) * 32 + kg)
#define ATT_LDV(dst_, Vc_, b_) _Pragma("unroll") for (int d4 = 0; d4 < 4; ++d4) dst_[d4] = *(const bf16x8*)((Vc_) + ((((b_) & 1) * 4 + d4) * 16 + cn) * ATT_VLD + ((b_) >> 1) * 32 + kg)
        float pv[2][4][4];
#define ATT_LDK2(dst_, Kc_, h_, ks_) _Pragma("unroll") for (int n_ = 0; n_ < 2; ++n_) dst_[n_] = *(const bf16x8*)((Kc_) + ((2 * (h_) + n_) * 16 + cn) * ATT_KLD + (ks_) * 32 + kg)
#define ATT_PACK(mt_, k2_)                                                                                             \
        {                                                                                                              \
            u32x4 w_;                                                                                                  \
            w_[0] = pack2(pv[mt_][2 * (k2_)][0], pv[mt_][2 * (k2_)][1]); w_[1] = pack2(pv[mt_][2 * (k2_)][2], pv[mt_][2 * (k2_)][3]);   \
            w_[2] = pack2(pv[mt_][2 * (k2_) + 1][0], pv[mt_][2 * (k2_) + 1][1]); w_[3] = pack2(pv[mt_][2 * (k2_) + 1][2], pv[mt_][2 * (k2_) + 1][3]);   \
            pb[mt_][k2_] = __builtin_bit_cast(bf16x8, w_);                                                             \
        }
#define ATT_QK(Kc_, Vc_)                                                                                               \
        {                                                                                                              \
            ATT_LDK2(fa[0], Kc_, 0, 0);                                                                                \
            _Pragma("unroll") for (int t_ = 0; t_ < 12; ++t_) {                                                      \
                const int h_ = t_ / 6, ks = t_ % 6;                                                                    \
                if (t_ < 11) { ATT_LDK2(fa[(t_ + 1) & 1], Kc_, (t_ + 1) / 6, (t_ + 1) % 6); } else { ATT_LDV(fa[0], Vc_, 0); }   \
                ATT_SB();                                                                                              \
                _Pragma("unroll") for (int n_ = 0; n_ < 2; ++n_)                                                     \
                    _Pragma("unroll") for (int mt = 0; mt < 2; ++mt)                                                 \
                        s[2 * h_ + n_][mt] = __builtin_amdgcn_mfma_f32_16x16x32_bf16(fa[t_ & 1][n_], qb[mt][ks], ks == 0 ? negm[mt] : s[2 * h_ + n_][mt], 0, 0, 0);   \
                if (h_ == 1 && ks < 4) {                                                                               \
                    _Pragma("unroll") for (int r = 0; r < 4; ++r) pv[ks >> 1][ks & 1][r] = __builtin_amdgcn_exp2f(s[ks & 1][ks >> 1][r]);   \
                }                                                                                                      \
                if (h_ == 1 && ks >= 4) ATT_PACK(ks - 4, 0)                                                            \
                if (t_ < 11) ATT_SB();                                                                                 \
            }                                                                                                          \
        }
#define ATT_PBIG 4096.f
#define ATT_SOFTMAX(first_)                                                                                            \
        {                                                                                                              \
            float ps[2];                                                                                               \
            _Pragma("unroll") for (int mt = 0; mt < 2; ++mt) {                                                       \
                _Pragma("unroll") for (int nt = 2; nt < 4; ++nt)                                                     \
                    _Pragma("unroll") for (int r = 0; r < 4; ++r) pv[mt][nt][r] = __builtin_amdgcn_exp2f(s[nt][mt][r]);   \
                ps[mt] = 0.f;                                                                                          \
                _Pragma("unroll") for (int nt = 0; nt < 4; ++nt)                                                     \
                    _Pragma("unroll") for (int r = 0; r < 4; ++r) ps[mt] += pv[mt][nt][r];                           \
            }                                                                                                          \
            const bool ok = !(first_) && ps[0] <= ATT_PBIG && ps[1] <= ATT_PBIG;                                       \
            if (!__all(ok)) {                                                                                          \
                _Pragma("unroll") for (int mt = 0; mt < 2; ++mt) {                                                   \
                    float mx = fmaxf(fmaxf(s[0][mt][0], s[0][mt][1]), fmaxf(s[0][mt][2], s[0][mt][3]));               \
                    _Pragma("unroll") for (int nt = 1; nt < 4; ++nt) mx = fmaxf(mx, fmaxf(fmaxf(s[nt][mt][0], s[nt][mt][1]), fmaxf(s[nt][mt][2], s[nt][mt][3])));   \
                    mx = fmaxf(mx, xshfl<16>(mx));                                                                     \
                    mx = fmaxf(mx, xshfl<32>(mx));                                                                     \
                    const float dl = (first_) ? mx : fmaxf(mx, 0.f);                                                   \
                    const float al = (first_) ? 1.f : __builtin_amdgcn_exp2f(-dl);                                     \
                    negm[mt] = negm[mt] - dl;                                                                          \
                    lrow[mt] *= al;                                                                                    \
                    _Pragma("unroll") for (int dt = 0; dt < 8; ++dt) o[dt][mt] = o[dt][mt] * al;                     \
                    ps[mt] = 0.f;                                                                                      \
                    _Pragma("unroll") for (int nt = 0; nt < 4; ++nt)                                                 \
                        _Pragma("unroll") for (int r = 0; r < 4; ++r) { pv[mt][nt][r] = __builtin_amdgcn_exp2f(s[nt][mt][r] - dl); ps[mt] += pv[mt][nt][r]; }   \
                    ATT_PACK(mt, 0)                                                                                    \
                }                                                                                                      \
            }                                                                                                          \
            _Pragma("unroll") for (int mt = 0; mt < 2; ++mt) {                                                       \
                lrow[mt] += ps[mt];                                                                                    \
                ATT_PACK(mt, 1)                                                                                        \
            }                                                                                                          \
        }
#define ATT_PV(Vc_)                                                                                                    \
        {                                                                                                              \
            _Pragma("unroll") for (int b = 0; b < 4; ++b) {                                                          \
                if (b < 3) { ATT_LDV(fa[(b + 1) & 1], Vc_, b + 1); }                                                   \
                ATT_SB();                                                                                              \
                _Pragma("unroll") for (int d4 = 0; d4 < 4; ++d4)                                                     \
                    _Pragma("unroll") for (int mt = 0; mt < 2; ++mt) o[(b & 1) * 4 + d4][mt] = __builtin_amdgcn_mfma_f32_16x16x32_bf16(fa[b & 1][d4], pb[mt][b >> 1], o[(b & 1) * 4 + d4][mt], 0, 0, 0);   \
                ATT_SB();                                                                                              \
            }                                                                                                          \
        }
        __syncthreads();
#pragma unroll
        for (int i = 0; i < 3; ++i) { const int ch = tid + i * 512, row = ch / 24, kc = ch % 24; rk[i] = *(const u32x4*)(Kp + (long)row * 192 + kc * 8); }
#pragma unroll
        for (int i = 0; i < 2; ++i) { const int ch = tid + i * 512, row = ch >> 3, kc = ch & 7; rv[i] = *(const u32x4*)(Vp + (long)row * Lk + kc * 8); }
#pragma unroll
        for (int i = 0; i < 3; ++i) { const int ch = tid + i * 512, row = ch / 24, kc = ch % 24; *(u32x4*)(Ks + row * ATT_KLD + kc * 8) = rk[i]; }
#pragma unroll
        for (int i = 0; i < 2; ++i) { const int ch = tid + i * 512, row = ch >> 3, kc = ch & 7; *(u32x4*)(Vs + row * ATT_VLD + kc * 8) = rv[i]; }
        __syncthreads();
        for (int it = 0; it < nkt; ++it) {
            const int cur = it & 1;
            const bool more = it + 1 < nkt;
            const long key0 = (long)(it + 1) * 64;
            if (more) {
#pragma unroll
                for (int i = 0; i < 3; ++i) { const int ch = tid + i * 512, row = ch / 24, kc = ch % 24; rk[i] = *(const u32x4*)(Kp + (key0 + row) * 192 + kc * 8); }
#pragma unroll
                for (int i = 0; i < 2; ++i) { const int ch = tid + i * 512, row = ch >> 3, kc = ch & 7; rv[i] = *(const u32x4*)(Vp + (long)row * Lk + key0 + kc * 8); }
            }
            const bf16_t* Kc = Ks + cur * 64 * ATT_KLD;
            ATT_QK(Kc, Vs + cur * 128 * ATT_VLD) ATT_SOFTMAX(it == 0) ATT_PV(Vs + cur * 128 * ATT_VLD)
            if (more) {
                bf16_t* Kn = Ks + (cur ^ 1) * 64 * ATT_KLD;
                bf16_t* Vn = Vs + (cur ^ 1) * 128 * ATT_VLD;
#pragma unroll
                for (int i = 0; i < 3; ++i) { const int ch = tid + i * 512, row = ch / 24, kc = ch % 24; *(u32x4*)(Kn + row * ATT_KLD + kc * 8) = rk[i]; }
#pragma unroll
                for (int i = 0; i < 2; ++i) { const int ch = tid + i * 512, row = ch >> 3, kc = ch & 7; *(u32x4*)(Vn + row * ATT_VLD + kc * 8) = rv[i]; }
            }
            __syncthreads();
        }
#undef ATT_QK
#undef ATT_SB
#undef ATT_LDK
#undef ATT_LDV
#undef ATT_SOFTMAX
#undef ATT_LDK2
#undef ATT_PACK
#undef ATT_PBIG
#undef ATT_PV
#pragma unroll
        for (int mt = 0; mt < 2; ++mt) {
            float l = lrow[mt];
            l += xshfl<16>(l); l += xshfl<32>(l);
            const float il = __builtin_amdgcn_rcpf(l);
            bf16_t* op = p.Ob + (long)(s0 + q0 + wave * 32 + mt * 16 + cn) * DM + h * 128 + 4 * g;
#pragma unroll
            for (int dt = 0; dt < 8; ++dt)
                *(uint2*)(op + dt * 16) = make_uint2(pack2(o[dt][mt][0] * il, o[dt][mt][1] * il), pack2(o[dt][mt][2] * il, o[dt][mt][3] * il));
        }
    }
}
__device__ __forceinline__ unsigned f2ord(float f) { const unsigned u = __float_as_uint(f); return u ^ ((u >> 31) ? 0xFFFFFFFFu : 0x80000000u); }
__device__ __forceinline__ float ord2f(unsigned o) { const unsigned u = (o >> 31) ? (o ^ 0x80000000u) : ~o; return __uint_as_float(u); }

#define KCE(a, b) { const unsigned hi_ = max(a, b), lo_ = min(a, b); a = hi_; b = lo_; }
__device__ __forceinline__ void sort16_desc(unsigned (&v)[16]) {
#define S2(a, b) KCE(v[a], v[b])
    S2(0, 13) S2(1, 12) S2(2, 15) S2(3, 14) S2(4, 8) S2(5, 6) S2(7, 11) S2(9, 10)
    S2(0, 5) S2(1, 7) S2(2, 9) S2(3, 4) S2(6, 13) S2(8, 14) S2(10, 15) S2(11, 12)
    S2(0, 1) S2(2, 3) S2(4, 5) S2(6, 8) S2(7, 9) S2(10, 11) S2(12, 13) S2(14, 15)
    S2(0, 2) S2(1, 3) S2(4, 10) S2(5, 11) S2(6, 7) S2(8, 9) S2(12, 14) S2(13, 15)
    S2(1, 2) S2(3, 12) S2(4, 6) S2(5, 7) S2(8, 10) S2(9, 11) S2(13, 14)
    S2(1, 4) S2(2, 6) S2(5, 8) S2(7, 10) S2(9, 13) S2(11, 14)
    S2(2, 4) S2(3, 6) S2(9, 12) S2(11, 13)
    S2(3, 5) S2(6, 8) S2(7, 9) S2(10, 12)
    S2(3, 4) S2(5, 6) S2(7, 8) S2(9, 10) S2(11, 12)
    S2(6, 7) S2(8, 9)
#undef S2
}
#define KCF(a, b) { const float hi_ = __builtin_fmaxf(a, b), lo_ = __builtin_fminf(a, b); a = hi_; b = lo_; }
__device__ __forceinline__ void sort16f_desc(float (&v)[16]) {
#define S2(a, b) KCF(v[a], v[b])
    S2(0, 13) S2(1, 12) S2(2, 15) S2(3, 14) S2(4, 8) S2(5, 6) S2(7, 11) S2(9, 10)
    S2(0, 5) S2(1, 7) S2(2, 9) S2(3, 4) S2(6, 13) S2(8, 14) S2(10, 15) S2(11, 12)
    S2(0, 1) S2(2, 3) S2(4, 5) S2(6, 8) S2(7, 9) S2(10, 11) S2(12, 13) S2(14, 15)
    S2(0, 2) S2(1, 3) S2(4, 10) S2(5, 11) S2(6, 7) S2(8, 9) S2(12, 14) S2(13, 15)
    S2(1, 2) S2(3, 12) S2(4, 6) S2(5, 7) S2(8, 10) S2(9, 11) S2(13, 14)
    S2(1, 4) S2(2, 6) S2(5, 8) S2(7, 10) S2(9, 13) S2(11, 14)
    S2(2, 4) S2(3, 6) S2(9, 12) S2(11, 13)
    S2(3, 5) S2(6, 8) S2(7, 9) S2(10, 12)
    S2(3, 4) S2(5, 6) S2(7, 8) S2(9, 10) S2(11, 12)
    S2(6, 7) S2(8, 9)
#undef S2
}
__device__ __forceinline__ void merge16f_desc(float (&a)[16], const float (&b)[16]) {
#pragma unroll
    for (int i = 0; i < 16; ++i) a[i] = __builtin_fmaxf(a[i], b[15 - i]);
#pragma unroll
    for (int j = 8; j > 0; j >>= 1)
#pragma unroll
        for (int i = 0; i < 16; ++i) {
            const int l = i ^ j;
            if (l > i) { KCF(a[i], a[l]) }
        }
}
__device__ __forceinline__ void merge16_desc(unsigned (&a)[16], const unsigned (&b)[16]) {
#pragma unroll
    for (int i = 0; i < 16; ++i) a[i] = max(a[i], b[15 - i]);
#pragma unroll
    for (int j = 8; j > 0; j >>= 1)
#pragma unroll
        for (int i = 0; i < 16; ++i) {
            const int l = i ^ j;
            if (l > i) { KCE(a[i], a[l]) }
        }
}

#define RT_QLD 144
#define RT_SLD 130
#define ROUTE_SMEM_BYTES (256 * RT_SLD * 4 + 256 * 32)
__device__ __forceinline__ void ph_p_route(CP& p, int l, char* smem) {
    const int ntm = T_TOK / 256;
    const bf16_t* Bt = p.wtPq + (long)l * 2048 * 1024;
    for (int u = lbid(); u < 8 * ntm; u += gridDim.x) {
        int tm, h;
        tile_map(u, ntm, 8, tm, h);
        const int row0 = tm * 256;
        bf16_t* Qs = (bf16_t*)smem;
        bf16_t* SK = (bf16_t*)(smem + 65536);
        float* sc = (float*)smem;
        unsigned char* ib = (unsigned char*)smem + 256 * RT_SLD * 4;
        __syncthreads();
        f32x4 acc[2][2][4][2];
        gemm_tile256_acc<0>(p.H + (long)row0 * DM, DM, Bt + (long)h * 256 * 1024, 1024, 1024, (bf16_t*)smem, acc);
        const int tid = ltid(), lane = tid & 63, wave = tid >> 6;
        const int g4 = (lane >> 4) * 4, cn = lane & 15, kg = (lane >> 4) * 8;
        const int wr = wave >> 2, wc = wave & 3, fr = cn, fq = lane >> 4;
        const int trow = tid >> 1, half = tid & 1;
        float top[2][16];
#pragma unroll
        for (int pp = 0; pp < 2; ++pp) {
            __syncthreads();
#pragma unroll
            for (int ai = 0; ai < 2; ++ai)
#pragma unroll
                for (int m = 0; m < 4; ++m)
#pragma unroll
                    for (int n = 0; n < 2; ++n) {
                        const f32x4 v = acc[ai][pp][m][n];
                        *(uint2*)((char*)Qs + ai * 32768 + SCAN_KOFF(wc * 32 + n * 16 + fr, wr * 8 + m * 2 + (fq >> 1)) + (fq & 1) * 8) = make_uint2(pack2(v[0], v[1]), pack2(v[2], v[3]));
                    }
            {
                const bf16_t* skg = p.subk + ((long)l * 16 + h * 2 + pp) * 128 * 128;
                u32x4 kv[4];
#pragma unroll
                for (int i = 0; i < 4; ++i) kv[i] = *(const u32x4*)(skg + (tid + i * NTHREADS) * 8);
#pragma unroll
                for (int i = 0; i < 4; ++i) { const int ch = tid + i * NTHREADS; *(u32x4*)(SK + (ch >> 4) * RT_QLD + (ch & 15) * 8) = kv[i]; }
            }
            __syncthreads();
            f32x4 sacc[2][8];
#pragma unroll
            for (int mt = 0; mt < 2; ++mt)
#pragma unroll
                for (int nt = 0; nt < 8; ++nt) sacc[mt][nt] = (f32x4){0.f, 0.f, 0.f, 0.f};
            {
                const int q_ = (lane >> 2) & 3, pp_ = lane & 3;
                const char* qi = (const char*)Qs + (wave >> 2) * 32768;
#pragma unroll
                for (int ks = 0; ks < 4; ++ks) {
                    bf16x8 bfr[8];
#pragma unroll
                    for (int nt = 0; nt < 8; ++nt) bfr[nt] = *(const bf16x8*)(SK + (nt * 16 + cn) * RT_QLD + ks * 32 + kg);
#pragma unroll
                    for (int mt = 0; mt < 2; ++mt) {
                        const int d0 = ks * 32 + fq * 8 + q_, chk = (wave & 3) * 4 + mt * 2 + (pp_ >> 1);
                        const s16x4 lo = __builtin_amdgcn_ds_read_tr16_b64_v4i16((__attribute__((address_space(3))) s16x4*)(qi + SCAN_KOFF(d0, chk) + 8 * (pp_ & 1)));
                        const s16x4 hi = __builtin_amdgcn_ds_read_tr16_b64_v4i16((__attribute__((address_space(3))) s16x4*)(qi + SCAN_KOFF(d0 + 4, chk) + 8 * (pp_ & 1)));
                        const bf16x8 afr = __builtin_shufflevector(lo, hi, 0, 1, 2, 3, 4, 5, 6, 7);
#pragma unroll
                        for (int nt = 0; nt < 8; ++nt) sacc[mt][nt] = __builtin_amdgcn_mfma_f32_16x16x32_bf16(afr, bfr[nt], sacc[mt][nt], 0, 0, 0);
                    }
                }
            }
            __syncthreads();
#pragma unroll
            for (int mt = 0; mt < 2; ++mt)
#pragma unroll
                for (int nt = 0; nt < 8; ++nt)
#pragma unroll
                    for (int r = 0; r < 4; ++r) sc[(wave * 32 + mt * 16 + g4 + r) * RT_SLD + nt * 16 + cn] = sacc[mt][nt][r];
            __syncthreads();
            const float* srow = sc + trow * RT_SLD + half;
#pragma unroll
            for (int grp = 0; grp < 4; ++grp) {
                float v[16];
#pragma unroll
                for (int i = 0; i < 16; ++i) {
                    const int k = grp * 16 + i;
                    v[i] = __uint_as_float((__float_as_uint(srow[2 * k]) & 0xFFFFFF00u) | (unsigned)(2 * k));
                }
                sort16f_desc(v);
                if (grp == 0) {
#pragma unroll
                    for (int i = 0; i < 16; ++i) top[pp][i] = v[i];
                } else merge16f_desc(top[pp], v);
            }
            float oth[16];
#pragma unroll
            for (int i = 0; i < 16; ++i) top[pp][i] = __uint_as_float(__float_as_uint(top[pp][i]) | (unsigned)half);
#pragma unroll
            for (int i = 0; i < 16; ++i) oth[i] = xshfl<1>(top[pp][i]);
            merge16f_desc(top[pp], oth);
        }
        if (half == 0) {
            float s0[16], s1[16];
            unsigned iw[8];
#pragma unroll
            for (int i = 0; i < 8; ++i) iw[i] = 0u;
#pragma unroll
            for (int i = 0; i < 16; ++i) {
                s0[i] = __uint_as_float((__float_as_uint(top[0][i]) & 0xFFFFFF00u) | 0x80u);
                s1[i] = __uint_as_float((__float_as_uint(top[1][i]) & 0xFFFFFF00u) | 0x80u);
                iw[i >> 2] |= (__float_as_uint(top[0][i]) & 0xFFu) << ((i & 3) * 8);
                iw[4 + (i >> 2)] |= (__float_as_uint(top[1][i]) & 0xFFu) << ((i & 3) * 8);
            }
            unsigned* ibw = (unsigned*)(ib + trow * 32);
#pragma unroll
            for (int i = 0; i < 8; ++i) ibw[i] = iw[i];
            float ct[16];
            {
                float cg[4][16];
#pragma unroll
                for (int g_ = 0; g_ < 4; ++g_)
#pragma unroll
                    for (int i = 0; i < 16; ++i) cg[g_][i] = -3.0e38f;
                int cnt = 0;
#pragma unroll
                for (int a2 = 0; a2 < 16; ++a2)
#pragma unroll
                    for (int b2 = 0; b2 < 16; ++b2)
                        if ((a2 + 1) * (b2 + 1) <= 16) {
                            cg[cnt >> 4][cnt & 15] = __uint_as_float((__float_as_uint(s0[a2] + s1[b2]) & 0xFFFFFF00u) | (unsigned)(255 - (a2 * 16 + b2)));
                            ++cnt;
                        }
                if (s0[0] + s1[15] < 0.f) sort16f_desc(cg[0]);
                sort16f_desc(cg[1]); sort16f_desc(cg[2]);
                KCF(cg[3][0], cg[3][1])
#pragma unroll
                for (int i = 0; i < 16; ++i) ct[i] = cg[0][i];
                merge16f_desc(ct, cg[1]); merge16f_desc(ct, cg[2]); merge16f_desc(ct, cg[3]);
            }
            float cv[16];
#pragma unroll
            for (int i = 0; i < 16; ++i) cv[i] = __uint_as_float((__float_as_uint(ct[i]) & 0xFFFFFF00u) | 0x80u);
            const float mx = cv[0];
            float sum = 0.f;
#pragma unroll
            for (int i = 0; i < 16; ++i) { cv[i] = __expf(cv[i] - mx); sum += cv[i]; }
            const float inv = 1.f / sum;
            const long ob = ((long)(row0 + trow) * 8 + h) * 16;
            asm volatile("s_waitcnt lgkmcnt(0)" ::: "memory");
            const unsigned char* ibr = ib + trow * 32;
#pragma unroll
            for (int i = 0; i < 16; ++i) {
                const int fl = 255 - (int)(__float_as_uint(ct[i]) & 255u), a2 = fl >> 4, b2 = fl & 15;
                p.eidx[ob + i] = (int)ibr[a2] * 128 + (int)ibr[16 + b2];
                p.pgate[ob + i] = cv[i] * inv;
            }
        }
    }
}

#define PE_T 2
#define PE_LOADU(RA, BB, T_)                                                                                       \
    _Pragma("unroll") for (int k_ = 0; k_ < 8; ++k_) {                                                           \
        const int kk_ = (BB) * 8 + k_;                                                                           \
        const int e_ = __builtin_amdgcn_readlane((BB) < 8 ? e0[T_] : e1[T_], kk_ & 63);                          \
        RA[k_] = *(const u32x4*)(tabu + (long)e_ * 1024);                                                        \
    }
#define PE_LOADV(RA, BB, T_)                                                                                       \
    _Pragma("unroll") for (int k_ = 0; k_ < 8; ++k_) {                                                           \
        const int kk_ = (BB) * 8 + k_;                                                                           \
        const int e_ = __builtin_amdgcn_readlane((BB) < 8 ? e0[T_] : e1[T_], kk_ & 63);                          \
        RA[k_] = *(const u32x4*)(tabv + (long)e_ * 1024);                                                        \
    }
#define PE_X1(v_) __builtin_amdgcn_mov_dpp((int)(v_), 0xB1, 0xF, 0xF, true)
#define PE_X2(v_) __builtin_amdgcn_mov_dpp((int)(v_), 0x4E, 0xF, 0xF, true)
#define PE_X4(v_) __builtin_amdgcn_update_dpp(__builtin_amdgcn_update_dpp(0, (int)(v_), 0x104, 0xF, 0x5, false), (int)(v_), 0x114, 0xF, 0xA, false)
#define PE_X8(v_) __builtin_amdgcn_mov_dpp((int)(v_), 0x128, 0xF, 0xF, true)
#define PE_BREV(k_) ((((k_) & 1) << 2) | ((k_) & 2) | (((k_) >> 2) & 1))
#define PE_DOT(UA, BB, T_)                                                                                         \
    {                                                                                                              \
        int d_[8];                                                                                                 \
        _Pragma("unroll") for (int k_ = 0; k_ < 8; ++k_) {                                                       \
            int a_ = __builtin_amdgcn_sdot4((int)UA[k_][0], qx[T_][0], 0, false);                                \
            a_ = __builtin_amdgcn_sdot4((int)UA[k_][1], qx[T_][1], a_, false);                                   \
            a_ = __builtin_amdgcn_sdot4((int)UA[k_][2], qx[T_][2], a_, false);                                   \
            d_[k_] = __builtin_amdgcn_sdot4((int)UA[k_][3], qx[T_][3], a_, false);                               \
        }                                                                                                          \
               \
        int t4_[4], t2_[2], t1_;                                                                                   \
        _Pragma("unroll") for (int i_ = 0; i_ < 4; ++i_) { const int snd_ = b2 ? d_[i_] : d_[i_ + 4]; const int kp_ = b2 ? d_[i_ + 4] : d_[i_]; t4_[i_] = kp_ + PE_X4(snd_); } \
        _Pragma("unroll") for (int i_ = 0; i_ < 2; ++i_) { const int snd_ = b1 ? t4_[i_] : t4_[i_ + 2]; const int kp_ = b1 ? t4_[i_ + 2] : t4_[i_]; t2_[i_] = kp_ + PE_X2(snd_); } \
        { const int snd_ = b0 ? t2_[0] : t2_[1]; const int kp_ = b0 ? t2_[1] : t2_[0]; t1_ = kp_ + PE_X1(snd_); }  \
        t1_ += PE_X8(t1_);                                                                                         \
        t1_ += xshfl_i<16>(t1_);                                                                                       \
        t1_ += xshfl_i<32>(t1_);                                                                                       \
                                         \
        const bool mine_ = (lane >> 3) == ((BB) & 7);                                                              \
        hlo[T_] = (mine_ && (BB) < 8) ? t1_ : hlo[T_];                                                             \
        hhi[T_] = (mine_ && (BB) >= 8) ? t1_ : hhi[T_];                                                            \
    }
#define PE_AXPY(VA, BB, T_)                                                                                        \
    {                                                                                                              \
        const unsigned psel_ = (BB) < 8 ? pklo[T_] : pkhi[T_];                                                     \
        _Pragma("unroll") for (int h_ = 0; h_ < 2; ++h_) {                                                       \
            const int wp_ = __builtin_amdgcn_readlane((int)psel_, ((BB) & 7) * 8 + h_ * 4);                        \
            _Pragma("unroll") for (int i_ = 0; i_ < 4; ++i_) {                                                   \
                const unsigned a_ = VA[h_ * 4][i_], b_ = VA[h_ * 4 + 1][i_], c_ = VA[h_ * 4 + 2][i_], d_ = VA[h_ * 4 + 3][i_];   \
                const unsigned t0_ = __builtin_amdgcn_perm(b_, a_, 0x05010400u), t1_ = __builtin_amdgcn_perm(b_, a_, 0x07030602u);   \
                const unsigned t2_ = __builtin_amdgcn_perm(d_, c_, 0x05010400u), t3_ = __builtin_amdgcn_perm(d_, c_, 0x07030602u);   \
                acc[T_][i_ * 4 + 0] = __builtin_amdgcn_sdot4((int)__builtin_amdgcn_perm(t2_, t0_, 0x05040100u), wp_, acc[T_][i_ * 4 + 0], false);   \
                acc[T_][i_ * 4 + 1] = __builtin_amdgcn_sdot4((int)__builtin_amdgcn_perm(t2_, t0_, 0x07060302u), wp_, acc[T_][i_ * 4 + 1], false);   \
                acc[T_][i_ * 4 + 2] = __builtin_amdgcn_sdot4((int)__builtin_amdgcn_perm(t3_, t1_, 0x05040100u), wp_, acc[T_][i_ * 4 + 2], false);   \
                acc[T_][i_ * 4 + 3] = __builtin_amdgcn_sdot4((int)__builtin_amdgcn_perm(t3_, t1_, 0x07060302u), wp_, acc[T_][i_ * 4 + 3], false);   \
            }                                                                                                      \
        }                                                                                                          \
    }
template <int NEXT = 0>
__device__ __forceinline__ void ph_p_eval(CP& p, const float* mods_l, int l, const float* w_next, const float* mods_next, const float gscale = 1.f) {
    const int lane = ltid() & 63, wave = ltid() >> 6;
    const bool b0 = (lane & 1) != 0, b1 = (lane & 2) != 0, b2 = (lane & 4) != 0;
    const int rstride = gridDim.x * 8;
    const int first = lbid() * 8 + wave;
    const int ntok = (T_TOK - first + rstride - 1) / rstride;
    const int nsweep = __builtin_amdgcn_readfirstlane((T_TOK - lbid() * 8 + rstride - 1) / rstride + PE_T - 1) / PE_T;
    const unsigned char* tabu = p.tabU + (long)(l & 1) * 16384 * 2048 + lane * 16;
    const unsigned char* tabv = tabu + 16384L * 1024;
    const float* su_ = p.su + (l & 1) * 32768; const float* sv_ = su_ + 16384;
    u32x4 hpa[PE_T], hpb[PE_T]; unsigned kp0[PE_T], kp1[PE_T];
#define PE_PREFETCH(SW)                                                                                            \
    _Pragma("unroll") for (int t = 0; t < PE_T; ++t) {                                                           \
        const int ti_ = (SW) * PE_T + t;                                                                           \
        const long row_ = first + (ti_ < ntok ? ti_ : 0) * rstride;                                                \
        hpa[t] = *(const u32x4*)(p.H + row_ * DM + lane * 16); hpb[t] = *(const u32x4*)(p.H + row_ * DM + lane * 16 + 8);   \
        kp0[t] = (unsigned)p.eidx[row_ * 128 + lane]; kp1[t] = (unsigned)p.eidx[row_ * 128 + 64 + lane];          \
    }
    int e0[PE_T], e1[PE_T];
    float sgu0[PE_T], sgu1[PE_T], sgv0[PE_T], sgv1[PE_T];
    u32x4 rA[8], rB[8];
#define PE_SORT(SW)                                                                                                \
    _Pragma("unroll") for (int t = 0; t < PE_T; ++t) {                                                           \
        const int ti_ = (SW) * PE_T + t;                                                                           \
        const long row_ = first + (ti_ < ntok ? ti_ : 0) * rstride;                                                \
          \
        unsigned k0 = (kp0[t] << 7) | (unsigned)lane;                                                              \
        unsigned k1 = (kp1[t] << 7) | (unsigned)(64 + lane);                                                       \
        _Pragma("unroll") for (int size = 2; size <= 128; size <<= 1) {                                          \
            _Pragma("unroll") for (int stride = size >> 1; stride > 0; stride >>= 1) {                           \
                if (stride == 64) {                                                                                \
                    const unsigned lo = min(k0, k1), hi = max(k0, k1);                                             \
                    k0 = lo; k1 = hi;                                                                              \
                } else {                                                                                           \
                    unsigned o0, o1;                                                                               \
                    if (stride == 1) { o0 = (unsigned)PE_X1(k0); o1 = (unsigned)PE_X1(k1); }                       \
                    else if (stride == 2) { o0 = (unsigned)PE_X2(k0); o1 = (unsigned)PE_X2(k1); }                  \
                    else if (stride == 4) { o0 = (unsigned)PE_X4(k0); o1 = (unsigned)PE_X4(k1); }                  \
                    else if (stride == 8) { o0 = (unsigned)PE_X8(k0); o1 = (unsigned)PE_X8(k1); }                  \
                    else if (stride == 16) { o0 = (unsigned)xshfl_i<16>((int)k0); o1 = (unsigned)xshfl_i<16>((int)k1); }   \
                    else { o0 = (unsigned)xshfl_i<32>((int)k0); o1 = (unsigned)xshfl_i<32>((int)k1); }             \
                    const bool lower = (lane & stride) == 0;                                                       \
                    const bool asc0 = size == 128 ? true : ((lane & size) == 0);                                   \
                    const bool asc1 = size == 128 ? true : (((lane + 64) & size) == 0);                            \
                    k0 = (lower == asc0) ? min(k0, o0) : max(k0, o0);                                              \
                    k1 = (lower == asc1) ? min(k1, o1) : max(k1, o1);                                              \
                }                                                                                                  \
            }                                                                                                      \
        }                                                                                                          \
        e0[t] = (int)(k0 >> 7); e1[t] = (int)(k1 >> 7);                                                            \
        const int sl0 = (int)(k0 & 127u), sl1 = (int)(k1 & 127u);                                                  \
          \
        sgu0[t] = su_[e0[t]]; sgu1[t] = su_[e1[t]];                                                                \
        sgv0[t] = p.pgate[row_ * 128 + sl0] * sv_[e0[t]]; sgv1[t] = p.pgate[row_ * 128 + sl1] * sv_[e1[t]];        \
    }
    PE_PREFETCH(0)
    PE_SORT(0)
    PE_LOADU(rA, 0, 0)
    for (int sw = 0; sw < nsweep; ++sw) {
        __syncthreads();
        int rows[PE_T]; bool valid[PE_T];
        int qx[PE_T][4];
        float wlo[PE_T], whi[PE_T], swq[PE_T], sxv[PE_T];
        int hlo[PE_T], hhi[PE_T];
        int acc[PE_T][16];
        unsigned pklo[PE_T], pkhi[PE_T];
#pragma unroll
        for (int t = 0; t < PE_T; ++t) {
            const int ti = sw * PE_T + t;
            valid[t] = ti < ntok;
            const int row = first + (valid[t] ? ti : 0) * rstride;
            rows[t] = row;
            float x[16];
            {
                const u32x4 a = hpa[t], b = hpb[t];
#pragma unroll
                for (int i = 0; i < 4; ++i) { x[2 * i] = bflo(a[i]); x[2 * i + 1] = bfhi(a[i]); x[8 + 2 * i] = bflo(b[i]); x[8 + 2 * i + 1] = bfhi(b[i]); }
            }
            float mx = 0.f;
#pragma unroll
            for (int i = 0; i < 16; ++i) mx = fmaxf(mx, fabsf(x[i]));
            mx = wave_max(mx);
            const float sx = mx > 0.f ? mx * (1.f / 127.f) : 1.f;
            const float isx = 1.f / sx;
#pragma unroll
            for (int i = 0; i < 4; ++i) {
                unsigned pk = 0;
#pragma unroll
                for (int q = 0; q < 4; ++q) pk |= (unsigned)((int)rintf(x[i * 4 + q] * isx) & 0xFF) << (q * 8);
                qx[t][i] = (int)pk;
            }
            sxv[t] = sx;
            hlo[t] = 0; hhi[t] = 0;
#pragma unroll
            for (int i = 0; i < 16; ++i) acc[t][i] = 0;
        }
        for (int bb = 0; bb < 16; ++bb) {
            if ((bb & 3) == 0) __builtin_amdgcn_s_barrier();
            PE_LOADU(rB, bb, 1)
            PE_DOT(rA, bb, 0)
            if (bb + 1 < 16) { PE_LOADU(rA, bb + 1, 0) } else { PE_LOADV(rA, 0, 0) }
            PE_DOT(rB, bb, 1)
        }
#pragma unroll
        for (int t = 0; t < PE_T; ++t) {
            wlo[t] = sgv0[t] * gelu_tanh(sgu0[t] * sxv[t] * (float)hlo[t]); whi[t] = sgv1[t] * gelu_tanh(sgu1[t] * sxv[t] * (float)hhi[t]);
            float am = fmaxf(fabsf(wlo[t]), fabsf(whi[t]));
            am = wave_max(am);
            swq[t] = am > 0.f ? am * (1.f / 127.f) : 1.f;
            const float iw = 1.f / swq[t];
            const unsigned q0 = (unsigned)((int)rintf(wlo[t] * iw) & 0xFF), q1 = (unsigned)((int)rintf(whi[t] * iw) & 0xFF);
            const unsigned a0 = q0 | ((unsigned)xshfl_i<1>((int)q0) << 8);
            const unsigned a1 = q1 | ((unsigned)xshfl_i<1>((int)q1) << 8);
            pklo[t] = a0 | ((unsigned)xshfl_i<2>((int)a0) << 16);
            pkhi[t] = a1 | ((unsigned)xshfl_i<2>((int)a1) << 16);
        }
        if (sw + 1 < nsweep) { PE_PREFETCH(sw + 1) }
        f32x4 xvp[PE_T][4];
#pragma unroll
        for (int t = 0; t < PE_T; ++t)
#pragma unroll
            for (int q = 0; q < 4; ++q) xvp[t][q] = *(const f32x4*)(p.out + (long)rows[t] * DM + lane * 16 + q * 4);
        for (int bb = 0; bb < 16; ++bb) {
            if ((bb & 3) == 0) __builtin_amdgcn_s_barrier();
            PE_LOADV(rB, bb, 1)
            PE_AXPY(rA, bb, 0)
            if (bb + 1 < 16) { PE_LOADV(rA, bb + 1, 0) }
            PE_AXPY(rB, bb, 1)
        }
        if (sw + 1 < nsweep) { PE_SORT(sw + 1) PE_LOADU(rA, 0, 0) }
#pragma unroll
        for (int t = 0; t < PE_T; ++t) {
            if (!valid[t]) continue;
            const int row = rows[t];
            float y[16];
#pragma unroll
            for (int i = 0; i < 16; ++i) y[i] = swq[t] * (float)acc[t][i];
            const float* gv = mods_l + (long)tok_modrow(row) * 6144 + 5 * 1024;
            float* xr = p.out + (long)row * DM + lane * 16;
            float4 xv[4], gg[4];
#pragma unroll
            for (int q = 0; q < 4; ++q) { xv[q] = make_float4(xvp[t][q][0], xvp[t][q][1], xvp[t][q][2], xvp[t][q][3]); gg[q] = *(const float4*)(gv + lane * 16 + q * 4); }
            float4 nw[4], nsc[4], nsh[4];
            if (NEXT) {
                const float* mr = mods_next + (long)tok_modrow(row) * 6144;
#pragma unroll
                for (int q = 0; q < 4; ++q) { nw[q] = *(const float4*)(w_next + lane * 16 + q * 4); nsc[q] = *(const float4*)(mr + 1024 + lane * 16 + q * 4); nsh[q] = *(const float4*)(mr + lane * 16 + q * 4); }
            }
            float ss = 0.f;
#pragma unroll
            for (int q = 0; q < 4; ++q) {
                xv[q].x += gscale * gg[q].x * y[q * 4 + 0]; xv[q].y += gscale * gg[q].y * y[q * 4 + 1];
                xv[q].z += gscale * gg[q].z * y[q * 4 + 2]; xv[q].w += gscale * gg[q].w * y[q * 4 + 3];
                *(float4*)(xr + q * 4) = xv[q];
                ss += xv[q].x * xv[q].x + xv[q].y * xv[q].y + xv[q].z * xv[q].z + xv[q].w * xv[q].w;
            }
            if (NEXT) {
                ss = wave_sum(ss);
                const float r = rsqrtf(ss * (1.f / 1024.f) + 1e-6f);
#pragma unroll
                for (int q = 0; q < 4; ++q) {
                    const float h0 = xv[q].x * r * nw[q].x * (1.f + nsc[q].x) + nsh[q].x, h1 = xv[q].y * r * nw[q].y * (1.f + nsc[q].y) + nsh[q].y;
                    const float h2 = xv[q].z * r * nw[q].z * (1.f + nsc[q].z) + nsh[q].z, h3 = xv[q].w * r * nw[q].w * (1.f + nsc[q].w) + nsh[q].w;
                    *(uint2*)(p.H + (long)row * DM + lane * 16 + q * 4) = make_uint2(pack2(h0, h1), pack2(h2, h3));
                }
            }
        }
    }
}
#define SMEM_MAX 147456

#define BARRIER() do { XcdBarrier b_; b_.bar = p.bar; b_.x = xb_xcc_id(); b_.st = (volatile LAS unsigned*)(smem + SMEM_MAX); xcd_barrier(b_); } while (0)
__device__ __forceinline__ CP& kparams() {
    CP* kp = (CP*)__builtin_amdgcn_kernarg_segment_ptr();
    asm volatile("" : "+s"(kp));
    return *kp;
}
__global__ void __launch_bounds__(NTHREADS, 2) k_mega(Params p_unused) {
    extern __shared__ __attribute__((aligned(16))) char smem[];
#define p kparams()
    if (threadIdx.x == 0) *(uint4*)(smem + SMEM_MAX) = make_uint4(0u, 0u, 0u, 0u);
    __syncthreads();
    (void)xcd_barrier_post(p.bar, (volatile LAS unsigned*)(smem + SMEM_MAX));
    ph_init(p, smem);
    BARRIER();
#pragma unroll
    for (int l = 0; l < 4; ++l) {
        const int j = l >> 1;
#define mods_l (kparams().mods + (long)l * 9 * 6144)
        if (l == 0) {
            ph_norm<1>(p, p.norm_mix, mods_l, 0, 1024);
            BARRIER();
        }
        if ((l & 1) == 0) {
            ph_e_gemm(p, j, smem);
            BARRIER();
            ph_e_prep(p, j, smem);
            ph_fft_a(p, smem);
            BARRIER();
            ph_e_scan(p, j, smem);
            ph_fft_b(p, smem);
            ph_tab(p, l, 64);
            ph_tab(p, l + 1, 64);
            if (l == 0) ph_init2(p, smem, 64);
            BARRIER();
            ph_e_mix(p, j);
            BARRIER();
            if (l == 0) ph_out_gemm<1>(p, p.mix, p.wtE_out + (long)j * 1024 * 1024, mods_l, 2 * 1024, smem);
            else ph_out_gemm<0>(p, p.mix, p.wtE_out + (long)j * 1024 * 1024, mods_l, 2 * 1024, smem);
            BARRIER();
        } else {
            ph_o_gemm1(p, j, smem);
            BARRIER();
            ph_o_norm(p, j);
            BARRIER();
            ph_o_gemm2(p, j, smem);
            BARRIER();
            ph_o_qknorm(p, j);
            BARRIER();
            ph_o_attn(p, smem);
            BARRIER();
            ph_out_gemm(p, p.Ob, p.wtO_out + (long)j * 1024 * 1024, mods_l, 2 * 1024, smem);
            BARRIER();
        }
        ph_norm(p, p.norm_ffn + l * 1024, mods_l, 3 * 1024, 4 * 1024);
        BARRIER();
        ph_p_route(p, l, smem);
        BARRIER();
        if (l < 3) ph_p_eval<1>(p, mods_l, l, p.norm_mix + (l + 1) * 1024, p.mods + (long)(l + 1) * 9 * 6144);
        else ph_p_eval<0>(p, mods_l, l, p.norm_mix, p.mods);
        if (l < 3) BARRIER();
    }
#undef p
#undef mods_l
}

static inline size_t al256(size_t x) { return (x + 255) & ~(size_t)255; }

extern "C" void kernel_launch(void* const* d_in, const int* in_sizes, int n_in, void* d_out, int out_size, void* d_ws, size_t ws_size, hipStream_t stream) {
    Params p{};
    const float* const* in = (const float* const*)d_in;
    p.x_prompt = in[0]; p.x_sample = in[1]; p.state_gdn = in[2]; p.cache_ckv = in[3]; p.cache_kr = in[4]; p.c = in[5]; p.c_ctx = in[6];
    p.w_mod = in[7]; p.b_mod = in[8]; p.norm_mix = in[9]; p.norm_ffn = in[10];
    p.even_w_in = in[11]; p.even_conv_w = in[12]; p.gdn_a_log = in[13]; p.gdn_dt_bias = in[14]; p.gdn_o_norm = in[15]; p.even_w_out = in[16];
    p.odd_w_in = in[17]; p.mla_q_norm = in[18]; p.mla_kv_norm = in[19]; p.mla_w_uq = in[20]; p.mla_w_ukv = in[21]; p.mla_q_headnorm = in[22]; p.mla_k_headnorm = in[23]; p.odd_w_out = in[24];
    p.peer_w_q = in[25]; p.peer_sub_keys = in[26]; p.peer_u = in[27]; p.peer_v = in[28];
    p.out = (float*)d_out;
    char* ws = (char*)d_ws;
    size_t off = 0;
    auto take = [&](size_t bytes) { char* r = ws + off; off = al256(off + bytes); return r; };
    p.bar = (unsigned*)take(16384);
    p.mods = (float*)take(4L * 9 * 6144 * 4);
    p.wtE_in = (bf16_t*)take(2L * N_EIN * 1024 * 2);
    p.wtE_out = (bf16_t*)take(2L * 1024 * 1024 * 2);
    p.wtO_in = (bf16_t*)take(2L * N_OIN * 1024 * 2);
    p.wtUq = (bf16_t*)take(2L * 1536 * 512 * 2);
    p.wtUkv = (bf16_t*)take(2L * 2048 * 256 * 2);
    p.wtO_out = (bf16_t*)take(2L * 1024 * 1024 * 2);
    p.wtPq = (bf16_t*)take(4L * 2048 * 1024 * 2);
    p.subk = (bf16_t*)take(4L * 16 * 128 * 128 * 2);
    p.fftMA = (bf16_t*)take(128L * 128 * 2);
    p.fftMB = (bf16_t*)take(128L * 128 * 2);
    p.fftTW = (float*)take(4096L * 2 * 4);
    p.dftP = (bf16_t*)take(256L * 512 * 2);
    p.tabU = (unsigned char*)take(2L * 16384 * 2048);
    p.tabV = p.tabU;
    p.su = (float*)take(2L * 32768 * 4);
    p.sv = p.su;
    p.H = (bf16_t*)take((long)T_TOK * 1024 * 2);
    const size_t ubase = off;
    p.qkvraw = (bf16_t*)take((long)T_TOK * 1536 * 2);
    p.mix = p.qkvraw;
    p.gate = (bf16_t*)take((long)T_TOK * 512 * 2);
    p.ba = (float*)take((long)T_TOK * 16 * 4);
    p.ZtA = (bf16_t*)take((long)T_TOK * 1024 * 2);
    p.qn = (bf16_t*)take((long)T_TOK * 512 * 2);
    p.kn = (bf16_t*)take((long)T_TOK * 512 * 2);
    p.Wb = (bf16_t*)take(4608L * 8192 * 2);
    p.Ub = (bf16_t*)take(4608L * 8192 * 2);
    p.QKb = (bf16_t*)take(4608L * 4096 * 2);
    p.gcb = (float*)take(4608L * 192 * 4);
    p.of = (bf16_t*)take((long)T_TOK * 512 * 2);
    p.ob = (bf16_t*)take((long)T_TOK * 512 * 2);
    p.HB = (bf16_t*)take(8L * 64 * 512 * 2 * 64 * 2);
    const size_t even_end = off;
    off = ubase;
    p.Podd = (float*)take((long)T_TOK * 832 * 4);
    p.Ob = (bf16_t*)p.Podd;
    p.cq = (bf16_t*)take((long)T_TOK * 512 * 2);
    p.ckv_all = (bf16_t*)take((long)(T_TOK + 2048) * 256 * 2);
    p.kr_all = (float*)take((long)(T_TOK + 2048) * 64 * 4);
    p.Qb = (bf16_t*)take((long)T_TOK * 1536 * 2);
    p.Kb = (bf16_t*)take((KB_S + 8L * 8 * 4352 * 192) * 2);
    p.Vtb = (bf16_t*)take((VT_S + 8L * 8 * 128 * 4352) * 2);
    const size_t odd_end = off;
    off = ubase;
    p.eidx = (int*)take((long)T_TOK * 128 * 4);
    p.pgate = (float*)take((long)T_TOK * 128 * 4);
    const size_t peer_end = off;
    size_t need = even_end > odd_end ? even_end : odd_end;
    if (peer_end > need) need = peer_end;
    if (need > ws_size) return;

    static int grid = 0;
    if (!grid) {
        int dev = 0, cus = 0, per_cu = 0;
        hipGetDevice(&dev);
        hipDeviceGetAttribute(&cus, hipDeviceAttributeMultiprocessorCount, dev);
        if (hipFuncSetAttribute((const void*)k_mega, hipFuncAttributeMaxDynamicSharedMemorySize, SMEM_MAX + 16) != hipSuccess) return;
        if (hipOccupancyMaxActiveBlocksPerMultiprocessor(&per_cu, (const void*)k_mega, NTHREADS, SMEM_MAX + 16) != hipSuccess || per_cu < 1) return;
        grid = cus;
    }
    hipMemsetAsync(p.bar, 0, XCD_BAR_WORDS * sizeof(unsigned), stream);
    hipLaunchKernelGGL(k_mega, dim3(grid), dim3(NTHREADS), SMEM_MAX + 16, stream, p);
}
```

```cpp
#include <hip/hip_runtime.h>
#include <stdint.h>

typedef unsigned short bf16_t;
typedef short bf16x8 __attribute__((ext_vector_type(8)));
typedef float f32x4 __attribute__((ext_vector_type(4)));
typedef unsigned u32x4 __attribute__((ext_vector_type(4)));
typedef int i32x4 __attribute__((ext_vector_type(4)));

#define T_TOK   36864
#define TP_TOK  4096
#define DM      1024
#define NTHREADS 512
#define N_EIN   3328
#define N_OIN   1024
#define OUT_STATE 37748736L
#define OUT_CKV   41943040L
#define OUT_KR    44040192L

struct Params {
    const float *x_prompt, *x_sample, *state_gdn, *cache_ckv, *cache_kr, *c, *c_ctx, *w_mod, *b_mod, *norm_mix, *norm_ffn;
    const float *even_w_in, *even_conv_w, *gdn_a_log, *gdn_dt_bias, *gdn_o_norm, *even_w_out;
    const float *odd_w_in, *mla_q_norm, *mla_kv_norm, *mla_w_uq, *mla_w_ukv, *mla_q_headnorm, *mla_k_headnorm, *odd_w_out;
    const float *peer_w_q, *peer_sub_keys, *peer_u, *peer_v;
    float* out;
    unsigned* bar;
    float* mods;
    bf16_t *wtE_in, *wtE_out, *wtO_in, *wtUq, *wtUkv, *wtO_out, *wtPq, *subk, *dftP, *fftMA, *fftMB, *HB;
    float* fftTW;
    unsigned char *tabU, *tabV;
    float *su, *sv;
    bf16_t* H;
    bf16_t *qkvraw, *gate, *ZtA, *qn, *kn, *Wb, *Ub, *QKb, *of, *ob, *mix;
    float *ba, *gcb;
    float *Podd, *kr_all;
    bf16_t *cq, *ckv_all, *Qb, *Kb, *Vtb, *Ob;
    float* pgate;
    int* eidx;
};

typedef const Params __attribute__((address_space(4))) CP;

__device__ __forceinline__ int ltid() { int t = threadIdx.x; asm volatile("" : "+v"(t)); return t; }
__device__ __forceinline__ int lbid() { int b = blockIdx.x; asm volatile("" : "+s"(b)); return b; }
typedef __bf16 bf16v2 __attribute__((ext_vector_type(2)));
typedef float f32x2 __attribute__((ext_vector_type(2)));
__device__ __forceinline__ bf16_t f2bf(float f) { return __builtin_bit_cast(unsigned short, (__bf16)f); }
__device__ __forceinline__ float bf2f(bf16_t h) { return __uint_as_float(((unsigned)h) << 16); }
__device__ __forceinline__ unsigned pack2(float lo, float hi) { const f32x2 v = {lo, hi}; return __builtin_bit_cast(unsigned, __builtin_convertvector(v, bf16v2)); }
__device__ __forceinline__ float bflo(unsigned u) { return __uint_as_float(u << 16); }
__device__ __forceinline__ float bfhi(unsigned u) { return __uint_as_float(u & 0xFFFF0000u); }
__device__ __forceinline__ float silu_f(float x) { return x / (1.f + __expf(-x)); }
__device__ __forceinline__ float sigmoid_f(float x) { return 1.f / (1.f + __expf(-x)); }
__device__ __forceinline__ float softplus_f(float x) { return fmaxf(x, 0.f) + __logf(1.f + __expf(-fabsf(x))); }
__device__ __forceinline__ float gelu_tanh(float x) {
    const float u = 0.7978845608028654f * (x + 0.044715f * x * x * x);
    return 0.5f * x * (1.f + tanhf(u));
}
template <int M>
__device__ __forceinline__ int xshfl_i(int v) {
    if constexpr (M == 1) return __builtin_amdgcn_mov_dpp(v, 0xB1, 0xF, 0xF, true);
    else if constexpr (M == 2) return __builtin_amdgcn_mov_dpp(v, 0x4E, 0xF, 0xF, true);
    else if constexpr (M == 4) return __builtin_amdgcn_update_dpp(__builtin_amdgcn_update_dpp(0, v, 0x104, 0xF, 0x5, false), v, 0x114, 0xF, 0xA, false);
    else if constexpr (M == 8) return __builtin_amdgcn_mov_dpp(v, 0x128, 0xF, 0xF, true);
    else if constexpr (M == 16) { const auto r = __builtin_amdgcn_permlane16_swap((unsigned)v, (unsigned)v, false, false); return (int)(r[0] ^ r[1] ^ (unsigned)v); }
    else { const auto r = __builtin_amdgcn_permlane32_swap((unsigned)v, (unsigned)v, false, false); return (int)(r[0] ^ r[1] ^ (unsigned)v); }
}
template <int M>
__device__ __forceinline__ float xshfl(float v) { return __int_as_float(xshfl_i<M>(__float_as_int(v))); }
template <int CTRL> __device__ __forceinline__ float dppf(float v) { return __int_as_float(__builtin_amdgcn_mov_dpp(__float_as_int(v), CTRL, 0xF, 0xF, true)); }
__device__ __forceinline__ float wave_sum(float v) {
    v += dppf<0xB1>(v); v += dppf<0x4E>(v); v += dppf<0x141>(v); v += dppf<0x140>(v);
    { const auto r = __builtin_amdgcn_permlane16_swap(__float_as_uint(v), __float_as_uint(v), false, false); v = __uint_as_float(r[0]) + __uint_as_float(r[1]); }
    { const auto r = __builtin_amdgcn_permlane32_swap(__float_as_uint(v), __float_as_uint(v), false, false); v = __uint_as_float(r[0]) + __uint_as_float(r[1]); }
    return v;
}
__device__ __forceinline__ float wave_max(float v) {
    v = fmaxf(v, dppf<0xB1>(v)); v = fmaxf(v, dppf<0x4E>(v)); v = fmaxf(v, dppf<0x141>(v)); v = fmaxf(v, dppf<0x140>(v));
    { const auto r = __builtin_amdgcn_permlane16_swap(__float_as_uint(v), __float_as_uint(v), false, false); v = fmaxf(__uint_as_float(r[0]), __uint_as_float(r[1])); }
    { const auto r = __builtin_amdgcn_permlane32_swap(__float_as_uint(v), __float_as_uint(v), false, false); v = fmaxf(__uint_as_float(r[0]), __uint_as_float(r[1])); }
    return v;
}
__device__ __forceinline__ int tok_modrow(int t) { return t < TP_TOK ? 0 : 1 + ((t - TP_TOK) >> 12); }
__device__ __forceinline__ int tok_seq0(int t) { return t < TP_TOK ? (t & ~255) : (TP_TOK + ((t - TP_TOK) & ~4095)); }
__device__ __forceinline__ int tok_len(int t) { return t < TP_TOK ? 256 : 4096; }

template <int MT, int NT>
__device__ __forceinline__ void wave_mma(f32x4 (&acc)[MT][NT], const bf16_t* A, int lda, const bf16_t* B, int ldb, int K) {
    const int lane = ltid() & 63, r = lane & 15, kg = (lane >> 4) * 8;
#pragma unroll 1
    for (int k0 = 0; k0 < K; k0 += 32) {
        bf16x8 a[MT], b[NT];
#pragma unroll
        for (int m = 0; m < MT; ++m) a[m] = *(const bf16x8*)(A + (m * 16 + r) * lda + k0 + kg);
#pragma unroll
        for (int n = 0; n < NT; ++n) b[n] = *(const bf16x8*)(B + (n * 16 + r) * ldb + k0 + kg);
#pragma unroll
        for (int m = 0; m < MT; ++m)
#pragma unroll
            for (int n = 0; n < NT; ++n) acc[m][n] = __builtin_amdgcn_mfma_f32_16x16x32_bf16(a[m], b[n], acc[m][n], 0, 0, 0);
    }
}
template <int MT, int NT, int KSTEPS>
__device__ __forceinline__ void wave_mma_u(f32x4 (&acc)[MT][NT], const bf16_t* A, int lda, const bf16_t* B, int ldb) {
    const int lane = ltid() & 63, r = lane & 15, kg = (lane >> 4) * 8;
    bf16x8 a[KSTEPS][MT], b[KSTEPS][NT];
#pragma unroll
    for (int ks = 0; ks < KSTEPS; ++ks) {
#pragma unroll
        for (int m = 0; m < MT; ++m) a[ks][m] = *(const bf16x8*)(A + (m * 16 + r) * lda + ks * 32 + kg);
#pragma unroll
        for (int n = 0; n < NT; ++n) b[ks][n] = *(const bf16x8*)(B + (n * 16 + r) * ldb + ks * 32 + kg);
    }
#pragma unroll
    for (int ks = 0; ks < KSTEPS; ++ks)
#pragma unroll
        for (int m = 0; m < MT; ++m)
#pragma unroll
            for (int n = 0; n < NT; ++n) acc[m][n] = __builtin_amdgcn_mfma_f32_16x16x32_bf16(a[ks][m], b[ks][n], acc[m][n], 0, 0, 0);
}

#define GLD 72
#define GEMM_SMEM_BYTES (2 * (256 + 128) * GLD * 2)
template <int PERM = 0, class Epi>
__device__ __forceinline__ void gemm_tile(const bf16_t* __restrict__ A, long lda, const bf16_t* __restrict__ B, long ldb, int K, bf16_t* smem, Epi epi) {
    const int tid = ltid(), lane = tid & 63, wave = tid >> 6;
    const int wm = wave >> 1, wn = wave & 1;
    bf16_t* As = smem;
    bf16_t* Bs = smem + 2 * 256 * GLD;
    f32x4 acc[4][4];
#pragma unroll
    for (int m = 0; m < 4; ++m)
#pragma unroll
        for (int n = 0; n < 4; ++n) acc[m][n] = (f32x4){0.f, 0.f, 0.f, 0.f};
    uint4 ra[4], rb[2];
    const int lrow = tid >> 3, lkc = (tid & 7) * 8;
    const bf16_t* ap = A + (long)lrow * (PERM ? 64 : 1) * lda + lkc;
    const bf16_t* bp = B + (long)lrow * ldb + lkc;
    const long astep = (PERM ? 1 : 64) * lda;
#pragma unroll
    for (int i = 0; i < 4; ++i) ra[i] = *(const uint4*)(ap + (long)i * astep);
#pragma unroll
    for (int i = 0; i < 2; ++i) rb[i] = *(const uint4*)(bp + (long)i * 64 * ldb);
    __builtin_amdgcn_sched_barrier(0);
#pragma unroll
    for (int i = 0; i < 4; ++i) *(uint4*)(As + (i * 64 + lrow) * GLD + lkc) = ra[i];
#pragma unroll
    for (int i = 0; i < 2; ++i) *(uint4*)(Bs + (i * 64 + lrow) * GLD + lkc) = rb[i];
    __syncthreads();
    const int nk = K >> 6;
    for (int kt = 0; kt < nk; ++kt) {
        const int cur = kt & 1;
        if (kt + 1 < nk) {
            const long k0 = (long)(kt + 1) * 64;
#pragma unroll
            for (int i = 0; i < 4; ++i) ra[i] = *(const uint4*)(ap + (long)i * astep + k0);
#pragma unroll
            for (int i = 0; i < 2; ++i) rb[i] = *(const uint4*)(bp + (long)i * 64 * ldb + k0);
            __builtin_amdgcn_sched_barrier(0);
        }
        const bf16_t* Ac = As + cur * 256 * GLD + (wm * 64) * GLD;
        const bf16_t* Bc = Bs + cur * 128 * GLD + (wn * 64) * GLD;
        wave_mma<4, 4>(acc, Ac, GLD, Bc, GLD, 32);
        wave_mma<4, 4>(acc, Ac + 32, GLD, Bc + 32, GLD, 32);
        if (kt + 1 < nk) {
            bf16_t* An = As + (cur ^ 1) * 256 * GLD;
            bf16_t* Bn = Bs + (cur ^ 1) * 128 * GLD;
#pragma unroll
            for (int i = 0; i < 4; ++i) *(uint4*)(An + (i * 64 + lrow) * GLD + lkc) = ra[i];
#pragma unroll
            for (int i = 0; i < 2; ++i) *(uint4*)(Bn + (i * 64 + lrow) * GLD + lkc) = rb[i];
        }
        __syncthreads();
    }
#pragma unroll
    for (int m = 0; m < 4; ++m)
#pragma unroll
        for (int n = 0; n < 4; ++n) epi(wm * 64 + m * 16 + (lane >> 4) * 4, wn * 64 + n * 16 + (lane & 15), acc[m][n]);
}
namespace g8 {
constexpr int BK = 64, HALF = 128, HT = HALF * BK;
__device__ __forceinline__ int lds_byte(int r, int c) {
    const int st = (r >> 4) * 2 + (c >> 5), rr = r & 15, cc = c & 31, ob = rr * 64 + cc * 2;
    return st * 1024 + (ob ^ (((ob >> 9) & 1) << 5));
}
__device__ __forceinline__ void stage_rc(int b, int& R, int& C) {
    const int st = b / 1024, sb = b % 1024, swz = sb ^ (((sb >> 9) & 1) << 5);
    R = (st >> 1) * 16 + swz / 64; C = (st & 1) * 32 + (swz % 64) / 2;
}
}

template <int PERM = 0, int PRE = 0>
__device__ __forceinline__ void gemm_tile256_acc(const bf16_t* __restrict__ A, long lda, const bf16_t* __restrict__ Bt, long ldb, int K, bf16_t* shm, f32x4 (&acc)[2][2][4][2]) {
    using namespace g8;
#define G8_SA(b, h) (shm + ((b) * 2 + (h)) * HT)
#define G8_SB(b, h) (shm + (4 + (b) * 2 + (h)) * HT)
#define G8_STAGE_A(T, P, h, kt) do { for (int _i = 0; _i < 2; ++_i) { const int _b = (T) * 16 + _i * 8192; int _r, _c; stage_rc(_b, _r, _c); \
        const int _R = (h) * HALF + _r; const long _ar = PERM ? (long)((_R & 63) * 64 + (_R >> 6)) : (long)_R; \
        __builtin_amdgcn_global_load_lds((const unsigned*)(A + _ar * lda + (long)(kt) * BK + _c), (__attribute__((address_space(3))) unsigned*)((char*)(P) + _b), 16, 0, 0); } } while (0)
#define G8_STAGE_B(T, P, h, kt) do { for (int _i = 0; _i < 2; ++_i) { const int _b = (T) * 16 + _i * 8192; int _r, _c; stage_rc(_b, _r, _c); \
        __builtin_amdgcn_global_load_lds((const unsigned*)(Bt + (long)((h) * HALF + _r) * ldb + (long)(kt) * BK + _c), (__attribute__((address_space(3))) unsigned*)((char*)(P) + _b), 16, 0, 0); } } while (0)
#define G8_LDA(dst, b, h) _Pragma("unroll") for (int m = 0; m < 4; ++m) _Pragma("unroll") for (int k = 0; k < 2; ++k) \
        dst[m][k] = *reinterpret_cast<const bf16x8*>((char*)G8_SA(b, h) + lds_byte(wr * 64 + m * 16 + fr, k * 32 + fq * 8))
#define G8_LDB(dst, b, h) _Pragma("unroll") for (int n = 0; n < 2; ++n) _Pragma("unroll") for (int k = 0; k < 2; ++k) \
        dst[n][k] = *reinterpret_cast<const bf16x8*>((char*)G8_SB(b, h) + lds_byte(wc * 32 + n * 16 + fr, k * 32 + fq * 8))
#define G8_MMA(ai, bj, At_, Bt_) do { __builtin_amdgcn_s_setprio(1); \
        _Pragma("unroll") for (int m = 0; m < 4; ++m) _Pragma("unroll") for (int n = 0; n < 2; ++n) _Pragma("unroll") for (int k = 0; k < 2; ++k) \
            acc[ai][bj][m][n] = __builtin_amdgcn_mfma_f32_16x16x32_bf16(At_[m][k], Bt_[n][k], acc[ai][bj][m][n], 0, 0, 0); \
        __builtin_amdgcn_s_setprio(0); } while (0)
#define G8_WAIT_V(n) asm volatile("s_waitcnt vmcnt(" #n ")" ::: "memory")
#define G8_WAIT_L(n) asm volatile("s_waitcnt lgkmcnt(" #n ")" ::: "memory")
#define G8_BAR __builtin_amdgcn_s_barrier()
#define G8_SCHED __builtin_amdgcn_sched_barrier(0)
    int tz = ltid();
    int wid = tz >> 6, lane = tz & 63, wr = wid >> 2, wc = wid & 3, fr = lane & 15, fq = lane >> 4;
#pragma unroll
    for (int a = 0; a < 2; ++a)
#pragma unroll
        for (int b = 0; b < 2; ++b)
#pragma unroll
            for (int m = 0; m < 4; ++m)
#pragma unroll
                for (int n = 0; n < 2; ++n) acc[a][b][m][n] = (f32x4){0.f, 0.f, 0.f, 0.f};
    bf16x8 At[4][2], B0[2][2], B1[2][2];
    const int nt = K / BK;
    if (PRE) {
        if (wr == 1) G8_BAR;
        G8_WAIT_V(0); G8_BAR;
        G8_BAR;
    } else {
        G8_STAGE_B(tz, G8_SB(0, 0), 0, 0); G8_STAGE_A(tz, G8_SA(0, 0), 0, 0);
        G8_STAGE_B(tz, G8_SB(0, 1), 1, 0); G8_STAGE_A(tz, G8_SA(0, 1), 1, 0);
        if (wr == 1) G8_BAR;
        G8_WAIT_V(4); G8_BAR;
        G8_STAGE_B(tz, G8_SB(1, 0), 0, 1); G8_STAGE_A(tz, G8_SA(1, 0), 0, 1); G8_STAGE_B(tz, G8_SB(1, 1), 1, 1);
        G8_WAIT_V(6); G8_BAR;
    }
    for (int t = 0; t < nt - 2; t += 2) {
        G8_LDB(B0, 0, 0); G8_SCHED; G8_LDA(At, 0, 0); G8_STAGE_A(tz, G8_SA(1, 1), 1, t + 1);
        G8_WAIT_L(8); G8_BAR; G8_WAIT_L(0); G8_MMA(0, 0, At, B0); G8_BAR; G8_SCHED;
        G8_LDB(B1, 0, 1); G8_STAGE_B(tz, G8_SB(0, 0), 0, t + 2);
        G8_BAR; G8_WAIT_L(0); G8_MMA(0, 1, At, B1); G8_BAR;
        G8_LDA(At, 0, 1); G8_STAGE_A(tz, G8_SA(0, 0), 0, t + 2);
        G8_BAR; G8_WAIT_L(0); G8_MMA(1, 0, At, B0); G8_BAR; G8_SCHED;
        G8_STAGE_B(tz, G8_SB(0, 1), 1, t + 2);
        G8_WAIT_V(6); G8_BAR; G8_MMA(1, 1, At, B1); G8_BAR;
        G8_LDB(B0, 1, 0); G8_SCHED; G8_LDA(At, 1, 0); G8_STAGE_A(tz, G8_SA(0, 1), 1, t + 2);
        G8_WAIT_L(8); G8_BAR; G8_WAIT_L(0); G8_MMA(0, 0, At, B0); G8_BAR; G8_SCHED;
        G8_LDB(B1, 1, 1); G8_STAGE_B(tz, G8_SB(1, 0), 0, t + 3);
        G8_BAR; G8_WAIT_L(0); G8_MMA(0, 1, At, B1); G8_BAR;
        G8_LDA(At, 1, 1); G8_STAGE_A(tz, G8_SA(1, 0), 0, t + 3);
        G8_BAR; G8_WAIT_L(0); G8_MMA(1, 0, At, B0); G8_BAR; G8_SCHED;
        G8_STAGE_B(tz, G8_SB(1, 1), 1, t + 3);
        G8_WAIT_V(6); G8_BAR; G8_MMA(1, 1, At, B1); G8_BAR;
    }
    tz = ltid(); wid = tz >> 6; lane = tz & 63; wr = wid >> 2; wc = wid & 3; fr = lane & 15; fq = lane >> 4;
    { G8_LDB(B0, 0, 0); G8_WAIT_V(0); G8_LDA(At, 0, 0); G8_STAGE_A(tz, G8_SA(1, 1), 1, nt - 1);
      G8_BAR; G8_WAIT_L(0); G8_MMA(0, 0, At, B0); G8_BAR;
      G8_LDB(B1, 0, 1); G8_BAR; G8_WAIT_L(0); G8_MMA(0, 1, At, B1); G8_BAR;
      G8_LDA(At, 0, 1); G8_WAIT_V(4); G8_BAR; G8_WAIT_L(0); G8_MMA(1, 0, At, B0); G8_MMA(1, 1, At, B1); G8_BAR; }
    { G8_LDB(B0, 1, 0); G8_LDA(At, 1, 0); G8_WAIT_V(2); G8_BAR; G8_WAIT_L(0); G8_MMA(0, 0, At, B0); G8_BAR;
      G8_LDB(B1, 1, 1); G8_WAIT_V(0); G8_BAR; G8_WAIT_L(0); G8_MMA(0, 1, At, B1); G8_BAR;
      G8_LDA(At, 1, 1); G8_BAR; G8_WAIT_L(0); G8_MMA(1, 0, At, B0); G8_MMA(1, 1, At, B1); G8_BAR; }
    if (wr == 0) G8_BAR;
#undef G8_SA
#undef G8_SB
#undef G8_STAGE_A
#undef G8_STAGE_B
#undef G8_LDA
#undef G8_LDB
#undef G8_MMA
#undef G8_WAIT_V
#undef G8_WAIT_L
#undef G8_BAR
#undef G8_SCHED
}

template <int PERM = 0>
__device__ __forceinline__ void g8_prologue(const bf16_t* __restrict__ A, long lda, const bf16_t* __restrict__ Bt, long ldb, bf16_t* shm) {
    using namespace g8;
    const int tz = ltid();
#define G8P_STAGE_A(P, h, kt) do { for (int _i = 0; _i < 2; ++_i) { const int _b = tz * 16 + _i * 8192; int _r, _c; stage_rc(_b, _r, _c); \
        const int _R = (h) * HALF + _r; const long _ar = PERM ? (long)((_R & 63) * 64 + (_R >> 6)) : (long)_R; \
        __builtin_amdgcn_global_load_lds((const unsigned*)(A + _ar * lda + (long)(kt) * BK + _c), (__attribute__((address_space(3))) unsigned*)((char*)(P) + _b), 16, 0, 0); } } while (0)
#define G8P_STAGE_B(P, h, kt) do { for (int _i = 0; _i < 2; ++_i) { const int _b = tz * 16 + _i * 8192; int _r, _c; stage_rc(_b, _r, _c); \
        __builtin_amdgcn_global_load_lds((const unsigned*)(Bt + (long)((h) * HALF + _r) * ldb + (long)(kt) * BK + _c), (__attribute__((address_space(3))) unsigned*)((char*)(P) + _b), 16, 0, 0); } } while (0)
#define G8P_SA(b, h) (shm + ((b) * 2 + (h)) * HT)
#define G8P_SB(b, h) (shm + (4 + (b) * 2 + (h)) * HT)
    G8P_STAGE_B(G8P_SB(0, 0), 0, 0); G8P_STAGE_A(G8P_SA(0, 0), 0, 0);
    G8P_STAGE_B(G8P_SB(0, 1), 1, 0); G8P_STAGE_A(G8P_SA(0, 1), 1, 0);
    G8P_STAGE_B(G8P_SB(1, 0), 0, 1); G8P_STAGE_A(G8P_SA(1, 0), 0, 1); G8P_STAGE_B(G8P_SB(1, 1), 1, 1);
#undef G8P_STAGE_A
#undef G8P_STAGE_B
#undef G8P_SA
#undef G8P_SB
}

template <int PERM = 0, class Epi>
__device__ __forceinline__ void gemm_tile256(const bf16_t* __restrict__ A, long lda, const bf16_t* __restrict__ Bt, long ldb, int K, bf16_t* shm, Epi epi) {
    f32x4 acc[2][2][4][2];
    gemm_tile256_acc<PERM>(A, lda, Bt, ldb, K, shm, acc);
    const int tz = ltid(), wid = tz >> 6, lane = tz & 63, wr = wid >> 2, wc = wid & 3, fr = lane & 15, fq = lane >> 4;
#pragma unroll
    for (int ai = 0; ai < 2; ++ai)
#pragma unroll
        for (int bj = 0; bj < 2; ++bj)
#pragma unroll
            for (int m = 0; m < 4; ++m)
#pragma unroll
                for (int n = 0; n < 2; ++n) epi(ai * 128 + wr * 64 + m * 16 + fq * 4, bj * 128 + wc * 32 + n * 16 + fr, acc[ai][bj][m][n]);
}

__device__ __forceinline__ void tile_map(int u, int nM, int nN, int& pm, int& pn) {
    const int nwg = nM * nN;
    int wgid = u;
    { const int q = nwg / 8, r = nwg % 8, xcd = wgid % 8, off = wgid / 8; wgid = (xcd < r ? xcd * (q + 1) : r * (q + 1) + (xcd - r) * q) + off; }
    const int nig = 8 * nN, gid = wgid / nig, fm = gid * 8, gsz = (nM - fm) < 8 ? (nM - fm) : 8;
    pm = fm + ((wgid % nig) % gsz); pn = (wgid % nig) / gsz;
}
#define XB_TMO      128
#define XB_XCNT(j)  (256  + 64 * (j))
#define XB_XSUB(j)  (1280 + 64 * (j))
#define XB_XGEN(j)  (2304 + 64 * (j))
#define XB_TOP      3328
#define XB_TOPGEN   3392
#define XCD_BAR_WORDS 3456
#define XB_SPIN_CAP (1u << 18)
#define LAS __attribute__((address_space(3)))

__device__ __forceinline__ unsigned xb_ld(unsigned* p)              { return __hip_atomic_load(p, __ATOMIC_RELAXED, __HIP_MEMORY_SCOPE_AGENT); }
__device__ __forceinline__ unsigned xb_add(unsigned* p, unsigned v) { return __hip_atomic_fetch_add(p, v, __ATOMIC_RELAXED, __HIP_MEMORY_SCOPE_AGENT); }
__device__ __forceinline__ unsigned xb_xcc_id() { return (unsigned)__builtin_amdgcn_s_getreg((3 << 11) | 20) & 0xFu; }
#define XB_SPIN(cond, bar) do { unsigned _sp = 0; while (cond) { __builtin_amdgcn_s_sleep(1); \
    if ((++_sp & 255u) == 0u) { if (xb_ld(&(bar)[XB_TMO])) break; if (_sp > XB_SPIN_CAP) { atomicAdd(&(bar)[XB_TMO], 1u); break; } } } } while (0)

struct XcdBarrier {
    unsigned* bar; unsigned x;
    volatile LAS unsigned* st;
};

__device__ __forceinline__ XcdBarrier xcd_barrier_post(unsigned* bar, volatile LAS unsigned* st) {
    XcdBarrier b; b.bar = bar; b.x = xb_xcc_id(); b.st = st;
    if (threadIdx.x == 0) (void)xb_add(&bar[XB_XCNT(b.x)], 1u);
    return b;
}
__device__ __forceinline__ void xcd_barrier_complete(unsigned* bar, unsigned x, unsigned& nloc, unsigned& nx) {
    const unsigned G = gridDim.x * gridDim.y * gridDim.z;
    unsigned sum, cnt, mine, sp = 0u;
    for (;;) {
        sum = 0u; cnt = 0u; mine = 0u;
#pragma unroll
        for (unsigned j = 0; j < 16; ++j) { const unsigned c = xb_ld(&bar[XB_XCNT(j)]); sum += c; cnt += (c > 0u) ? 1u : 0u; mine = (j == x) ? c : mine; }
        if (sum == G) break;
        __builtin_amdgcn_s_sleep(1);
        if ((++sp & 255u) == 0u) { if (xb_ld(&bar[XB_TMO])) break; if (sp > XB_SPIN_CAP) { atomicAdd(&bar[XB_TMO], 1u); break; } }
    }
    nloc = mine > 0u ? mine : 1u; nx = cnt > 0u ? cnt : 1u;
}

__device__ __forceinline__ void xcd_barrier(const XcdBarrier& b) {
    asm volatile("s_waitcnt vmcnt(0)" ::: "memory");
    __syncthreads();
    if (threadIdx.x == 0) {
        unsigned* bar = b.bar;
        __builtin_amdgcn_s_waitcnt(0);
        unsigned nloc = b.st[0], nx = b.st[1];
        if (nloc == 0u) { xcd_barrier_complete(bar, b.x, nloc, nx); b.st[0] = nloc; b.st[1] = nx; }
        const unsigned old = xb_add(&bar[XB_XSUB(b.x)], 1u);
        const unsigned gen = old / nloc;
        if (old + 1u == (gen + 1u) * nloc) {
            __builtin_amdgcn_fence(__ATOMIC_RELEASE, "agent");
            asm volatile("s_waitcnt vmcnt(0)" ::: "memory");
            const unsigned og = xb_add(&bar[XB_TOP], 1u);
            const unsigned tg = og / nx;
            if (og + 1u == (tg + 1u) * nx) xb_add(&bar[XB_TOPGEN], 1u);
            else XB_SPIN(xb_ld(&bar[XB_TOPGEN]) == tg, bar);
            __builtin_amdgcn_fence(__ATOMIC_ACQUIRE, "agent");
            xb_add(&bar[XB_XGEN(b.x)], 1u);
            asm volatile("s_waitcnt vmcnt(0)" ::: "memory");
        } else {
            XB_SPIN(xb_ld(&bar[XB_XGEN(b.x)]) == gen, bar);
            __builtin_amdgcn_fence(__ATOMIC_ACQUIRE, "agent");
            asm volatile("s_waitcnt vmcnt(0)" ::: "memory");
        }
    }
    __syncthreads();
}

__device__ __forceinline__ void conv_t(const float* __restrict__ src, int ldsrc, int Nvalid, int Nstore, int K, bf16_t* __restrict__ dst, float* ts, int b0 = 0) {
    const int tid = ltid();
    const int ntn = (Nstore + 63) / 64, ntk = K / 64;
    for (int tile = lbid() - b0; tile < ntn * ntk; tile += gridDim.x - b0) {
        const int tn = tile % ntn, tk = tile / ntn;
        {
            const int kk = tid >> 3, n8 = (tid & 7) * 8;
#pragma unroll
            for (int i = 0; i < 8; ++i) {
                const int n = tn * 64 + n8 + i;
                ts[kk * 65 + n8 + i] = n < Nvalid ? src[(long)(tk * 64 + kk) * ldsrc + n] : 0.f;
            }
        }
        __syncthreads();
        {
            const int nn = tid >> 3, k8 = (tid & 7) * 8;
            const int n = tn * 64 + nn;
            if (n < Nstore) {
                uint4 v;
                v.x = pack2(ts[(k8 + 0) * 65 + nn], ts[(k8 + 1) * 65 + nn]);
                v.y = pack2(ts[(k8 + 2) * 65 + nn], ts[(k8 + 3) * 65 + nn]);
                v.z = pack2(ts[(k8 + 4) * 65 + nn], ts[(k8 + 5) * 65 + nn]);
                v.w = pack2(ts[(k8 + 6) * 65 + nn], ts[(k8 + 7) * 65 + nn]);
                *(uint4*)(dst + (long)n * K + tk * 64 + k8) = v;
            }
        }
        __syncthreads();
    }
}

__device__ __forceinline__ void fold_fourier(CP& p, int j, char* smem, int b0) {
    const int tid = ltid(), bid = lbid() - b0, nb = gridDim.x - b0;
    float* wt = (float*)smem;
    for (int unit = bid; unit < 256; unit += nb) {
        const int g = unit >> 6, kb = unit & 63;
        const int dq = ltid() & 127, kq = ltid() >> 7;
        const float rs = __builtin_amdgcn_sinf((float)dq * (1.f / 128.f)), rc = __builtin_amdgcn_cosf((float)dq * (1.f / 128.f));
        __syncthreads();
        for (int i = tid; i < 16 * 128; i += NTHREADS) {
            const int kk = i >> 7, d = i & 127;
            wt[kk * 129 + d] = p.even_w_in[((long)j * 1024 + kb * 16 + kk) * 2576 + 2064 + g * 128 + d];
        }
        __syncthreads();
        float ar[4], ai[4];
#pragma unroll
        for (int q = 0; q < 4; ++q) { ar[q] = 0.f; ai[q] = 0.f; }
        for (int d0 = 0; d0 < 128; d0 += 16) {
            float s = __builtin_amdgcn_sinf((float)((d0 * dq) & 127) * (1.f / 128.f)), c = __builtin_amdgcn_cosf((float)((d0 * dq) & 127) * (1.f / 128.f));
#pragma unroll
            for (int dd = 0; dd < 16; ++dd) {
#pragma unroll
                for (int q = 0; q < 4; ++q) {
                    const float w = wt[(kq * 4 + q) * 129 + d0 + dd];
                    ar[q] += w * c;
                    ai[q] -= w * s;
                }
                const float cn = c * rc - s * rs, sn = s * rc + c * rs;
                c = cn; s = sn;
            }
        }
        const float sc = 0.08838834764831845f;
        bf16_t* dst = p.wtE_in + (long)j * N_EIN * 1024;
#pragma unroll
        for (int q = 0; q < 4; ++q) {
            dst[(long)(2064 + g * 128 + dq) * 1024 + kb * 16 + kq * 4 + q] = f2bf(ar[q] * sc);
            dst[(long)(2576 + g * 128 + dq) * 1024 + kb * 16 + kq * 4 + q] = f2bf(ai[q] * sc);
        }
    }
    __syncthreads();
    for (long i = (long)bid * NTHREADS + tid; i < 240L * 1024; i += (long)nb * NTHREADS) p.wtE_in[(long)j * N_EIN * 1024 + 3088L * 1024 + i] = 0;
}
__device__ __forceinline__ void ph_init2(CP& p, char* smem, int b0) {
    if ((int)lbid() < b0) return;
    __syncthreads();
    float* ts = (float*)smem;
    conv_t(p.even_w_in + 1024L * 2576, 2576, 2064, 2064, 1024, p.wtE_in + (long)N_EIN * 1024, ts, b0);
    for (int j = 0; j < 2; ++j) {
        conv_t(p.even_w_out + (long)j * 1024 * 1024, 1024, 1024, 1024, 1024, p.wtE_out + (long)j * 1024 * 1024, ts, b0);
        conv_t(p.odd_w_in + (long)j * 1024 * 832, 832, 832, N_OIN, 1024, p.wtO_in + (long)j * N_OIN * 1024, ts, b0);
        conv_t(p.mla_w_uq + (long)j * 512 * 1536, 1536, 1536, 1536, 512, p.wtUq + (long)j * 1536 * 512, ts, b0);
        conv_t(p.mla_w_ukv + (long)j * 256 * 2048, 2048, 2048, 2048, 256, p.wtUkv + (long)j * 2048 * 256, ts, b0);
        conv_t(p.odd_w_out + (long)j * 1024 * 1024, 1024, 1024, 1024, 1024, p.wtO_out + (long)j * 1024 * 1024, ts, b0);
    }
    for (int l = 0; l < 4; ++l) conv_t(p.peer_w_q + (long)l * 1024 * 2048, 2048, 2048, 2048, 1024, p.wtPq + (long)l * 2048 * 1024, ts, b0);
    fold_fourier(p, 1, smem, b0);
}

__device__ __forceinline__ void ph_init(CP& p, char* smem) {
    const int tid = ltid(), bid = lbid(), nb = gridDim.x;
    {
        float* sl = (float*)smem;
        {
            float cv[18];
#pragma unroll
            for (int jj = 0; jj < 18; ++jj) { const int i = tid + jj * NTHREADS; cv[jj] = i < 1024 ? p.c_ctx[i] : p.c[i - 1024]; }
#pragma unroll
            for (int jj = 0; jj < 18; ++jj) sl[tid + jj * NTHREADS] = silu_f(cv[jj]);
        }
        __syncthreads();
        float* part16 = sl + 9 * 1024;
        for (int unit = bid; unit < 192; unit += nb) {
            const int l = unit / 48, cb = unit % 48;
            const int c4 = (tid & 31) * 4, kq = tid >> 5;
            f32x4 acc[9];
#pragma unroll
            for (int r = 0; r < 9; ++r) acc[r] = (f32x4){0.f, 0.f, 0.f, 0.f};
            const float* wp = p.w_mod + ((long)l * 1024 + kq * 64) * 6144 + cb * 128 + c4;
            f32x4 w[8], wn[8];
#pragma unroll
            for (int q = 0; q < 8; ++q) w[q] = *(const f32x4*)(wp + (long)q * 6144);
            for (int k = 0; k < 64; k += 8) {
                if (k + 8 < 64) {
#pragma unroll
                    for (int q = 0; q < 8; ++q) wn[q] = *(const f32x4*)(wp + (long)(k + 8 + q) * 6144);
                }
#pragma unroll
                for (int q = 0; q < 8; ++q)
#pragma unroll
                    for (int r = 0; r < 9; ++r) acc[r] = acc[r] + w[q] * sl[r * 1024 + kq * 64 + k + q];
#pragma unroll
                for (int q = 0; q < 8; ++q) w[q] = wn[q];
            }
#pragma unroll
            for (int r = 0; r < 9; ++r) *(f32x4*)(part16 + (kq * 9 + r) * 128 + c4) = acc[r];
            __syncthreads();
            if (tid < 128) {
                const int col = cb * 128 + tid;
                const float bias = p.b_mod[l * 6144 + col];
#pragma unroll
                for (int r = 0; r < 9; ++r) {
                    float s = bias;
#pragma unroll
                    for (int g = 0; g < 16; ++g) s += part16[(g * 9 + r) * 128 + tid];
                    p.mods[((long)l * 9 + r) * 6144 + col] = s;
                }
            }
            __syncthreads();
        }
    }
    {
        float* ts = (float*)smem;
        conv_t(p.even_w_in, 2576, 2064, 2064, 1024, p.wtE_in, ts);
    }
    fold_fourier(p, 0, smem, 0);
    for (long i = (long)bid * NTHREADS + tid; i < 4L * 8 * 2 * 128 * 128; i += (long)nb * NTHREADS) p.subk[i] = f2bf(p.peer_sub_keys[i]);
    for (int i = bid * NTHREADS + tid; i < 128 * 128; i += nb * NTHREADS) {
        const int jrow = i >> 7, kk = i & 127;
        {
            const int k1 = jrow >> 1, po = jrow & 1, pi = kk >> 6, n1 = kk & 63;
            float s, c;
            sincospif((float)((k1 * n1) & 63) / 32.f, &s, &c);
            const float v = po == 0 ? (pi == 0 ? c : s) : (pi == 0 ? -s : c);
            p.fftMA[i] = f2bf(v * 0.125f);
        }
        {
            const int k2 = jrow, pi = kk >> 6, n2 = kk & 63;
            float s, c;
            sincospif((float)((k2 * n2) & 63) / 32.f, &s, &c);
            p.fftMB[i] = jrow < 64 ? f2bf((pi == 0 ? c : s) * 0.125f) : (bf16_t)0;
        }
    }
    for (int i = bid * NTHREADS + tid; i < 4096; i += nb * NTHREADS) {
        const int n2 = i >> 6, k1 = i & 63;
        float s, c;
        sincospif((float)(n2 * k1) / 2048.f, &s, &c);
        p.fftTW[i * 2] = c; p.fftTW[i * 2 + 1] = s;
    }
    for (long i = (long)bid * NTHREADS + tid; i < 256L * 512; i += (long)nb * NTHREADS) {
        const int k = (int)(i >> 9), np = (int)(i & 511), n = np & 255;
        const int prod = (k * n) & 255;
        float s, c;
        sincospif((float)prod / 128.f, &s, &c);
        p.dftP[i] = f2bf(((np >> 8) ? s : c) * (1.f / 16.f));
    }
}

__device__ __forceinline__ void ph_tab(CP& p, int l, int b0) {
    const int lane = ltid() & 63, wave = ltid() >> 6;
    if ((int)lbid() < b0) return;
    unsigned char* tab = p.tabU + (long)(l & 1) * 16384 * 2048;
    float* su = p.su + (l & 1) * 32768; float* sv = su + 16384;
    const int rstep = (gridDim.x - b0) * 8;
    int row = (lbid() - b0) * 8 + wave;
    f32x4 nx[4];
#define TAB_SRC(R) ((((R) >= 16384) ? p.peer_v : p.peer_u) + ((long)l * 16384 + ((R) & 16383)) * 1024 + lane * 16)
    if (row < 32768) {
#pragma unroll
        for (int i = 0; i < 4; ++i) nx[i] = *(const f32x4*)(TAB_SRC(row) + i * 4);
    }
    for (; row < 32768; row += rstep) {
        const bool isv = row >= 16384;
        const int e = row & 16383;
        float v[16];
#pragma unroll
        for (int i = 0; i < 4; ++i) { v[i * 4] = nx[i][0]; v[i * 4 + 1] = nx[i][1]; v[i * 4 + 2] = nx[i][2]; v[i * 4 + 3] = nx[i][3]; }
        if (row + rstep < 32768) {
#pragma unroll
            for (int i = 0; i < 4; ++i) nx[i] = *(const f32x4*)(TAB_SRC(row + rstep) + i * 4);
        }
        float m = 0.f;
#pragma unroll
        for (int i = 0; i < 16; ++i) m = fmaxf(m, fabsf(v[i]));
        m = wave_max(m);
        const float scale = m > 0.f ? m * (1.f / 127.f) : 1.f;
        const float inv = 1.f / scale;
        unsigned w[4];
#pragma unroll
        for (int i = 0; i < 4; ++i) {
            unsigned pk = 0;
#pragma unroll
            for (int q = 0; q < 4; ++q) {
                int qi = (int)rintf(v[i * 4 + q] * inv);
                qi = qi < -127 ? -127 : (qi > 127 ? 127 : qi);
                pk |= (unsigned)(qi & 0xFF) << (q * 8);
            }
            w[i] = pk;
        }
        *(uint4*)(tab + (isv ? 16384L * 1024 : 0L) + (long)e * 1024 + lane * 16) = make_uint4(w[0], w[1], w[2], w[3]);
        if (lane == 0) (isv ? sv : su)[e] = scale;
    }
#undef TAB_SRC
}

template <int FROM_INPUT = 0>
__device__ __forceinline__ void ph_norm(CP& p, const float* __restrict__ w, const float* __restrict__ mods_l, int sh_off, int sc_off) {
    const int lane = ltid() & 63, wave = ltid() >> 6;
    const int nw = gridDim.x * 8;
    for (int row = lbid() * 8 + wave; row < T_TOK; row += nw) {
        const float* xr = FROM_INPUT ? (row < TP_TOK ? p.x_prompt + (long)row * DM : p.x_sample + (long)(row - TP_TOK) * DM) : p.out + (long)row * DM;
        float4 v[4];
        float ss = 0.f;
#pragma unroll
        for (int i = 0; i < 4; ++i) {
            v[i] = *(const float4*)(xr + i * 256 + lane * 4);
            ss += v[i].x * v[i].x + v[i].y * v[i].y + v[i].z * v[i].z + v[i].w * v[i].w;
        }
        ss = wave_sum(ss);
        const float r = rsqrtf(ss * (1.f / 1024.f) + 1e-6f);
        const float* mr = mods_l + (long)tok_modrow(row) * 6144;
        float4 ww[4], sc[4], sh[4];
#pragma unroll
        for (int i = 0; i < 4; ++i) {
            const int c = i * 256 + lane * 4;
            ww[i] = *(const float4*)(w + c); sc[i] = *(const float4*)(mr + sc_off + c); sh[i] = *(const float4*)(mr + sh_off + c);
        }
#pragma unroll
        for (int i = 0; i < 4; ++i) {
            const int c = i * 256 + lane * 4;
            const float h0 = v[i].x * r * ww[i].x * (1.f + sc[i].x) + sh[i].x;
            const float h1 = v[i].y * r * ww[i].y * (1.f + sc[i].y) + sh[i].y;
            const float h2 = v[i].z * r * ww[i].z * (1.f + sc[i].z) + sh[i].z;
            const float h3 = v[i].w * r * ww[i].w * (1.f + sc[i].w) + sh[i].w;
            *(uint2*)(p.H + (long)row * DM + c) = make_uint2(pack2(h0, h1), pack2(h2, h3));
        }
    }
}
#define SCAN_KPERM(k_) (((k_) & ~31) | ((((k_) >> 2) & 3) << 3) | ((((k_) >> 4) & 1) << 2) | ((k_) & 3))
#define ZA_OFF ((long)TP_TOK * 1024)
template <int PERM>
__device__ __forceinline__ void e_gemm_epi(CP& p, f32x4 (&acc)[2][2][4][2], int col0, int row0, int s0, int n20, int b) {
    const int tz = ltid(), wid = tz >> 6, lane = tz & 63, wr = wid >> 2, wc = wid & 3, fr = lane & 15, fq = lane >> 4;
#define EG_TOK(ai, m, i) (PERM ? s0 + 64 * ((m) * 16 + fq * 4 + (i)) + n20 + (ai) * 2 + wr : row0 + (ai) * 128 + wr * 64 + (m) * 16 + fq * 4 + (i))
    if (col0 + 256 <= 2048) {
        const bool isg = col0 >= 1536;
        bf16_t* const base = isg ? p.gate + (col0 - 1536) : p.qkvraw + col0;
        const long ld = isg ? 512 : 1536;
#pragma unroll
        for (int ai = 0; ai < 2; ++ai)
#pragma unroll
            for (int m = 0; m < 4; ++m)
#pragma unroll
                for (int i = 0; i < 4; ++i) {
                    bf16_t* d = base + (long)EG_TOK(ai, m, i) * ld + wc * 32 + fr;
#pragma unroll
                    for (int bj = 0; bj < 2; ++bj)
#pragma unroll
                        for (int n = 0; n < 2; ++n) d[bj * 128 + n * 16] = f2bf(acc[ai][bj][m][n][i]);
                }
    } else {
#pragma unroll
        for (int bj = 0; bj < 2; ++bj)
#pragma unroll
            for (int n = 0; n < 2; ++n) {
                const int col = col0 + bj * 128 + wc * 32 + n * 16 + fr;
                if (col < 2064) {
#pragma unroll
                    for (int ai = 0; ai < 2; ++ai)
#pragma unroll
                        for (int m = 0; m < 4; ++m)
#pragma unroll
                            for (int i = 0; i < 4; ++i) p.ba[(long)EG_TOK(ai, m, i) * 16 + (col - 2048)] = acc[ai][bj][m][n][i];
                } else if (col < 3088) {
                    const int cc = col - 2064, part = cc >> 9, cf = cc & 511;
#pragma unroll
                    for (int ai = 0; ai < 2; ++ai)
#pragma unroll
                        for (int m = 0; m < 4; ++m) {
                            const f32x4 v = acc[ai][bj][m][n];
                            bf16_t* dst;
                            if (PERM) dst = p.ZtA + ZA_OFF + (((((long)b * 512 + cf) * 64 + (n20 + ai * 2 + wr)) * 2 + part) * 64 + (m * 16 + fq * 4));
                            else dst = p.ZtA + (long)s0 * 1024 + ((long)cf * 2 + part) * 256 + (ai * 128 + wr * 64 + m * 16 + fq * 4);
                            *(uint2*)dst = make_uint2(pack2(v[0], v[1]), pack2(v[2], v[3]));
                        }
                }
            }
    }
#undef EG_TOK
}
__device__ __forceinline__ void ph_e_gemm(CP& p, int j, char* smem) {
    const int ntn = N_EIN / 256, ntm = T_TOK / 256;
    const bf16_t* Bt = p.wtE_in + (long)j * N_EIN * 1024;
#define EG_PROLOGUE(U)                                                                                             \
    {                                                                                                              \
        int tm_, tn_;                                                                                              \
        tile_map((U), ntm, ntn, tm_, tn_);                                                                         \
        if (tm_ < 16) g8_prologue<0>(p.H + (long)tm_ * 256 * DM, DM, Bt + (long)tn_ * 256 * 1024, 1024, (bf16_t*)smem);   \
        else { const int q_ = tm_ - 16; g8_prologue<1>(p.H + (long)(TP_TOK + (q_ >> 4) * 4096 + (q_ & 15) * 4) * DM, DM, Bt + (long)tn_ * 256 * 1024, 1024, (bf16_t*)smem); }   \
    }
    int u = lbid();
    if (u < ntn * ntm) EG_PROLOGUE(u)
    for (; u < ntn * ntm; u += gridDim.x) {
        int tm, tn;
        tile_map(u, ntm, ntn, tm, tn);
        const int col0 = tn * 256;
        const int un = u + gridDim.x;
        f32x4 acc[2][2][4][2];
        if (tm < 16) {
            const int row0 = tm * 256;
            gemm_tile256_acc<0, 1>(p.H + (long)row0 * DM, DM, Bt + (long)col0 * 1024, 1024, 1024, (bf16_t*)smem, acc);
            if (un < ntn * ntm) EG_PROLOGUE(un)
            e_gemm_epi<0>(p, acc, col0, row0, row0, 0, 0);
        } else {
            const int q = tm - 16, b = q >> 4, n20 = (q & 15) * 4;
            const int s0 = TP_TOK + b * 4096;
            gemm_tile256_acc<1, 1>(p.H + (long)(s0 + n20) * DM, DM, Bt + (long)col0 * 1024, 1024, 1024, (bf16_t*)smem, acc);
            if (un < ntn * ntm) EG_PROLOGUE(un)
            e_gemm_epi<1>(p, acc, col0, 0, s0, n20, b);
        }
    }
#undef EG_PROLOGUE
}

#define PREP_SMEM_BYTES (66048 + 34816 + 16384 + 2048 + 256 + 15360)
__device__ __forceinline__ void ph_e_prep(CP& p, int j, char* smem) {
    const float* cw = p.even_conv_w + (long)j * 3 * 1536;
    for (int u = lbid(); u < 576 * 4; u += gridDim.x) {
        const int cg = u >> 2, h = u & 3;
        const int t0 = cg * 64;
        const int s0 = tok_seq0(t0), L = tok_len(t0);
        int lz = 0, tid = ltid();
        asm volatile("" : "+s"(lz), "+v"(tid));
        const int lane = tid & 63, wave = tid >> 6;
        char* sm = smem + lz;
        bf16_t* raw = (bf16_t*)sm;
        float* KK = (float*)sm;
        float* QKr = KK + 64 * 65;
        float* Am = QKr + 64 * 65;
        bf16_t* qn = (bf16_t*)(sm + 66048);
        bf16_t* kn = qn + 64 * 136;
        bf16_t* vv = (bf16_t*)(sm + 66048 + 34816);
        float* sb = (float*)(sm + 66048 + 34816 + 16384);
        float* sg = sb + 128;
        float* sgr = sg + 128;
        float* seg = sgr + 128;
        float* sone = seg + 128;
        bf16_t* Dinv = (bf16_t*)(sm + 66048 + 34816 + 16384 + 2048 + 256);
        bf16_t* A10 = Dinv + 4 * 32 * 40;
        __syncthreads();
        for (int i = tid; i < 3 * 66 * 16; i += NTHREADS) {
            const int part = i / (66 * 16), rem = i % (66 * 16), rr = rem >> 4, ch = rem & 15;
            const int t = t0 - 1 + rr;
            uint4 v = make_uint4(0, 0, 0, 0);
            if (t >= s0 && t < s0 + L) v = *(const uint4*)(p.qkvraw + (long)t * 1536 + part * 512 + h * 128 + ch * 8);
            *(uint4*)(raw + (part * 66 + rr) * 128 + ch * 8) = v;
        }
        if (tid >= 128 && tid < 192) sone[tid - 128] = 1.f;
        if (tid < 128) {
            const int dir = tid >> 6, i = tid & 63;
            const int t = t0 + (dir ? 63 - i : i);
            const float* bar_ = p.ba + (long)t * 16;
            sb[dir * 64 + i] = sigmoid_f(bar_[dir * 4 + h]);
            const float a = __expf(p.gdn_a_log[(j * 2 + dir) * 4 + h]);
            sgr[dir * 64 + i] = -a * softplus_f(bar_[(2 + dir) * 4 + h] + p.gdn_dt_bias[(j * 2 + dir) * 4 + h]);
        }
        __syncthreads();
        if (tid < 128) {
            float v = sgr[tid];
#pragma unroll
            for (int off = 1; off < 64; off <<= 1) {
                const float o = __int_as_float(__builtin_amdgcn_ds_bpermute(((lane - off) & 63) << 2, __float_as_int(v)));
                v += lane >= off ? o : 0.f;
            }
            sg[tid] = v;
            seg[tid] = __expf(v);
        }
        {
            const int d = lane * 2;
#pragma unroll
            for (int part = 0; part < 3; ++part) {
                const int ch = part * 512 + h * 128 + d;
                const float w00 = cw[ch], w01 = cw[ch + 1], w10 = cw[1536 + ch], w11 = cw[1536 + ch + 1], w20 = cw[3072 + ch], w21 = cw[3072 + ch + 1];
                float y0[8], y1[8], ss[8];
#pragma unroll
                for (int r8 = 0; r8 < 8; ++r8) {
                    const int rr = wave * 8 + r8;
                    const unsigned x0 = *(const unsigned*)(raw + (part * 66 + rr) * 128 + d);
                    const unsigned x1 = *(const unsigned*)(raw + (part * 66 + rr + 1) * 128 + d);
                    const unsigned x2 = *(const unsigned*)(raw + (part * 66 + rr + 2) * 128 + d);
                    y0[r8] = silu_f(w00 * bflo(x0) + w10 * bflo(x1) + w20 * bflo(x2));
                    y1[r8] = silu_f(w01 * bfhi(x0) + w11 * bfhi(x1) + w21 * bfhi(x2));
                    ss[r8] = y0[r8] * y0[r8] + y1[r8] * y1[r8];
                }
                float tot = 0.f;
                if (part < 2) {
                    const bool b5 = (lane & 32) != 0, b4 = (lane & 16) != 0, b3 = (lane & 8) != 0;
                    float t4[4], t2[2];
#pragma unroll
                    for (int i = 0; i < 4; ++i) { const float snd = b5 ? ss[i] : ss[i + 4]; const float kp = b5 ? ss[i + 4] : ss[i]; t4[i] = kp + xshfl<32>(snd); }
#pragma unroll
                    for (int i = 0; i < 2; ++i) { const float snd = b4 ? t4[i] : t4[i + 2]; const float kp = b4 ? t4[i + 2] : t4[i]; t2[i] = kp + xshfl<16>(snd); }
                    { const float snd = b3 ? t2[0] : t2[1]; const float kp = b3 ? t2[1] : t2[0]; tot = kp + xshfl<8>(snd); }
                    tot += xshfl<4>(tot); tot += xshfl<2>(tot); tot += xshfl<1>(tot);
                    tot = rsqrtf(tot + 1e-6f);
                }
#pragma unroll
                for (int r8 = 0; r8 < 8; ++r8) {
                    const int rr = wave * 8 + r8;
                    float a0 = y0[r8], a1 = y1[r8];
                    if (part < 2) { const float rn = __int_as_float(__builtin_amdgcn_readlane(__float_as_int(tot), r8 * 8)); a0 *= rn; a1 *= rn; }
                    const unsigned pk = pack2(a0, a1);
                    if (part == 0) { *(unsigned*)(qn + rr * 136 + d) = pk; *(unsigned*)(p.qn + ((long)(t0 + rr) * 4 + h) * 128 + SCAN_KPERM(d)) = pk; }
                    else if (part == 1) { *(unsigned*)(kn + rr * 136 + d) = pk; *(unsigned*)(p.kn + ((long)(t0 + rr) * 4 + h) * 128 + d) = pk; }
                    else { *(unsigned*)(vv + rr * 128 + d) = pk; }
                }
            }
        }
        __syncthreads();
        {
            const int mat = wave >> 2, rt = wave & 3;
            f32x4 acc[1][4];
#pragma unroll
            for (int n = 0; n < 4; ++n) acc[0][n] = (f32x4){0.f, 0.f, 0.f, 0.f};
            wave_mma<1, 4>(acc, (mat ? qn : kn) + rt * 16 * 136, 136, kn, 136, 128);
            float* dst = mat ? QKr : KK;
#pragma unroll
            for (int n = 0; n < 4; ++n)
#pragma unroll
                for (int r = 0; r < 4; ++r) dst[(rt * 16 + (lane >> 4) * 4 + r) * 65 + n * 16 + (lane & 15)] = acc[0][n][r];
        }
        __syncthreads();
        {
            const int dir = tid >> 8, q = tid & 255;
            const long ud = ((long)(dir ? (s0 + L - 64 - (t0 - s0)) / 64 : cg) * 4 + h) * 2 + dir;
            bf16_t* qkout = p.QKb + ud * 4096;
            for (int e = q; e < 4096; e += 256) {
                const int i = e >> 6, jj = e & 63;
                const int ti = dir ? 63 - i : i, tj = dir ? 63 - jj : jj;
                const float dec = jj <= i ? __expf(sg[dir * 64 + i] - sg[dir * 64 + jj]) : 0.f;
                Am[(dir * 64 + i) * 64 + jj] = jj < i ? sb[dir * 64 + i] * KK[ti * 65 + tj] * dec : 0.f;
                qkout[e] = f2bf(QKr[ti * 65 + tj] * 0.08838834764831845f * dec);
            }
            if (q < 64) {
                const float gq = sg[dir * 64 + q];
                p.gcb[ud * 192 + q] = gq;
                p.gcb[ud * 192 + 64 + q] = 0.08838834764831845f * __expf(gq);
                p.gcb[ud * 192 + 128 + q] = __expf(sg[dir * 64 + 63] - gq);
            }
        }
        __syncthreads();
        if (tid < 128) {
            const int dir = tid >> 6, blk = (tid >> 5) & 1, c = tid & 31;
            const float* Dm = Am + (dir * 64 + blk * 32) * 64 + blk * 32;
            float x[32];
#pragma unroll
            for (int i = 0; i < 32; ++i) x[i] = (i == c) ? 1.f : 0.f;
#pragma unroll
            for (int i = 1; i < 32; ++i) {
                f32x4 dr[8];
#pragma unroll
                for (int q4 = 0; q4 < 8; ++q4) if (q4 * 4 < i) dr[q4] = *(const f32x4*)(Dm + i * 64 + q4 * 4);
                float a = x[i];
#pragma unroll
                for (int jj = 0; jj < i; ++jj) a -= dr[jj >> 2][jj & 3] * x[jj];
                x[i] = a;
            }
            bf16_t* dv = Dinv + (dir * 2 + blk) * 32 * 40 + c;
#pragma unroll
            for (int i = 0; i < 32; ++i) dv[i * 40] = f2bf(x[i]);
        }
        for (int e = tid; e < 2048; e += NTHREADS) {
            const int dir = e >> 10, i = (e >> 5) & 31, jj = e & 31;
            A10[(dir * 32 + i) * 40 + jj] = f2bf(Am[(dir * 64 + 32 + i) * 64 + jj]);
        }
        __syncthreads();
        {
            const int dir = wave >> 2, slab = wave & 3;
            const long ud = ((long)(dir ? (s0 + L - 64 - (t0 - s0)) / 64 : cg) * 4 + h) * 2 + dir;
            bf16_t* RT = (bf16_t*)sm + wave * 4096;
#define RT_AT(c_, i_) (RT + (c_) * 64 + (((((i_) >> 3) ^ ((c_) & 7))) << 3) + ((i_) & 7))
            const int c = slab * 64 + lane;
            const int g4 = (lane >> 4) * 4, cn = lane & 15, kg = (lane >> 4) * 8;
            {
                const bf16_t* src = c < 128 ? vv + c : kn + (c - 128);
                const int sst = c < 128 ? 128 : 136;
                const float* fac = c < 128 ? sone : seg + dir * 64;
                const float* fb = sb + dir * 64;
#pragma unroll
                for (int i8 = 0; i8 < 8; ++i8) {
                    unsigned w[4];
#pragma unroll
                    for (int e = 0; e < 4; ++e) {
                        float v[2];
#pragma unroll
                        for (int q = 0; q < 2; ++q) {
                            const int i = i8 * 8 + e * 2 + q;
                            const int ti = dir ? 63 - i : i;
                            const float f0 = bf2f(src[ti * sst]) * fb[i];
                            v[q] = f0 * fac[i];
                        }
                        w[e] = pack2(v[0], v[1]);
                    }
                    *(uint4*)RT_AT(lane, i8 * 8) = make_uint4(w[0], w[1], w[2], w[3]);
                }
            }
            asm volatile("s_waitcnt lgkmcnt(0)" ::: "memory");
            const bf16_t* D0 = Dinv + (dir * 2 + 0) * 32 * 40;
            const bf16_t* D1 = Dinv + (dir * 2 + 1) * 32 * 40;
            const bf16_t* A1 = A10 + dir * 32 * 40;
            bf16_t* dstb = (c < 128 ? p.Ub : p.Wb) + ud * 8192;
            const int cbase = (slab & 1) * 64;
            int wcol[4];
#pragma unroll
            for (int nt = 0; nt < 4; ++nt) { const int k_ = cbase + nt * 16 + cn; wcol[nt] = c < 128 ? k_ : SCAN_KPERM(k_); }
            bf16x8 bfr[4];
            f32x4 X0[2][4];
#pragma unroll
            for (int nt = 0; nt < 4; ++nt) bfr[nt] = *(const bf16x8*)RT_AT(nt * 16 + cn, kg);
#pragma unroll
            for (int mt = 0; mt < 2; ++mt) {
                const bf16x8 af = *(const bf16x8*)(D0 + (mt * 16 + cn) * 40 + kg);
#pragma unroll
                for (int nt = 0; nt < 4; ++nt) X0[mt][nt] = __builtin_amdgcn_mfma_f32_16x16x32_bf16(af, bfr[nt], (f32x4){0.f, 0.f, 0.f, 0.f}, 0, 0, 0);
            }
#pragma unroll
            for (int mt = 0; mt < 2; ++mt)
#pragma unroll
                for (int nt = 0; nt < 4; ++nt) {
#pragma unroll
                    for (int r = 0; r < 4; ++r) dstb[(mt * 16 + g4 + r) * 128 + wcol[nt]] = f2bf(X0[mt][nt][r]);
                    *(uint2*)RT_AT(nt * 16 + cn, mt * 16 + g4) = make_uint2(pack2(X0[mt][nt][0], X0[mt][nt][1]), pack2(X0[mt][nt][2], X0[mt][nt][3]));
                }
            asm volatile("s_waitcnt lgkmcnt(0)" ::: "memory");
            f32x4 R1[2][4];
#pragma unroll
            for (int nt = 0; nt < 4; ++nt) bfr[nt] = *(const bf16x8*)RT_AT(nt * 16 + cn, kg);
#pragma unroll
            for (int mt = 0; mt < 2; ++mt) {
                const bf16x8 af = *(const bf16x8*)(A1 + (mt * 16 + cn) * 40 + kg);
#pragma unroll
                for (int nt = 0; nt < 4; ++nt) {
                    const f32x4 pr = __builtin_amdgcn_mfma_f32_16x16x32_bf16(af, bfr[nt], (f32x4){0.f, 0.f, 0.f, 0.f}, 0, 0, 0);
                    const uint2 rr = *(const uint2*)RT_AT(nt * 16 + cn, 32 + mt * 16 + g4);
                    R1[mt][nt][0] = bflo(rr.x) - pr[0]; R1[mt][nt][1] = bfhi(rr.x) - pr[1];
                    R1[mt][nt][2] = bflo(rr.y) - pr[2]; R1[mt][nt][3] = bfhi(rr.y) - pr[3];
                }
            }
            asm volatile("s_waitcnt lgkmcnt(0)" ::: "memory");
#pragma unroll
            for (int mt = 0; mt < 2; ++mt)
#pragma unroll
                for (int nt = 0; nt < 4; ++nt)
                    *(uint2*)RT_AT(nt * 16 + cn, 32 + mt * 16 + g4) = make_uint2(pack2(R1[mt][nt][0], R1[mt][nt][1]), pack2(R1[mt][nt][2], R1[mt][nt][3]));
            asm volatile("s_waitcnt lgkmcnt(0)" ::: "memory");
#pragma unroll
            for (int nt = 0; nt < 4; ++nt) bfr[nt] = *(const bf16x8*)RT_AT(nt * 16 + cn, 32 + kg);
#pragma unroll
            for (int mt = 0; mt < 2; ++mt) {
                const bf16x8 af = *(const bf16x8*)(D1 + (mt * 16 + cn) * 40 + kg);
#pragma unroll
                for (int nt = 0; nt < 4; ++nt) {
                    const f32x4 x1 = __builtin_amdgcn_mfma_f32_16x16x32_bf16(af, bfr[nt], (f32x4){0.f, 0.f, 0.f, 0.f}, 0, 0, 0);
#pragma unroll
                    for (int r = 0; r < 4; ++r) dstb[(32 + mt * 16 + g4 + r) * 128 + wcol[nt]] = f2bf(x1[r]);
                }
            }
        }
    }
#undef RT_AT
}
typedef short s16x4 __attribute__((ext_vector_type(4)));
#define SCAN_KOFF(r_, ch_) (256 * (r_) + 16 * ((ch_) ^ ((((r_) & 3) << 2) | (((r_) >> 2) & 3))))
#define SCAN_SMEM_BYTES (17408 + 17408 + 9216 + 18432 + 8 * 4352 + 8 * 2 * 2304 + 512)
__device__ __forceinline__ void ph_e_scan(CP& p, int j, char* smem) {
    for (int st = lbid(); st < 192; st += gridDim.x) {
        const int tid = ltid(), lane = tid & 63, wave = tid >> 6;
        bf16_t* Ws = (bf16_t*)smem;
        bf16_t* Qs = Ws + 64 * 136;
        bf16_t* QKs = Qs + 64 * 136;
        bf16_t* KnT = QKs + 64 * 72;
        bf16_t* St = KnT + 128 * 72 + wave * (16 * 136);
        bf16_t* VNt = KnT + 128 * 72 + 8 * (16 * 136) + wave * (2 * 16 * 72);
        bf16_t* VNs = VNt + 16 * 72;
        float* gcs = (float*)((char*)KnT + 16384);
        const int g4 = (lane >> 4) * 4, cn = lane & 15;
        int seq, h, dir;
        if (st < 64) { seq = 16 + (st >> 3); h = (st >> 1) & 3; dir = st & 1; }
        else { const int q = st - 64; seq = q >> 3; h = (q >> 1) & 3; dir = q & 1; }
        const int L = seq < 16 ? 256 : 4096;
        const int s0 = seq < 16 ? seq * 256 : TP_TOK + (seq - 16) * 4096;
        const int nch = L / 64;
        f32x4 S[8][1];
        if (seq >= 16) {
            const float* sp = p.state_gdn + ((((long)(seq - 16) * 2 + j) * 2 + dir) * 4 + h) * 16384 + (g4 * 128 + wave * 16 + cn);
#pragma unroll
            for (int mt = 0; mt < 8; ++mt)
#pragma unroll
                for (int r = 0; r < 4; ++r) S[mt][0][r] = sp[(mt * 16 + r) * 128];
        } else {
#pragma unroll
            for (int mt = 0; mt < 8; ++mt) S[mt][0] = (f32x4){0.f, 0.f, 0.f, 0.f};
        }
        u32x4 pw[2], pq[2], pk[2], pqk;
        float pgc = 0.f;
        float pu[16];
#define SCAN_LOAD_MAIN(M)                                                                                              \
        {                                                                                                              \
            const long ud_ = ((long)(s0 / 64 + (M)) * 4 + h) * 2 + dir;                                               \
            _Pragma("unroll") for (int i_ = 0; i_ < 2; ++i_) {                                                       \
                const int id_ = tid + i_ * NTHREADS, c_ = id_ >> 4, ch_ = id_ & 15;                                   \
                const int t_ = dir ? s0 + L - 1 - ((M) * 64 + c_) : s0 + (M) * 64 + c_;                               \
                pw[i_] = *(const u32x4*)(p.Wb + ud_ * 8192 + c_ * 128 + ch_ * 8);                                     \
                pq[i_] = *(const u32x4*)(p.qn + ((long)t_ * 4 + h) * 128 + ch_ * 8);                                  \
                pk[i_] = *(const u32x4*)(p.kn + ((long)t_ * 4 + h) * 128 + ch_ * 8);                                  \
            }                                                                                                          \
            pqk = *(const u32x4*)(p.QKb + ud_ * 4096 + (tid >> 3) * 64 + (tid & 7) * 8);                              \
            if (tid < 192) pgc = p.gcb[ud_ * 192 + tid];                                                              \
        }
#define SCAN_LOAD_U(M)                                                                                                 \
        {                                                                                                              \
            const long ud_ = ((long)(s0 / 64 + (M)) * 4 + h) * 2 + dir;                                               \
            long uo_ = ud_ * 8192 + (g4 * 128 + wave * 16 + cn);                                                       \
            asm volatile("" : "+v"(uo_));        \
            const bf16_t* ub_ = p.Ub + uo_;                                                                            \
            _Pragma("unroll") for (int mt_ = 0; mt_ < 4; ++mt_)                                                      \
                _Pragma("unroll") for (int r_ = 0; r_ < 4; ++r_)                                                     \
                    pu[mt_ * 4 + r_] = bf2f(ub_[(mt_ * 16 + r_) * 128]);                                              \
        }
        SCAN_LOAD_MAIN(0)
        SCAN_LOAD_U(0)
        for (int m = 0; m < nch; ++m) {
            __syncthreads();
#pragma unroll
            for (int i = 0; i < 2; ++i) {
                const int id = tid + i * NTHREADS, c = id >> 4, ch = id & 15;
                *(u32x4*)(Ws + c * 136 + ch * 8) = pw[i];
                *(u32x4*)(Qs + c * 136 + ch * 8) = pq[i];
                *(u32x4*)((char*)KnT + SCAN_KOFF(c, ch)) = pk[i];
            }
            *(u32x4*)(QKs + (tid >> 3) * 72 + (tid & 7) * 8) = pqk;
            if (tid < 192) gcs[tid] = pgc;
            __syncthreads();
            if (m + 1 < nch) SCAN_LOAD_MAIN(m + 1)
            f32x4 ws[4][1], qs[4][1];
#pragma unroll
            for (int mt = 0; mt < 4; ++mt) { ws[mt][0] = (f32x4){0.f, 0.f, 0.f, 0.f}; qs[mt][0] = (f32x4){0.f, 0.f, 0.f, 0.f}; }
            {
                bf16x8 sb[4];
#pragma unroll
                for (int ks = 0; ks < 4; ++ks) {
                    u32x4 w_;
                    w_[0] = pack2(S[2 * ks][0][0], S[2 * ks][0][1]); w_[1] = pack2(S[2 * ks][0][2], S[2 * ks][0][3]);
                    w_[2] = pack2(S[2 * ks + 1][0][0], S[2 * ks + 1][0][1]); w_[3] = pack2(S[2 * ks + 1][0][2], S[2 * ks + 1][0][3]);
                    sb[ks] = __builtin_bit_cast(bf16x8, w_);
                }
                const int kg_ = (lane >> 4) * 8;
                bf16x8 aw[4][4], aq[4][4];
#pragma unroll
                for (int ks = 0; ks < 4; ++ks)
#pragma unroll
                    for (int mt = 0; mt < 4; ++mt) {
                        aw[ks][mt] = *(const bf16x8*)(Ws + (mt * 16 + cn) * 136 + ks * 32 + kg_);
                        aq[ks][mt] = *(const bf16x8*)(Qs + (mt * 16 + cn) * 136 + ks * 32 + kg_);
                    }
#pragma unroll
                for (int ks = 0; ks < 4; ++ks)
#pragma unroll
                    for (int mt = 0; mt < 4; ++mt) {
                        ws[mt][0] = __builtin_amdgcn_mfma_f32_16x16x32_bf16(aw[ks][mt], sb[ks], ws[mt][0], 0, 0, 0);
                        qs[mt][0] = __builtin_amdgcn_mfma_f32_16x16x32_bf16(aq[ks][mt], sb[ks], qs[mt][0], 0, 0, 0);
                    }
            }
            const float glast = gcs[63];
            f32x4 vn[4];
#pragma unroll
            for (int mt = 0; mt < 4; ++mt) {
                float sc[4];
#pragma unroll
                for (int r = 0; r < 4; ++r) {
                    const int c = mt * 16 + g4 + r;
                    vn[mt][r] = pu[mt * 4 + r] - ws[mt][0][r];
                    sc[r] = vn[mt][r] * gcs[128 + c];
                }
                *(uint2*)(VNt + cn * 72 + mt * 16 + g4) = make_uint2(pack2(vn[mt][0], vn[mt][1]), pack2(vn[mt][2], vn[mt][3]));
                *(uint2*)(VNs + cn * 72 + mt * 16 + g4) = make_uint2(pack2(sc[0], sc[1]), pack2(sc[2], sc[3]));
            }
            if (m + 1 < nch) SCAN_LOAD_U(m + 1)
            asm volatile("s_waitcnt lgkmcnt(0)" ::: "memory");
            f32x4 oo[4][1];
#pragma unroll
            for (int mt = 0; mt < 4; ++mt)
#pragma unroll
                for (int r = 0; r < 4; ++r) oo[mt][0][r] = gcs[64 + mt * 16 + g4 + r] * qs[mt][0][r];
            wave_mma_u<4, 1, 2>(oo, QKs, 72, VNt, 72);
            {
                const int t0_ = dir ? s0 + L - 1 - (m * 64 + g4) : s0 + m * 64 + g4;
                long oo_ = ((long)t0_ * 4 + h) * 128 + wave * 16 + cn;
                asm volatile("" : "+v"(oo_));
                bf16_t* od = (dir ? p.ob : p.of) + oo_;
                if (dir) {
#pragma unroll
                    for (int mt = 0; mt < 4; ++mt)
#pragma unroll
                        for (int r = 0; r < 4; ++r) od[-(mt * 16 + r) * 512] = f2bf(oo[mt][0][r]);
                } else {
#pragma unroll
                    for (int mt = 0; mt < 4; ++mt)
#pragma unroll
                        for (int r = 0; r < 4; ++r) od[(mt * 16 + r) * 512] = f2bf(oo[mt][0][r]);
                }
            }
            const float eg = __expf(glast);
#pragma unroll
            for (int mt = 0; mt < 8; ++mt) S[mt][0] = S[mt][0] * eg;
            {
                const int q_ = (lane >> 2) & 3, pp_ = lane & 3, g_ = lane >> 4;
#pragma unroll
                for (int ks = 0; ks < 2; ++ks) {
                    const bf16x8 bfr = *(const bf16x8*)(VNs + cn * 72 + ks * 32 + g_ * 8);
                    s16x4 lo[8], hi[8];
#pragma unroll
                    for (int mt = 0; mt < 8; ++mt) {
                        const int r0 = ks * 32 + g_ * 8 + q_, chk = mt * 2 + (pp_ >> 1);
                        lo[mt] = __builtin_amdgcn_ds_read_tr16_b64_v4i16((__attribute__((address_space(3))) s16x4*)((char*)KnT + SCAN_KOFF(r0, chk) + 8 * (pp_ & 1)));
                        hi[mt] = __builtin_amdgcn_ds_read_tr16_b64_v4i16((__attribute__((address_space(3))) s16x4*)((char*)KnT + SCAN_KOFF(r0 + 4, chk) + 8 * (pp_ & 1)));
                    }
#pragma unroll
                    for (int mt = 0; mt < 8; ++mt) {
                        const bf16x8 afr = __builtin_shufflevector(lo[mt], hi[mt], 0, 1, 2, 3, 4, 5, 6, 7);
                        S[mt][0] = __builtin_amdgcn_mfma_f32_16x16x32_bf16(afr, bfr, S[mt][0], 0, 0, 0);
                    }
                }
            }
        }
#undef SCAN_LOAD_MAIN
#undef SCAN_LOAD_U
        if (seq < 16) {
            float* dp = p.out + OUT_STATE + ((((long)seq * 2 + j) * 2 + dir) * 4 + h) * 16384 + (g4 * 128 + wave * 16 + cn);
#pragma unroll
            for (int mt = 0; mt < 8; ++mt)
#pragma unroll
                for (int r = 0; r < 4; ++r) dp[(mt * 16 + r) * 128] = S[mt][0][r];
        }
    }
}

__device__ __forceinline__ void ph_fft_a(CP& p, char* smem) {
    __syncthreads();
    float* tws = (float*)(smem + GEMM_SMEM_BYTES);
    {
        const int t_ = ltid();
        f32x4 t4[4];
#pragma unroll
        for (int i = 0; i < 4; ++i) t4[i] = *(const f32x4*)(p.fftTW + (t_ + i * NTHREADS) * 4);
#pragma unroll
        for (int i = 0; i < 4; ++i) *(f32x4*)(tws + (t_ + i * NTHREADS) * 4) = t4[i];
    }
    __syncthreads();
    for (int u = lbid(); u < 1024; u += gridDim.x) {
        gemm_tile<0>(p.ZtA + ZA_OFF + (long)u * 256 * 128, 128, p.fftMA, 128, 128, (bf16_t*)smem, [&](int r, int c, f32x4 v) {
            const int gr = u * 256 + r;
            const int n2 = gr & 63, cf = (gr >> 6) & 511, b = gr >> 15;
            const int k1 = c >> 1, po = c & 1;
            f32x4 h;
#pragma unroll
            for (int i = 0; i < 4; ++i) {
                const float other = xshfl<1>(v[i]);
                const float2 tw = *(const float2*)(tws + ((n2 + i) * 64 + k1) * 2);
                h[i] = po == 0 ? (v[i] * tw.x + other * tw.y) : (v[i] * tw.x - other * tw.y);
            }
            bf16_t* dst = p.HB + (((((long)b * 64 + k1) * 512 + cf) * 2 + po) * 64 + n2);
            *(uint2*)dst = make_uint2(pack2(h[0], h[1]), pack2(h[2], h[3]));
        });
    }
}
__device__ __forceinline__ void ph_fft_b(CP& p, char* smem) {
    __syncthreads();
    const int nb = gridDim.x;
    for (int uu = lbid(); uu < 1024 + 64; uu += nb) {
        const int u = 1024 + 63 - uu;
        if (u < 0) continue;
        if (u < 1024) {
            gemm_tile<0>(p.HB + (long)u * 256 * 128, 128, p.fftMB, 128, 128, (bf16_t*)smem, [&](int r, int c, f32x4 v) {
                if (c < 64) {
                    const int gr = u * 256 + r;
                    const int cf = gr & 511, k1 = (gr >> 9) & 63, b = gr >> 15;
                    const long tok = TP_TOK + (long)b * 4096 + k1 + 64 * c;
                    *(uint2*)(p.mix + tok * DM + 512 + cf) = make_uint2(pack2(v[0], v[1]), pack2(v[2], v[3]));
                }
            });
        } else {
            const int q = u - 1024, seq = q >> 2, tm = (q >> 1) & 1, tn = q & 1;
            const int s0 = seq * 256;
            gemm_tile<0>(p.ZtA + (long)s0 * 1024 + (long)tm * 256 * 512, 512, p.dftP + (long)tn * 128 * 512, 512, 512, (bf16_t*)smem, [&](int r, int c, f32x4 v) {
                const int cf = tm * 256 + r, k = tn * 128 + c;
                *(uint2*)(p.mix + (long)(s0 + k) * DM + 512 + cf) = make_uint2(pack2(v[0], v[1]), pack2(v[2], v[3]));
            });
        }
    }
}

__device__ __forceinline__ void ph_e_mix(CP& p, int j) {
    const int lane = ltid() & 63, wave = ltid() >> 6;
    const float* onw = p.gdn_o_norm + j * 128;
    const float w0 = onw[lane * 2], w1 = onw[lane * 2 + 1];
    for (int row = lbid() * 8 + wave; row < T_TOK; row += gridDim.x * 8) {
        unsigned av[4], bv[4], gvv[4];
#pragma unroll
        for (int h = 0; h < 4; ++h) {
            av[h] = *(const unsigned*)(p.of + ((long)row * 4 + h) * 128 + lane * 2);
            bv[h] = *(const unsigned*)(p.ob + ((long)row * 4 + h) * 128 + lane * 2);
            gvv[h] = *(const unsigned*)(p.gate + (long)row * 512 + h * 128 + lane * 2);
        }
#pragma unroll
        for (int h = 0; h < 4; ++h) {
            const float o0 = bflo(av[h]) + bflo(bv[h]), o1 = bfhi(av[h]) + bfhi(bv[h]);
            const float ss = wave_sum(o0 * o0 + o1 * o1);
            const float r = rsqrtf(ss * (1.f / 128.f) + 1e-6f);
            *(unsigned*)(p.mix + (long)row * DM + h * 128 + lane * 2) = pack2(o0 * r * w0 * silu_f(bflo(gvv[h])), o1 * r * w1 * silu_f(bfhi(gvv[h])));
        }
    }
}

template <int FROM_INPUT = 0>
__device__ __forceinline__ void ph_out_gemm(CP& p, const bf16_t* A, const bf16_t* Wt, const float* mods_l, int g_off, char* smem, const float gscale = 1.f) {
    const int ntn = 4, ntm = T_TOK / 256;
#define OG_PROLOGUE(U) { int tm_, tn_; tile_map((U), ntm, ntn, tm_, tn_); g8_prologue<0>(A + (long)tm_ * 256 * DM, DM, Wt + (long)tn_ * 256 * 1024, 1024, (bf16_t*)smem); }
    int u = lbid();
    if (u < ntn * ntm) OG_PROLOGUE(u)
    for (; u < ntn * ntm; u += gridDim.x) {
        int tm, tn;
        tile_map(u, ntm, ntn, tm, tn);
        const int row0 = tm * 256, col0 = tn * 256;
        const float* gv = mods_l + (long)tok_modrow(row0) * 6144 + g_off;
        f32x4 acc[2][2][4][2];
        gemm_tile256_acc<0, 1>(A + (long)row0 * DM, DM, Wt + (long)col0 * 1024, 1024, 1024, (bf16_t*)smem, acc);
        if (u + (int)gridDim.x < ntn * ntm) OG_PROLOGUE(u + gridDim.x)
        const int tz = ltid(), wid = tz >> 6, lane = tz & 63, wr = wid >> 2, wc = wid & 3, fr = lane & 15, fq = lane >> 4;
#pragma unroll
        for (int ai = 0; ai < 2; ++ai)
#pragma unroll
            for (int bj = 0; bj < 2; ++bj) {
                const long xo = (long)(row0 + ai * 128 + wr * 64 + fq * 4) * DM + col0 + bj * 128 + wc * 32 + fr;
                float* xb = p.out + xo;
                const float* xs = FROM_INPUT ? (row0 < TP_TOK ? p.x_prompt + xo : p.x_sample + (xo - (long)TP_TOK * DM)) : xb;
                const float g0 = gv[col0 + bj * 128 + wc * 32 + fr] * gscale, g1 = gv[col0 + bj * 128 + wc * 32 + 16 + fr] * gscale;
                float xv[4][2][4];
#pragma unroll
                for (int m = 0; m < 4; ++m)
#pragma unroll
                    for (int n = 0; n < 2; ++n)
#pragma unroll
                        for (int i = 0; i < 4; ++i) xv[m][n][i] = xs[(long)(m * 16 + i) * DM + n * 16];
#pragma unroll
                for (int m = 0; m < 4; ++m)
#pragma unroll
                    for (int n = 0; n < 2; ++n)
#pragma unroll
                        for (int i = 0; i < 4; ++i) xb[(long)(m * 16 + i) * DM + n * 16] = xv[m][n][i] + (n ? g1 : g0) * acc[ai][bj][m][n][i];
            }
    }
#undef OG_PROLOGUE
}
__device__ __forceinline__ void ph_o_gemm1(CP& p, int j, char* smem) {
    const int ntn = N_OIN / 256, ntm = T_TOK / 256;
    const bf16_t* Bt = p.wtO_in + (long)j * N_OIN * 1024;
    for (int u = lbid(); u < ntn * ntm; u += gridDim.x) {
        int tm, tn;
        tile_map(u, ntm, ntn, tm, tn);
        const int row0 = tm * 256, col0 = tn * 256;
        gemm_tile256<0>(p.H + (long)row0 * DM, DM, Bt + (long)col0 * 1024, 1024, 1024, (bf16_t*)smem, [&](int r, int c, f32x4 v) {
            const int col = col0 + c;
            if (col < 832) {
#pragma unroll
                for (int i = 0; i < 4; ++i) p.Podd[(long)(row0 + r + i) * 832 + col] = v[i];
            }
        });
    }
}

__device__ __forceinline__ void ph_o_norm(CP& p, int j) {
    const int lane = ltid() & 63, wave = ltid() >> 6;
    float qw[8], kw[4];
#pragma unroll
    for (int i = 0; i < 8; ++i) qw[i] = p.mla_q_norm[j * 512 + i * 64 + lane];
#pragma unroll
    for (int i = 0; i < 4; ++i) kw[i] = p.mla_kv_norm[j * 256 + i * 64 + lane];
    for (int row = lbid() * 8 + wave; row < T_TOK + 2048; row += gridDim.x * 8) {
        if (row < T_TOK) {
            const float* pr = p.Podd + (long)row * 832;
            float q[8], k[4];
            float ssq = 0.f, ssk = 0.f;
#pragma unroll
            for (int i = 0; i < 8; ++i) { q[i] = pr[i * 64 + lane]; ssq += q[i] * q[i]; }
#pragma unroll
            for (int i = 0; i < 4; ++i) { k[i] = pr[512 + i * 64 + lane]; ssk += k[i] * k[i]; }
            const float kr = pr[768 + lane];
            ssq = wave_sum(ssq); ssk = wave_sum(ssk);
            const float rq = rsqrtf(ssq * (1.f / 512.f) + 1e-6f), rk = rsqrtf(ssk * (1.f / 256.f) + 1e-6f);
#pragma unroll
            for (int i = 0; i < 8; ++i) p.cq[(long)row * 512 + i * 64 + lane] = f2bf(q[i] * rq * qw[i]);
#pragma unroll
            for (int i = 0; i < 4; ++i) {
                const float v = k[i] * rk * kw[i];
                p.ckv_all[(long)row * 256 + i * 64 + lane] = f2bf(v);
                if (row < TP_TOK) p.out[OUT_CKV + (((long)(row >> 8) * 2 + j) * 256 + (row & 255)) * 256 + i * 64 + lane] = v;
            }
            p.kr_all[(long)row * 64 + lane] = kr;
            if (row < TP_TOK) p.out[OUT_KR + (((long)(row >> 8) * 2 + j) * 256 + (row & 255)) * 64 + lane] = kr;
        } else {
            const int rc = row - T_TOK, b = rc >> 8, t = rc & 255;
            const float* src = p.cache_ckv + (((long)b * 2 + j) * 256 + t) * 256;
#pragma unroll
            for (int i = 0; i < 4; ++i) p.ckv_all[(long)row * 256 + i * 64 + lane] = f2bf(src[i * 64 + lane]);
            p.kr_all[(long)row * 64 + lane] = p.cache_kr[(((long)b * 2 + j) * 256 + t) * 64 + lane];
        }
    }
}

#define KB_S (16L * 8 * 256 * 192)
#define VT_S (16L * 8 * 128 * 256)
__device__ __forceinline__ void ph_o_gemm2(CP& p, int j, char* smem) {
    const int nA = 6 * (T_TOK / 256);
    const int nB = 8 * ((T_TOK + 2048) / 256);
    for (int u = lbid(); u < nA + nB; u += gridDim.x) {
        if (u < nA) {
            int tm, tn;
            tile_map(u, T_TOK / 256, 6, tm, tn);
            const int row0 = tm * 256, col0 = tn * 256;
            const int s0 = tok_seq0(row0), L = tok_len(row0);
            f32x4 acc[2][2][4][2];
            gemm_tile256_acc<0>(p.cq + (long)row0 * 512, 512, p.wtUq + (long)j * 1536 * 512 + (long)col0 * 512, 512, 512, (bf16_t*)smem, acc);
            const int tz = ltid(), wid = tz >> 6, lane = tz & 63, wr = wid >> 2, wc = wid & 3, fr = lane & 15, fq = lane >> 4;
#pragma unroll
            for (int bj = 0; bj < 2; ++bj)
#pragma unroll
                for (int n = 0; n < 2; ++n) {
                    const int col = col0 + bj * 128 + wc * 32 + n * 16 + fr, h = col / 192, d = col - h * 192;
                    bf16_t* qd = p.Qb + (long)s0 * 1536 + ((long)h * L + (row0 - s0) + wr * 64 + fq * 4) * 192 + d;
#pragma unroll
                    for (int ai = 0; ai < 2; ++ai)
#pragma unroll
                        for (int m = 0; m < 4; ++m)
#pragma unroll
                            for (int i = 0; i < 4; ++i) qd[(ai * 128 + m * 16 + i) * 192] = f2bf(acc[ai][bj][m][n][i]);
                }
        } else {
            const int q = u - nA;
            int tm, tn;
            tile_map(q, (T_TOK + 2048) / 256, 8, tm, tn);
            const int row0 = tm * 256, col0 = tn * 256;
            long kbase, vbase; int Lk, pos0;
            if (row0 < TP_TOK) { const int s = row0 >> 8; kbase = (long)s * 8 * 256 * 192; vbase = (long)s * 8 * 128 * 256; Lk = 256; pos0 = 0; }
            else if (row0 < T_TOK) { const int b = (row0 - TP_TOK) >> 12; kbase = KB_S + (long)b * 8 * 4352 * 192; vbase = VT_S + (long)b * 8 * 128 * 4352; Lk = 4352; pos0 = (row0 - TP_TOK) & 4095; }
            else { const int b = (row0 - T_TOK) >> 8; kbase = KB_S + (long)b * 8 * 4352 * 192; vbase = VT_S + (long)b * 8 * 128 * 4352; Lk = 4352; pos0 = 4096; }
            f32x4 acc[2][2][4][2];
            gemm_tile256_acc<0>(p.ckv_all + (long)row0 * 256, 256, p.wtUkv + (long)j * 2048 * 256 + (long)col0 * 256, 256, 256, (bf16_t*)smem, acc);
            const int tz = ltid(), wid = tz >> 6, lane = tz & 63, wr = wid >> 2, wc = wid & 3, fr = lane & 15, fq = lane >> 4;
            const int h = tn;
            bf16_t* kd = p.Kb + kbase + ((long)h * Lk + pos0 + wr * 64 + fq * 4) * 192 + wc * 32 + fr;
#pragma unroll
            for (int ai = 0; ai < 2; ++ai)
#pragma unroll
                for (int m = 0; m < 4; ++m)
#pragma unroll
                    for (int i = 0; i < 4; ++i)
#pragma unroll
                        for (int n = 0; n < 2; ++n) kd[(ai * 128 + m * 16 + i) * 192 + n * 16] = f2bf(acc[ai][0][m][n][i]);
            bf16_t* vd = p.Vtb + vbase + ((long)h * 128 + wc * 32 + fr) * Lk;
#pragma unroll
            for (int ai = 0; ai < 2; ++ai)
#pragma unroll
                for (int m = 0; m < 4; ++m) {
                    const int kp = pos0 + ai * 128 + wr * 64 + m * 16 + fq * 4, kq = (kp & ~31) | (((kp >> 2) & 3) << 3) | (((kp >> 4) & 1) << 2);
#pragma unroll
                    for (int n = 0; n < 2; ++n) {
                        const f32x4 v = acc[ai][1][m][n];
                        *(uint2*)(vd + (long)n * 16 * Lk + kq) = make_uint2(pack2(v[0], v[1]), pack2(v[2], v[3]));
                    }
                }
        }
    }
}

__device__ __forceinline__ void ph_o_qknorm(CP& p, int j) {
    const int lane = ltid() & 63, wave = ltid() >> 6;
    const float* qnw = p.mla_q_headnorm + j * 192;
    const float* knw = p.mla_k_headnorm + j * 192;
    const float qw0 = qnw[lane], qw1 = qnw[64 + lane], qw2 = qnw[128 + lane];
    const float kw0 = knw[lane], kw1 = knw[64 + lane], kw2 = knw[128 + lane];
    const float inv = exp2f(-(float)(lane & 15) * 0.8304820237218406f);
    for (int row = lbid() * 8 + wave; row < T_TOK + 2048; row += gridDim.x * 8) {
        bool rope = false; float cs = 1.f, sn = 0.f;
        long kbase; int Lk, pos;
        if (row < TP_TOK) { const int s = row >> 8; kbase = (long)s * 8 * 256 * 192; Lk = 256; pos = row & 255; }
        else if (row < T_TOK) {
            const int b = (row - TP_TOK) >> 12; pos = (row - TP_TOK) & 4095; kbase = KB_S + (long)b * 8 * 4352 * 192; Lk = 4352; rope = true;
            const float ang = (float)((lane & 32) ? (pos & 63) : (pos >> 6)) * inv;
            sincosf(ang, &sn, &cs);
        } else { const int rc = row - T_TOK; const int b = rc >> 8; pos = 4096 + (rc & 255); kbase = KB_S + (long)b * 8 * 4352 * 192; Lk = 4352; }
        const float kr = p.kr_all[(long)row * 64 + lane];
        const bool hi = (lane & 16) != 0;
        const bool isq = row < T_TOK;
        const int s0 = isq ? tok_seq0(row) : 0, L = isq ? tok_len(row) : 1;
        bf16_t* kp0 = p.Kb + kbase + (long)pos * 192;
        bf16_t* qp0 = p.Qb + (long)s0 * 1536 + (long)(row - s0) * 192;
        float k0[8], k1[8], q0[8], q1[8], q2[8];
#pragma unroll
        for (int h = 0; h < 8; ++h) {
            const bf16_t* kp = kp0 + (long)h * Lk * 192;
            k0[h] = bf2f(kp[lane]); k1[h] = bf2f(kp[64 + lane]);
        }
        if (isq) {
#pragma unroll
            for (int h = 0; h < 8; ++h) {
                const bf16_t* qp = qp0 + (long)h * L * 192;
                q0[h] = bf2f(qp[lane]); q1[h] = bf2f(qp[64 + lane]); q2[h] = bf2f(qp[128 + lane]);
            }
        }
#pragma unroll
        for (int h = 0; h < 8; ++h) {
            bf16_t* kp = kp0 + (long)h * Lk * 192;
            const float ss = wave_sum(k0[h] * k0[h] + k1[h] * k1[h] + kr * kr);
            const float r = rsqrtf(ss * (1.f / 192.f) + 1e-6f);
            float y2 = kr * r * kw2;
            if (rope) {
                const float o = xshfl<16>(y2);
                y2 = hi ? (o * sn + y2 * cs) : (y2 * cs - o * sn);
            }
            kp[lane] = f2bf(k0[h] * r * kw0); kp[64 + lane] = f2bf(k1[h] * r * kw1); kp[128 + lane] = f2bf(y2);
        }
        if (isq) {
#pragma unroll
            for (int h = 0; h < 8; ++h) {
                bf16_t* qp = qp0 + (long)h * L * 192;
                const float ss = wave_sum(q0[h] * q0[h] + q1[h] * q1[h] + q2[h] * q2[h]);
                const float r = rsqrtf(ss * (1.f / 192.f) + 1e-6f) * 0.10411755f;
                float y2 = q2[h] * r * qw2;
                if (rope) {
                    const float o = xshfl<16>(y2);
                    y2 = hi ? (o * sn + y2 * cs) : (y2 * cs - o * sn);
                }
                qp[lane] = f2bf(q0[h] * r * qw0); qp[64 + lane] = f2bf(q1[h] * r * qw1); qp[128 + lane] = f2bf(y2);
            }
        }
    }
}

#define ATT_KLD 208
#define ATT_VLD 80
#define ATTN_SMEM_BYTES (2 * 64 * ATT_KLD * 2 + 3 * 128 * ATT_VLD * 2)
__device__ __forceinline__ void ph_o_attn(CP& p, char* smem) {
    for (int u = lbid(); u < 1152; u += gridDim.x) {
        int lz = 0, tid = ltid();
        asm volatile("" : "+s"(lz), "+v"(tid));
        const int lane = tid & 63, wave = tid >> 6;
        const int g = lane >> 4, cn = lane & 15, kg = g * 8;
        bf16_t* Ks = (bf16_t*)(smem + lz);
        bf16_t* Vs = Ks + 2 * 64 * ATT_KLD;
        int s0, L, Lk, h, q0; long kbase, vbase;
        if (u < 1024) { const int b = u >> 7; h = (u >> 4) & 7; q0 = (u & 15) * 256; s0 = TP_TOK + b * 4096; L = 4096; Lk = 4352; kbase = KB_S + (long)b * 8 * 4352 * 192; vbase = VT_S + (long)b * 8 * 128 * 4352; }
        else { const int q = u - 1024; const int s = q >> 3; h = q & 7; q0 = 0; s0 = s * 256; L = 256; Lk = 256; kbase = (long)s * 8 * 256 * 192; vbase = (long)s * 8 * 128 * 256; }
        const bf16_t* Qp = p.Qb + (long)s0 * 1536 + ((long)h * L + q0 + wave * 32) * 192;
        const bf16_t* Kp = p.Kb + kbase + (long)h * Lk * 192;
        const bf16_t* Vp = p.Vtb + vbase + (long)h * 128 * Lk;
        bf16x8 qb[2][6];
#pragma unroll
        for (int mt = 0; mt < 2; ++mt)
#pragma unroll
            for (int ks = 0; ks < 6; ++ks) qb[mt][ks] = *(const bf16x8*)(Qp + (mt * 16 + cn) * 192 + ks * 32 + kg);
        f32x4 o[8][2];
        f32x4 negm[2];
        float lrow[2];
#pragma unroll
        for (int mt = 0; mt < 2; ++mt) {
#pragma unroll
            for (int dt = 0; dt < 8; ++dt) o[dt][mt] = (f32x4){0.f, 0.f, 0.f, 0.f};
            negm[mt] = (f32x4){0.f, 0.f, 0.f, 0.f}; lrow[mt] = 0.f;
        }
        const int nkt = Lk / 64;
        u32x4 rk[3], rv[2];
        f32x4 s[4][2];
        bf16x8 pb[2][2];
        bf16x8 fa[2][4];
#define ATT_SB() __builtin_amdgcn_sched_barrier(0)
#define ATT_LDK(dst_, Kc_, ks_) _Pragma("unroll") for (int nt = 0; nt < 4; ++nt) dst_[nt] = *(const bf16x8*)((Kc_) + (nt * 16 + cn) * ATT_KLD + (ks_) * 32 + kg)
#define ATT_LDV(dst_, Vc_, b_) _Pragma("unroll") for (int d4 = 0; d4 < 4; ++d4) dst_[d4] = *(const bf16x8*)((Vc_) + ((((b_) & 1) * 4 + d4) * 16 + cn) * ATT_VLD + ((b_) >> 1) * 32 + kg)
        float pv[2][4][4];
#define ATT_LDK2(dst_, Kc_, h_, ks_) _Pragma("unroll") for (int n_ = 0; n_ < 2; ++n_) dst_[n_] = *(const bf16x8*)((Kc_) + ((2 * (h_) + n_) * 16 + cn) * ATT_KLD + (ks_) * 32 + kg)
#define ATT_PACK(mt_, k2_)                                                                                             \
        {                                                                                                              \
            u32x4 w_;                                                                                                  \
            w_[0] = pack2(pv[mt_][2 * (k2_)][0], pv[mt_][2 * (k2_)][1]); w_[1] = pack2(pv[mt_][2 * (k2_)][2], pv[mt_][2 * (k2_)][3]);   \
            w_[2] = pack2(pv[mt_][2 * (k2_) + 1][0], pv[mt_][2 * (k2_) + 1][1]); w_[3] = pack2(pv[mt_][2 * (k2_) + 1][2], pv[mt_][2 * (k2_) + 1][3]);   \
            pb[mt_][k2_] = __builtin_bit_cast(bf16x8, w_);                                                             \
        }
#define ATT_QK(Kc_, Vc_)                                                                                               \
        {                                                                                                              \
            ATT_LDK2(fa[0], Kc_, 0, 0);                                                                                \
            _Pragma("unroll") for (int t_ = 0; t_ < 12; ++t_) {                                                      \
                const int h_ = t_ / 6, ks = t_ % 6;                                                                    \
                if (t_ < 11) { ATT_LDK2(fa[(t_ + 1) & 1], Kc_, (t_ + 1) / 6, (t_ + 1) % 6); } else { ATT_LDV(fa[0], Vc_, 0); }   \
                ATT_SB();                                                                                              \
                _Pragma("unroll") for (int n_ = 0; n_ < 2; ++n_)                                                     \
                    _Pragma("unroll") for (int mt = 0; mt < 2; ++mt)                                                 \
                        s[2 * h_ + n_][mt] = __builtin_amdgcn_mfma_f32_16x16x32_bf16(fa[t_ & 1][n_], qb[mt][ks], ks == 0 ? negm[mt] : s[2 * h_ + n_][mt], 0, 0, 0);   \
                if (h_ == 1 && ks < 4) {                                                                               \
                    _Pragma("unroll") for (int r = 0; r < 4; ++r) pv[ks >> 1][ks & 1][r] = __builtin_amdgcn_exp2f(s[ks & 1][ks >> 1][r]);   \
                }                                                                                                      \
                if (h_ == 1 && ks >= 4) ATT_PACK(ks - 4, 0)                                                            \
                if (t_ < 11) ATT_SB();                                                                                 \
            }                                                                                                          \
        }
#define ATT_PBIG 4096.f
#define ATT_SOFTMAX(first_)                                                                                            \
        {                                                                                                              \
            float ps[2];                                                                                               \
            _Pragma("unroll") for (int mt = 0; mt < 2; ++mt) {                                                       \
                _Pragma("unroll") for (int nt = 2; nt < 4; ++nt)                                                     \
                    _Pragma("unroll") for (int r = 0; r < 4; ++r) pv[mt][nt][r] = __builtin_amdgcn_exp2f(s[nt][mt][r]);   \
                ps[mt] = 0.f;                                                                                          \
                _Pragma("unroll") for (int nt = 0; nt < 4; ++nt)                                                     \
                    _Pragma("unroll") for (int r = 0; r < 4; ++r) ps[mt] += pv[mt][nt][r];                           \
            }                                                                                                          \
            const bool ok = !(first_) && ps[0] <= ATT_PBIG && ps[1] <= ATT_PBIG;                                       \
            if (!__all(ok)) {                                                                                          \
                _Pragma("unroll") for (int mt = 0; mt < 2; ++mt) {                                                   \
                    float mx = fmaxf(fmaxf(s[0][mt][0], s[0][mt][1]), fmaxf(s[0][mt][2], s[0][mt][3]));               \
                    _Pragma("unroll") for (int nt = 1; nt < 4; ++nt) mx = fmaxf(mx, fmaxf(fmaxf(s[nt][mt][0], s[nt][mt][1]), fmaxf(s[nt][mt][2], s[nt][mt][3])));   \
                    mx = fmaxf(mx, xshfl<16>(mx));                                                                     \
                    mx = fmaxf(mx, xshfl<32>(mx));                                                                     \
                    const float dl = (first_) ? mx : fmaxf(mx, 0.f);                                                   \
                    const float al = (first_) ? 1.f : __builtin_amdgcn_exp2f(-dl);                                     \
                    negm[mt] = negm[mt] - dl;                                                                          \
                    lrow[mt] *= al;                                                                                    \
                    _Pragma("unroll") for (int dt = 0; dt < 8; ++dt) o[dt][mt] = o[dt][mt] * al;                     \
                    ps[mt] = 0.f;                                                                                      \
                    _Pragma("unroll") for (int nt = 0; nt < 4; ++nt)                                                 \
                        _Pragma("unroll") for (int r = 0; r < 4; ++r) { pv[mt][nt][r] = __builtin_amdgcn_exp2f(s[nt][mt][r] - dl); ps[mt] += pv[mt][nt][r]; }   \
                    ATT_PACK(mt, 0)                                                                                    \
                }                                                                                                      \
            }                                                                                                          \
            _Pragma("unroll") for (int mt = 0; mt < 2; ++mt) {                                                       \
                lrow[mt] += ps[mt];                                                                                    \
                ATT_PACK(mt, 1)                                                                                        \
            }                                                                                                          \
        }
#define ATT_PV(Vc_)                                                                                                    \
        {                                                                                                              \
            _Pragma("unroll") for (int b = 0; b < 4; ++b) {                                                          \
                if (b < 3) { ATT_LDV(fa[(b + 1) & 1], Vc_, b + 1); }                                                   \
                ATT_SB();                                                                                              \
                _Pragma("unroll") for (int d4 = 0; d4 < 4; ++d4)                                                     \
                    _Pragma("unroll") for (int mt = 0; mt < 2; ++mt) o[(b & 1) * 4 + d4][mt] = __builtin_amdgcn_mfma_f32_16x16x32_bf16(fa[b & 1][d4], pb[mt][b >> 1], o[(b & 1) * 4 + d4][mt], 0, 0, 0);   \
                ATT_SB();                                                                                              \
            }                                                                                                          \
        }
        __syncthreads();
#pragma unroll
        for (int i = 0; i < 3; ++i) { const int ch = tid + i * 512, row = ch / 24, kc = ch % 24; rk[i] = *(const u32x4*)(Kp + (long)row * 192 + kc * 8); }
#pragma unroll
        for (int i = 0; i < 2; ++i) { const int ch = tid + i * 512, row = ch >> 3, kc = ch & 7; rv[i] = *(const u32x4*)(Vp + (long)row * Lk + kc * 8); }
#pragma unroll
        for (int i = 0; i < 3; ++i) { const int ch = tid + i * 512, row = ch / 24, kc = ch % 24; *(u32x4*)(Ks + row * ATT_KLD + kc * 8) = rk[i]; }
#pragma unroll
        for (int i = 0; i < 2; ++i) { const int ch = tid + i * 512, row = ch >> 3, kc = ch & 7; *(u32x4*)(Vs + row * ATT_VLD + kc * 8) = rv[i]; }
        __syncthreads();
        for (int it = 0; it < nkt; ++it) {
            const int cur = it & 1;
            const bool more = it + 1 < nkt;
            const long key0 = (long)(it + 1) * 64;
            if (more) {
#pragma unroll
                for (int i = 0; i < 3; ++i) { const int ch = tid + i * 512, row = ch / 24, kc = ch % 24; rk[i] = *(const u32x4*)(Kp + (key0 + row) * 192 + kc * 8); }
#pragma unroll
                for (int i = 0; i < 2; ++i) { const int ch = tid + i * 512, row = ch >> 3, kc = ch & 7; rv[i] = *(const u32x4*)(Vp + (long)row * Lk + key0 + kc * 8); }
            }
            const bf16_t* Kc = Ks + cur * 64 * ATT_KLD;
            ATT_QK(Kc, Vs + cur * 128 * ATT_VLD) ATT_SOFTMAX(it == 0) ATT_PV(Vs + cur * 128 * ATT_VLD)
            if (more) {
                bf16_t* Kn = Ks + (cur ^ 1) * 64 * ATT_KLD;
                bf16_t* Vn = Vs + (cur ^ 1) * 128 * ATT_VLD;
#pragma unroll
                for (int i = 0; i < 3; ++i) { const int ch = tid + i * 512, row = ch / 24, kc = ch % 24; *(u32x4*)(Kn + row * ATT_KLD + kc * 8) = rk[i]; }
#pragma unroll
                for (int i = 0; i < 2; ++i) { const int ch = tid + i * 512, row = ch >> 3, kc = ch & 7; *(u32x4*)(Vn + row * ATT_VLD + kc * 8) = rv[i]; }
            }
            __syncthreads();
        }
#undef ATT_QK
#undef ATT_SB
#undef ATT_LDK
#undef ATT_LDV
#undef ATT_SOFTMAX
#undef ATT_LDK2
#undef ATT_PACK
#undef ATT_PBIG
#undef ATT_PV
#pragma unroll
        for (int mt = 0; mt < 2; ++mt) {
            float l = lrow[mt];
            l += xshfl<16>(l); l += xshfl<32>(l);
            const float il = __builtin_amdgcn_rcpf(l);
            bf16_t* op = p.Ob + (long)(s0 + q0 + wave * 32 + mt * 16 + cn) * DM + h * 128 + 4 * g;
#pragma unroll
            for (int dt = 0; dt < 8; ++dt)
                *(uint2*)(op + dt * 16) = make_uint2(pack2(o[dt][mt][0] * il, o[dt][mt][1] * il), pack2(o[dt][mt][2] * il, o[dt][mt][3] * il));
        }
    }
}
__device__ __forceinline__ unsigned f2ord(float f) { const unsigned u = __float_as_uint(f); return u ^ ((u >> 31) ? 0xFFFFFFFFu : 0x80000000u); }
__device__ __forceinline__ float ord2f(unsigned o) { const unsigned u = (o >> 31) ? (o ^ 0x80000000u) : ~o; return __uint_as_float(u); }

#define KCE(a, b) { const unsigned hi_ = max(a, b), lo_ = min(a, b); a = hi_; b = lo_; }
__device__ __forceinline__ void sort16_desc(unsigned (&v)[16]) {
#define S2(a, b) KCE(v[a], v[b])
    S2(0, 13) S2(1, 12) S2(2, 15) S2(3, 14) S2(4, 8) S2(5, 6) S2(7, 11) S2(9, 10)
    S2(0, 5) S2(1, 7) S2(2, 9) S2(3, 4) S2(6, 13) S2(8, 14) S2(10, 15) S2(11, 12)
    S2(0, 1) S2(2, 3) S2(4, 5) S2(6, 8) S2(7, 9) S2(10, 11) S2(12, 13) S2(14, 15)
    S2(0, 2) S2(1, 3) S2(4, 10) S2(5, 11) S2(6, 7) S2(8, 9) S2(12, 14) S2(13, 15)
    S2(1, 2) S2(3, 12) S2(4, 6) S2(5, 7) S2(8, 10) S2(9, 11) S2(13, 14)
    S2(1, 4) S2(2, 6) S2(5, 8) S2(7, 10) S2(9, 13) S2(11, 14)
    S2(2, 4) S2(3, 6) S2(9, 12) S2(11, 13)
    S2(3, 5) S2(6, 8) S2(7, 9) S2(10, 12)
    S2(3, 4) S2(5, 6) S2(7, 8) S2(9, 10) S2(11, 12)
    S2(6, 7) S2(8, 9)
#undef S2
}
#define KCF(a, b) { const float hi_ = __builtin_fmaxf(a, b), lo_ = __builtin_fminf(a, b); a = hi_; b = lo_; }
__device__ __forceinline__ void sort16f_desc(float (&v)[16]) {
#define S2(a, b) KCF(v[a], v[b])
    S2(0, 13) S2(1, 12) S2(2, 15) S2(3, 14) S2(4, 8) S2(5, 6) S2(7, 11) S2(9, 10)
    S2(0, 5) S2(1, 7) S2(2, 9) S2(3, 4) S2(6, 13) S2(8, 14) S2(10, 15) S2(11, 12)
    S2(0, 1) S2(2, 3) S2(4, 5) S2(6, 8) S2(7, 9) S2(10, 11) S2(12, 13) S2(14, 15)
    S2(0, 2) S2(1, 3) S2(4, 10) S2(5, 11) S2(6, 7) S2(8, 9) S2(12, 14) S2(13, 15)
    S2(1, 2) S2(3, 12) S2(4, 6) S2(5, 7) S2(8, 10) S2(9, 11) S2(13, 14)
    S2(1, 4) S2(2, 6) S2(5, 8) S2(7, 10) S2(9, 13) S2(11, 14)
    S2(2, 4) S2(3, 6) S2(9, 12) S2(11, 13)
    S2(3, 5) S2(6, 8) S2(7, 9) S2(10, 12)
    S2(3, 4) S2(5, 6) S2(7, 8) S2(9, 10) S2(11, 12)
    S2(6, 7) S2(8, 9)
#undef S2
}
__device__ __forceinline__ void merge16f_desc(float (&a)[16], const float (&b)[16]) {
#pragma unroll
    for (int i = 0; i < 16; ++i) a[i] = __builtin_fmaxf(a[i], b[15 - i]);
#pragma unroll
    for (int j = 8; j > 0; j >>= 1)
#pragma unroll
        for (int i = 0; i < 16; ++i) {
            const int l = i ^ j;
            if (l > i) { KCF(a[i], a[l]) }
        }
}
__device__ __forceinline__ void merge16_desc(unsigned (&a)[16], const unsigned (&b)[16]) {
#pragma unroll
    for (int i = 0; i < 16; ++i) a[i] = max(a[i], b[15 - i]);
#pragma unroll
    for (int j = 8; j > 0; j >>= 1)
#pragma unroll
        for (int i = 0; i < 16; ++i) {
            const int l = i ^ j;
            if (l > i) { KCE(a[i], a[l]) }
        }
}

#define RT_QLD 144
#define RT_SLD 130
#define ROUTE_SMEM_BYTES (256 * RT_SLD * 4 + 256 * 32)
__device__ __forceinline__ void ph_p_route(CP& p, int l, char* smem) {
    const int ntm = T_TOK / 256;
    const bf16_t* Bt = p.wtPq + (long)l * 2048 * 1024;
    for (int u = lbid(); u < 8 * ntm; u += gridDim.x) {
        int tm, h;
        tile_map(u, ntm, 8, tm, h);
        const int row0 = tm * 256;
        bf16_t* Qs = (bf16_t*)smem;
        bf16_t* SK = (bf16_t*)(smem + 65536);
        float* sc = (float*)smem;
        unsigned char* ib = (unsigned char*)smem + 256 * RT_SLD * 4;
        __syncthreads();
        f32x4 acc[2][2][4][2];
        gemm_tile256_acc<0>(p.H + (long)row0 * DM, DM, Bt + (long)h * 256 * 1024, 1024, 1024, (bf16_t*)smem, acc);
        const int tid = ltid(), lane = tid & 63, wave = tid >> 6;
        const int g4 = (lane >> 4) * 4, cn = lane & 15, kg = (lane >> 4) * 8;
        const int wr = wave >> 2, wc = wave & 3, fr = cn, fq = lane >> 4;
        const int trow = tid >> 1, half = tid & 1;
        float top[2][16];
#pragma unroll
        for (int pp = 0; pp < 2; ++pp) {
            __syncthreads();
#pragma unroll
            for (int ai = 0; ai < 2; ++ai)
#pragma unroll
                for (int m = 0; m < 4; ++m)
#pragma unroll
                    for (int n = 0; n < 2; ++n) {
                        const f32x4 v = acc[ai][pp][m][n];
                        *(uint2*)((char*)Qs + ai * 32768 + SCAN_KOFF(wc * 32 + n * 16 + fr, wr * 8 + m * 2 + (fq >> 1)) + (fq & 1) * 8) = make_uint2(pack2(v[0], v[1]), pack2(v[2], v[3]));
                    }
            {
                const bf16_t* skg = p.subk + ((long)l * 16 + h * 2 + pp) * 128 * 128;
                u32x4 kv[4];
#pragma unroll
                for (int i = 0; i < 4; ++i) kv[i] = *(const u32x4*)(skg + (tid + i * NTHREADS) * 8);
#pragma unroll
                for (int i = 0; i < 4; ++i) { const int ch = tid + i * NTHREADS; *(u32x4*)(SK + (ch >> 4) * RT_QLD + (ch & 15) * 8) = kv[i]; }
            }
            __syncthreads();
            f32x4 sacc[2][8];
#pragma unroll
            for (int mt = 0; mt < 2; ++mt)
#pragma unroll
                for (int nt = 0; nt < 8; ++nt) sacc[mt][nt] = (f32x4){0.f, 0.f, 0.f, 0.f};
            {
                const int q_ = (lane >> 2) & 3, pp_ = lane & 3;
                const char* qi = (const char*)Qs + (wave >> 2) * 32768;
#pragma unroll
                for (int ks = 0; ks < 4; ++ks) {
                    bf16x8 bfr[8];
#pragma unroll
                    for (int nt = 0; nt < 8; ++nt) bfr[nt] = *(const bf16x8*)(SK + (nt * 16 + cn) * RT_QLD + ks * 32 + kg);
#pragma unroll
                    for (int mt = 0; mt < 2; ++mt) {
                        const int d0 = ks * 32 + fq * 8 + q_, chk = (wave & 3) * 4 + mt * 2 + (pp_ >> 1);
                        const s16x4 lo = __builtin_amdgcn_ds_read_tr16_b64_v4i16((__attribute__((address_space(3))) s16x4*)(qi + SCAN_KOFF(d0, chk) + 8 * (pp_ & 1)));
                        const s16x4 hi = __builtin_amdgcn_ds_read_tr16_b64_v4i16((__attribute__((address_space(3))) s16x4*)(qi + SCAN_KOFF(d0 + 4, chk) + 8 * (pp_ & 1)));
                        const bf16x8 afr = __builtin_shufflevector(lo, hi, 0, 1, 2, 3, 4, 5, 6, 7);
#pragma unroll
                        for (int nt = 0; nt < 8; ++nt) sacc[mt][nt] = __builtin_amdgcn_mfma_f32_16x16x32_bf16(afr, bfr[nt], sacc[mt][nt], 0, 0, 0);
                    }
                }
            }
            __syncthreads();
#pragma unroll
            for (int mt = 0; mt < 2; ++mt)
#pragma unroll
                for (int nt = 0; nt < 8; ++nt)
#pragma unroll
                    for (int r = 0; r < 4; ++r) sc[(wave * 32 + mt * 16 + g4 + r) * RT_SLD + nt * 16 + cn] = sacc[mt][nt][r];
            __syncthreads();
            const float* srow = sc + trow * RT_SLD + half;
#pragma unroll
            for (int grp = 0; grp < 4; ++grp) {
                float v[16];
#pragma unroll
                for (int i = 0; i < 16; ++i) {
                    const int k = grp * 16 + i;
                    v[i] = __uint_as_float((__float_as_uint(srow[2 * k]) & 0xFFFFFF00u) | (unsigned)(2 * k));
                }
                sort16f_desc(v);
                if (grp == 0) {
#pragma unroll
                    for (int i = 0; i < 16; ++i) top[pp][i] = v[i];
                } else merge16f_desc(top[pp], v);
            }
            float oth[16];
#pragma unroll
            for (int i = 0; i < 16; ++i) top[pp][i] = __uint_as_float(__float_as_uint(top[pp][i]) | (unsigned)half);
#pragma unroll
            for (int i = 0; i < 16; ++i) oth[i] = xshfl<1>(top[pp][i]);
            merge16f_desc(top[pp], oth);
        }
        if (half == 0) {
            float s0[16], s1[16];
            unsigned iw[8];
#pragma unroll
            for (int i = 0; i < 8; ++i) iw[i] = 0u;
#pragma unroll
            for (int i = 0; i < 16; ++i) {
                s0[i] = __uint_as_float((__float_as_uint(top[0][i]) & 0xFFFFFF00u) | 0x80u);
                s1[i] = __uint_as_float((__float_as_uint(top[1][i]) & 0xFFFFFF00u) | 0x80u);
                iw[i >> 2] |= (__float_as_uint(top[0][i]) & 0xFFu) << ((i & 3) * 8);
                iw[4 + (i >> 2)] |= (__float_as_uint(top[1][i]) & 0xFFu) << ((i & 3) * 8);
            }
            unsigned* ibw = (unsigned*)(ib + trow * 32);
#pragma unroll
            for (int i = 0; i < 8; ++i) ibw[i] = iw[i];
            float ct[16];
            {
                float cg[4][16];
#pragma unroll
                for (int g_ = 0; g_ < 4; ++g_)
#pragma unroll
                    for (int i = 0; i < 16; ++i) cg[g_][i] = -3.0e38f;
                int cnt = 0;
#pragma unroll
                for (int a2 = 0; a2 < 16; ++a2)
#pragma unroll
                    for (int b2 = 0; b2 < 16; ++b2)
                        if ((a2 + 1) * (b2 + 1) <= 16) {
                            cg[cnt >> 4][cnt & 15] = __uint_as_float((__float_as_uint(s0[a2] + s1[b2]) & 0xFFFFFF00u) | (unsigned)(255 - (a2 * 16 + b2)));
                            ++cnt;
                        }
                if (s0[0] + s1[15] < 0.f) sort16f_desc(cg[0]);
                sort16f_desc(cg[1]); sort16f_desc(cg[2]);
                KCF(cg[3][0], cg[3][1])
#pragma unroll
                for (int i = 0; i < 16; ++i) ct[i] = cg[0][i];
                merge16f_desc(ct, cg[1]); merge16f_desc(ct, cg[2]); merge16f_desc(ct, cg[3]);
            }
            float cv[16];
#pragma unroll
            for (int i = 0; i < 16; ++i) cv[i] = __uint_as_float((__float_as_uint(ct[i]) & 0xFFFFFF00u) | 0x80u);
            const float mx = cv[0];
            float sum = 0.f;
#pragma unroll
            for (int i = 0; i < 16; ++i) { cv[i] = __expf(cv[i] - mx); sum += cv[i]; }
            const float inv = 1.f / sum;
            const long ob = ((long)(row0 + trow) * 8 + h) * 16;
            asm volatile("s_waitcnt lgkmcnt(0)" ::: "memory");
            const unsigned char* ibr = ib + trow * 32;
#pragma unroll
            for (int i = 0; i < 16; ++i) {
                const int fl = 255 - (int)(__float_as_uint(ct[i]) & 255u), a2 = fl >> 4, b2 = fl & 15;
                p.eidx[ob + i] = (int)ibr[a2] * 128 + (int)ibr[16 + b2];
                p.pgate[ob + i] = cv[i] * inv;
            }
        }
    }
}

#define PE_T 2
#define PE_LOADU(RA, BB, T_)                                                                                       \
    _Pragma("unroll") for (int k_ = 0; k_ < 8; ++k_) {                                                           \
        const int kk_ = (BB) * 8 + k_;                                                                           \
        const int e_ = __builtin_amdgcn_readlane((BB) < 8 ? e0[T_] : e1[T_], kk_ & 63);                          \
        RA[k_] = *(const u32x4*)(tabu + (long)e_ * 1024);                                                        \
    }
#define PE_LOADV(RA, BB, T_)                                                                                       \
    _Pragma("unroll") for (int k_ = 0; k_ < 8; ++k_) {                                                           \
        const int kk_ = (BB) * 8 + k_;                                                                           \
        const int e_ = __builtin_amdgcn_readlane((BB) < 8 ? e0[T_] : e1[T_], kk_ & 63);                          \
        RA[k_] = *(const u32x4*)(tabv + (long)e_ * 1024);                                                        \
    }
#define PE_X1(v_) __builtin_amdgcn_mov_dpp((int)(v_), 0xB1, 0xF, 0xF, true)
#define PE_X2(v_) __builtin_amdgcn_mov_dpp((int)(v_), 0x4E, 0xF, 0xF, true)
#define PE_X4(v_) __builtin_amdgcn_update_dpp(__builtin_amdgcn_update_dpp(0, (int)(v_), 0x104, 0xF, 0x5, false), (int)(v_), 0x114, 0xF, 0xA, false)
#define PE_X8(v_) __builtin_amdgcn_mov_dpp((int)(v_), 0x128, 0xF, 0xF, true)
#define PE_BREV(k_) ((((k_) & 1) << 2) | ((k_) & 2) | (((k_) >> 2) & 1))
#define PE_DOT(UA, BB, T_)                                                                                         \
    {                                                                                                              \
        int d_[8];                                                                                                 \
        _Pragma("unroll") for (int k_ = 0; k_ < 8; ++k_) {                                                       \
            int a_ = __builtin_amdgcn_sdot4((int)UA[k_][0], qx[T_][0], 0, false);                                \
            a_ = __builtin_amdgcn_sdot4((int)UA[k_][1], qx[T_][1], a_, false);                                   \
            a_ = __builtin_amdgcn_sdot4((int)UA[k_][2], qx[T_][2], a_, false);                                   \
            d_[k_] = __builtin_amdgcn_sdot4((int)UA[k_][3], qx[T_][3], a_, false);                               \
        }                                                                                                          \
               \
        int t4_[4], t2_[2], t1_;                                                                                   \
        _Pragma("unroll") for (int i_ = 0; i_ < 4; ++i_) { const int snd_ = b2 ? d_[i_] : d_[i_ + 4]; const int kp_ = b2 ? d_[i_ + 4] : d_[i_]; t4_[i_] = kp_ + PE_X4(snd_); } \
        _Pragma("unroll") for (int i_ = 0; i_ < 2; ++i_) { const int snd_ = b1 ? t4_[i_] : t4_[i_ + 2]; const int kp_ = b1 ? t4_[i_ + 2] : t4_[i_]; t2_[i_] = kp_ + PE_X2(snd_); } \
        { const int snd_ = b0 ? t2_[0] : t2_[1]; const int kp_ = b0 ? t2_[1] : t2_[0]; t1_ = kp_ + PE_X1(snd_); }  \
        t1_ += PE_X8(t1_);                                                                                         \
        t1_ += xshfl_i<16>(t1_);                                                                                       \
        t1_ += xshfl_i<32>(t1_);                                                                                       \
                                         \
        const bool mine_ = (lane >> 3) == ((BB) & 7);                                                              \
        hlo[T_] = (mine_ && (BB) < 8) ? t1_ : hlo[T_];                                                             \
        hhi[T_] = (mine_ && (BB) >= 8) ? t1_ : hhi[T_];                                                            \
    }
#define PE_AXPY(VA, BB, T_)                                                                                        \
    {                                                                                                              \
        const unsigned psel_ = (BB) < 8 ? pklo[T_] : pkhi[T_];                                                     \
        _Pragma("unroll") for (int h_ = 0; h_ < 2; ++h_) {                                                       \
            const int wp_ = __builtin_amdgcn_readlane((int)psel_, ((BB) & 7) * 8 + h_ * 4);                        \
            _Pragma("unroll") for (int i_ = 0; i_ < 4; ++i_) {                                                   \
                const unsigned a_ = VA[h_ * 4][i_], b_ = VA[h_ * 4 + 1][i_], c_ = VA[h_ * 4 + 2][i_], d_ = VA[h_ * 4 + 3][i_];   \
                const unsigned t0_ = __builtin_amdgcn_perm(b_, a_, 0x05010400u), t1_ = __builtin_amdgcn_perm(b_, a_, 0x07030602u);   \
                const unsigned t2_ = __builtin_amdgcn_perm(d_, c_, 0x05010400u), t3_ = __builtin_amdgcn_perm(d_, c_, 0x07030602u);   \
                acc[T_][i_ * 4 + 0] = __builtin_amdgcn_sdot4((int)__builtin_amdgcn_perm(t2_, t0_, 0x05040100u), wp_, acc[T_][i_ * 4 + 0], false);   \
                acc[T_][i_ * 4 + 1] = __builtin_amdgcn_sdot4((int)__builtin_amdgcn_perm(t2_, t0_, 0x07060302u), wp_, acc[T_][i_ * 4 + 1], false);   \
                acc[T_][i_ * 4 + 2] = __builtin_amdgcn_sdot4((int)__builtin_amdgcn_perm(t3_, t1_, 0x05040100u), wp_, acc[T_][i_ * 4 + 2], false);   \
                acc[T_][i_ * 4 + 3] = __builtin_amdgcn_sdot4((int)__builtin_amdgcn_perm(t3_, t1_, 0x07060302u), wp_, acc[T_][i_ * 4 + 3], false);   \
            }                                                                                                      \
        }                                                                                                          \
    }
template <int NEXT = 0>
__device__ __forceinline__ void ph_p_eval(CP& p, const float* mods_l, int l, const float* w_next, const float* mods_next, const float gscale = 1.f) {
    const int lane = ltid() & 63, wave = ltid() >> 6;
    const bool b0 = (lane & 1) != 0, b1 = (lane & 2) != 0, b2 = (lane & 4) != 0;
    const int rstride = gridDim.x * 8;
    const int first = lbid() * 8 + wave;
    const int ntok = (T_TOK - first + rstride - 1) / rstride;
    const int nsweep = __builtin_amdgcn_readfirstlane((T_TOK - lbid() * 8 + rstride - 1) / rstride + PE_T - 1) / PE_T;
    const unsigned char* tabu = p.tabU + (long)(l & 1) * 16384 * 2048 + lane * 16;
    const unsigned char* tabv = tabu + 16384L * 1024;
    const float* su_ = p.su + (l & 1) * 32768; const float* sv_ = su_ + 16384;
    u32x4 hpa[PE_T], hpb[PE_T]; unsigned kp0[PE_T], kp1[PE_T];
#define PE_PREFETCH(SW)                                                                                            \
    _Pragma("unroll") for (int t = 0; t < PE_T; ++t) {                                                           \
        const int ti_ = (SW) * PE_T + t;                                                                           \
        const long row_ = first + (ti_ < ntok ? ti_ : 0) * rstride;                                                \
        hpa[t] = *(const u32x4*)(p.H + row_ * DM + lane * 16); hpb[t] = *(const u32x4*)(p.H + row_ * DM + lane * 16 + 8);   \
        kp0[t] = (unsigned)p.eidx[row_ * 128 + lane]; kp1[t] = (unsigned)p.eidx[row_ * 128 + 64 + lane];          \
    }
    int e0[PE_T], e1[PE_T];
    float sgu0[PE_T], sgu1[PE_T], sgv0[PE_T], sgv1[PE_T];
    u32x4 rA[8], rB[8];
#define PE_SORT(SW)                                                                                                \
    _Pragma("unroll") for (int t = 0; t < PE_T; ++t) {                                                           \
        const int ti_ = (SW) * PE_T + t;                                                                           \
        const long row_ = first + (ti_ < ntok ? ti_ : 0) * rstride;                                                \
          \
        unsigned k0 = (kp0[t] << 7) | (unsigned)lane;                                                              \
        unsigned k1 = (kp1[t] << 7) | (unsigned)(64 + lane);                                                       \
        _Pragma("unroll") for (int size = 2; size <= 128; size <<= 1) {                                          \
            _Pragma("unroll") for (int stride = size >> 1; stride > 0; stride >>= 1) {                           \
                if (stride == 64) {                                                                                \
                    const unsigned lo = min(k0, k1), hi = max(k0, k1);                                             \
                    k0 = lo; k1 = hi;                                                                              \
                } else {                                                                                           \
                    unsigned o0, o1;                                                                               \
                    if (stride == 1) { o0 = (unsigned)PE_X1(k0); o1 = (unsigned)PE_X1(k1); }                       \
                    else if (stride == 2) { o0 = (unsigned)PE_X2(k0); o1 = (unsigned)PE_X2(k1); }                  \
                    else if (stride == 4) { o0 = (unsigned)PE_X4(k0); o1 = (unsigned)PE_X4(k1); }                  \
                    else if (stride == 8) { o0 = (unsigned)PE_X8(k0); o1 = (unsigned)PE_X8(k1); }                  \
                    else if (stride == 16) { o0 = (unsigned)xshfl_i<16>((int)k0); o1 = (unsigned)xshfl_i<16>((int)k1); }   \
                    else { o0 = (unsigned)xshfl_i<32>((int)k0); o1 = (unsigned)xshfl_i<32>((int)k1); }             \
                    const bool lower = (lane & stride) == 0;                                                       \
                    const bool asc0 = size == 128 ? true : ((lane & size) == 0);                                   \
                    const bool asc1 = size == 128 ? true : (((lane + 64) & size) == 0);                            \
                    k0 = (lower == asc0) ? min(k0, o0) : max(k0, o0);                                              \
                    k1 = (lower == asc1) ? min(k1, o1) : max(k1, o1);                                              \
                }                                                                                                  \
            }                                                                                                      \
        }                                                                                                          \
        e0[t] = (int)(k0 >> 7); e1[t] = (int)(k1 >> 7);                                                            \
        const int sl0 = (int)(k0 & 127u), sl1 = (int)(k1 & 127u);                                                  \
          \
        sgu0[t] = su_[e0[t]]; sgu1[t] = su_[e1[t]];                                                                \
        sgv0[t] = p.pgate[row_ * 128 + sl0] * sv_[e0[t]]; sgv1[t] = p.pgate[row_ * 128 + sl1] * sv_[e1[t]];        \
    }
    PE_PREFETCH(0)
    PE_SORT(0)
    PE_LOADU(rA, 0, 0)
    for (int sw = 0; sw < nsweep; ++sw) {
        __syncthreads();
        int rows[PE_T]; bool valid[PE_T];
        int qx[PE_T][4];
        float wlo[PE_T], whi[PE_T], swq[PE_T], sxv[PE_T];
        int hlo[PE_T], hhi[PE_T];
        int acc[PE_T][16];
        unsigned pklo[PE_T], pkhi[PE_T];
#pragma unroll
        for (int t = 0; t < PE_T; ++t) {
            const int ti = sw * PE_T + t;
            valid[t] = ti < ntok;
            const int row = first + (valid[t] ? ti : 0) * rstride;
            rows[t] = row;
            float x[16];
            {
                const u32x4 a = hpa[t], b = hpb[t];
#pragma unroll
                for (int i = 0; i < 4; ++i) { x[2 * i] = bflo(a[i]); x[2 * i + 1] = bfhi(a[i]); x[8 + 2 * i] = bflo(b[i]); x[8 + 2 * i + 1] = bfhi(b[i]); }
            }
            float mx = 0.f;
#pragma unroll
            for (int i = 0; i < 16; ++i) mx = fmaxf(mx, fabsf(x[i]));
            mx = wave_max(mx);
            const float sx = mx > 0.f ? mx * (1.f / 127.f) : 1.f;
            const float isx = 1.f / sx;
#pragma unroll
            for (int i = 0; i < 4; ++i) {
                unsigned pk = 0;
#pragma unroll
                for (int q = 0; q < 4; ++q) pk |= (unsigned)((int)rintf(x[i * 4 + q] * isx) & 0xFF) << (q * 8);
                qx[t][i] = (int)pk;
            }
            sxv[t] = sx;
            hlo[t] = 0; hhi[t] = 0;
#pragma unroll
            for (int i = 0; i < 16; ++i) acc[t][i] = 0;
        }
        for (int bb = 0; bb < 16; ++bb) {
            if ((bb & 3) == 0) __builtin_amdgcn_s_barrier();
            PE_LOADU(rB, bb, 1)
            PE_DOT(rA, bb, 0)
            if (bb + 1 < 16) { PE_LOADU(rA, bb + 1, 0) } else { PE_LOADV(rA, 0, 0) }
            PE_DOT(rB, bb, 1)
        }
#pragma unroll
        for (int t = 0; t < PE_T; ++t) {
            wlo[t] = sgv0[t] * gelu_tanh(sgu0[t] * sxv[t] * (float)hlo[t]); whi[t] = sgv1[t] * gelu_tanh(sgu1[t] * sxv[t] * (float)hhi[t]);
            float am = fmaxf(fabsf(wlo[t]), fabsf(whi[t]));
            am = wave_max(am);
            swq[t] = am > 0.f ? am * (1.f / 127.f) : 1.f;
            const float iw = 1.f / swq[t];
            const unsigned q0 = (unsigned)((int)rintf(wlo[t] * iw) & 0xFF), q1 = (unsigned)((int)rintf(whi[t] * iw) & 0xFF);
            const unsigned a0 = q0 | ((unsigned)xshfl_i<1>((int)q0) << 8);
            const unsigned a1 = q1 | ((unsigned)xshfl_i<1>((int)q1) << 8);
            pklo[t] = a0 | ((unsigned)xshfl_i<2>((int)a0) << 16);
            pkhi[t] = a1 | ((unsigned)xshfl_i<2>((int)a1) << 16);
        }
        if (sw + 1 < nsweep) { PE_PREFETCH(sw + 1) }
        f32x4 xvp[PE_T][4];
#pragma unroll
        for (int t = 0; t < PE_T; ++t)
#pragma unroll
            for (int q = 0; q < 4; ++q) xvp[t][q] = *(const f32x4*)(p.out + (long)rows[t] * DM + lane * 16 + q * 4);
        for (int bb = 0; bb < 16; ++bb) {
            if ((bb & 3) == 0) __builtin_amdgcn_s_barrier();
            PE_LOADV(rB, bb, 1)
            PE_AXPY(rA, bb, 0)
            if (bb + 1 < 16) { PE_LOADV(rA, bb + 1, 0) }
            PE_AXPY(rB, bb, 1)
        }
        if (sw + 1 < nsweep) { PE_SORT(sw + 1) PE_LOADU(rA, 0, 0) }
#pragma unroll
        for (int t = 0; t < PE_T; ++t) {
            if (!valid[t]) continue;
            const int row = rows[t];
            float y[16];
#pragma unroll
            for (int i = 0; i < 16; ++i) y[i] = swq[t] * (float)acc[t][i];
            const float* gv = mods_l + (long)tok_modrow(row) * 6144 + 5 * 1024;
            float* xr = p.out + (long)row * DM + lane * 16;
            float4 xv[4], gg[4];
#pragma unroll
            for (int q = 0; q < 4; ++q) { xv[q] = make_float4(xvp[t][q][0], xvp[t][q][1], xvp[t][q][2], xvp[t][q][3]); gg[q] = *(const float4*)(gv + lane * 16 + q * 4); }
            float4 nw[4], nsc[4], nsh[4];
            if (NEXT) {
                const float* mr = mods_next + (long)tok_modrow(row) * 6144;
#pragma unroll
                for (int q = 0; q < 4; ++q) { nw[q] = *(const float4*)(w_next + lane * 16 + q * 4); nsc[q] = *(const float4*)(mr + 1024 + lane * 16 + q * 4); nsh[q] = *(const float4*)(mr + lane * 16 + q * 4); }
            }
            float ss = 0.f;
#pragma unroll
            for (int q = 0; q < 4; ++q) {
                xv[q].x += gscale * gg[q].x * y[q * 4 + 0]; xv[q].y += gscale * gg[q].y * y[q * 4 + 1];
                xv[q].z += gscale * gg[q].z * y[q * 4 + 2]; xv[q].w += gscale * gg[q].w * y[q * 4 + 3];
                *(float4*)(xr + q * 4) = xv[q];
                ss += xv[q].x * xv[q].x + xv[q].y * xv[q].y + xv[q].z * xv[q].z + xv[q].w * xv[q].w;
            }
            if (NEXT) {
                ss = wave_sum(ss);
                const float r = rsqrtf(ss * (1.f / 1024.f) + 1e-6f);
#pragma unroll
                for (int q = 0; q < 4; ++q) {
                    const float h0 = xv[q].x * r * nw[q].x * (1.f + nsc[q].x) + nsh[q].x, h1 = xv[q].y * r * nw[q].y * (1.f + nsc[q].y) + nsh[q].y;
                    const float h2 = xv[q].z * r * nw[q].z * (1.f + nsc[q].z) + nsh[q].z, h3 = xv[q].w * r * nw[q].w * (1.f + nsc[q].w) + nsh[q].w;
                    *(uint2*)(p.H + (long)row * DM + lane * 16 + q * 4) = make_uint2(pack2(h0, h1), pack2(h2, h3));
                }
            }
        }
    }
}
#define SMEM_MAX 147456

#define BARRIER() do { XcdBarrier b_; b_.bar = p.bar; b_.x = xb_xcc_id(); b_.st = (volatile LAS unsigned*)(smem + SMEM_MAX); xcd_barrier(b_); } while (0)
__device__ __forceinline__ CP& kparams() {
    CP* kp = (CP*)__builtin_amdgcn_kernarg_segment_ptr();
    asm volatile("" : "+s"(kp));
    return *kp;
}
__global__ void __launch_bounds__(NTHREADS, 2) k_mega(Params p_unused) {
    extern __shared__ __attribute__((aligned(16))) char smem[];
#define p kparams()
    if (threadIdx.x == 0) *(uint4*)(smem + SMEM_MAX) = make_uint4(0u, 0u, 0u, 0u);
    __syncthreads();
    (void)xcd_barrier_post(p.bar, (volatile LAS unsigned*)(smem + SMEM_MAX));
    ph_init(p, smem);
    BARRIER();
#pragma unroll
    for (int l = 0; l < 4; ++l) {
        const int j = l >> 1;
#define mods_l (kparams().mods + (long)l * 9 * 6144)
        if (l == 0) {
            ph_norm<1>(p, p.norm_mix, mods_l, 0, 1024);
            BARRIER();
        }
        if ((l & 1) == 0) {
            ph_e_gemm(p, j, smem);
            BARRIER();
            ph_e_prep(p, j, smem);
            ph_fft_a(p, smem);
            BARRIER();
            ph_e_scan(p, j, smem);
            ph_fft_b(p, smem);
            ph_tab(p, l, 64);
            ph_tab(p, l + 1, 64);
            if (l == 0) ph_init2(p, smem, 64);
            BARRIER();
            ph_e_mix(p, j);
            BARRIER();
            if (l == 0) ph_out_gemm<1>(p, p.mix, p.wtE_out + (long)j * 1024 * 1024, mods_l, 2 * 1024, smem);
            else ph_out_gemm<0>(p, p.mix, p.wtE_out + (long)j * 1024 * 1024, mods_l, 2 * 1024, smem);
            BARRIER();
        } else {
            ph_o_gemm1(p, j, smem);
            BARRIER();
            ph_o_norm(p, j);
            BARRIER();
            ph_o_gemm2(p, j, smem);
            BARRIER();
            ph_o_qknorm(p, j);
            BARRIER();
            ph_o_attn(p, smem);
            BARRIER();
            ph_out_gemm(p, p.Ob, p.wtO_out + (long)j * 1024 * 1024, mods_l, 2 * 1024, smem);
            BARRIER();
        }
        ph_norm(p, p.norm_ffn + l * 1024, mods_l, 3 * 1024, 4 * 1024);
        BARRIER();
        ph_p_route(p, l, smem);
        BARRIER();
        if (l < 3) ph_p_eval<1>(p, mods_l, l, p.norm_mix + (l + 1) * 1024, p.mods + (long)(l + 1) * 9 * 6144);
        else ph_p_eval<0>(p, mods_l, l, p.norm_mix, p.mods);
        if (l < 3) BARRIER();
    }
#undef p
#undef mods_l
}

static inline size_t al256(size_t x) { return (x + 255) & ~(size_t)255; }

extern "C" void kernel_launch(void* const* d_in, const int* in_sizes, int n_in, void* d_out, int out_size, void* d_ws, size_t ws_size, hipStream_t stream) {
    Params p{};
    const float* const* in = (const float* const*)d_in;
    p.x_prompt = in[0]; p.x_sample = in[1]; p.state_gdn = in[2]; p.cache_ckv = in[3]; p.cache_kr = in[4]; p.c = in[5]; p.c_ctx = in[6];
    p.w_mod = in[7]; p.b_mod = in[8]; p.norm_mix = in[9]; p.norm_ffn = in[10];
    p.even_w_in = in[11]; p.even_conv_w = in[12]; p.gdn_a_log = in[13]; p.gdn_dt_bias = in[14]; p.gdn_o_norm = in[15]; p.even_w_out = in[16];
    p.odd_w_in = in[17]; p.mla_q_norm = in[18]; p.mla_kv_norm = in[19]; p.mla_w_uq = in[20]; p.mla_w_ukv = in[21]; p.mla_q_headnorm = in[22]; p.mla_k_headnorm = in[23]; p.odd_w_out = in[24];
    p.peer_w_q = in[25]; p.peer_sub_keys = in[26]; p.peer_u = in[27]; p.peer_v = in[28];
    p.out = (float*)d_out;
    char* ws = (char*)d_ws;
    size_t off = 0;
    auto take = [&](size_t bytes) { char* r = ws + off; off = al256(off + bytes); return r; };
    p.bar = (unsigned*)take(16384);
    p.mods = (float*)take(4L * 9 * 6144 * 4);
    p.wtE_in = (bf16_t*)take(2L * N_EIN * 1024 * 2);
    p.wtE_out = (bf16_t*)take(2L * 1024 * 1024 * 2);
    p.wtO_in = (bf16_t*)take(2L * N_OIN * 1024 * 2);
    p.wtUq = (bf16_t*)take(2L * 1536 * 512 * 2);
    p.wtUkv = (bf16_t*)take(2L * 2048 * 256 * 2);
    p.wtO_out = (bf16_t*)take(2L * 1024 * 1024 * 2);
    p.wtPq = (bf16_t*)take(4L * 2048 * 1024 * 2);
    p.subk = (bf16_t*)take(4L * 16 * 128 * 128 * 2);
    p.fftMA = (bf16_t*)take(128L * 128 * 2);
    p.fftMB = (bf16_t*)take(128L * 128 * 2);
    p.fftTW = (float*)take(4096L * 2 * 4);
    p.dftP = (bf16_t*)take(256L * 512 * 2);
    p.tabU = (unsigned char*)take(2L * 16384 * 2048);
    p.tabV = p.tabU;
    p.su = (float*)take(2L * 32768 * 4);
    p.sv = p.su;
    p.H = (bf16_t*)take((long)T_TOK * 1024 * 2);
    const size_t ubase = off;
    p.qkvraw = (bf16_t*)take((long)T_TOK * 1536 * 2);
    p.mix = p.qkvraw;
    p.gate = (bf16_t*)take((long)T_TOK * 512 * 2);
    p.ba = (float*)take((long)T_TOK * 16 * 4);
    p.ZtA = (bf16_t*)take((long)T_TOK * 1024 * 2);
    p.qn = (bf16_t*)take((long)T_TOK * 512 * 2);
    p.kn = (bf16_t*)take((long)T_TOK * 512 * 2);
    p.Wb = (bf16_t*)take(4608L * 8192 * 2);
    p.Ub = (bf16_t*)take(4608L * 8192 * 2);
    p.QKb = (bf16_t*)take(4608L * 4096 * 2);
    p.gcb = (float*)take(4608L * 192 * 4);
    p.of = (bf16_t*)take((long)T_TOK * 512 * 2);
    p.ob = (bf16_t*)take((long)T_TOK * 512 * 2);
    p.HB = (bf16_t*)take(8L * 64 * 512 * 2 * 64 * 2);
    const size_t even_end = off;
    off = ubase;
    p.Podd = (float*)take((long)T_TOK * 832 * 4);
    p.Ob = (bf16_t*)p.Podd;
    p.cq = (bf16_t*)take((long)T_TOK * 512 * 2);
    p.ckv_all = (bf16_t*)take((long)(T_TOK + 2048) * 256 * 2);
    p.kr_all = (float*)take((long)(T_TOK + 2048) * 64 * 4);
    p.Qb = (bf16_t*)take((long)T_TOK * 1536 * 2);
    p.Kb = (bf16_t*)take((KB_S + 8L * 8 * 4352 * 192) * 2);
    p.Vtb = (bf16_t*)take((VT_S + 8L * 8 * 128 * 4352) * 2);
    const size_t odd_end = off;
    off = ubase;
    p.eidx = (int*)take((long)T_TOK * 128 * 4);
    p.pgate = (float*)take((long)T_TOK * 128 * 4);
    const size_t peer_end = off;
    size_t need = even_end > odd_end ? even_end : odd_end;
    if (peer_end > need) need = peer_end;
    if (need > ws_size) return;

    static int grid = 0;
    if (!grid) {
        int dev = 0, cus = 0, per_cu = 0;
        hipGetDevice(&dev);
        hipDeviceGetAttribute(&cus, hipDeviceAttributeMultiprocessorCount, dev);
        if (hipFuncSetAttribute((const void*)k_mega, hipFuncAttributeMaxDynamicSharedMemorySize, SMEM_MAX + 16) != hipSuccess) return;
        if (hipOccupancyMaxActiveBlocksPerMultiprocessor(&per_cu, (const void*)k_mega, NTHREADS, SMEM_MAX + 16) != hipSuccess || per_cu < 1) return;
        grid = cus;
    }
    hipMemsetAsync(p.bar, 0, XCD_BAR_WORDS * sizeof(unsigned), stream);
    hipLaunchKernelGGL(k_mega, dim3(grid), dim3(NTHREADS), SMEM_MAX + 16, stream, p);
}
```

```cpp
#include <hip/hip_runtime.h>
#include <stdint.h>

typedef unsigned short bf16_t;
typedef short bf16x8 __attribute__((ext_vector_type(8)));
typedef float f32x4 __attribute__((ext_vector_type(4)));
typedef unsigned u32x4 __attribute__((ext_vector_type(4)));
typedef int i32x4 __attribute__((ext_vector_type(4)));

#define T_TOK   36864
#define TP_TOK  4096
#define DM      1024
#define NTHREADS 512
#define N_EIN   3328
#define N_OIN   1024
#define OUT_STATE 37748736L
#define OUT_CKV   41943040L
#define OUT_KR    44040192L

struct Params {
    const float *x_prompt, *x_sample, *state_gdn, *cache_ckv, *cache_kr, *c, *c_ctx, *w_mod, *b_mod, *norm_mix, *norm_ffn;
    const float *even_w_in, *even_conv_w, *gdn_a_log, *gdn_dt_bias, *gdn_o_norm, *even_w_out;
    const float *odd_w_in, *mla_q_norm, *mla_kv_norm, *mla_w_uq, *mla_w_ukv, *mla_q_headnorm, *mla_k_headnorm, *odd_w_out;
    const float *peer_w_q, *peer_sub_keys, *peer_u, *peer_v;
    float* out;
    unsigned* bar;
    float* mods;
    bf16_t *wtE_in, *wtE_out, *wtO_in, *wtUq, *wtUkv, *wtO_out, *wtPq, *subk, *dftP, *fftMA, *fftMB, *HB;
    float* fftTW;
    unsigned char *tabU, *tabV;
    float *su, *sv;
    bf16_t* H;
    bf16_t *qkvraw, *gate, *ZtA, *qn, *kn, *Wb, *Ub, *QKb, *of, *ob, *mix;
    float *ba, *gcb;
    float *Podd, *kr_all;
    bf16_t *cq, *ckv_all, *Qb, *Kb, *Vtb, *Ob;
    float* pgate;
    int* eidx;
};

typedef const Params __attribute__((address_space(4))) CP;

__device__ __forceinline__ int ltid() { int t = threadIdx.x; asm volatile("" : "+v"(t)); return t; }
__device__ __forceinline__ int lbid() { int b = blockIdx.x; asm volatile("" : "+s"(b)); return b; }
typedef __bf16 bf16v2 __attribute__((ext_vector_type(2)));
typedef float f32x2 __attribute__((ext_vector_type(2)));
__device__ __forceinline__ bf16_t f2bf(float f) { return __builtin_bit_cast(unsigned short, (__bf16)f); }
__device__ __forceinline__ float bf2f(bf16_t h) { return __uint_as_float(((unsigned)h) << 16); }
__device__ __forceinline__ unsigned pack2(float lo, float hi) { const f32x2 v = {lo, hi}; return __builtin_bit_cast(unsigned, __builtin_convertvector(v, bf16v2)); }
__device__ __forceinline__ float bflo(unsigned u) { return __uint_as_float(u << 16); }
__device__ __forceinline__ float bfhi(unsigned u) { return __uint_as_float(u & 0xFFFF0000u); }
__device__ __forceinline__ float silu_f(float x) { return x / (1.f + __expf(-x)); }
__device__ __forceinline__ float sigmoid_f(float x) { return 1.f / (1.f + __expf(-x)); }
__device__ __forceinline__ float softplus_f(float x) { return fmaxf(x, 0.f) + __logf(1.f + __expf(-fabsf(x))); }
__device__ __forceinline__ float gelu_tanh(float x) {
    const float u = 0.7978845608028654f * (x + 0.044715f * x * x * x);
    return 0.5f * x * (1.f + tanhf(u));
}
template <int M>
__device__ __forceinline__ int xshfl_i(int v) {
    if constexpr (M == 1) return __builtin_amdgcn_mov_dpp(v, 0xB1, 0xF, 0xF, true);
    else if constexpr (M == 2) return __builtin_amdgcn_mov_dpp(v, 0x4E, 0xF, 0xF, true);
    else if constexpr (M == 4) return __builtin_amdgcn_update_dpp(__builtin_amdgcn_update_dpp(0, v, 0x104, 0xF, 0x5, false), v, 0x114, 0xF, 0xA, false);
    else if constexpr (M == 8) return __builtin_amdgcn_mov_dpp(v, 0x128, 0xF, 0xF, true);
    else if constexpr (M == 16) { const auto r = __builtin_amdgcn_permlane16_swap((unsigned)v, (unsigned)v, false, false); return (int)(r[0] ^ r[1] ^ (unsigned)v); }
    else { const auto r = __builtin_amdgcn_permlane32_swap((unsigned)v, (unsigned)v, false, false); return (int)(r[0] ^ r[1] ^ (unsigned)v); }
}
template <int M>
__device__ __forceinline__ float xshfl(float v) { return __int_as_float(xshfl_i<M>(__float_as_int(v))); }
template <int CTRL> __device__ __forceinline__ float dppf(float v) { return __int_as_float(__builtin_amdgcn_mov_dpp(__float_as_int(v), CTRL, 0xF, 0xF, true)); }
__device__ __forceinline__ float wave_sum(float v) {
    v += dppf<0xB1>(v); v += dppf<0x4E>(v); v += dppf<0x141>(v); v += dppf<0x140>(v);
    { const auto r = __builtin_amdgcn_permlane16_swap(__float_as_uint(v), __float_as_uint(v), false, false); v = __uint_as_float(r[0]) + __uint_as_float(r[1]); }
    { const auto r = __builtin_amdgcn_permlane32_swap(__float_as_uint(v), __float_as_uint(v), false, false); v = __uint_as_float(r[0]) + __uint_as_float(r[1]); }
    return v;
}
__device__ __forceinline__ float wave_max(float v) {
    v = fmaxf(v, dppf<0xB1>(v)); v = fmaxf(v, dppf<0x4E>(v)); v = fmaxf(v, dppf<0x141>(v)); v = fmaxf(v, dppf<0x140>(v));
    { const auto r = __builtin_amdgcn_permlane16_swap(__float_as_uint(v), __float_as_uint(v), false, false); v = fmaxf(__uint_as_float(r[0]), __uint_as_float(r[1])); }
    { const auto r = __builtin_amdgcn_permlane32_swap(__float_as_uint(v), __float_as_uint(v), false, false); v = fmaxf(__uint_as_float(r[0]), __uint_as_float(r[1])); }
    return v;
}
__device__ __forceinline__ int tok_modrow(int t) { return t < TP_TOK ? 0 : 1 + ((t - TP_TOK) >> 12); }
__device__ __forceinline__ int tok_seq0(int t) { return t < TP_TOK ? (t & ~255) : (TP_TOK + ((t - TP_TOK) & ~4095)); }
__device__ __forceinline__ int tok_len(int t) { return t < TP_TOK ? 256 : 4096; }

template <int MT, int NT>
__device__ __forceinline__ void wave_mma(f32x4 (&acc)[MT][NT], const bf16_t* A, int lda, const bf16_t* B, int ldb, int K) {
    const int lane = ltid() & 63, r = lane & 15, kg = (lane >> 4) * 8;
#pragma unroll 1
    for (int k0 = 0; k0 < K; k0 += 32) {
        bf16x8 a[MT], b[NT];
#pragma unroll
        for (int m = 0; m < MT; ++m) a[m] = *(const bf16x8*)(A + (m * 16 + r) * lda + k0 + kg);
#pragma unroll
        for (int n = 0; n < NT; ++n) b[n] = *(const bf16x8*)(B + (n * 16 + r) * ldb + k0 + kg);
#pragma unroll
        for (int m = 0; m < MT; ++m)
#pragma unroll
            for (int n = 0; n < NT; ++n) acc[m][n] = __builtin_amdgcn_mfma_f32_16x16x32_bf16(a[m], b[n], acc[m][n], 0, 0, 0);
    }
}
template <int MT, int NT, int KSTEPS>
__device__ __forceinline__ void wave_mma_u(f32x4 (&acc)[MT][NT], const bf16_t* A, int lda, const bf16_t* B, int ldb) {
    const int lane = ltid() & 63, r = lane & 15, kg = (lane >> 4) * 8;
    bf16x8 a[KSTEPS][MT], b[KSTEPS][NT];
#pragma unroll
    for (int ks = 0; ks < KSTEPS; ++ks) {
#pragma unroll
        for (int m = 0; m < MT; ++m) a[ks][m] = *(const bf16x8*)(A + (m * 16 + r) * lda + ks * 32 + kg);
#pragma unroll
        for (int n = 0; n < NT; ++n) b[ks][n] = *(const bf16x8*)(B + (n * 16 + r) * ldb + ks * 32 + kg);
    }
#pragma unroll
    for (int ks = 0; ks < KSTEPS; ++ks)
#pragma unroll
        for (int m = 0; m < MT; ++m)
#pragma unroll
            for (int n = 0; n < NT; ++n) acc[m][n] = __builtin_amdgcn_mfma_f32_16x16x32_bf16(a[ks][m], b[ks][n], acc[m][n], 0, 0, 0);
}

#define GLD 72
#define GEMM_SMEM_BYTES (2 * (256 + 128) * GLD * 2)
template <int PERM = 0, class Epi>
__device__ __forceinline__ void gemm_tile(const bf16_t* __restrict__ A, long lda, const bf16_t* __restrict__ B, long ldb, int K, bf16_t* smem, Epi epi) {
    const int tid = ltid(), lane = tid & 63, wave = tid >> 6;
    const int wm = wave >> 1, wn = wave & 1;
    bf16_t* As = smem;
    bf16_t* Bs = smem + 2 * 256 * GLD;
    f32x4 acc[4][4];
#pragma unroll
    for (int m = 0; m < 4; ++m)
#pragma unroll
        for (int n = 0; n < 4; ++n) acc[m][n] = (f32x4){0.f, 0.f, 0.f, 0.f};
    uint4 ra[4], rb[2];
    const int lrow = tid >> 3, lkc = (tid & 7) * 8;
    const bf16_t* ap = A + (long)lrow * (PERM ? 64 : 1) * lda + lkc;
    const bf16_t* bp = B + (long)lrow * ldb + lkc;
    const long astep = (PERM ? 1 : 64) * lda;
#pragma unroll
    for (int i = 0; i < 4; ++i) ra[i] = *(const uint4*)(ap + (long)i * astep);
#pragma unroll
    for (int i = 0; i < 2; ++i) rb[i] = *(const uint4*)(bp + (long)i * 64 * ldb);
    __builtin_amdgcn_sched_barrier(0);
#pragma unroll
    for (int i = 0; i < 4; ++i) *(uint4*)(As + (i * 64 + lrow) * GLD + lkc) = ra[i];
#pragma unroll
    for (int i = 0; i < 2; ++i) *(uint4*)(Bs + (i * 64 + lrow) * GLD + lkc) = rb[i];
    __syncthreads();
    const int nk = K >> 6;
    for (int kt = 0; kt < nk; ++kt) {
        const int cur = kt & 1;
        if (kt + 1 < nk) {
            const long k0 = (long)(kt + 1) * 64;
#pragma unroll
            for (int i = 0; i < 4; ++i) ra[i] = *(const uint4*)(ap + (long)i * astep + k0);
#pragma unroll
            for (int i = 0; i < 2; ++i) rb[i] = *(const uint4*)(bp + (long)i * 64 * ldb + k0);
            __builtin_amdgcn_sched_barrier(0);
        }
        const bf16_t* Ac = As + cur * 256 * GLD + (wm * 64) * GLD;
        const bf16_t* Bc = Bs + cur * 128 * GLD + (wn * 64) * GLD;
        wave_mma<4, 4>(acc, Ac, GLD, Bc, GLD, 32);
        wave_mma<4, 4>(acc, Ac + 32, GLD, Bc + 32, GLD, 32);
        if (kt + 1 < nk) {
            bf16_t* An = As + (cur ^ 1) * 256 * GLD;
            bf16_t* Bn = Bs + (cur ^ 1) * 128 * GLD;
#pragma unroll
            for (int i = 0; i < 4; ++i) *(uint4*)(An + (i * 64 + lrow) * GLD + lkc) = ra[i];
#pragma unroll
            for (int i = 0; i < 2; ++i) *(uint4*)(Bn + (i * 64 + lrow) * GLD + lkc) = rb[i];
        }
        __syncthreads();
    }
#pragma unroll
    for (int m = 0; m < 4; ++m)
#pragma unroll
        for (int n = 0; n < 4; ++n) epi(wm * 64 + m * 16 + (lane >> 4) * 4, wn * 64 + n * 16 + (lane & 15), acc[m][n]);
}
namespace g8 {
constexpr int BK = 64, HALF = 128, HT = HALF * BK;
__device__ __forceinline__ int lds_byte(int r, int c) {
    const int st = (r >> 4) * 2 + (c >> 5), rr = r & 15, cc = c & 31, ob = rr * 64 + cc * 2;
    return st * 1024 + (ob ^ (((ob >> 9) & 1) << 5));
}
__device__ __forceinline__ void stage_rc(int b, int& R, int& C) {
    const int st = b / 1024, sb = b % 1024, swz = sb ^ (((sb >> 9) & 1) << 5);
    R = (st >> 1) * 16 + swz / 64; C = (st & 1) * 32 + (swz % 64) / 2;
}
}

template <int PERM = 0, int PRE = 0>
__device__ __forceinline__ void gemm_tile256_acc(const bf16_t* __restrict__ A, long lda, const bf16_t* __restrict__ Bt, long ldb, int K, bf16_t* shm, f32x4 (&acc)[2][2][4][2]) {
    using namespace g8;
#define G8_SA(b, h) (shm + ((b) * 2 + (h)) * HT)
#define G8_SB(b, h) (shm + (4 + (b) * 2 + (h)) * HT)
#define G8_STAGE_A(T, P, h, kt) do { for (int _i = 0; _i < 2; ++_i) { const int _b = (T) * 16 + _i * 8192; int _r, _c; stage_rc(_b, _r, _c); \
        const int _R = (h) * HALF + _r; const long _ar = PERM ? (long)((_R & 63) * 64 + (_R >> 6)) : (long)_R; \
        __builtin_amdgcn_global_load_lds((const unsigned*)(A + _ar * lda + (long)(kt) * BK + _c), (__attribute__((address_space(3))) unsigned*)((char*)(P) + _b), 16, 0, 0); } } while (0)
#define G8_STAGE_B(T, P, h, kt) do { for (int _i = 0; _i < 2; ++_i) { const int _b = (T) * 16 + _i * 8192; int _r, _c; stage_rc(_b, _r, _c); \
        __builtin_amdgcn_global_load_lds((const unsigned*)(Bt + (long)((h) * HALF + _r) * ldb + (long)(kt) * BK + _c), (__attribute__((address_space(3))) unsigned*)((char*)(P) + _b), 16, 0, 0); } } while (0)
#define G8_LDA(dst, b, h) _Pragma("unroll") for (int m = 0; m < 4; ++m) _Pragma("unroll") for (int k = 0; k < 2; ++k) \
        dst[m][k] = *reinterpret_cast<const bf16x8*>((char*)G8_SA(b, h) + lds_byte(wr * 64 + m * 16 + fr, k * 32 + fq * 8))
#define G8_LDB(dst, b, h) _Pragma("unroll") for (int n = 0; n < 2; ++n) _Pragma("unroll") for (int k = 0; k < 2; ++k) \
        dst[n][k] = *reinterpret_cast<const bf16x8*>((char*)G8_SB(b, h) + lds_byte(wc * 32 + n * 16 + fr, k * 32 + fq * 8))
#define G8_MMA(ai, bj, At_, Bt_) do { __builtin_amdgcn_s_setprio(1); \
        _Pragma("unroll") for (int m = 0; m < 4; ++m) _Pragma("unroll") for (int n = 0; n < 2; ++n) _Pragma("unroll") for (int k = 0; k < 2; ++k) \
            acc[ai][bj][m][n] = __builtin_amdgcn_mfma_f32_16x16x32_bf16(At_[m][k], Bt_[n][k], acc[ai][bj][m][n], 0, 0, 0); \
        __builtin_amdgcn_s_setprio(0); } while (0)
#define G8_WAIT_V(n) asm volatile("s_waitcnt vmcnt(" #n ")" ::: "memory")
#define G8_WAIT_L(n) asm volatile("s_waitcnt lgkmcnt(" #n ")" ::: "memory")
#define G8_BAR __builtin_amdgcn_s_barrier()
#define G8_SCHED __builtin_amdgcn_sched_barrier(0)
    int tz = ltid();
    int wid = tz >> 6, lane = tz & 63, wr = wid >> 2, wc = wid & 3, fr = lane & 15, fq = lane >> 4;
#pragma unroll
    for (int a = 0; a < 2; ++a)
#pragma unroll
        for (int b = 0; b < 2; ++b)
#pragma unroll
            for (int m = 0; m < 4; ++m)
#pragma unroll
                for (int n = 0; n < 2; ++n) acc[a][b][m][n] = (f32x4){0.f, 0.f, 0.f, 0.f};
    bf16x8 At[4][2], B0[2][2], B1[2][2];
    const int nt = K / BK;
    if (PRE) {
        if (wr == 1) G8_BAR;
        G8_WAIT_V(0); G8_BAR;
        G8_BAR;
    } else {
        G8_STAGE_B(tz, G8_SB(0, 0), 0, 0); G8_STAGE_A(tz, G8_SA(0, 0), 0, 0);
        G8_STAGE_B(tz, G8_SB(0, 1), 1, 0); G8_STAGE_A(tz, G8_SA(0, 1), 1, 0);
        if (wr == 1) G8_BAR;
        G8_WAIT_V(4); G8_BAR;
        G8_STAGE_B(tz, G8_SB(1, 0), 0, 1); G8_STAGE_A(tz, G8_SA(1, 0), 0, 1); G8_STAGE_B(tz, G8_SB(1, 1), 1, 1);
        G8_WAIT_V(6); G8_BAR;
    }
    for (int t = 0; t < nt - 2; t += 2) {
        G8_LDB(B0, 0, 0); G8_SCHED; G8_LDA(At, 0, 0); G8_STAGE_A(tz, G8_SA(1, 1), 1, t + 1);
        G8_WAIT_L(8); G8_BAR; G8_WAIT_L(0); G8_MMA(0, 0, At, B0); G8_BAR; G8_SCHED;
        G8_LDB(B1, 0, 1); G8_STAGE_B(tz, G8_SB(0, 0), 0, t + 2);
        G8_BAR; G8_WAIT_L(0); G8_MMA(0, 1, At, B1); G8_BAR;
        G8_LDA(At, 0, 1); G8_STAGE_A(tz, G8_SA(0, 0), 0, t + 2);
        G8_BAR; G8_WAIT_L(0); G8_MMA(1, 0, At, B0); G8_BAR; G8_SCHED;
        G8_STAGE_B(tz, G8_SB(0, 1), 1, t + 2);
        G8_WAIT_V(6); G8_BAR; G8_MMA(1, 1, At, B1); G8_BAR;
        G8_LDB(B0, 1, 0); G8_SCHED; G8_LDA(At, 1, 0); G8_STAGE_A(tz, G8_SA(0, 1), 1, t + 2);
        G8_WAIT_L(8); G8_BAR; G8_WAIT_L(0); G8_MMA(0, 0, At, B0); G8_BAR; G8_SCHED;
        G8_LDB(B1, 1, 1); G8_STAGE_B(tz, G8_SB(1, 0), 0, t + 3);
        G8_BAR; G8_WAIT_L(0); G8_MMA(0, 1, At, B1); G8_BAR;
        G8_LDA(At, 1, 1); G8_STAGE_A(tz, G8_SA(1, 0), 0, t + 3);
        G8_BAR; G8_WAIT_L(0); G8_MMA(1, 0, At, B0); G8_BAR; G8_SCHED;
        G8_STAGE_B(tz, G8_SB(1, 1), 1, t + 3);
        G8_WAIT_V(6); G8_BAR; G8_MMA(1, 1, At, B1); G8_BAR;
    }
    tz = ltid(); wid = tz >> 6; lane = tz & 63; wr = wid >> 2; wc = wid & 3; fr = lane & 15; fq = lane >> 4;
    { G8_LDB(B0, 0, 0); G8_WAIT_V(0); G8_LDA(At, 0, 0); G8_STAGE_A(tz, G8_SA(1, 1), 1, nt - 1);
      G8_BAR; G8_WAIT_L(0); G8_MMA(0, 0, At, B0); G8_BAR;
      G8_LDB(B1, 0, 1); G8_BAR; G8_WAIT_L(0); G8_MMA(0, 1, At, B1); G8_BAR;
      G8_LDA(At, 0, 1); G8_WAIT_V(4); G8_BAR; G8_WAIT_L(0); G8_MMA(1, 0, At, B0); G8_MMA(1, 1, At, B1); G8_BAR; }
    { G8_LDB(B0, 1, 0); G8_LDA(At, 1, 0); G8_WAIT_V(2); G8_BAR; G8_WAIT_L(0); G8_MMA(0, 0, At, B0); G8_BAR;
      G8_LDB(B1, 1, 1); G8_WAIT_V(0); G8_BAR; G8_WAIT_L(0); G8_MMA(0, 1, At, B1); G8_BAR;
      G8_LDA(At, 1, 1); G8_BAR; G8_WAIT_L(0); G8_MMA(1, 0, At, B0); G8_MMA(1, 1, At, B1); G8_BAR; }
    if (wr == 0) G8_BAR;
#undef G8_SA
#undef G8_SB
#undef G8_STAGE_A
#undef G8_STAGE_B
#undef G8_LDA
#undef G8_LDB
#undef G8_MMA
#undef G8_WAIT_V
#undef G8_WAIT_L
#undef G8_BAR
#undef G8_SCHED
}

template <int PERM = 0>
__device__ __forceinline__ void g8_prologue(const bf16_t* __restrict__ A, long lda, const bf16_t* __restrict__ Bt, long ldb, bf16_t* shm) {
    using namespace g8;
    const int tz = ltid();
#define G8P_STAGE_A(P, h, kt) do { for (int _i = 0; _i < 2; ++_i) { const int _b = tz * 16 + _i * 8192; int _r, _c; stage_rc(_b, _r, _c); \
        const int _R = (h) * HALF + _r; const long _ar = PERM ? (long)((_R & 63) * 64 + (_R >> 6)) : (long)_R; \
        __builtin_amdgcn_global_load_lds((const unsigned*)(A + _ar * lda + (long)(kt) * BK + _c), (__attribute__((address_space(3))) unsigned*)((char*)(P) + _b), 16, 0, 0); } } while (0)
#define G8P_STAGE_B(P, h, kt) do { for (int _i = 0; _i < 2; ++_i) { const int _b = tz * 16 + _i * 8192; int _r, _c; stage_rc(_b, _r, _c); \
        __builtin_amdgcn_global_load_lds((const unsigned*)(Bt + (long)((h) * HALF + _r) * ldb + (long)(kt) * BK + _c), (__attribute__((address_space(3))) unsigned*)((char*)(P) + _b), 16, 0, 0); } } while (0)
#define G8P_SA(b, h) (shm + ((b) * 2 + (h)) * HT)
#define G8P_SB(b, h) (shm + (4 + (b) * 2 + (h)) * HT)
    G8P_STAGE_B(G8P_SB(0, 0), 0, 0); G8P_STAGE_A(G8P_SA(0, 0), 0, 0);
    G8P_STAGE_B(G8P_SB(0, 1), 1, 0); G8P_STAGE_A(G8P_SA(0, 1), 1, 0);
    G8P_STAGE_B(G8P_SB(1, 0), 0, 1); G8P_STAGE_A(G8P_SA(1, 0), 0, 1); G8P_STAGE_B(G8P_SB(1, 1), 1, 1);
#undef G8P_STAGE_A
#undef G8P_STAGE_B
#undef G8P_SA
#undef G8P_SB
}

template <int PERM = 0, class Epi>
__device__ __forceinline__ void gemm_tile256(const bf16_t* __restrict__ A, long lda, const bf16_t* __restrict__ Bt, long ldb, int K, bf16_t* shm, Epi epi) {
    f32x4 acc[2][2][4][2];
    gemm_tile256_acc<PERM>(A, lda, Bt, ldb, K, shm, acc);
    const int tz = ltid(), wid = tz >> 6, lane = tz & 63, wr = wid >> 2, wc = wid & 3, fr = lane & 15, fq = lane >> 4;
#pragma unroll
    for (int ai = 0; ai < 2; ++ai)
#pragma unroll
        for (int bj = 0; bj < 2; ++bj)
#pragma unroll
            for (int m = 0; m < 4; ++m)
#pragma unroll
                for (int n = 0; n < 2; ++n) epi(ai * 128 + wr * 64 + m * 16 + fq * 4, bj * 128 + wc * 32 + n * 16 + fr, acc[ai][bj][m][n]);
}

__device__ __forceinline__ void tile_map(int u, int nM, int nN, int& pm, int& pn) {
    const int nwg = nM * nN;
    int wgid = u;
    { const int q = nwg / 8, r = nwg % 8, xcd = wgid % 8, off = wgid / 8; wgid = (xcd < r ? xcd * (q + 1) : r * (q + 1) + (xcd - r) * q) + off; }
    const int nig = 8 * nN, gid = wgid / nig, fm = gid * 8, gsz = (nM - fm) < 8 ? (nM - fm) : 8;
    pm = fm + ((wgid % nig) % gsz); pn = (wgid % nig) / gsz;
}
#define XB_TMO      128
#define XB_XCNT(j)  (256  + 64 * (j))
#define XB_XSUB(j)  (1280 + 64 * (j))
#define XB_XGEN(j)  (2304 + 64 * (j))
#define XB_TOP      3328
#define XB_TOPGEN   3392
#define XCD_BAR_WORDS 3456
#define XB_SPIN_CAP (1u << 18)
#define LAS __attribute__((address_space(3)))

__device__ __forceinline__ unsigned xb_ld(unsigned* p)              { return __hip_atomic_load(p, __ATOMIC_RELAXED, __HIP_MEMORY_SCOPE_AGENT); }
__device__ __forceinline__ unsigned xb_add(unsigned* p, unsigned v) { return __hip_atomic_fetch_add(p, v, __ATOMIC_RELAXED, __HIP_MEMORY_SCOPE_AGENT); }
__device__ __forceinline__ unsigned xb_xcc_id() { return (unsigned)__builtin_amdgcn_s_getreg((3 << 11) | 20) & 0xFu; }
#define XB_SPIN(cond, bar) do { unsigned _sp = 0; while (cond) { __builtin_amdgcn_s_sleep(1); \
    if ((++_sp & 255u) == 0u) { if (xb_ld(&(bar)[XB_TMO])) break; if (_sp > XB_SPIN_CAP) { atomicAdd(&(bar)[XB_TMO], 1u); break; } } } } while (0)

struct XcdBarrier {
    unsigned* bar; unsigned x;
    volatile LAS unsigned* st;
};

__device__ __forceinline__ XcdBarrier xcd_barrier_post(unsigned* bar, volatile LAS unsigned* st) {
    XcdBarrier b; b.bar = bar; b.x = xb_xcc_id(); b.st = st;
    if (threadIdx.x == 0) (void)xb_add(&bar[XB_XCNT(b.x)], 1u);
    return b;
}
__device__ __forceinline__ void xcd_barrier_complete(unsigned* bar, unsigned x, unsigned& nloc, unsigned& nx) {
    const unsigned G = gridDim.x * gridDim.y * gridDim.z;
    unsigned sum, cnt, mine, sp = 0u;
    for (;;) {
        sum = 0u; cnt = 0u; mine = 0u;
#pragma unroll
        for (unsigned j = 0; j < 16; ++j) { const unsigned c = xb_ld(&bar[XB_XCNT(j)]); sum += c; cnt += (c > 0u) ? 1u : 0u; mine = (j == x) ? c : mine; }
        if (sum == G) break;
        __builtin_amdgcn_s_sleep(1);
        if ((++sp & 255u) == 0u) { if (xb_ld(&bar[XB_TMO])) break; if (sp > XB_SPIN_CAP) { atomicAdd(&bar[XB_TMO], 1u); break; } }
    }
    nloc = mine > 0u ? mine : 1u; nx = cnt > 0u ? cnt : 1u;
}

__device__ __forceinline__ void xcd_barrier(const XcdBarrier& b) {
    asm volatile("s_waitcnt vmcnt(0)" ::: "memory");
    __syncthreads();
    if (threadIdx.x == 0) {
        unsigned* bar = b.bar;
        __builtin_amdgcn_s_waitcnt(0);
        unsigned nloc = b.st[0], nx = b.st[1];
        if (nloc == 0u) { xcd_barrier_complete(bar, b.x, nloc, nx); b.st[0] = nloc; b.st[1] = nx; }
        const unsigned old = xb_add(&bar[XB_XSUB(b.x)], 1u);
        const unsigned gen = old / nloc;
        if (old + 1u == (gen + 1u) * nloc) {
            __builtin_amdgcn_fence(__ATOMIC_RELEASE, "agent");
            asm volatile("s_waitcnt vmcnt(0)" ::: "memory");
            const unsigned og = xb_add(&bar[XB_TOP], 1u);
            const unsigned tg = og / nx;
            if (og + 1u == (tg + 1u) * nx) xb_add(&bar[XB_TOPGEN], 1u);
            else XB_SPIN(xb_ld(&bar[XB_TOPGEN]) == tg, bar);
            __builtin_amdgcn_fence(__ATOMIC_ACQUIRE, "agent");
            xb_add(&bar[XB_XGEN(b.x)], 1u);
            asm volatile("s_waitcnt vmcnt(0)" ::: "memory");
        } else {
            XB_SPIN(xb_ld(&bar[XB_XGEN(b.x)]) == gen, bar);
            __builtin_amdgcn_fence(__ATOMIC_ACQUIRE, "agent");
            asm volatile("s_waitcnt vmcnt(0)" ::: "memory");
        }
    }
    __syncthreads();
}

__device__ __forceinline__ void conv_t(const float* __restrict__ src, int ldsrc, int Nvalid, int Nstore, int K, bf16_t* __restrict__ dst, float* ts, int b0 = 0) {
    const int tid = ltid();
    const int ntn = (Nstore + 63) / 64, ntk = K / 64;
    for (int tile = lbid() - b0; tile < ntn * ntk; tile += gridDim.x - b0) {
        const int tn = tile % ntn, tk = tile / ntn;
        {
            const int kk = tid >> 3, n8 = (tid & 7) * 8;
#pragma unroll
            for (int i = 0; i < 8; ++i) {
                const int n = tn * 64 + n8 + i;
                ts[kk * 65 + n8 + i] = n < Nvalid ? src[(long)(tk * 64 + kk) * ldsrc + n] : 0.f;
            }
        }
        __syncthreads();
        {
            const int nn = tid >> 3, k8 = (tid & 7) * 8;
            const int n = tn * 64 + nn;
            if (n < Nstore) {
                uint4 v;
                v.x = pack2(ts[(k8 + 0) * 65 + nn], ts[(k8 + 1) * 65 + nn]);
                v.y = pack2(ts[(k8 + 2) * 65 + nn], ts[(k8 + 3) * 65 + nn]);
                v.z = pack2(ts[(k8 + 4) * 65 + nn], ts[(k8 + 5) * 65 + nn]);
                v.w = pack2(ts[(k8 + 6) * 65 + nn], ts[(k8 + 7) * 65 + nn]);
                *(uint4*)(dst + (long)n * K + tk * 64 + k8) = v;
            }
        }
        __syncthreads();
    }
}

__device__ __forceinline__ void fold_fourier(CP& p, int j, char* smem, int b0) {
    const int tid = ltid(), bid = lbid() - b0, nb = gridDim.x - b0;
    float* wt = (float*)smem;
    for (int unit = bid; unit < 256; unit += nb) {
        const int g = unit >> 6, kb = unit & 63;
        const int dq = ltid() & 127, kq = ltid() >> 7;
        const float rs = __builtin_amdgcn_sinf((float)dq * (1.f / 128.f)), rc = __builtin_amdgcn_cosf((float)dq * (1.f / 128.f));
        __syncthreads();
        for (int i = tid; i < 16 * 128; i += NTHREADS) {
            const int kk = i >> 7, d = i & 127;
            wt[kk * 129 + d] = p.even_w_in[((long)j * 1024 + kb * 16 + kk) * 2576 + 2064 + g * 128 + d];
        }
        __syncthreads();
        float ar[4], ai[4];
#pragma unroll
        for (int q = 0; q < 4; ++q) { ar[q] = 0.f; ai[q] = 0.f; }
        for (int d0 = 0; d0 < 128; d0 += 16) {
            float s = __builtin_amdgcn_sinf((float)((d0 * dq) & 127) * (1.f / 128.f)), c = __builtin_amdgcn_cosf((float)((d0 * dq) & 127) * (1.f / 128.f));
#pragma unroll
            for (int dd = 0; dd < 16; ++dd) {
#pragma unroll
                for (int q = 0; q < 4; ++q) {
                    const float w = wt[(kq * 4 + q) * 129 + d0 + dd];
                    ar[q] += w * c;
                    ai[q] -= w * s;
                }
                const float cn = c * rc - s * rs, sn = s * rc + c * rs;
                c = cn; s = sn;
            }
        }
        const float sc = 0.08838834764831845f;
        bf16_t* dst = p.wtE_in + (long)j * N_EIN * 1024;
#pragma unroll
        for (int q = 0; q < 4; ++q) {
            dst[(long)(2064 + g * 128 + dq) * 1024 + kb * 16 + kq * 4 + q] = f2bf(ar[q] * sc);
            dst[(long)(2576 + g * 128 + dq) * 1024 + kb * 16 + kq * 4 + q] = f2bf(ai[q] * sc);
        }
    }
    __syncthreads();
    for (long i = (long)bid * NTHREADS + tid; i < 240L * 1024; i += (long)nb * NTHREADS) p.wtE_in[(long)j * N_EIN * 1024 + 3088L * 1024 + i] = 0;
}
__device__ __forceinline__ void ph_init2(CP& p, char* smem, int b0) {
    if ((int)lbid() < b0) return;
    __syncthreads();
    float* ts = (float*)smem;
    conv_t(p.even_w_in + 1024L * 2576, 2576, 2064, 2064, 1024, p.wtE_in + (long)N_EIN * 1024, ts, b0);
    for (int j = 0; j < 2; ++j) {
        conv_t(p.even_w_out + (long)j * 1024 * 1024, 1024, 1024, 1024, 1024, p.wtE_out + (long)j * 1024 * 1024, ts, b0);
        conv_t(p.odd_w_in + (long)j * 1024 * 832, 832, 832, N_OIN, 1024, p.wtO_in + (long)j * N_OIN * 1024, ts, b0);
        conv_t(p.mla_w_uq + (long)j * 512 * 1536, 1536, 1536, 1536, 512, p.wtUq + (long)j * 1536 * 512, ts, b0);
        conv_t(p.mla_w_ukv + (long)j * 256 * 2048, 2048, 2048, 2048, 256, p.wtUkv + (long)j * 2048 * 256, ts, b0);
        conv_t(p.odd_w_out + (long)j * 1024 * 1024, 1024, 1024, 1024, 1024, p.wtO_out + (long)j * 1024 * 1024, ts, b0);
    }
    for (int l = 0; l < 4; ++l) conv_t(p.peer_w_q + (long)l * 1024 * 2048, 2048, 2048, 2048, 1024, p.wtPq + (long)l * 2048 * 1024, ts, b0);
    fold_fourier(p, 1, smem, b0);
}

__device__ __forceinline__ void ph_init(CP& p, char* smem) {
    const int tid = ltid(), bid = lbid(), nb = gridDim.x;
    {
        float* sl = (float*)smem;
        {
            float cv[18];
#pragma unroll
            for (int jj = 0; jj < 18; ++jj) { const int i = tid + jj * NTHREADS; cv[jj] = i < 1024 ? p.c_ctx[i] : p.c[i - 1024]; }
#pragma unroll
            for (int jj = 0; jj < 18; ++jj) sl[tid + jj * NTHREADS] = silu_f(cv[jj]);
        }
        __syncthreads();
        float* part16 = sl + 9 * 1024;
        for (int unit = bid; unit < 192; unit += nb) {
            const int l = unit / 48, cb = unit % 48;
            const int c4 = (tid & 31) * 4, kq = tid >> 5;
            f32x4 acc[9];
#pragma unroll
            for (int r = 0; r < 9; ++r) acc[r] = (f32x4){0.f, 0.f, 0.f, 0.f};
            const float* wp = p.w_mod + ((long)l * 1024 + kq * 64) * 6144 + cb * 128 + c4;
            f32x4 w[8], wn[8];
#pragma unroll
            for (int q = 0; q < 8; ++q) w[q] = *(const f32x4*)(wp + (long)q * 6144);
            for (int k = 0; k < 64; k += 8) {
                if (k + 8 < 64) {
#pragma unroll
                    for (int q = 0; q < 8; ++q) wn[q] = *(const f32x4*)(wp + (long)(k + 8 + q) * 6144);
                }
#pragma unroll
                for (int q = 0; q < 8; ++q)
#pragma unroll
                    for (int r = 0; r < 9; ++r) acc[r] = acc[r] + w[q] * sl[r * 1024 + kq * 64 + k + q];
#pragma unroll
                for (int q = 0; q < 8; ++q) w[q] = wn[q];
            }
#pragma unroll
            for (int r = 0; r < 9; ++r) *(f32x4*)(part16 + (kq * 9 + r) * 128 + c4) = acc[r];
            __syncthreads();
            if (tid < 128) {
                const int col = cb * 128 + tid;
                const float bias = p.b_mod[l * 6144 + col];
#pragma unroll
                for (int r = 0; r < 9; ++r) {
                    float s = bias;
#pragma unroll
                    for (int g = 0; g < 16; ++g) s += part16[(g * 9 + r) * 128 + tid];
                    p.mods[((long)l * 9 + r) * 6144 + col] = s;
                }
            }
            __syncthreads();
        }
    }
    {
        float* ts = (float*)smem;
        conv_t(p.even_w_in, 2576, 2064, 2064, 1024, p.wtE_in, ts);
    }
    fold_fourier(p, 0, smem, 0);
    for (long i = ((long)bid * NTHREADS + tid) * 8; i < 4L * 8 * 2 * 128 * 128; i += (long)nb * NTHREADS * 8) {
        const f32x4 a = *(const f32x4*)(p.peer_sub_keys + i), b = *(const f32x4*)(p.peer_sub_keys + i + 4);
        *(uint4*)(p.subk + i) = make_uint4(pack2(a[0], a[1]), pack2(a[2], a[3]), pack2(b[0], b[1]), pack2(b[2], b[3]));
    }
    for (int i = bid * NTHREADS + tid; i < 128 * 128; i += nb * NTHREADS) {
        const int jrow = i >> 7, kk = i & 127;
        {
            const int k1 = jrow >> 1, po = jrow & 1, pi = kk >> 6, n1 = kk & 63;
            float s, c;
            sincospif((float)((k1 * n1) & 63) / 32.f, &s, &c);
            const float v = po == 0 ? (pi == 0 ? c : s) : (pi == 0 ? -s : c);
            p.fftMA[i] = f2bf(v * 0.125f);
        }
        {
            const int k2 = jrow, pi = kk >> 6, n2 = kk & 63;
            float s, c;
            sincospif((float)((k2 * n2) & 63) / 32.f, &s, &c);
            p.fftMB[i] = jrow < 64 ? f2bf((pi == 0 ? c : s) * 0.125f) : (bf16_t)0;
        }
    }
    for (int i = bid * NTHREADS + tid; i < 4096; i += nb * NTHREADS) {
        const int n2 = i >> 6, k1 = i & 63;
        float s, c;
        sincospif((float)(n2 * k1) / 2048.f, &s, &c);
        p.fftTW[i * 2] = c; p.fftTW[i * 2 + 1] = s;
    }
    for (long i = (long)bid * NTHREADS + tid; i < 256L * 512; i += (long)nb * NTHREADS) {
        const int k = (int)(i >> 9), np = (int)(i & 511), n = np & 255;
        const int prod = (k * n) & 255;
        float s, c;
        sincospif((float)prod / 128.f, &s, &c);
        p.dftP[i] = f2bf(((np >> 8) ? s : c) * (1.f / 16.f));
    }
}

__device__ __forceinline__ void ph_tab(CP& p, int l, int b0) {
    const int lane = ltid() & 63, wave = ltid() >> 6;
    if ((int)lbid() < b0) return;
    unsigned char* tab = p.tabU + (long)(l & 1) * 16384 * 2048;
    float* su = p.su + (l & 1) * 32768; float* sv = su + 16384;
    const int rstep = (gridDim.x - b0) * 8;
    int row = (lbid() - b0) * 8 + wave;
    f32x4 nx[4];
#define TAB_SRC(R) ((((R) >= 16384) ? p.peer_v : p.peer_u) + ((long)l * 16384 + ((R) & 16383)) * 1024 + lane * 16)
    if (row < 32768) {
#pragma unroll
        for (int i = 0; i < 4; ++i) nx[i] = *(const f32x4*)(TAB_SRC(row) + i * 4);
    }
    for (; row < 32768; row += rstep) {
        const bool isv = row >= 16384;
        const int e = row & 16383;
        float v[16];
#pragma unroll
        for (int i = 0; i < 4; ++i) { v[i * 4] = nx[i][0]; v[i * 4 + 1] = nx[i][1]; v[i * 4 + 2] = nx[i][2]; v[i * 4 + 3] = nx[i][3]; }
        if (row + rstep < 32768) {
#pragma unroll
            for (int i = 0; i < 4; ++i) nx[i] = *(const f32x4*)(TAB_SRC(row + rstep) + i * 4);
        }
        float m = 0.f;
#pragma unroll
        for (int i = 0; i < 16; ++i) m = fmaxf(m, fabsf(v[i]));
        m = wave_max(m);
        const float scale = m > 0.f ? m * (1.f / 127.f) : 1.f;
        const float inv = 1.f / scale;
        unsigned w[4];
#pragma unroll
        for (int i = 0; i < 4; ++i) {
            unsigned pk = 0;
#pragma unroll
            for (int q = 0; q < 4; ++q) {
                int qi = (int)rintf(v[i * 4 + q] * inv);
                qi = qi < -127 ? -127 : (qi > 127 ? 127 : qi);
                pk |= (unsigned)(qi & 0xFF) << (q * 8);
            }
            w[i] = pk;
        }
        *(uint4*)(tab + (isv ? 16384L * 1024 : 0L) + (long)e * 1024 + lane * 16) = make_uint4(w[0], w[1], w[2], w[3]);
        if (lane == 0) (isv ? sv : su)[e] = scale;
    }
#undef TAB_SRC
}

template <int FROM_INPUT = 0>
__device__ __forceinline__ void ph_norm(CP& p, const float* __restrict__ w, const float* __restrict__ mods_l, int sh_off, int sc_off) {
    const int lane = ltid() & 63, wave = ltid() >> 6;
    const int nw = gridDim.x * 8;
    for (int row = lbid() * 8 + wave; row < T_TOK; row += nw) {
        const float* xr = FROM_INPUT ? (row < TP_TOK ? p.x_prompt + (long)row * DM : p.x_sample + (long)(row - TP_TOK) * DM) : p.out + (long)row * DM;
        float4 v[4];
        float ss = 0.f;
#pragma unroll
        for (int i = 0; i < 4; ++i) {
            v[i] = *(const float4*)(xr + i * 256 + lane * 4);
            ss += v[i].x * v[i].x + v[i].y * v[i].y + v[i].z * v[i].z + v[i].w * v[i].w;
        }
        ss = wave_sum(ss);
        const float r = rsqrtf(ss * (1.f / 1024.f) + 1e-6f);
        const float* mr = mods_l + (long)tok_modrow(row) * 6144;
        float4 ww[4], sc[4], sh[4];
#pragma unroll
        for (int i = 0; i < 4; ++i) {
            const int c = i * 256 + lane * 4;
            ww[i] = *(const float4*)(w + c); sc[i] = *(const float4*)(mr + sc_off + c); sh[i] = *(const float4*)(mr + sh_off + c);
        }
#pragma unroll
        for (int i = 0; i < 4; ++i) {
            const int c = i * 256 + lane * 4;
            const float h0 = v[i].x * r * ww[i].x * (1.f + sc[i].x) + sh[i].x;
            const float h1 = v[i].y * r * ww[i].y * (1.f + sc[i].y) + sh[i].y;
            const float h2 = v[i].z * r * ww[i].z * (1.f + sc[i].z) + sh[i].z;
            const float h3 = v[i].w * r * ww[i].w * (1.f + sc[i].w) + sh[i].w;
            *(uint2*)(p.H + (long)row * DM + c) = make_uint2(pack2(h0, h1), pack2(h2, h3));
        }
    }
}
#define SCAN_KPERM(k_) (((k_) & ~31) | ((((k_) >> 2) & 3) << 3) | ((((k_) >> 4) & 1) << 2) | ((k_) & 3))
#define ZA_OFF ((long)TP_TOK * 1024)
template <int PERM>
__device__ __forceinline__ void e_gemm_epi(CP& p, f32x4 (&acc)[2][2][4][2], int col0, int row0, int s0, int n20, int b) {
    const int tz = ltid(), wid = tz >> 6, lane = tz & 63, wr = wid >> 2, wc = wid & 3, fr = lane & 15, fq = lane >> 4;
#define EG_TOK(ai, m, i) (PERM ? s0 + 64 * ((m) * 16 + fq * 4 + (i)) + n20 + (ai) * 2 + wr : row0 + (ai) * 128 + wr * 64 + (m) * 16 + fq * 4 + (i))
    if (col0 + 256 <= 2048) {
        const bool isg = col0 >= 1536;
        bf16_t* const base = isg ? p.gate + (col0 - 1536) : p.qkvraw + col0;
        const long ld = isg ? 512 : 1536;
#pragma unroll
        for (int ai = 0; ai < 2; ++ai)
#pragma unroll
            for (int m = 0; m < 4; ++m)
#pragma unroll
                for (int i = 0; i < 4; ++i) {
                    bf16_t* d = base + (long)EG_TOK(ai, m, i) * ld + wc * 32 + fr;
#pragma unroll
                    for (int bj = 0; bj < 2; ++bj)
#pragma unroll
                        for (int n = 0; n < 2; ++n) d[bj * 128 + n * 16] = f2bf(acc[ai][bj][m][n][i]);
                }
    } else {
#pragma unroll
        for (int bj = 0; bj < 2; ++bj)
#pragma unroll
            for (int n = 0; n < 2; ++n) {
                const int col = col0 + bj * 128 + wc * 32 + n * 16 + fr;
                if (col < 2064) {
#pragma unroll
                    for (int ai = 0; ai < 2; ++ai)
#pragma unroll
                        for (int m = 0; m < 4; ++m)
#pragma unroll
                            for (int i = 0; i < 4; ++i) p.ba[(long)EG_TOK(ai, m, i) * 16 + (col - 2048)] = acc[ai][bj][m][n][i];
                } else if (col < 3088) {
                    const int cc = col - 2064, part = cc >> 9, cf = cc & 511;
#pragma unroll
                    for (int ai = 0; ai < 2; ++ai)
#pragma unroll
                        for (int m = 0; m < 4; ++m) {
                            const f32x4 v = acc[ai][bj][m][n];
                            bf16_t* dst;
                            if (PERM) dst = p.ZtA + ZA_OFF + (((((long)b * 512 + cf) * 64 + (n20 + ai * 2 + wr)) * 2 + part) * 64 + (m * 16 + fq * 4));
                            else dst = p.ZtA + (long)s0 * 1024 + ((long)cf * 2 + part) * 256 + (ai * 128 + wr * 64 + m * 16 + fq * 4);
                            *(uint2*)dst = make_uint2(pack2(v[0], v[1]), pack2(v[2], v[3]));
                        }
                }
            }
    }
#undef EG_TOK
}
__device__ __forceinline__ void ph_e_gemm(CP& p, int j, char* smem) {
    const int ntn = N_EIN / 256, ntm = T_TOK / 256;
    const bf16_t* Bt = p.wtE_in + (long)j * N_EIN * 1024;
#define EG_PROLOGUE(U)                                                                                             \
    {                                                                                                              \
        int tm_, tn_;                                                                                              \
        tile_map((U), ntm, ntn, tm_, tn_);                                                                         \
        if (tm_ < 16) g8_prologue<0>(p.H + (long)tm_ * 256 * DM, DM, Bt + (long)tn_ * 256 * 1024, 1024, (bf16_t*)smem);   \
        else { const int q_ = tm_ - 16; g8_prologue<1>(p.H + (long)(TP_TOK + (q_ >> 4) * 4096 + (q_ & 15) * 4) * DM, DM, Bt + (long)tn_ * 256 * 1024, 1024, (bf16_t*)smem); }   \
    }
    int u = lbid();
    if (u < ntn * ntm) EG_PROLOGUE(u)
    for (; u < ntn * ntm; u += gridDim.x) {
        int tm, tn;
        tile_map(u, ntm, ntn, tm, tn);
        const int col0 = tn * 256;
        const int un = u + gridDim.x;
        f32x4 acc[2][2][4][2];
        if (tm < 16) {
            const int row0 = tm * 256;
            gemm_tile256_acc<0, 1>(p.H + (long)row0 * DM, DM, Bt + (long)col0 * 1024, 1024, 1024, (bf16_t*)smem, acc);
            if (un < ntn * ntm) EG_PROLOGUE(un)
            e_gemm_epi<0>(p, acc, col0, row0, row0, 0, 0);
        } else {
            const int q = tm - 16, b = q >> 4, n20 = (q & 15) * 4;
            const int s0 = TP_TOK + b * 4096;
            gemm_tile256_acc<1, 1>(p.H + (long)(s0 + n20) * DM, DM, Bt + (long)col0 * 1024, 1024, 1024, (bf16_t*)smem, acc);
            if (un < ntn * ntm) EG_PROLOGUE(un)
            e_gemm_epi<1>(p, acc, col0, 0, s0, n20, b);
        }
    }
#undef EG_PROLOGUE
}

#define PREP_SMEM_BYTES (66048 + 34816 + 16384 + 2048 + 256 + 15360)
__device__ __forceinline__ void ph_e_prep(CP& p, int j, char* smem) {
    const float* cw = p.even_conv_w + (long)j * 3 * 1536;
    for (int u = lbid(); u < 576 * 4; u += gridDim.x) {
        const int cg = u >> 2, h = u & 3;
        const int t0 = cg * 64;
        const int s0 = tok_seq0(t0), L = tok_len(t0);
        int lz = 0, tid = ltid();
        asm volatile("" : "+s"(lz), "+v"(tid));
        const int lane = tid & 63, wave = tid >> 6;
        char* sm = smem + lz;
        bf16_t* raw = (bf16_t*)sm;
        float* KK = (float*)sm;
        float* QKr = KK + 64 * 65;
        float* Am = QKr + 64 * 65;
        bf16_t* qn = (bf16_t*)(sm + 66048);
        bf16_t* kn = qn + 64 * 136;
        bf16_t* vv = (bf16_t*)(sm + 66048 + 34816);
        float* sb = (float*)(sm + 66048 + 34816 + 16384);
        float* sg = sb + 128;
        float* sgr = sg + 128;
        float* seg = sgr + 128;
        float* sone = seg + 128;
        bf16_t* Dinv = (bf16_t*)(sm + 66048 + 34816 + 16384 + 2048 + 256);
        bf16_t* A10 = Dinv + 4 * 32 * 40;
        __syncthreads();
        u32x4 rv_[7];
#pragma unroll
        for (int jj = 0; jj < 7; ++jj) {
            int i = tid + jj * NTHREADS;
            i = i < 3 * 66 * 16 ? i : 3 * 66 * 16 - 1;
            const int part = i / (66 * 16), rem = i % (66 * 16), rr = rem >> 4, ch = rem & 15;
            int t = t0 - 1 + rr;
            t = t < s0 ? s0 : (t > s0 + L - 1 ? s0 + L - 1 : t);
            rv_[jj] = *(const u32x4*)(p.qkvraw + (long)t * 1536 + part * 512 + h * 128 + ch * 8);
        }
        float gb0_, gb1_, gal_, gdt_;
        {
            const int gt_ = tid & 127, dir = gt_ >> 6, i = gt_ & 63;
            const float* bar_ = p.ba + (long)(t0 + (dir ? 63 - i : i)) * 16;
            gb0_ = bar_[dir * 4 + h]; gb1_ = bar_[(2 + dir) * 4 + h];
            gal_ = p.gdn_a_log[(j * 2 + dir) * 4 + h]; gdt_ = p.gdn_dt_bias[(j * 2 + dir) * 4 + h];
        }
#pragma unroll
        for (int jj = 0; jj < 7; ++jj) {
            const int i = tid + jj * NTHREADS;
            const int part = i / (66 * 16), rem = i % (66 * 16), rr = rem >> 4, ch = rem & 15;
            const int t = t0 - 1 + rr;
            const bool in_ = t >= s0 && t < s0 + L;
            u32x4 v = rv_[jj];
#pragma unroll
            for (int q = 0; q < 4; ++q) v[q] = in_ ? v[q] : 0u;
            if (i < 3 * 66 * 16) *(u32x4*)(raw + (part * 66 + rr) * 128 + ch * 8) = v;
        }
        if (tid >= 128 && tid < 192) sone[tid - 128] = 1.f;
        if (tid < 128) {
            const int dir = tid >> 6, i = tid & 63;
            sb[dir * 64 + i] = sigmoid_f(gb0_);
            const float a = __expf(gal_);
            sgr[dir * 64 + i] = -a * softplus_f(gb1_ + gdt_);
        }
        __syncthreads();
        if (tid < 128) {
            float v = sgr[tid];
#pragma unroll
            for (int off = 1; off < 64; off <<= 1) {
                const float o = __int_as_float(__builtin_amdgcn_ds_bpermute(((lane - off) & 63) << 2, __float_as_int(v)));
                v += lane >= off ? o : 0.f;
            }
            sg[tid] = v;
            seg[tid] = __expf(v);
        }
        {
            const int d = lane * 2;
#pragma unroll
            for (int part = 0; part < 3; ++part) {
                const int ch = part * 512 + h * 128 + d;
                const float w00 = cw[ch], w01 = cw[ch + 1], w10 = cw[1536 + ch], w11 = cw[1536 + ch + 1], w20 = cw[3072 + ch], w21 = cw[3072 + ch + 1];
                float y0[8], y1[8], ss[8];
#pragma unroll
                for (int r8 = 0; r8 < 8; ++r8) {
                    const int rr = wave * 8 + r8;
                    const unsigned x0 = *(const unsigned*)(raw + (part * 66 + rr) * 128 + d);
                    const unsigned x1 = *(const unsigned*)(raw + (part * 66 + rr + 1) * 128 + d);
                    const unsigned x2 = *(const unsigned*)(raw + (part * 66 + rr + 2) * 128 + d);
                    y0[r8] = silu_f(w00 * bflo(x0) + w10 * bflo(x1) + w20 * bflo(x2));
                    y1[r8] = silu_f(w01 * bfhi(x0) + w11 * bfhi(x1) + w21 * bfhi(x2));
                    ss[r8] = y0[r8] * y0[r8] + y1[r8] * y1[r8];
                }
                float tot = 0.f;
                if (part < 2) {
                    const bool b5 = (lane & 32) != 0, b4 = (lane & 16) != 0, b3 = (lane & 8) != 0;
                    float t4[4], t2[2];
#pragma unroll
                    for (int i = 0; i < 4; ++i) { const float snd = b5 ? ss[i] : ss[i + 4]; const float kp = b5 ? ss[i + 4] : ss[i]; t4[i] = kp + xshfl<32>(snd); }
#pragma unroll
                    for (int i = 0; i < 2; ++i) { const float snd = b4 ? t4[i] : t4[i + 2]; const float kp = b4 ? t4[i + 2] : t4[i]; t2[i] = kp + xshfl<16>(snd); }
                    { const float snd = b3 ? t2[0] : t2[1]; const float kp = b3 ? t2[1] : t2[0]; tot = kp + xshfl<8>(snd); }
                    tot += xshfl<4>(tot); tot += xshfl<2>(tot); tot += xshfl<1>(tot);
                    tot = rsqrtf(tot + 1e-6f);
                }
#pragma unroll
                for (int r8 = 0; r8 < 8; ++r8) {
                    const int rr = wave * 8 + r8;
                    float a0 = y0[r8], a1 = y1[r8];
                    if (part < 2) { const float rn = __int_as_float(__builtin_amdgcn_readlane(__float_as_int(tot), r8 * 8)); a0 *= rn; a1 *= rn; }
                    const unsigned pk = pack2(a0, a1);
                    if (part == 0) { *(unsigned*)(qn + rr * 136 + d) = pk; *(unsigned*)(p.qn + ((long)(t0 + rr) * 4 + h) * 128 + SCAN_KPERM(d)) = pk; }
                    else if (part == 1) { *(unsigned*)(kn + rr * 136 + d) = pk; *(unsigned*)(p.kn + ((long)(t0 + rr) * 4 + h) * 128 + d) = pk; }
                    else { *(unsigned*)(vv + rr * 128 + d) = pk; }
                }
            }
        }
        __syncthreads();
        {
            const int mat = wave >> 2, rt = wave & 3;
            f32x4 acc[1][4];
#pragma unroll
            for (int n = 0; n < 4; ++n) acc[0][n] = (f32x4){0.f, 0.f, 0.f, 0.f};
            wave_mma<1, 4>(acc, (mat ? qn : kn) + rt * 16 * 136, 136, kn, 136, 128);
            float* dst = mat ? QKr : KK;
#pragma unroll
            for (int n = 0; n < 4; ++n)
#pragma unroll
                for (int r = 0; r < 4; ++r) dst[(rt * 16 + (lane >> 4) * 4 + r) * 65 + n * 16 + (lane & 15)] = acc[0][n][r];
        }
        __syncthreads();
        {
            const int dir = tid >> 8, q = tid & 255;
            const long ud = ((long)(dir ? (s0 + L - 64 - (t0 - s0)) / 64 : cg) * 4 + h) * 2 + dir;
            bf16_t* qkout = p.QKb + ud * 4096;
            for (int e = q; e < 4096; e += 256) {
                const int i = e >> 6, jj = e & 63;
                const int ti = dir ? 63 - i : i, tj = dir ? 63 - jj : jj;
                const float dec = jj <= i ? __expf(sg[dir * 64 + i] - sg[dir * 64 + jj]) : 0.f;
                Am[(dir * 64 + i) * 64 + jj] = jj < i ? sb[dir * 64 + i] * KK[ti * 65 + tj] * dec : 0.f;
                qkout[e] = f2bf(QKr[ti * 65 + tj] * 0.08838834764831845f * dec);
            }
            if (q < 64) {
                const float gq = sg[dir * 64 + q];
                p.gcb[ud * 192 + q] = gq;
                p.gcb[ud * 192 + 64 + q] = 0.08838834764831845f * __expf(gq);
                p.gcb[ud * 192 + 128 + q] = __expf(sg[dir * 64 + 63] - gq);
            }
        }
        __syncthreads();
        if (tid < 128) {
            const int dir = tid >> 6, blk = (tid >> 5) & 1, c = tid & 31;
            const float* Dm = Am + (dir * 64 + blk * 32) * 64 + blk * 32;
            float x[32];
#pragma unroll
            for (int i = 0; i < 32; ++i) x[i] = (i == c) ? 1.f : 0.f;
#pragma unroll
            for (int i = 1; i < 32; ++i) {
                f32x4 dr[8];
#pragma unroll
                for (int q4 = 0; q4 < 8; ++q4) if (q4 * 4 < i) dr[q4] = *(const f32x4*)(Dm + i * 64 + q4 * 4);
                float a = x[i];
#pragma unroll
                for (int jj = 0; jj < i; ++jj) a -= dr[jj >> 2][jj & 3] * x[jj];
                x[i] = a;
            }
            bf16_t* dv = Dinv + (dir * 2 + blk) * 32 * 40 + c;
#pragma unroll
            for (int i = 0; i < 32; ++i) dv[i * 40] = f2bf(x[i]);
        }
        for (int e = tid; e < 2048; e += NTHREADS) {
            const int dir = e >> 10, i = (e >> 5) & 31, jj = e & 31;
            A10[(dir * 32 + i) * 40 + jj] = f2bf(Am[(dir * 64 + 32 + i) * 64 + jj]);
        }
        __syncthreads();
        {
            const int dir = wave >> 2, slab = wave & 3;
            const long ud = ((long)(dir ? (s0 + L - 64 - (t0 - s0)) / 64 : cg) * 4 + h) * 2 + dir;
            bf16_t* RT = (bf16_t*)sm + wave * 4096;
#define RT_AT(c_, i_) (RT + (c_) * 64 + (((((i_) >> 3) ^ ((c_) & 7))) << 3) + ((i_) & 7))
            const int c = slab * 64 + lane;
            const int g4 = (lane >> 4) * 4, cn = lane & 15, kg = (lane >> 4) * 8;
            {
                const bf16_t* src = c < 128 ? vv + c : kn + (c - 128);
                const int sst = c < 128 ? 128 : 136;
                const float* fac = c < 128 ? sone : seg + dir * 64;
                const float* fb = sb + dir * 64;
#pragma unroll
                for (int i8 = 0; i8 < 8; ++i8) {
                    unsigned w[4];
#pragma unroll
                    for (int e = 0; e < 4; ++e) {
                        float v[2];
#pragma unroll
                        for (int q = 0; q < 2; ++q) {
                            const int i = i8 * 8 + e * 2 + q;
                            const int ti = dir ? 63 - i : i;
                            const float f0 = bf2f(src[ti * sst]) * fb[i];
                            v[q] = f0 * fac[i];
                        }
                        w[e] = pack2(v[0], v[1]);
                    }
                    *(uint4*)RT_AT(lane, i8 * 8) = make_uint4(w[0], w[1], w[2], w[3]);
                }
            }
            asm volatile("s_waitcnt lgkmcnt(0)" ::: "memory");
            const bf16_t* D0 = Dinv + (dir * 2 + 0) * 32 * 40;
            const bf16_t* D1 = Dinv + (dir * 2 + 1) * 32 * 40;
            const bf16_t* A1 = A10 + dir * 32 * 40;
            bf16_t* dstb = (c < 128 ? p.Ub : p.Wb) + ud * 8192;
            const bool isU = __builtin_amdgcn_readfirstlane(slab) < 2;
            const int cbase = (slab & 1) * 64;
            int wcol[4];
#pragma unroll
            for (int nt = 0; nt < 4; ++nt) { const int k_ = cbase + nt * 16 + cn; wcol[nt] = c < 128 ? k_ : SCAN_KPERM(k_); }
            bf16x8 bfr[4];
            f32x4 X0[2][4];
#pragma unroll
            for (int nt = 0; nt < 4; ++nt) bfr[nt] = *(const bf16x8*)RT_AT(nt * 16 + cn, kg);
#pragma unroll
            for (int mt = 0; mt < 2; ++mt) {
                const bf16x8 af = *(const bf16x8*)(D0 + (mt * 16 + cn) * 40 + kg);
#pragma unroll
                for (int nt = 0; nt < 4; ++nt) X0[mt][nt] = __builtin_amdgcn_mfma_f32_16x16x32_bf16(af, bfr[nt], (f32x4){0.f, 0.f, 0.f, 0.f}, 0, 0, 0);
            }
#pragma unroll
            for (int nt = 0; nt < 4; ++nt) {
                const uint2 xa = make_uint2(pack2(X0[0][nt][0], X0[0][nt][1]), pack2(X0[0][nt][2], X0[0][nt][3]));
                const uint2 xb = make_uint2(pack2(X0[1][nt][0], X0[1][nt][1]), pack2(X0[1][nt][2], X0[1][nt][3]));
                if (isU) *(uint4*)(dstb + ((((slab & 1) * 4 + nt) * 2 + 0) * 64 + lane) * 8) = make_uint4(xa.x, xa.y, xb.x, xb.y);
                else {
#pragma unroll
                    for (int mt = 0; mt < 2; ++mt)
#pragma unroll
                        for (int r = 0; r < 4; ++r) dstb[(mt * 16 + g4 + r) * 128 + wcol[nt]] = f2bf(X0[mt][nt][r]);
                }
                *(uint2*)RT_AT(nt * 16 + cn, g4) = xa;
                *(uint2*)RT_AT(nt * 16 + cn, 16 + g4) = xb;
            }
            asm volatile("s_waitcnt lgkmcnt(0)" ::: "memory");
            f32x4 R1[2][4];
#pragma unroll
            for (int nt = 0; nt < 4; ++nt) bfr[nt] = *(const bf16x8*)RT_AT(nt * 16 + cn, kg);
#pragma unroll
            for (int mt = 0; mt < 2; ++mt) {
                const bf16x8 af = *(const bf16x8*)(A1 + (mt * 16 + cn) * 40 + kg);
#pragma unroll
                for (int nt = 0; nt < 4; ++nt) {
                    const f32x4 pr = __builtin_amdgcn_mfma_f32_16x16x32_bf16(af, bfr[nt], (f32x4){0.f, 0.f, 0.f, 0.f}, 0, 0, 0);
                    const uint2 rr = *(const uint2*)RT_AT(nt * 16 + cn, 32 + mt * 16 + g4);
                    R1[mt][nt][0] = bflo(rr.x) - pr[0]; R1[mt][nt][1] = bfhi(rr.x) - pr[1];
                    R1[mt][nt][2] = bflo(rr.y) - pr[2]; R1[mt][nt][3] = bfhi(rr.y) - pr[3];
                }
            }
            asm volatile("s_waitcnt lgkmcnt(0)" ::: "memory");
#pragma unroll
            for (int mt = 0; mt < 2; ++mt)
#pragma unroll
                for (int nt = 0; nt < 4; ++nt)
                    *(uint2*)RT_AT(nt * 16 + cn, 32 + mt * 16 + g4) = make_uint2(pack2(R1[mt][nt][0], R1[mt][nt][1]), pack2(R1[mt][nt][2], R1[mt][nt][3]));
            asm volatile("s_waitcnt lgkmcnt(0)" ::: "memory");
#pragma unroll
            for (int nt = 0; nt < 4; ++nt) bfr[nt] = *(const bf16x8*)RT_AT(nt * 16 + cn, 32 + kg);
            {
                const bf16x8 af0 = *(const bf16x8*)(D1 + cn * 40 + kg), af1 = *(const bf16x8*)(D1 + (16 + cn) * 40 + kg);
#pragma unroll
                for (int nt = 0; nt < 4; ++nt) {
                    const f32x4 xa = __builtin_amdgcn_mfma_f32_16x16x32_bf16(af0, bfr[nt], (f32x4){0.f, 0.f, 0.f, 0.f}, 0, 0, 0);
                    const f32x4 xb = __builtin_amdgcn_mfma_f32_16x16x32_bf16(af1, bfr[nt], (f32x4){0.f, 0.f, 0.f, 0.f}, 0, 0, 0);
                    if (isU) *(uint4*)(dstb + ((((slab & 1) * 4 + nt) * 2 + 1) * 64 + lane) * 8) = make_uint4(pack2(xa[0], xa[1]), pack2(xa[2], xa[3]), pack2(xb[0], xb[1]), pack2(xb[2], xb[3]));
                    else {
#pragma unroll
                        for (int r = 0; r < 4; ++r) { dstb[(32 + g4 + r) * 128 + wcol[nt]] = f2bf(xa[r]); dstb[(48 + g4 + r) * 128 + wcol[nt]] = f2bf(xb[r]); }
                    }
                }
            }
        }
    }
#undef RT_AT
}
typedef short s16x4 __attribute__((ext_vector_type(4)));
#define SCAN_KOFF(r_, ch_) (256 * (r_) + 16 * ((ch_) ^ ((((r_) & 3) << 2) | (((r_) >> 2) & 3))))
#define SCAN_SMEM_BYTES (17408 + 17408 + 9216 + 18432 + 8 * 4352 + 8 * 2 * 2304 + 512)
__device__ __forceinline__ void ph_e_scan(CP& p, int j, char* smem) {
    for (int st = lbid(); st < 192; st += gridDim.x) {
        const int tid = ltid(), lane = tid & 63, wave = tid >> 6;
        bf16_t* Ws = (bf16_t*)smem;
        bf16_t* Qs = Ws + 64 * 136;
        bf16_t* QKs = Qs + 64 * 136;
        bf16_t* KnT = QKs + 64 * 72;
        bf16_t* St = KnT + 128 * 72 + wave * (16 * 136);
        bf16_t* VNt = KnT + 128 * 72 + 8 * (16 * 136) + wave * (2 * 16 * 72);
        bf16_t* VNs = VNt + 16 * 72;
        float* gcs = (float*)((char*)KnT + 16384);
        const int g4 = (lane >> 4) * 4, cn = lane & 15;
        int seq, h, dir;
        if (st < 64) { seq = 16 + (st >> 3); h = (st >> 1) & 3; dir = st & 1; }
        else { const int q = st - 64; seq = q >> 3; h = (q >> 1) & 3; dir = q & 1; }
        const int L = seq < 16 ? 256 : 4096;
        const int s0 = seq < 16 ? seq * 256 : TP_TOK + (seq - 16) * 4096;
        const int nch = L / 64;
        f32x4 S[8][1];
        if (seq >= 16) {
            const float* sp = p.state_gdn + ((((long)(seq - 16) * 2 + j) * 2 + dir) * 4 + h) * 16384 + (g4 * 128 + wave * 16 + cn);
#pragma unroll
            for (int mt = 0; mt < 8; ++mt)
#pragma unroll
                for (int r = 0; r < 4; ++r) S[mt][0][r] = sp[(mt * 16 + r) * 128];
        } else {
#pragma unroll
            for (int mt = 0; mt < 8; ++mt) S[mt][0] = (f32x4){0.f, 0.f, 0.f, 0.f};
        }
        u32x4 pw[2], pq[2], pk[2], pqk;
        float pgc = 0.f;
        u32x4 pu4[2];
#define SCAN_LOAD_MAIN(M)                                                                                              \
        {                                                                                                              \
            const long ud_ = ((long)(s0 / 64 + (M)) * 4 + h) * 2 + dir;                                               \
            _Pragma("unroll") for (int i_ = 0; i_ < 2; ++i_) {                                                       \
                const int id_ = tid + i_ * NTHREADS, c_ = id_ >> 4, ch_ = id_ & 15;                                   \
                const int t_ = dir ? s0 + L - 1 - ((M) * 64 + c_) : s0 + (M) * 64 + c_;                               \
                pw[i_] = *(const u32x4*)(p.Wb + ud_ * 8192 + c_ * 128 + ch_ * 8);                                     \
                pq[i_] = *(const u32x4*)(p.qn + ((long)t_ * 4 + h) * 128 + ch_ * 8);                                  \
                pk[i_] = *(const u32x4*)(p.kn + ((long)t_ * 4 + h) * 128 + ch_ * 8);                                  \
            }                                                                                                          \
            pqk = *(const u32x4*)(p.QKb + ud_ * 4096 + (tid >> 3) * 64 + (tid & 7) * 8);                              \
            if (tid < 192) pgc = p.gcb[ud_ * 192 + tid];                                                              \
        }
#define SCAN_LOAD_U(M)                                                                                                 \
        {                                                                                                              \
            const long ud_ = ((long)(s0 / 64 + (M)) * 4 + h) * 2 + dir;                                               \
            long uo_ = ud_ * 8192 + (wave * 128 + lane) * 8;          \
            asm volatile("" : "+v"(uo_));        \
            const u32x4* ub_ = (const u32x4*)(p.Ub + uo_);                                                            \
            pu4[0] = ub_[0]; pu4[1] = ub_[64];                                                                         \
        }
        SCAN_LOAD_MAIN(0)
        SCAN_LOAD_U(0)
        for (int m = 0; m < nch; ++m) {
            __syncthreads();
#pragma unroll
            for (int i = 0; i < 2; ++i) {
                const int id = tid + i * NTHREADS, c = id >> 4, ch = id & 15;
                *(u32x4*)(Ws + c * 136 + ch * 8) = pw[i];
                *(u32x4*)(Qs + c * 136 + ch * 8) = pq[i];
                *(u32x4*)((char*)KnT + SCAN_KOFF(c, ch)) = pk[i];
            }
            *(u32x4*)(QKs + (tid >> 3) * 72 + (tid & 7) * 8) = pqk;
            if (tid < 192) gcs[tid] = pgc;
            __syncthreads();
            if (m + 1 < nch) SCAN_LOAD_MAIN(m + 1)
            f32x4 ws[4][1], qs[4][1];
#pragma unroll
            for (int mt = 0; mt < 4; ++mt) { ws[mt][0] = (f32x4){0.f, 0.f, 0.f, 0.f}; qs[mt][0] = (f32x4){0.f, 0.f, 0.f, 0.f}; }
            {
                bf16x8 sb[4];
#pragma unroll
                for (int ks = 0; ks < 4; ++ks) {
                    u32x4 w_;
                    w_[0] = pack2(S[2 * ks][0][0], S[2 * ks][0][1]); w_[1] = pack2(S[2 * ks][0][2], S[2 * ks][0][3]);
                    w_[2] = pack2(S[2 * ks + 1][0][0], S[2 * ks + 1][0][1]); w_[3] = pack2(S[2 * ks + 1][0][2], S[2 * ks + 1][0][3]);
                    sb[ks] = __builtin_bit_cast(bf16x8, w_);
                }
                const int kg_ = (lane >> 4) * 8;
                bf16x8 aw[4][4], aq[4][4];
#pragma unroll
                for (int ks = 0; ks < 4; ++ks)
#pragma unroll
                    for (int mt = 0; mt < 4; ++mt) {
                        aw[ks][mt] = *(const bf16x8*)(Ws + (mt * 16 + cn) * 136 + ks * 32 + kg_);
                        aq[ks][mt] = *(const bf16x8*)(Qs + (mt * 16 + cn) * 136 + ks * 32 + kg_);
                    }
#pragma unroll
                for (int ks = 0; ks < 4; ++ks)
#pragma unroll
                    for (int mt = 0; mt < 4; ++mt) {
                        ws[mt][0] = __builtin_amdgcn_mfma_f32_16x16x32_bf16(aw[ks][mt], sb[ks], ws[mt][0], 0, 0, 0);
                        qs[mt][0] = __builtin_amdgcn_mfma_f32_16x16x32_bf16(aq[ks][mt], sb[ks], qs[mt][0], 0, 0, 0);
                    }
            }
            const float glast = gcs[63];
            f32x4 vn[4];
#pragma unroll
            for (int mt = 0; mt < 4; ++mt) {
                float sc[4];
#pragma unroll
                for (int r = 0; r < 4; ++r) {
                    const int c = mt * 16 + g4 + r;
                    const unsigned uw_ = pu4[mt >> 1][(mt & 1) * 2 + (r >> 1)];
                    vn[mt][r] = ((r & 1) ? bfhi(uw_) : bflo(uw_)) - ws[mt][0][r];
                    sc[r] = vn[mt][r] * gcs[128 + c];
                }
                *(uint2*)(VNt + cn * 72 + mt * 16 + g4) = make_uint2(pack2(vn[mt][0], vn[mt][1]), pack2(vn[mt][2], vn[mt][3]));
                *(uint2*)(VNs + cn * 72 + mt * 16 + g4) = make_uint2(pack2(sc[0], sc[1]), pack2(sc[2], sc[3]));
            }
            if (m + 1 < nch) SCAN_LOAD_U(m + 1)
            asm volatile("s_waitcnt lgkmcnt(0)" ::: "memory");
            f32x4 oo[4][1];
#pragma unroll
            for (int mt = 0; mt < 4; ++mt)
#pragma unroll
                for (int r = 0; r < 4; ++r) oo[mt][0][r] = gcs[64 + mt * 16 + g4 + r] * qs[mt][0][r];
            wave_mma_u<4, 1, 2>(oo, QKs, 72, VNt, 72);
            {
                const int t0_ = dir ? s0 + L - 1 - (m * 64 + g4) : s0 + m * 64 + g4;
                long oo_ = ((long)t0_ * 4 + h) * 128 + wave * 16 + cn;
                asm volatile("" : "+v"(oo_));
                bf16_t* od = (dir ? p.ob : p.of) + oo_;
                if (dir) {
#pragma unroll
                    for (int mt = 0; mt < 4; ++mt)
#pragma unroll
                        for (int r = 0; r < 4; ++r) od[-(mt * 16 + r) * 512] = f2bf(oo[mt][0][r]);
                } else {
#pragma unroll
                    for (int mt = 0; mt < 4; ++mt)
#pragma unroll
                        for (int r = 0; r < 4; ++r) od[(mt * 16 + r) * 512] = f2bf(oo[mt][0][r]);
                }
            }
            const float eg = __expf(glast);
#pragma unroll
            for (int mt = 0; mt < 8; ++mt) S[mt][0] = S[mt][0] * eg;
            {
                const int q_ = (lane >> 2) & 3, pp_ = lane & 3, g_ = lane >> 4;
#pragma unroll
                for (int ks = 0; ks < 2; ++ks) {
                    const bf16x8 bfr = *(const bf16x8*)(VNs + cn * 72 + ks * 32 + g_ * 8);
                    s16x4 lo[8], hi[8];
#pragma unroll
                    for (int mt = 0; mt < 8; ++mt) {
                        const int r0 = ks * 32 + g_ * 8 + q_, chk = mt * 2 + (pp_ >> 1);
                        lo[mt] = __builtin_amdgcn_ds_read_tr16_b64_v4i16((__attribute__((address_space(3))) s16x4*)((char*)KnT + SCAN_KOFF(r0, chk) + 8 * (pp_ & 1)));
                        hi[mt] = __builtin_amdgcn_ds_read_tr16_b64_v4i16((__attribute__((address_space(3))) s16x4*)((char*)KnT + SCAN_KOFF(r0 + 4, chk) + 8 * (pp_ & 1)));
                    }
#pragma unroll
                    for (int mt = 0; mt < 8; ++mt) {
                        const bf16x8 afr = __builtin_shufflevector(lo[mt], hi[mt], 0, 1, 2, 3, 4, 5, 6, 7);
                        S[mt][0] = __builtin_amdgcn_mfma_f32_16x16x32_bf16(afr, bfr, S[mt][0], 0, 0, 0);
                    }
                }
            }
        }
#undef SCAN_LOAD_MAIN
#undef SCAN_LOAD_U
        if (seq < 16) {
            float* dp = p.out + OUT_STATE + ((((long)seq * 2 + j) * 2 + dir) * 4 + h) * 16384 + (g4 * 128 + wave * 16 + cn);
#pragma unroll
            for (int mt = 0; mt < 8; ++mt)
#pragma unroll
                for (int r = 0; r < 4; ++r) dp[(mt * 16 + r) * 128] = S[mt][0][r];
        }
    }
}

__device__ __forceinline__ void ph_fft_a(CP& p, char* smem) {
    __syncthreads();
    float* tws = (float*)(smem + GEMM_SMEM_BYTES);
    {
        const int t_ = ltid();
        f32x4 t4[4];
#pragma unroll
        for (int i = 0; i < 4; ++i) t4[i] = *(const f32x4*)(p.fftTW + (t_ + i * NTHREADS) * 4);
#pragma unroll
        for (int i = 0; i < 4; ++i) *(f32x4*)(tws + (t_ + i * NTHREADS) * 4) = t4[i];
    }
    __syncthreads();
    for (int u = lbid(); u < 1024; u += gridDim.x) {
        gemm_tile<0>(p.ZtA + ZA_OFF + (long)u * 256 * 128, 128, p.fftMA, 128, 128, (bf16_t*)smem, [&](int r, int c, f32x4 v) {
            const int gr = u * 256 + r;
            const int n2 = gr & 63, cf = (gr >> 6) & 511, b = gr >> 15;
            const int k1 = c >> 1, po = c & 1;
            f32x4 h;
#pragma unroll
            for (int i = 0; i < 4; ++i) {
                const float other = xshfl<1>(v[i]);
                const float2 tw = *(const float2*)(tws + ((n2 + i) * 64 + k1) * 2);
                h[i] = po == 0 ? (v[i] * tw.x + other * tw.y) : (v[i] * tw.x - other * tw.y);
            }
            bf16_t* dst = p.HB + (((((long)b * 64 + k1) * 512 + cf) * 2 + po) * 64 + n2);
            *(uint2*)dst = make_uint2(pack2(h[0], h[1]), pack2(h[2], h[3]));
        });
    }
}
__device__ __forceinline__ void ph_fft_b(CP& p, char* smem) {
    __syncthreads();
    const int nb = gridDim.x;
    for (int uu = lbid(); uu < 1024 + 64; uu += nb) {
        const int u = 1024 + 63 - uu;
        if (u < 0) continue;
        if (u < 1024) {
            gemm_tile<0>(p.HB + (long)u * 256 * 128, 128, p.fftMB, 128, 128, (bf16_t*)smem, [&](int r, int c, f32x4 v) {
                if (c < 64) {
                    const int gr = u * 256 + r;
                    const int cf = gr & 511, k1 = (gr >> 9) & 63, b = gr >> 15;
                    const long tok = TP_TOK + (long)b * 4096 + k1 + 64 * c;
                    *(uint2*)(p.mix + tok * DM + 512 + cf) = make_uint2(pack2(v[0], v[1]), pack2(v[2], v[3]));
                }
            });
        } else {
            const int q = u - 1024, seq = q >> 2, tm = (q >> 1) & 1, tn = q & 1;
            const int s0 = seq * 256;
            gemm_tile<0>(p.ZtA + (long)s0 * 1024 + (long)tm * 256 * 512, 512, p.dftP + (long)tn * 128 * 512, 512, 512, (bf16_t*)smem, [&](int r, int c, f32x4 v) {
                const int cf = tm * 256 + r, k = tn * 128 + c;
                *(uint2*)(p.mix + (long)(s0 + k) * DM + 512 + cf) = make_uint2(pack2(v[0], v[1]), pack2(v[2], v[3]));
            });
        }
    }
}

__device__ __forceinline__ void ph_e_mix(CP& p, int j) {
    const int lane = ltid() & 63, wave = ltid() >> 6;
    const float* onw = p.gdn_o_norm + j * 128;
    const float w0 = onw[lane * 2], w1 = onw[lane * 2 + 1];
    const int rstep = gridDim.x * 8;
    int row = lbid() * 8 + wave;
    unsigned av[4], bv[4], gvv[4];
#define MIX_LOAD(R_, A_, B_, G_)                                                                                       \
    _Pragma("unroll") for (int h = 0; h < 4; ++h) {                                                                  \
        A_[h] = *(const unsigned*)(p.of + ((long)(R_) * 4 + h) * 128 + lane * 2);                                     \
        B_[h] = *(const unsigned*)(p.ob + ((long)(R_) * 4 + h) * 128 + lane * 2);                                     \
        G_[h] = *(const unsigned*)(p.gate + (long)(R_) * 512 + h * 128 + lane * 2);                                   \
    }
    {
        const int r0 = row < T_TOK ? row : T_TOK - 1;
        MIX_LOAD(r0, av, bv, gvv)
    }
    for (; row < T_TOK; row += rstep) {
        const int rn = row + rstep < T_TOK ? row + rstep : T_TOK - 1;
        unsigned an[4], bn[4], gn[4];
        MIX_LOAD(rn, an, bn, gn)
#pragma unroll
        for (int h = 0; h < 4; ++h) {
            const float o0 = bflo(av[h]) + bflo(bv[h]), o1 = bfhi(av[h]) + bfhi(bv[h]);
            const float ss = wave_sum(o0 * o0 + o1 * o1);
            const float r = rsqrtf(ss * (1.f / 128.f) + 1e-6f);
            *(unsigned*)(p.mix + (long)row * DM + h * 128 + lane * 2) = pack2(o0 * r * w0 * silu_f(bflo(gvv[h])), o1 * r * w1 * silu_f(bfhi(gvv[h])));
        }
#pragma unroll
        for (int h = 0; h < 4; ++h) { av[h] = an[h]; bv[h] = bn[h]; gvv[h] = gn[h]; }
    }
#undef MIX_LOAD
}

template <int FROM_INPUT = 0>
__device__ __forceinline__ void ph_out_gemm(CP& p, const bf16_t* A, const bf16_t* Wt, const float* mods_l, int g_off, char* smem, const float gscale = 1.f) {
    const int ntn = 4, ntm = T_TOK / 256;
#define OG_PROLOGUE(U) { int tm_, tn_; tile_map((U), ntm, ntn, tm_, tn_); g8_prologue<0>(A + (long)tm_ * 256 * DM, DM, Wt + (long)tn_ * 256 * 1024, 1024, (bf16_t*)smem); }
    int u = lbid();
    if (u < ntn * ntm) OG_PROLOGUE(u)
    for (; u < ntn * ntm; u += gridDim.x) {
        int tm, tn;
        tile_map(u, ntm, ntn, tm, tn);
        const int row0 = tm * 256, col0 = tn * 256;
        const float* gv = mods_l + (long)tok_modrow(row0) * 6144 + g_off;
        f32x4 acc[2][2][4][2];
        gemm_tile256_acc<0, 1>(A + (long)row0 * DM, DM, Wt + (long)col0 * 1024, 1024, 1024, (bf16_t*)smem, acc);
        if (u + (int)gridDim.x < ntn * ntm) OG_PROLOGUE(u + gridDim.x)
        const int tz = ltid(), wid = tz >> 6, lane = tz & 63, wr = wid >> 2, wc = wid & 3, fr = lane & 15, fq = lane >> 4;
#pragma unroll
        for (int ai = 0; ai < 2; ++ai)
#pragma unroll
            for (int bj = 0; bj < 2; ++bj) {
                const long xo = (long)(row0 + ai * 128 + wr * 64 + fq * 4) * DM + col0 + bj * 128 + wc * 32 + fr;
                float* xb = p.out + xo;
                const float* xs = FROM_INPUT ? (row0 < TP_TOK ? p.x_prompt + xo : p.x_sample + (xo - (long)TP_TOK * DM)) : xb;
                const float g0 = gv[col0 + bj * 128 + wc * 32 + fr] * gscale, g1 = gv[col0 + bj * 128 + wc * 32 + 16 + fr] * gscale;
                float xv[4][2][4];
#pragma unroll
                for (int m = 0; m < 4; ++m)
#pragma unroll
                    for (int n = 0; n < 2; ++n)
#pragma unroll
                        for (int i = 0; i < 4; ++i) xv[m][n][i] = xs[(long)(m * 16 + i) * DM + n * 16];
#pragma unroll
                for (int m = 0; m < 4; ++m)
#pragma unroll
                    for (int n = 0; n < 2; ++n)
#pragma unroll
                        for (int i = 0; i < 4; ++i) xb[(long)(m * 16 + i) * DM + n * 16] = xv[m][n][i] + (n ? g1 : g0) * acc[ai][bj][m][n][i];
            }
    }
#undef OG_PROLOGUE
}
__device__ __forceinline__ void ph_o_gemm1(CP& p, int j, char* smem) {
    const int ntn = N_OIN / 256, ntm = T_TOK / 256;
    const bf16_t* Bt = p.wtO_in + (long)j * N_OIN * 1024;
    for (int u = lbid(); u < ntn * ntm; u += gridDim.x) {
        int tm, tn;
        tile_map(u, ntm, ntn, tm, tn);
        const int row0 = tm * 256, col0 = tn * 256;
        gemm_tile256<0>(p.H + (long)row0 * DM, DM, Bt + (long)col0 * 1024, 1024, 1024, (bf16_t*)smem, [&](int r, int c, f32x4 v) {
            const int col = col0 + c;
            if (col < 832) {
#pragma unroll
                for (int i = 0; i < 4; ++i) p.Podd[(long)(row0 + r + i) * 832 + col] = v[i];
            }
        });
    }
}

__device__ __forceinline__ void ph_o_norm(CP& p, int j) {
    const int lane = ltid() & 63, wave = ltid() >> 6;
    float qw[8], kw[4];
#pragma unroll
    for (int i = 0; i < 8; ++i) qw[i] = p.mla_q_norm[j * 512 + i * 64 + lane];
#pragma unroll
    for (int i = 0; i < 4; ++i) kw[i] = p.mla_kv_norm[j * 256 + i * 64 + lane];
    for (int row = lbid() * 8 + wave; row < T_TOK + 2048; row += gridDim.x * 8) {
        if (row < T_TOK) {
            const float* pr = p.Podd + (long)row * 832;
            float q[8], k[4];
            float ssq = 0.f, ssk = 0.f;
#pragma unroll
            for (int i = 0; i < 8; ++i) { q[i] = pr[i * 64 + lane]; ssq += q[i] * q[i]; }
#pragma unroll
            for (int i = 0; i < 4; ++i) { k[i] = pr[512 + i * 64 + lane]; ssk += k[i] * k[i]; }
            const float kr = pr[768 + lane];
            ssq = wave_sum(ssq); ssk = wave_sum(ssk);
            const float rq = rsqrtf(ssq * (1.f / 512.f) + 1e-6f), rk = rsqrtf(ssk * (1.f / 256.f) + 1e-6f);
#pragma unroll
            for (int i = 0; i < 8; ++i) p.cq[(long)row * 512 + i * 64 + lane] = f2bf(q[i] * rq * qw[i]);
#pragma unroll
            for (int i = 0; i < 4; ++i) {
                const float v = k[i] * rk * kw[i];
                p.ckv_all[(long)row * 256 + i * 64 + lane] = f2bf(v);
                if (row < TP_TOK) p.out[OUT_CKV + (((long)(row >> 8) * 2 + j) * 256 + (row & 255)) * 256 + i * 64 + lane] = v;
            }
            p.kr_all[(long)row * 64 + lane] = kr;
            if (row < TP_TOK) p.out[OUT_KR + (((long)(row >> 8) * 2 + j) * 256 + (row & 255)) * 64 + lane] = kr;
        } else {
            const int rc = row - T_TOK, b = rc >> 8, t = rc & 255;
            const float* src = p.cache_ckv + (((long)b * 2 + j) * 256 + t) * 256;
#pragma unroll
            for (int i = 0; i < 4; ++i) p.ckv_all[(long)row * 256 + i * 64 + lane] = f2bf(src[i * 64 + lane]);
            p.kr_all[(long)row * 64 + lane] = p.cache_kr[(((long)b * 2 + j) * 256 + t) * 64 + lane];
        }
    }
}

#define KB_S (16L * 8 * 256 * 192)
#define VT_S (16L * 8 * 128 * 256)
__device__ __forceinline__ void ph_o_gemm2(CP& p, int j, char* smem) {
    const int nA = 6 * (T_TOK / 256);
    const int nB = 8 * ((T_TOK + 2048) / 256);
    for (int u = lbid(); u < nA + nB; u += gridDim.x) {
        if (u < nA) {
            int tm, tn;
            tile_map(u, T_TOK / 256, 6, tm, tn);
            const int row0 = tm * 256, col0 = tn * 256;
            const int s0 = tok_seq0(row0), L = tok_len(row0);
            f32x4 acc[2][2][4][2];
            gemm_tile256_acc<0>(p.cq + (long)row0 * 512, 512, p.wtUq + (long)j * 1536 * 512 + (long)col0 * 512, 512, 512, (bf16_t*)smem, acc);
            const int tz = ltid(), wid = tz >> 6, lane = tz & 63, wr = wid >> 2, wc = wid & 3, fr = lane & 15, fq = lane >> 4;
#pragma unroll
            for (int bj = 0; bj < 2; ++bj)
#pragma unroll
                for (int n = 0; n < 2; ++n) {
                    const int col = col0 + bj * 128 + wc * 32 + n * 16 + fr, h = col / 192, d = col - h * 192;
                    bf16_t* qd = p.Qb + (long)s0 * 1536 + ((long)h * L + (row0 - s0) + wr * 64 + fq * 4) * 192 + d;
#pragma unroll
                    for (int ai = 0; ai < 2; ++ai)
#pragma unroll
                        for (int m = 0; m < 4; ++m)
#pragma unroll
                            for (int i = 0; i < 4; ++i) qd[(ai * 128 + m * 16 + i) * 192] = f2bf(acc[ai][bj][m][n][i]);
                }
        } else {
            const int q = u - nA;
            int tm, tn;
            tile_map(q, (T_TOK + 2048) / 256, 8, tm, tn);
            const int row0 = tm * 256, col0 = tn * 256;
            long kbase, vbase; int Lk, pos0;
            if (row0 < TP_TOK) { const int s = row0 >> 8; kbase = (long)s * 8 * 256 * 192; vbase = (long)s * 8 * 128 * 256; Lk = 256; pos0 = 0; }
            else if (row0 < T_TOK) { const int b = (row0 - TP_TOK) >> 12; kbase = KB_S + (long)b * 8 * 4352 * 192; vbase = VT_S + (long)b * 8 * 128 * 4352; Lk = 4352; pos0 = (row0 - TP_TOK) & 4095; }
            else { const int b = (row0 - T_TOK) >> 8; kbase = KB_S + (long)b * 8 * 4352 * 192; vbase = VT_S + (long)b * 8 * 128 * 4352; Lk = 4352; pos0 = 4096; }
            f32x4 acc[2][2][4][2];
            gemm_tile256_acc<0>(p.ckv_all + (long)row0 * 256, 256, p.wtUkv + (long)j * 2048 * 256 + (long)col0 * 256, 256, 256, (bf16_t*)smem, acc);
            const int tz = ltid(), wid = tz >> 6, lane = tz & 63, wr = wid >> 2, wc = wid & 3, fr = lane & 15, fq = lane >> 4;
            const int h = tn;
            bf16_t* kd = p.Kb + kbase + ((long)h * Lk + pos0 + wr * 64 + fq * 4) * 192 + wc * 32 + fr;
#pragma unroll
            for (int ai = 0; ai < 2; ++ai)
#pragma unroll
                for (int m = 0; m < 4; ++m)
#pragma unroll
                    for (int i = 0; i < 4; ++i)
#pragma unroll
                        for (int n = 0; n < 2; ++n) kd[(ai * 128 + m * 16 + i) * 192 + n * 16] = f2bf(acc[ai][0][m][n][i]);
            bf16_t* vd = p.Vtb + vbase + ((long)h * 128 + wc * 32 + fr) * Lk;
#pragma unroll
            for (int ai = 0; ai < 2; ++ai)
#pragma unroll
                for (int m = 0; m < 4; ++m) {
                    const int kp = pos0 + ai * 128 + wr * 64 + m * 16 + fq * 4, kq = (kp & ~31) | (((kp >> 2) & 3) << 3) | (((kp >> 4) & 1) << 2);
#pragma unroll
                    for (int n = 0; n < 2; ++n) {
                        const f32x4 v = acc[ai][1][m][n];
                        *(uint2*)(vd + (long)n * 16 * Lk + kq) = make_uint2(pack2(v[0], v[1]), pack2(v[2], v[3]));
                    }
                }
        }
    }
}

__device__ __forceinline__ void ph_o_qknorm(CP& p, int j) {
    const int lane = ltid() & 63, wave = ltid() >> 6;
    const float* qnw = p.mla_q_headnorm + j * 192;
    const float* knw = p.mla_k_headnorm + j * 192;
    const float qw0 = qnw[lane], qw1 = qnw[64 + lane], qw2 = qnw[128 + lane];
    const float kw0 = knw[lane], kw1 = knw[64 + lane], kw2 = knw[128 + lane];
    const float inv = exp2f(-(float)(lane & 15) * 0.8304820237218406f);
    for (int row = lbid() * 8 + wave; row < T_TOK + 2048; row += gridDim.x * 8) {
        bool rope = false; float cs = 1.f, sn = 0.f;
        long kbase; int Lk, pos;
        if (row < TP_TOK) { const int s = row >> 8; kbase = (long)s * 8 * 256 * 192; Lk = 256; pos = row & 255; }
        else if (row < T_TOK) {
            const int b = (row - TP_TOK) >> 12; pos = (row - TP_TOK) & 4095; kbase = KB_S + (long)b * 8 * 4352 * 192; Lk = 4352; rope = true;
            const float ang = (float)((lane & 32) ? (pos & 63) : (pos >> 6)) * inv;
            sincosf(ang, &sn, &cs);
        } else { const int rc = row - T_TOK; const int b = rc >> 8; pos = 4096 + (rc & 255); kbase = KB_S + (long)b * 8 * 4352 * 192; Lk = 4352; }
        const float kr = p.kr_all[(long)row * 64 + lane];
        const bool hi = (lane & 16) != 0;
        const bool isq = row < T_TOK;
        const int s0 = isq ? tok_seq0(row) : 0, L = isq ? tok_len(row) : 1;
        bf16_t* kp0 = p.Kb + kbase + (long)pos * 192;
        bf16_t* qp0 = p.Qb + (long)s0 * 1536 + (long)(row - s0) * 192;
        float k0[8], k1[8], q0[8], q1[8], q2[8];
#pragma unroll
        for (int h = 0; h < 8; ++h) {
            const bf16_t* kp = kp0 + (long)h * Lk * 192;
            k0[h] = bf2f(kp[lane]); k1[h] = bf2f(kp[64 + lane]);
        }
        if (isq) {
#pragma unroll
            for (int h = 0; h < 8; ++h) {
                const bf16_t* qp = qp0 + (long)h * L * 192;
                q0[h] = bf2f(qp[lane]); q1[h] = bf2f(qp[64 + lane]); q2[h] = bf2f(qp[128 + lane]);
            }
        }
#pragma unroll
        for (int h = 0; h < 8; ++h) {
            bf16_t* kp = kp0 + (long)h * Lk * 192;
            const float ss = wave_sum(k0[h] * k0[h] + k1[h] * k1[h] + kr * kr);
            const float r = rsqrtf(ss * (1.f / 192.f) + 1e-6f);
            float y2 = kr * r * kw2;
            if (rope) {
                const float o = xshfl<16>(y2);
                y2 = hi ? (o * sn + y2 * cs) : (y2 * cs - o * sn);
            }
            kp[lane] = f2bf(k0[h] * r * kw0); kp[64 + lane] = f2bf(k1[h] * r * kw1); kp[128 + lane] = f2bf(y2);
        }
        if (isq) {
#pragma unroll
            for (int h = 0; h < 8; ++h) {
                bf16_t* qp = qp0 + (long)h * L * 192;
                const float ss = wave_sum(q0[h] * q0[h] + q1[h] * q1[h] + q2[h] * q2[h]);
                const float r = rsqrtf(ss * (1.f / 192.f) + 1e-6f) * 0.10411755f;
                float y2 = q2[h] * r * qw2;
                if (rope) {
                    const float o = xshfl<16>(y2);
                    y2 = hi ? (o * sn + y2 * cs) : (y2 * cs - o * sn);
                }
                qp[lane] = f2bf(q0[h] * r * qw0); qp[64 + lane] = f2bf(q1[h] * r * qw1); qp[128 + lane] = f2bf(y2);
            }
        }
    }
}

#define ATT_KLD 208
#define ATT_VLD 80
#define ATTN_SMEM_BYTES (2 * 64 * ATT_KLD * 2 + 3 * 128 * ATT_VLD * 2)
__device__ __forceinline__ void ph_o_attn(CP& p, char* smem) {
    for (int u = lbid(); u < 1152; u += gridDim.x) {
        int lz = 0, tid = ltid();
        asm volatile("" : "+s"(lz), "+v"(tid));
        const int lane = tid & 63, wave = tid >> 6;
        const int g = lane >> 4, cn = lane & 15, kg = g * 8;
        bf16_t* Ks = (bf16_t*)(smem + lz);
        bf16_t* Vs = Ks + 2 * 64 * ATT_KLD;
        int s0, L, Lk, h, q0; long kbase, vbase;
        if (u < 1024) { const int b = u >> 7; h = (u >> 4) & 7; q0 = (u & 15) * 256; s0 = TP_TOK + b * 4096; L = 4096; Lk = 4352; kbase = KB_S + (long)b * 8 * 4352 * 192; vbase = VT_S + (long)b * 8 * 128 * 4352; }
        else { const int q = u - 1024; const int s = q >> 3; h = q & 7; q0 = 0; s0 = s * 256; L = 256; Lk = 256; kbase = (long)s * 8 * 256 * 192; vbase = (long)s * 8 * 128 * 256; }
        const bf16_t* Qp = p.Qb + (long)s0 * 1536 + ((long)h * L + q0 + wave * 32) * 192;
        const bf16_t* Kp = p.Kb + kbase + (long)h * Lk * 192;
        const bf16_t* Vp = p.Vtb + vbase + (long)h * 128 * Lk;
        bf16x8 qb[2][6];
#pragma unroll
        for (int mt = 0; mt < 2; ++mt)
#pragma unroll
            for (int ks = 0; ks < 6; ++ks) qb[mt][ks] = *(const bf16x8*)(Qp + (mt * 16 + cn) * 192 + ks * 32 + kg);
        f32x4 o[8][2];
        f32x4 negm[2];
        float lrow[2];
#pragma unroll
        for (int mt = 0; mt < 2; ++mt) {
#pragma unroll
            for (int dt = 0; dt < 8; ++dt) o[dt][mt] = (f32x4){0.f, 0.f, 0.f, 0.f};
            negm[mt] = (f32x4){0.f, 0.f, 0.f, 0.f}; lrow[mt] = 0.f;
        }
        const int nkt = Lk / 64;
        u32x4 rk[3], rv[2];
        f32x4 s[4][2];
        bf16x8 pb[2][2];
        bf16x8 fa[2][4];
#define ATT_SB() __builtin_amdgcn_sched_barrier(0)
#define ATT_LDK(dst_, Kc_, ks_) _Pragma("unroll") for (int nt = 0; nt < 4; ++nt) dst_[nt] = *(const bf16x8*)((Kc_) + (nt * 16 + cn) * ATT_KLD + (ks_) * 32 + kg)
#define ATT_LDV(dst_, Vc_, b_) _Pragma("unroll") for (int d4 = 0; d4 < 4; ++d4) dst_[d4] = *(const bf16x8*)((Vc_) + ((((b_) & 1) * 4 + d4) * 16 + cn) * ATT_VLD + ((b_) >> 1) * 32 + kg)
        float pv[2][4][4];
#define ATT_LDK2(dst_, Kc_, h_, ks_) _Pragma("unroll") for (int n_ = 0; n_ < 2; ++n_) dst_[n_] = *(const bf16x8*)((Kc_) + ((2 * (h_) + n_) * 16 + cn) * ATT_KLD + (ks_) * 32 + kg)
#define ATT_PACK(mt_, k2_)                                                                                             \
        {                                                                                                              \
            u32x4 w_;                                                                                                  \
            w_[0] = pack2(pv[mt_][2 * (k2_)][0], pv[mt_][2 * (k2_)][1]); w_[1] = pack2(pv[mt_][2 * (k2_)][2], pv[mt_][2 * (k2_)][3]);   \
            w_[2] = pack2(pv[mt_][2 * (k2_) + 1][0], pv[mt_][2 * (k2_) + 1][1]); w_[3] = pack2(pv[mt_][2 * (k2_) + 1][2], pv[mt_][2 * (k2_) + 1][3]);   \
            pb[mt_][k2_] = __builtin_bit_cast(bf16x8, w_);                                                             \
        }
#define ATT_QK(Kc_, Vc_)                                                                                               \
        {                                                                                                              \
            ATT_LDK2(fa[0], Kc_, 0, 0);                                                                                \
            _Pragma("unroll") for (int t_ = 0; t_ < 12; ++t_) {                                                      \
                const int h_ = t_ / 6, ks = t_ % 6;                                                                    \
                if (t_ < 11) { ATT_LDK2(fa[(t_ + 1) & 1], Kc_, (t_ + 1) / 6, (t_ + 1) % 6); } else { ATT_LDV(fa[0], Vc_, 0); }   \
                ATT_SB();                                                                                              \
                _Pragma("unroll") for (int n_ = 0; n_ < 2; ++n_)                                                     \
                    _Pragma("unroll") for (int mt = 0; mt < 2; ++mt)                                                 \
                        s[2 * h_ + n_][mt] = __builtin_amdgcn_mfma_f32_16x16x32_bf16(fa[t_ & 1][n_], qb[mt][ks], ks == 0 ? negm[mt] : s[2 * h_ + n_][mt], 0, 0, 0);   \
                if (h_ == 1 && ks < 4) {                                                                               \
                    _Pragma("unroll") for (int r = 0; r < 4; ++r) pv[ks >> 1][ks & 1][r] = __builtin_amdgcn_exp2f(s[ks & 1][ks >> 1][r]);   \
                }                                                                                                      \
                if (h_ == 1 && ks >= 4) ATT_PACK(ks - 4, 0)                                                            \
                if (t_ < 11) ATT_SB();                                                                                 \
            }                                                                                                          \
        }
#define ATT_PBIG 4096.f
#define ATT_SOFTMAX(first_)                                                                                            \
        {                                                                                                              \
            float ps[2];                                                                                               \
            _Pragma("unroll") for (int mt = 0; mt < 2; ++mt) {                                                       \
                _Pragma("unroll") for (int nt = 2; nt < 4; ++nt)                                                     \
                    _Pragma("unroll") for (int r = 0; r < 4; ++r) pv[mt][nt][r] = __builtin_amdgcn_exp2f(s[nt][mt][r]);   \
                ps[mt] = 0.f;                                                                                          \
                _Pragma("unroll") for (int nt = 0; nt < 4; ++nt)                                                     \
                    _Pragma("unroll") for (int r = 0; r < 4; ++r) ps[mt] += pv[mt][nt][r];                           \
            }                                                                                                          \
            const bool ok = !(first_) && ps[0] <= ATT_PBIG && ps[1] <= ATT_PBIG;                                       \
            if (!__all(ok)) {                                                                                          \
                _Pragma("unroll") for (int mt = 0; mt < 2; ++mt) {                                                   \
                    float mx = fmaxf(fmaxf(s[0][mt][0], s[0][mt][1]), fmaxf(s[0][mt][2], s[0][mt][3]));               \
                    _Pragma("unroll") for (int nt = 1; nt < 4; ++nt) mx = fmaxf(mx, fmaxf(fmaxf(s[nt][mt][0], s[nt][mt][1]), fmaxf(s[nt][mt][2], s[nt][mt][3])));   \
                    mx = fmaxf(mx, xshfl<16>(mx));                                                                     \
                    mx = fmaxf(mx, xshfl<32>(mx));                                                                     \
                    const float dl = (first_) ? mx : fmaxf(mx, 0.f);                                                   \
                    const float al = (first_) ? 1.f : __builtin_amdgcn_exp2f(-dl);                                     \
                    negm[mt] = negm[mt] - dl;                                                                          \
                    lrow[mt] *= al;                                                                                    \
                    _Pragma("unroll") for (int dt = 0; dt < 8; ++dt) o[dt][mt] = o[dt][mt] * al;                     \
                    ps[mt] = 0.f;                                                                                      \
                    _Pragma("unroll") for (int nt = 0; nt < 4; ++nt)                                                 \
                        _Pragma("unroll") for (int r = 0; r < 4; ++r) { pv[mt][nt][r] = __builtin_amdgcn_exp2f(s[nt][mt][r] - dl); ps[mt] += pv[mt][nt][r]; }   \
                    ATT_PACK(mt, 0)                                                                                    \
                }                                                                                                      \
            }                                                                                                          \
            _Pragma("unroll") for (int mt = 0; mt < 2; ++mt) {                                                       \
                lrow[mt] += ps[mt];                                                                                    \
                ATT_PACK(mt, 1)                                                                                        \
            }                                                                                                          \
        }
#define ATT_PV(Vc_)                                                                                                    \
        {                                                                                                              \
            _Pragma("unroll") for (int b = 0; b < 4; ++b) {                                                          \
                if (b < 3) { ATT_LDV(fa[(b + 1) & 1], Vc_, b + 1); }                                                   \
                ATT_SB();                                                                                              \
                _Pragma("unroll") for (int d4 = 0; d4 < 4; ++d4)                                                     \
                    _Pragma("unroll") for (int mt = 0; mt < 2; ++mt) o[(b & 1) * 4 + d4][mt] = __builtin_amdgcn_mfma_f32_16x16x32_bf16(fa[b & 1][d4], pb[mt][b >> 1], o[(b & 1) * 4 + d4][mt], 0, 0, 0);   \
                ATT_SB();                                                                                              \
            }                                                                                                          \
        }
        __syncthreads();
#pragma unroll
        for (int i = 0; i < 3; ++i) { const int ch = tid + i * 512, row = ch / 24, kc = ch % 24; rk[i] = *(const u32x4*)(Kp + (long)row * 192 + kc * 8); }
#pragma unroll
        for (int i = 0; i < 2; ++i) { const int ch = tid + i * 512, row = ch >> 3, kc = ch & 7; rv[i] = *(const u32x4*)(Vp + (long)row * Lk + kc * 8); }
#pragma unroll
        for (int i = 0; i < 3; ++i) { const int ch = tid + i * 512, row = ch / 24, kc = ch % 24; *(u32x4*)(Ks + row * ATT_KLD + kc * 8) = rk[i]; }
#pragma unroll
        for (int i = 0; i < 2; ++i) { const int ch = tid + i * 512, row = ch >> 3, kc = ch & 7; *(u32x4*)(Vs + row * ATT_VLD + kc * 8) = rv[i]; }
        __syncthreads();
        for (int it = 0; it < nkt; ++it) {
            const int cur = it & 1;
            const bool more = it + 1 < nkt;
            const long key0 = (long)(it + 1) * 64;
            if (more) {
#pragma unroll
                for (int i = 0; i < 3; ++i) { const int ch = tid + i * 512, row = ch / 24, kc = ch % 24; rk[i] = *(const u32x4*)(Kp + (key0 + row) * 192 + kc * 8); }
#pragma unroll
                for (int i = 0; i < 2; ++i) { const int ch = tid + i * 512, row = ch >> 3, kc = ch & 7; rv[i] = *(const u32x4*)(Vp + (long)row * Lk + key0 + kc * 8); }
            }
            const bf16_t* Kc = Ks + cur * 64 * ATT_KLD;
            ATT_QK(Kc, Vs + cur * 128 * ATT_VLD) ATT_SOFTMAX(it == 0) ATT_PV(Vs + cur * 128 * ATT_VLD)
            if (more) {
                bf16_t* Kn = Ks + (cur ^ 1) * 64 * ATT_KLD;
                bf16_t* Vn = Vs + (cur ^ 1) * 128 * ATT_VLD;
#pragma unroll
                for (int i = 0; i < 3; ++i) { const int ch = tid + i * 512, row = ch / 24, kc = ch % 24; *(u32x4*)(Kn + row * ATT_KLD + kc * 8) = rk[i]; }
#pragma unroll
                for (int i = 0; i < 2; ++i) { const int ch = tid + i * 512, row = ch >> 3, kc = ch & 7; *(u32x4*)(Vn + row * ATT_VLD + kc * 8) = rv[i]; }
            }
            __syncthreads();
        }
#undef ATT_QK
#undef ATT_SB
#undef ATT_LDK
#undef ATT_LDV
#undef ATT_SOFTMAX
#undef ATT_LDK2
#undef ATT_PACK
#undef ATT_PBIG
#undef ATT_PV
#pragma unroll
        for (int mt = 0; mt < 2; ++mt) {
            float l = lrow[mt];
            l += xshfl<16>(l); l += xshfl<32>(l);
            const float il = __builtin_amdgcn_rcpf(l);
            bf16_t* op = p.Ob + (long)(s0 + q0 + wave * 32 + mt * 16 + cn) * DM + h * 128 + 4 * g;
#pragma unroll
            for (int dt = 0; dt < 8; ++dt)
                *(uint2*)(op + dt * 16) = make_uint2(pack2(o[dt][mt][0] * il, o[dt][mt][1] * il), pack2(o[dt][mt][2] * il, o[dt][mt][3] * il));
        }
    }
}
__device__ __forceinline__ unsigned f2ord(float f) { const unsigned u = __float_as_uint(f); return u ^ ((u >> 31) ? 0xFFFFFFFFu : 0x80000000u); }
__device__ __forceinline__ float ord2f(unsigned o) { const unsigned u = (o >> 31) ? (o ^ 0x80000000u) : ~o; return __uint_as_float(u); }

#define KCE(a, b) { const unsigned hi_ = max(a, b), lo_ = min(a, b); a = hi_; b = lo_; }
__device__ __forceinline__ void sort16_desc(unsigned (&v)[16]) {
#define S2(a, b) KCE(v[a], v[b])
    S2(0, 13) S2(1, 12) S2(2, 15) S2(3, 14) S2(4, 8) S2(5, 6) S2(7, 11) S2(9, 10)
    S2(0, 5) S2(1, 7) S2(2, 9) S2(3, 4) S2(6, 13) S2(8, 14) S2(10, 15) S2(11, 12)
    S2(0, 1) S2(2, 3) S2(4, 5) S2(6, 8) S2(7, 9) S2(10, 11) S2(12, 13) S2(14, 15)
    S2(0, 2) S2(1, 3) S2(4, 10) S2(5, 11) S2(6, 7) S2(8, 9) S2(12, 14) S2(13, 15)
    S2(1, 2) S2(3, 12) S2(4, 6) S2(5, 7) S2(8, 10) S2(9, 11) S2(13, 14)
    S2(1, 4) S2(2, 6) S2(5, 8) S2(7, 10) S2(9, 13) S2(11, 14)
    S2(2, 4) S2(3, 6) S2(9, 12) S2(11, 13)
    S2(3, 5) S2(6, 8) S2(7, 9) S2(10, 12)
    S2(3, 4) S2(5, 6) S2(7, 8) S2(9, 10) S2(11, 12)
    S2(6, 7) S2(8, 9)
#undef S2
}
#define KCF(a, b) { const float hi_ = __builtin_fmaxf(a, b), lo_ = __builtin_fminf(a, b); a = hi_; b = lo_; }
__device__ __forceinline__ void sort16f_desc(float (&v)[16]) {
#define S2(a, b) KCF(v[a], v[b])
    S2(0, 13) S2(1, 12) S2(2, 15) S2(3, 14) S2(4, 8) S2(5, 6) S2(7, 11) S2(9, 10)
    S2(0, 5) S2(1, 7) S2(2, 9) S2(3, 4) S2(6, 13) S2(8, 14) S2(10, 15) S2(11, 12)
    S2(0, 1) S2(2, 3) S2(4, 5) S2(6, 8) S2(7, 9) S2(10, 11) S2(12, 13) S2(14, 15)
    S2(0, 2) S2(1, 3) S2(4, 10) S2(5, 11) S2(6, 7) S2(8, 9) S2(12, 14) S2(13, 15)
    S2(1, 2) S2(3, 12) S2(4, 6) S2(5, 7) S2(8, 10) S2(9, 11) S2(13, 14)
    S2(1, 4) S2(2, 6) S2(5, 8) S2(7, 10) S2(9, 13) S2(11, 14)
    S2(2, 4) S2(3, 6) S2(9, 12) S2(11, 13)
    S2(3, 5) S2(6, 8) S2(7, 9) S2(10, 12)
    S2(3, 4) S2(5, 6) S2(7, 8) S2(9, 10) S2(11, 12)
    S2(6, 7) S2(8, 9)
#undef S2
}
__device__ __forceinline__ void merge16f_desc(float (&a)[16], const float (&b)[16]) {
#pragma unroll
    for (int i = 0; i < 16; ++i) a[i] = __builtin_fmaxf(a[i], b[15 - i]);
#pragma unroll
    for (int j = 8; j > 0; j >>= 1)
#pragma unroll
        for (int i = 0; i < 16; ++i) {
            const int l = i ^ j;
            if (l > i) { KCF(a[i], a[l]) }
        }
}
__device__ __forceinline__ void merge16_desc(unsigned (&a)[16], const unsigned (&b)[16]) {
#pragma unroll
    for (int i = 0; i < 16; ++i) a[i] = max(a[i], b[15 - i]);
#pragma unroll
    for (int j = 8; j > 0; j >>= 1)
#pragma unroll
        for (int i = 0; i < 16; ++i) {
            const int l = i ^ j;
            if (l > i) { KCE(a[i], a[l]) }
        }
}

#define RT_QLD 144
#define RT_SLD 130
#define ROUTE_SMEM_BYTES (256 * RT_SLD * 4 + 256 * 32)
__device__ __forceinline__ void ph_p_route(CP& p, int l, char* smem) {
    const int ntm = T_TOK / 256;
    const bf16_t* Bt = p.wtPq + (long)l * 2048 * 1024;
    for (int u = lbid(); u < 8 * ntm; u += gridDim.x) {
        int tm, h;
        tile_map(u, ntm, 8, tm, h);
        const int row0 = tm * 256;
        bf16_t* Qs = (bf16_t*)smem;
        bf16_t* SK = (bf16_t*)(smem + 65536);
        float* sc = (float*)smem;
        unsigned char* ib = (unsigned char*)smem + 256 * RT_SLD * 4;
        __syncthreads();
        f32x4 acc[2][2][4][2];
        gemm_tile256_acc<0>(p.H + (long)row0 * DM, DM, Bt + (long)h * 256 * 1024, 1024, 1024, (bf16_t*)smem, acc);
        const int tid = ltid(), lane = tid & 63, wave = tid >> 6;
        const int g4 = (lane >> 4) * 4, cn = lane & 15, kg = (lane >> 4) * 8;
        const int wr = wave >> 2, wc = wave & 3, fr = cn, fq = lane >> 4;
        const int trow = tid >> 1, half = tid & 1;
        float top[2][16];
#pragma unroll
        for (int pp = 0; pp < 2; ++pp) {
            const bf16_t* skg = p.subk + ((long)l * 16 + h * 2 + pp) * 128 * 128;
            u32x4 kv[4];
#pragma unroll
            for (int i = 0; i < 4; ++i) kv[i] = *(const u32x4*)(skg + (tid + i * NTHREADS) * 8);
            __syncthreads();
#pragma unroll
            for (int ai = 0; ai < 2; ++ai)
#pragma unroll
                for (int m = 0; m < 4; ++m)
#pragma unroll
                    for (int n = 0; n < 2; ++n) {
                        const f32x4 v = acc[ai][pp][m][n];
                        *(uint2*)((char*)Qs + ai * 32768 + SCAN_KOFF(wc * 32 + n * 16 + fr, wr * 8 + m * 2 + (fq >> 1)) + (fq & 1) * 8) = make_uint2(pack2(v[0], v[1]), pack2(v[2], v[3]));
                    }
#pragma unroll
            for (int i = 0; i < 4; ++i) { const int ch = tid + i * NTHREADS; *(u32x4*)(SK + (ch >> 4) * RT_QLD + (ch & 15) * 8) = kv[i]; }
            __syncthreads();
            f32x4 sacc[2][8];
#pragma unroll
            for (int mt = 0; mt < 2; ++mt)
#pragma unroll
                for (int nt = 0; nt < 8; ++nt) sacc[mt][nt] = (f32x4){0.f, 0.f, 0.f, 0.f};
            {
                const int q_ = (lane >> 2) & 3, pp_ = lane & 3;
                const char* qi = (const char*)Qs + (wave >> 2) * 32768;
#pragma unroll
                for (int ks = 0; ks < 4; ++ks) {
                    bf16x8 bfr[8];
#pragma unroll
                    for (int nt = 0; nt < 8; ++nt) bfr[nt] = *(const bf16x8*)(SK + (nt * 16 + cn) * RT_QLD + ks * 32 + kg);
#pragma unroll
                    for (int mt = 0; mt < 2; ++mt) {
                        const int d0 = ks * 32 + fq * 8 + q_, chk = (wave & 3) * 4 + mt * 2 + (pp_ >> 1);
                        const s16x4 lo = __builtin_amdgcn_ds_read_tr16_b64_v4i16((__attribute__((address_space(3))) s16x4*)(qi + SCAN_KOFF(d0, chk) + 8 * (pp_ & 1)));
                        const s16x4 hi = __builtin_amdgcn_ds_read_tr16_b64_v4i16((__attribute__((address_space(3))) s16x4*)(qi + SCAN_KOFF(d0 + 4, chk) + 8 * (pp_ & 1)));
                        const bf16x8 afr = __builtin_shufflevector(lo, hi, 0, 1, 2, 3, 4, 5, 6, 7);
#pragma unroll
                        for (int nt = 0; nt < 8; ++nt) sacc[mt][nt] = __builtin_amdgcn_mfma_f32_16x16x32_bf16(afr, bfr[nt], sacc[mt][nt], 0, 0, 0);
                    }
                }
            }
            __syncthreads();
#pragma unroll
            for (int mt = 0; mt < 2; ++mt)
#pragma unroll
                for (int nt = 0; nt < 8; ++nt)
#pragma unroll
                    for (int r = 0; r < 4; ++r) sc[(wave * 32 + mt * 16 + g4 + r) * RT_SLD + nt * 16 + cn] = sacc[mt][nt][r];
            __syncthreads();
            const float* srow = sc + trow * RT_SLD + half;
#pragma unroll
            for (int grp = 0; grp < 4; ++grp) {
                float v[16];
#pragma unroll
                for (int i = 0; i < 16; ++i) {
                    const int k = grp * 16 + i;
                    v[i] = __uint_as_float((__float_as_uint(srow[2 * k]) & 0xFFFFFF00u) | (unsigned)(2 * k));
                }
                sort16f_desc(v);
                if (grp == 0) {
#pragma unroll
                    for (int i = 0; i < 16; ++i) top[pp][i] = v[i];
                } else merge16f_desc(top[pp], v);
            }
            float oth[16];
#pragma unroll
            for (int i = 0; i < 16; ++i) top[pp][i] = __uint_as_float(__float_as_uint(top[pp][i]) | (unsigned)half);
#pragma unroll
            for (int i = 0; i < 16; ++i) oth[i] = xshfl<1>(top[pp][i]);
            merge16f_desc(top[pp], oth);
        }
        if (half == 0) {
            float s0[16], s1[16];
            unsigned iw[8];
#pragma unroll
            for (int i = 0; i < 8; ++i) iw[i] = 0u;
#pragma unroll
            for (int i = 0; i < 16; ++i) {
                s0[i] = __uint_as_float((__float_as_uint(top[0][i]) & 0xFFFFFF00u) | 0x80u);
                s1[i] = __uint_as_float((__float_as_uint(top[1][i]) & 0xFFFFFF00u) | 0x80u);
                iw[i >> 2] |= (__float_as_uint(top[0][i]) & 0xFFu) << ((i & 3) * 8);
                iw[4 + (i >> 2)] |= (__float_as_uint(top[1][i]) & 0xFFu) << ((i & 3) * 8);
            }
            unsigned* ibw = (unsigned*)(ib + trow * 32);
#pragma unroll
            for (int i = 0; i < 8; ++i) ibw[i] = iw[i];
            float ct[16];
            {
                float cg[4][16];
#pragma unroll
                for (int g_ = 0; g_ < 4; ++g_)
#pragma unroll
                    for (int i = 0; i < 16; ++i) cg[g_][i] = -3.0e38f;
                int cnt = 0;
#pragma unroll
                for (int a2 = 0; a2 < 16; ++a2)
#pragma unroll
                    for (int b2 = 0; b2 < 16; ++b2)
                        if ((a2 + 1) * (b2 + 1) <= 16) {
                            cg[cnt >> 4][cnt & 15] = __uint_as_float((__float_as_uint(s0[a2] + s1[b2]) & 0xFFFFFF00u) | (unsigned)(255 - (a2 * 16 + b2)));
                            ++cnt;
                        }
                if (s0[0] + s1[15] < 0.f) sort16f_desc(cg[0]);
                sort16f_desc(cg[1]); sort16f_desc(cg[2]);
                KCF(cg[3][0], cg[3][1])
#pragma unroll
                for (int i = 0; i < 16; ++i) ct[i] = cg[0][i];
                merge16f_desc(ct, cg[1]); merge16f_desc(ct, cg[2]); merge16f_desc(ct, cg[3]);
            }
            float cv[16];
#pragma unroll
            for (int i = 0; i < 16; ++i) cv[i] = __uint_as_float((__float_as_uint(ct[i]) & 0xFFFFFF00u) | 0x80u);
            const float mx = cv[0];
            float sum = 0.f;
#pragma unroll
            for (int i = 0; i < 16; ++i) { cv[i] = __expf(cv[i] - mx); sum += cv[i]; }
            const float inv = 1.f / sum;
            const long ob = ((long)(row0 + trow) * 8 + h) * 16;
            asm volatile("s_waitcnt lgkmcnt(0)" ::: "memory");
            const unsigned char* ibr = ib + trow * 32;
#pragma unroll
            for (int i = 0; i < 16; ++i) {
                const int fl = 255 - (int)(__float_as_uint(ct[i]) & 255u), a2 = fl >> 4, b2 = fl & 15;
                p.eidx[ob + i] = (int)ibr[a2] * 128 + (int)ibr[16 + b2];
                p.pgate[ob + i] = cv[i] * inv;
            }
        }
    }
}

#define PE_T 2
#define PE_LOADU(RA, BB, T_)                                                                                       \
    _Pragma("unroll") for (int k_ = 0; k_ < 8; ++k_) {                                                           \
        const int kk_ = (BB) * 8 + k_;                                                                           \
        const int e_ = __builtin_amdgcn_readlane((BB) < 8 ? e0[T_] : e1[T_], kk_ & 63);                          \
        RA[k_] = *(const u32x4*)(tabu + (long)e_ * 1024);                                                        \
    }
#define PE_LOADV(RA, BB, T_)                                                                                       \
    _Pragma("unroll") for (int k_ = 0; k_ < 8; ++k_) {                                                           \
        const int kk_ = (BB) * 8 + k_;                                                                           \
        const int e_ = __builtin_amdgcn_readlane((BB) < 8 ? e0[T_] : e1[T_], kk_ & 63);                          \
        RA[k_] = *(const u32x4*)(tabv + (long)e_ * 1024);                                                        \
    }
#define PE_X1(v_) __builtin_amdgcn_mov_dpp((int)(v_), 0xB1, 0xF, 0xF, true)
#define PE_X2(v_) __builtin_amdgcn_mov_dpp((int)(v_), 0x4E, 0xF, 0xF, true)
#define PE_X4(v_) __builtin_amdgcn_update_dpp(__builtin_amdgcn_update_dpp(0, (int)(v_), 0x104, 0xF, 0x5, false), (int)(v_), 0x114, 0xF, 0xA, false)
#define PE_X8(v_) __builtin_amdgcn_mov_dpp((int)(v_), 0x128, 0xF, 0xF, true)
#define PE_BREV(k_) ((((k_) & 1) << 2) | ((k_) & 2) | (((k_) >> 2) & 1))
#define PE_DOT(UA, BB, T_)                                                                                         \
    {                                                                                                              \
        int d_[8];                                                                                                 \
        _Pragma("unroll") for (int k_ = 0; k_ < 8; ++k_) {                                                       \
            int a_ = __builtin_amdgcn_sdot4((int)UA[k_][0], qx[T_][0], 0, false);                                \
            a_ = __builtin_amdgcn_sdot4((int)UA[k_][1], qx[T_][1], a_, false);                                   \
            a_ = __builtin_amdgcn_sdot4((int)UA[k_][2], qx[T_][2], a_, false);                                   \
            d_[k_] = __builtin_amdgcn_sdot4((int)UA[k_][3], qx[T_][3], a_, false);                               \
        }                                                                                                          \
               \
        int t4_[4], t2_[2], t1_;                                                                                   \
        _Pragma("unroll") for (int i_ = 0; i_ < 4; ++i_) { const int snd_ = b2 ? d_[i_] : d_[i_ + 4]; const int kp_ = b2 ? d_[i_ + 4] : d_[i_]; t4_[i_] = kp_ + PE_X4(snd_); } \
        _Pragma("unroll") for (int i_ = 0; i_ < 2; ++i_) { const int snd_ = b1 ? t4_[i_] : t4_[i_ + 2]; const int kp_ = b1 ? t4_[i_ + 2] : t4_[i_]; t2_[i_] = kp_ + PE_X2(snd_); } \
        { const int snd_ = b0 ? t2_[0] : t2_[1]; const int kp_ = b0 ? t2_[1] : t2_[0]; t1_ = kp_ + PE_X1(snd_); }  \
        t1_ += PE_X8(t1_);                                                                                         \
        t1_ += xshfl_i<16>(t1_);                                                                                       \
        t1_ += xshfl_i<32>(t1_);                                                                                       \
                                         \
        const bool mine_ = (lane >> 3) == ((BB) & 7);                                                              \
        hlo[T_] = (mine_ && (BB) < 8) ? t1_ : hlo[T_];                                                             \
        hhi[T_] = (mine_ && (BB) >= 8) ? t1_ : hhi[T_];                                                            \
    }
#define PE_AXPY(VA, BB, T_)                                                                                        \
    {                                                                                                              \
        const unsigned psel_ = (BB) < 8 ? pklo[T_] : pkhi[T_];                                                     \
        _Pragma("unroll") for (int h_ = 0; h_ < 2; ++h_) {                                                       \
            const int wp_ = __builtin_amdgcn_readlane((int)psel_, ((BB) & 7) * 8 + h_ * 4);                        \
            _Pragma("unroll") for (int i_ = 0; i_ < 4; ++i_) {                                                   \
                const unsigned a_ = VA[h_ * 4][i_], b_ = VA[h_ * 4 + 1][i_], c_ = VA[h_ * 4 + 2][i_], d_ = VA[h_ * 4 + 3][i_];   \
                const unsigned t0_ = __builtin_amdgcn_perm(b_, a_, 0x05010400u), t1_ = __builtin_amdgcn_perm(b_, a_, 0x07030602u);   \
                const unsigned t2_ = __builtin_amdgcn_perm(d_, c_, 0x05010400u), t3_ = __builtin_amdgcn_perm(d_, c_, 0x07030602u);   \
                acc[T_][i_ * 4 + 0] = __builtin_amdgcn_sdot4((int)__builtin_amdgcn_perm(t2_, t0_, 0x05040100u), wp_, acc[T_][i_ * 4 + 0], false);   \
                acc[T_][i_ * 4 + 1] = __builtin_amdgcn_sdot4((int)__builtin_amdgcn_perm(t2_, t0_, 0x07060302u), wp_, acc[T_][i_ * 4 + 1], false);   \
                acc[T_][i_ * 4 + 2] = __builtin_amdgcn_sdot4((int)__builtin_amdgcn_perm(t3_, t1_, 0x05040100u), wp_, acc[T_][i_ * 4 + 2], false);   \
                acc[T_][i_ * 4 + 3] = __builtin_amdgcn_sdot4((int)__builtin_amdgcn_perm(t3_, t1_, 0x07060302u), wp_, acc[T_][i_ * 4 + 3], false);   \
            }                                                                                                      \
        }                                                                                                          \
    }
template <int NEXT = 0>
__device__ __forceinline__ void ph_p_eval(CP& p, const float* mods_l, int l, const float* w_next, const float* mods_next, const float gscale = 1.f) {
    const int lane = ltid() & 63, wave = ltid() >> 6;
    const bool b0 = (lane & 1) != 0, b1 = (lane & 2) != 0, b2 = (lane & 4) != 0;
    const int rstride = gridDim.x * 8;
    const int first = lbid() * 8 + wave;
    const int ntok = (T_TOK - first + rstride - 1) / rstride;
    const int nsweep = __builtin_amdgcn_readfirstlane((T_TOK - lbid() * 8 + rstride - 1) / rstride + PE_T - 1) / PE_T;
    const unsigned char* tabu = p.tabU + (long)(l & 1) * 16384 * 2048 + lane * 16;
    const unsigned char* tabv = tabu + 16384L * 1024;
    const float* su_ = p.su + (l & 1) * 32768; const float* sv_ = su_ + 16384;
    u32x4 hpa[PE_T], hpb[PE_T]; unsigned kp0[PE_T], kp1[PE_T];
#define PE_PREFETCH(SW)                                                                                            \
    _Pragma("unroll") for (int t = 0; t < PE_T; ++t) {                                                           \
        const int ti_ = (SW) * PE_T + t;                                                                           \
        const long row_ = first + (ti_ < ntok ? ti_ : 0) * rstride;                                                \
        hpa[t] = *(const u32x4*)(p.H + row_ * DM + lane * 16); hpb[t] = *(const u32x4*)(p.H + row_ * DM + lane * 16 + 8);   \
        kp0[t] = (unsigned)p.eidx[row_ * 128 + lane]; kp1[t] = (unsigned)p.eidx[row_ * 128 + 64 + lane];          \
    }
    int e0[PE_T], e1[PE_T];
    float sgu0[PE_T], sgu1[PE_T], sgv0[PE_T], sgv1[PE_T];
    u32x4 rA[8], rB[8];
#define PE_SORT(SW)                                                                                                \
    _Pragma("unroll") for (int t = 0; t < PE_T; ++t) {                                                           \
        const int ti_ = (SW) * PE_T + t;                                                                           \
        const long row_ = first + (ti_ < ntok ? ti_ : 0) * rstride;                                                \
          \
        unsigned k0 = (kp0[t] << 7) | (unsigned)lane;                                                              \
        unsigned k1 = (kp1[t] << 7) | (unsigned)(64 + lane);                                                       \
        _Pragma("unroll") for (int size = 2; size <= 128; size <<= 1) {                                          \
            _Pragma("unroll") for (int stride = size >> 1; stride > 0; stride >>= 1) {                           \
                if (stride == 64) {                                                                                \
                    const unsigned lo = min(k0, k1), hi = max(k0, k1);                                             \
                    k0 = lo; k1 = hi;                                                                              \
                } else {                                                                                           \
                    unsigned o0, o1;                                                                               \
                    if (stride == 1) { o0 = (unsigned)PE_X1(k0); o1 = (unsigned)PE_X1(k1); }                       \
                    else if (stride == 2) { o0 = (unsigned)PE_X2(k0); o1 = (unsigned)PE_X2(k1); }                  \
                    else if (stride == 4) { o0 = (unsigned)PE_X4(k0); o1 = (unsigned)PE_X4(k1); }                  \
                    else if (stride == 8) { o0 = (unsigned)PE_X8(k0); o1 = (unsigned)PE_X8(k1); }                  \
                    else if (stride == 16) { o0 = (unsigned)xshfl_i<16>((int)k0); o1 = (unsigned)xshfl_i<16>((int)k1); }   \
                    else { o0 = (unsigned)xshfl_i<32>((int)k0); o1 = (unsigned)xshfl_i<32>((int)k1); }             \
                    const bool lower = (lane & stride) == 0;                                                       \
                    const bool asc0 = size == 128 ? true : ((lane & size) == 0);                                   \
                    const bool asc1 = size == 128 ? true : (((lane + 64) & size) == 0);                            \
                    k0 = (lower == asc0) ? min(k0, o0) : max(k0, o0);                                              \
                    k1 = (lower == asc1) ? min(k1, o1) : max(k1, o1);                                              \
                }                                                                                                  \
            }                                                                                                      \
        }                                                                                                          \
        e0[t] = (int)(k0 >> 7); e1[t] = (int)(k1 >> 7);                                                            \
        const int sl0 = (int)(k0 & 127u), sl1 = (int)(k1 & 127u);                                                  \
          \
        sgu0[t] = su_[e0[t]]; sgu1[t] = su_[e1[t]];                                                                \
        sgv0[t] = p.pgate[row_ * 128 + sl0] * sv_[e0[t]]; sgv1[t] = p.pgate[row_ * 128 + sl1] * sv_[e1[t]];        \
    }
    PE_PREFETCH(0)
    PE_SORT(0)
    PE_LOADU(rA, 0, 0)
    for (int sw = 0; sw < nsweep; ++sw) {
        __syncthreads();
        int rows[PE_T]; bool valid[PE_T];
        int qx[PE_T][4];
        float wlo[PE_T], whi[PE_T], swq[PE_T], sxv[PE_T];
        int hlo[PE_T], hhi[PE_T];
        int acc[PE_T][16];
        unsigned pklo[PE_T], pkhi[PE_T];
#pragma unroll
        for (int t = 0; t < PE_T; ++t) {
            const int ti = sw * PE_T + t;
            valid[t] = ti < ntok;
            const int row = first + (valid[t] ? ti : 0) * rstride;
            rows[t] = row;
            float x[16];
            {
                const u32x4 a = hpa[t], b = hpb[t];
#pragma unroll
                for (int i = 0; i < 4; ++i) { x[2 * i] = bflo(a[i]); x[2 * i + 1] = bfhi(a[i]); x[8 + 2 * i] = bflo(b[i]); x[8 + 2 * i + 1] = bfhi(b[i]); }
            }
            float mx = 0.f;
#pragma unroll
            for (int i = 0; i < 16; ++i) mx = fmaxf(mx, fabsf(x[i]));
            mx = wave_max(mx);
            const float sx = mx > 0.f ? mx * (1.f / 127.f) : 1.f;
            const float isx = 1.f / sx;
#pragma unroll
            for (int i = 0; i < 4; ++i) {
                unsigned pk = 0;
#pragma unroll
                for (int q = 0; q < 4; ++q) pk |= (unsigned)((int)rintf(x[i * 4 + q] * isx) & 0xFF) << (q * 8);
                qx[t][i] = (int)pk;
            }
            sxv[t] = sx;
            hlo[t] = 0; hhi[t] = 0;
#pragma unroll
            for (int i = 0; i < 16; ++i) acc[t][i] = 0;
        }
        for (int bb = 0; bb < 16; ++bb) {
            if ((bb & 3) == 0) __builtin_amdgcn_s_barrier();
            PE_LOADU(rB, bb, 1)
            PE_DOT(rA, bb, 0)
            if (bb + 1 < 16) { PE_LOADU(rA, bb + 1, 0) } else { PE_LOADV(rA, 0, 0) }
            PE_DOT(rB, bb, 1)
        }
#pragma unroll
        for (int t = 0; t < PE_T; ++t) {
            wlo[t] = sgv0[t] * gelu_tanh(sgu0[t] * sxv[t] * (float)hlo[t]); whi[t] = sgv1[t] * gelu_tanh(sgu1[t] * sxv[t] * (float)hhi[t]);
            float am = fmaxf(fabsf(wlo[t]), fabsf(whi[t]));
            am = wave_max(am);
            swq[t] = am > 0.f ? am * (1.f / 127.f) : 1.f;
            const float iw = 1.f / swq[t];
            const unsigned q0 = (unsigned)((int)rintf(wlo[t] * iw) & 0xFF), q1 = (unsigned)((int)rintf(whi[t] * iw) & 0xFF);
            const unsigned a0 = q0 | ((unsigned)xshfl_i<1>((int)q0) << 8);
            const unsigned a1 = q1 | ((unsigned)xshfl_i<1>((int)q1) << 8);
            pklo[t] = a0 | ((unsigned)xshfl_i<2>((int)a0) << 16);
            pkhi[t] = a1 | ((unsigned)xshfl_i<2>((int)a1) << 16);
        }
        if (sw + 1 < nsweep) { PE_PREFETCH(sw + 1) }
        f32x4 xvp[PE_T][4];
#pragma unroll
        for (int t = 0; t < PE_T; ++t)
#pragma unroll
            for (int q = 0; q < 4; ++q) xvp[t][q] = *(const f32x4*)(p.out + (long)rows[t] * DM + lane * 16 + q * 4);
        for (int bb = 0; bb < 16; ++bb) {
            if ((bb & 3) == 0) __builtin_amdgcn_s_barrier();
            PE_LOADV(rB, bb, 1)
            PE_AXPY(rA, bb, 0)
            if (bb + 1 < 16) { PE_LOADV(rA, bb + 1, 0) }
            PE_AXPY(rB, bb, 1)
        }
        if (sw + 1 < nsweep) { PE_SORT(sw + 1) PE_LOADU(rA, 0, 0) }
#pragma unroll
        for (int t = 0; t < PE_T; ++t) {
            if (!valid[t]) continue;
            const int row = rows[t];
            float y[16];
#pragma unroll
            for (int i = 0; i < 16; ++i) y[i] = swq[t] * (float)acc[t][i];
            const float* gv = mods_l + (long)tok_modrow(row) * 6144 + 5 * 1024;
            float* xr = p.out + (long)row * DM + lane * 16;
            float4 xv[4], gg[4];
#pragma unroll
            for (int q = 0; q < 4; ++q) { xv[q] = make_float4(xvp[t][q][0], xvp[t][q][1], xvp[t][q][2], xvp[t][q][3]); gg[q] = *(const float4*)(gv + lane * 16 + q * 4); }
            float4 nw[4], nsc[4], nsh[4];
            if (NEXT) {
                const float* mr = mods_next + (long)tok_modrow(row) * 6144;
#pragma unroll
                for (int q = 0; q < 4; ++q) { nw[q] = *(const float4*)(w_next + lane * 16 + q * 4); nsc[q] = *(const float4*)(mr + 1024 + lane * 16 + q * 4); nsh[q] = *(const float4*)(mr + lane * 16 + q * 4); }
            }
            float ss = 0.f;
#pragma unroll
            for (int q = 0; q < 4; ++q) {
                xv[q].x += gscale * gg[q].x * y[q * 4 + 0]; xv[q].y += gscale * gg[q].y * y[q * 4 + 1];
                xv[q].z += gscale * gg[q].z * y[q * 4 + 2]; xv[q].w += gscale * gg[q].w * y[q * 4 + 3];
                *(float4*)(xr + q * 4) = xv[q];
                ss += xv[q].x * xv[q].x + xv[q].y * xv[q].y + xv[q].z * xv[q].z + xv[q].w * xv[q].w;
            }
            if (NEXT) {
                ss = wave_sum(ss);
                const float r = rsqrtf(ss * (1.f / 1024.f) + 1e-6f);
#pragma unroll
                for (int q = 0; q < 4; ++q) {
                    const float h0 = xv[q].x * r * nw[q].x * (1.f + nsc[q].x) + nsh[q].x, h1 = xv[q].y * r * nw[q].y * (1.f + nsc[q].y) + nsh[q].y;
                    const float h2 = xv[q].z * r * nw[q].z * (1.f + nsc[q].z) + nsh[q].z, h3 = xv[q].w * r * nw[q].w * (1.f + nsc[q].w) + nsh[q].w;
                    *(uint2*)(p.H + (long)row * DM + lane * 16 + q * 4) = make_uint2(pack2(h0, h1), pack2(h2, h3));
                }
            }
        }
    }
}
#define SMEM_MAX 147456

#define BARRIER() do { XcdBarrier b_; b_.bar = p.bar; b_.x = xb_xcc_id(); b_.st = (volatile LAS unsigned*)(smem + SMEM_MAX); xcd_barrier(b_); } while (0)
__device__ __forceinline__ CP& kparams() {
    CP* kp = (CP*)__builtin_amdgcn_kernarg_segment_ptr();
    asm volatile("" : "+s"(kp));
    return *kp;
}
__global__ void __launch_bounds__(NTHREADS, 2) k_mega(Params p_unused) {
    extern __shared__ __attribute__((aligned(16))) char smem[];
#define p kparams()
    if (threadIdx.x == 0) *(uint4*)(smem + SMEM_MAX) = make_uint4(0u, 0u, 0u, 0u);
    __syncthreads();
    (void)xcd_barrier_post(p.bar, (volatile LAS unsigned*)(smem + SMEM_MAX));
    ph_init(p, smem);
    BARRIER();
#pragma unroll
    for (int l = 0; l < 4; ++l) {
        const int j = l >> 1;
#define mods_l (kparams().mods + (long)l * 9 * 6144)
        if (l == 0) {
            ph_norm<1>(p, p.norm_mix, mods_l, 0, 1024);
            BARRIER();
        }
        if ((l & 1) == 0) {
            ph_e_gemm(p, j, smem);
            BARRIER();
            ph_e_prep(p, j, smem);
            ph_fft_a(p, smem);
            BARRIER();
            ph_e_scan(p, j, smem);
            ph_fft_b(p, smem);
            ph_tab(p, l, 64);
            ph_tab(p, l + 1, 64);
            if (l == 0) ph_init2(p, smem, 64);
            BARRIER();
            ph_e_mix(p, j);
            BARRIER();
            if (l == 0) ph_out_gemm<1>(p, p.mix, p.wtE_out + (long)j * 1024 * 1024, mods_l, 2 * 1024, smem);
            else ph_out_gemm<0>(p, p.mix, p.wtE_out + (long)j * 1024 * 1024, mods_l, 2 * 1024, smem);
            BARRIER();
        } else {
            ph_o_gemm1(p, j, smem);
            BARRIER();
            ph_o_norm(p, j);
            BARRIER();
            ph_o_gemm2(p, j, smem);
            BARRIER();
            ph_o_qknorm(p, j);
            BARRIER();
            ph_o_attn(p, smem);
            BARRIER();
            ph_out_gemm(p, p.Ob, p.wtO_out + (long)j * 1024 * 1024, mods_l, 2 * 1024, smem);
            BARRIER();
        }
        ph_norm(p, p.norm_ffn + l * 1024, mods_l, 3 * 1024, 4 * 1024);
        BARRIER();
        ph_p_route(p, l, smem);
        BARRIER();
        if (l < 3) ph_p_eval<1>(p, mods_l, l, p.norm_mix + (l + 1) * 1024, p.mods + (long)(l + 1) * 9 * 6144);
        else ph_p_eval<0>(p, mods_l, l, p.norm_mix, p.mods);
        if (l < 3) BARRIER();
    }
#undef p
#undef mods_l
}

static inline size_t al256(size_t x) { return (x + 255) & ~(size_t)255; }

extern "C" void kernel_launch(void* const* d_in, const int* in_sizes, int n_in, void* d_out, int out_size, void* d_ws, size_t ws_size, hipStream_t stream) {
    Params p{};
    const float* const* in = (const float* const*)d_in;
    p.x_prompt = in[0]; p.x_sample = in[1]; p.state_gdn = in[2]; p.cache_ckv = in[3]; p.cache_kr = in[4]; p.c = in[5]; p.c_ctx = in[6];
    p.w_mod = in[7]; p.b_mod = in[8]; p.norm_mix = in[9]; p.norm_ffn = in[10];
    p.even_w_in = in[11]; p.even_conv_w = in[12]; p.gdn_a_log = in[13]; p.gdn_dt_bias = in[14]; p.gdn_o_norm = in[15]; p.even_w_out = in[16];
    p.odd_w_in = in[17]; p.mla_q_norm = in[18]; p.mla_kv_norm = in[19]; p.mla_w_uq = in[20]; p.mla_w_ukv = in[21]; p.mla_q_headnorm = in[22]; p.mla_k_headnorm = in[23]; p.odd_w_out = in[24];
    p.peer_w_q = in[25]; p.peer_sub_keys = in[26]; p.peer_u = in[27]; p.peer_v = in[28];
    p.out = (float*)d_out;
    char* ws = (char*)d_ws;
    size_t off = 0;
    auto take = [&](size_t bytes) { char* r = ws + off; off = al256(off + bytes); return r; };
    p.bar = (unsigned*)take(16384);
    p.mods = (float*)take(4L * 9 * 6144 * 4);
    p.wtE_in = (bf16_t*)take(2L * N_EIN * 1024 * 2);
    p.wtE_out = (bf16_t*)take(2L * 1024 * 1024 * 2);
    p.wtO_in = (bf16_t*)take(2L * N_OIN * 1024 * 2);
    p.wtUq = (bf16_t*)take(2L * 1536 * 512 * 2);
    p.wtUkv = (bf16_t*)take(2L * 2048 * 256 * 2);
    p.wtO_out = (bf16_t*)take(2L * 1024 * 1024 * 2);
    p.wtPq = (bf16_t*)take(4L * 2048 * 1024 * 2);
    p.subk = (bf16_t*)take(4L * 16 * 128 * 128 * 2);
    p.fftMA = (bf16_t*)take(128L * 128 * 2);
    p.fftMB = (bf16_t*)take(128L * 128 * 2);
    p.fftTW = (float*)take(4096L * 2 * 4);
    p.dftP = (bf16_t*)take(256L * 512 * 2);
    p.tabU = (unsigned char*)take(2L * 16384 * 2048);
    p.tabV = p.tabU;
    p.su = (float*)take(2L * 32768 * 4);
    p.sv = p.su;
    p.H = (bf16_t*)take((long)T_TOK * 1024 * 2);
    const size_t ubase = off;
    p.qkvraw = (bf16_t*)take((long)T_TOK * 1536 * 2);
    p.mix = p.qkvraw;
    p.gate = (bf16_t*)take((long)T_TOK * 512 * 2);
    p.ba = (float*)take((long)T_TOK * 16 * 4);
    p.ZtA = (bf16_t*)take((long)T_TOK * 1024 * 2);
    p.qn = (bf16_t*)take((long)T_TOK * 512 * 2);
    p.kn = (bf16_t*)take((long)T_TOK * 512 * 2);
    p.Wb = (bf16_t*)take(4608L * 8192 * 2);
    p.Ub = (bf16_t*)take(4608L * 8192 * 2);
    p.QKb = (bf16_t*)take(4608L * 4096 * 2);
    p.gcb = (float*)take(4608L * 192 * 4);
    p.of = (bf16_t*)take((long)T_TOK * 512 * 2);
    p.ob = (bf16_t*)take((long)T_TOK * 512 * 2);
    p.HB = (bf16_t*)take(8L * 64 * 512 * 2 * 64 * 2);
    const size_t even_end = off;
    off = ubase;
    p.Podd = (float*)take((long)T_TOK * 832 * 4);
    p.Ob = (bf16_t*)p.Podd;
    p.cq = (bf16_t*)take((long)T_TOK * 512 * 2);
    p.ckv_all = (bf16_t*)take((long)(T_TOK + 2048) * 256 * 2);
    p.kr_all = (float*)take((long)(T_TOK + 2048) * 64 * 4);
    p.Qb = (bf16_t*)take((long)T_TOK * 1536 * 2);
    p.Kb = (bf16_t*)take((KB_S + 8L * 8 * 4352 * 192) * 2);
    p.Vtb = (bf16_t*)take((VT_S + 8L * 8 * 128 * 4352) * 2);
    const size_t odd_end = off;
    off = ubase;
    p.eidx = (int*)take((long)T_TOK * 128 * 4);
    p.pgate = (float*)take((long)T_TOK * 128 * 4);
    const size_t peer_end = off;
    size_t need = even_end > odd_end ? even_end : odd_end;
    if (peer_end > need) need = peer_end;
    if (need > ws_size) return;

    static int grid = 0;
    if (!grid) {
        int dev = 0, cus = 0, per_cu = 0;
        hipGetDevice(&dev);
        hipDeviceGetAttribute(&cus, hipDeviceAttributeMultiprocessorCount, dev);
        if (hipFuncSetAttribute((const void*)k_mega, hipFuncAttributeMaxDynamicSharedMemorySize, SMEM_MAX + 16) != hipSuccess) return;
        if (hipOccupancyMaxActiveBlocksPerMultiprocessor(&per_cu, (const void*)k_mega, NTHREADS, SMEM_MAX + 16) != hipSuccess || per_cu < 1) return;
        grid = cus;
    }
    hipMemsetAsync(p.bar, 0, XCD_BAR_WORDS * sizeof(unsigned), stream);
    hipLaunchKernelGGL(k_mega, dim3(grid), dim3(NTHREADS), SMEM_MAX + 16, stream, p);
}
```
